# Optimizing an MI355X kernel written in HIP

```python
import jax, jax.numpy as jnp
from jax import lax
import numpy as np

D_MODEL = 2048
BATCH = 8
SEQ = 2048
DEPTH = 2

HEAD_DIM = 128
N_HEADS = D_MODEL // HEAD_DIM
ATT_WIDTH = N_HEADS * HEAD_DIM
ALIBI_MAX_BIAS = 8.0
N_MIXERS = 2
N_NSA_LAYERS = (DEPTH + 1) // 2
N_DIL_LAYERS = DEPTH // 2

NSA_KV_HEADS = N_HEADS // 4
NSA_GROUP = N_HEADS // NSA_KV_HEADS
NSA_KV_WIDTH = NSA_KV_HEADS * HEAD_DIM
CMP_BLOCK = 32
CMP_STRIDE = 16
SEL_BLOCK = 64
N_SEL = 16
NSA_WINDOW = 512
SEL_QUERY_BLOCK = 16
FORCE_SCORE = 1.0e6
NSA_PROJ = ATT_WIDTH + 6 * NSA_KV_WIDTH + 3 * N_HEADS

DIL_PAIRS = ((128, 1), (512, 4), (2048, 16))
DIL_PROJ = ATT_WIDTH * (1 + 2 * len(DIL_PAIRS))
BAND_BLOCK = 128

N_EXPERTS = 16
N_EXPERT_GROUPS = 4
EXPERTS_PER_GROUP = N_EXPERTS // N_EXPERT_GROUPS
TOP_K = 2
D_EXPERT = (D_MODEL * 11) // 16
MOE_BLOCK = 256

RMS_EPS = 1e-6
NEG_INF = -1.0e30

kernel_name = 'hybrid_nsa_dilated_moe_adaln'


def rms_norm(x, g):
    xf = x.astype(jnp.float32)
    y = xf * lax.rsqrt(jnp.mean(xf * xf, axis=-1, keepdims=True) + RMS_EPS)
    return (y * g.astype(jnp.float32)).astype(x.dtype)


def alibi_slopes(n):
    return 2.0 ** (-ALIBI_MAX_BIAS * jnp.arange(1, n + 1, dtype=jnp.float32) / n)


def banded_attention(q, k, v, window, dist_scale, slopes, with_lse):
    N, L, H, dh = q.shape
    Hkv = k.shape[2]
    G = H // Hkv
    n_prev = -(-window // BAND_BLOCK)
    nb = -(-L // BAND_BLOCK)
    Lp = nb * BAND_BLOCK
    front = n_prev * BAND_BLOCK
    kl = front + BAND_BLOCK
    qp = jnp.pad(q, ((0, 0), (0, Lp - L), (0, 0), (0, 0)))
    kp = jnp.pad(k, ((0, 0), (front, Lp - L), (0, 0), (0, 0)))
    vp = jnp.pad(v, ((0, 0), (front, Lp - L), (0, 0), (0, 0)))
    sl = slopes.reshape(Hkv, G)[None, :, :, None, None]
    scale = dh ** -0.5

    def block(i):
        start = i * BAND_BLOCK
        qb = lax.dynamic_slice_in_dim(qp, start, BAND_BLOCK, axis=1).reshape(N, BAND_BLOCK, Hkv, G, dh)
        kb = lax.dynamic_slice_in_dim(kp, start, kl, axis=1)
        vb = lax.dynamic_slice_in_dim(vp, start, kl, axis=1)
        s = jnp.einsum('nqgrd,nkgd->ngrqk', qb, kb).astype(jnp.float32) * scale
        qpos = start + jnp.arange(BAND_BLOCK)
        kpos = start - front + jnp.arange(kl)
        dist = qpos[:, None] - kpos[None, :]
        valid = (dist >= 0) & (dist <= window) & (kpos[None, :] >= 0)
        s = jnp.where(valid, s - sl * (dist * dist_scale).astype(jnp.float32), NEG_INF)
        lse = jax.nn.logsumexp(s, axis=-1)
        p = jnp.exp(s - lse[..., None])
        o = jnp.einsum('ngrqk,nkgd->nqgrd', p.astype(vb.dtype), vb).reshape(N, BAND_BLOCK, H, dh)
        if with_lse:
            return o, lse.transpose(0, 3, 1, 2).reshape(N, BAND_BLOCK, H)
        return o

    res = lax.map(block, jnp.arange(nb))
    if with_lse:
        o, lse = res
        o = jnp.moveaxis(o, 0, 1).reshape(N, Lp, H, dh)[:, :L]
        lse = jnp.moveaxis(lse, 0, 1).reshape(N, Lp, H)[:, :L]
        return o, lse
    return jnp.moveaxis(res, 0, 1).reshape(N, Lp, H, dh)[:, :L]


def nsa_mixer(h, w_in, w_phi1, w_phi2, phi_pos, w_out):
    B, S, _ = h.shape
    H, G, Hkv, dh = N_HEADS, NSA_GROUP, NSA_KV_HEADS, HEAD_DIM
    proj = h @ w_in
    q = proj[..., :ATT_WIDTH].reshape(B, S, H, dh)
    kvs = [proj[..., ATT_WIDTH + j * NSA_KV_WIDTH: ATT_WIDTH + (j + 1) * NSA_KV_WIDTH].reshape(B, S, Hkv, dh)
           for j in range(6)]
    kc, vc, ks, vs, kw, vw = kvs
    gates = jax.nn.sigmoid(proj[..., ATT_WIDTH + 6 * NSA_KV_WIDTH:].reshape(B, S, H, 3))
    slopes = alibi_slopes(H)
    sl = slopes.reshape(Hkv, G)
    scale = dh ** -0.5
    qg = q.reshape(B, S, Hkv, G, dh)
    tpos = jnp.arange(S)

    n_sub = CMP_BLOCK // CMP_STRIDE
    NC = S // CMP_STRIDE - n_sub + 1

    def compress(t, j):
        ch = t.reshape(B, S // CMP_STRIDE, CMP_STRIDE, Hkv, dh)
        blk = jnp.concatenate([ch[:, i:i + NC] for i in range(n_sub)], axis=2)
        blk = blk + phi_pos[j][None, None, :, None, :]
        hid = jax.nn.gelu(jnp.einsum('bnlgd,lde->bnge', blk, w_phi1[j]))
        return jnp.einsum('bnge,ef->bngf', hid, w_phi2[j])

    k_cmp = compress(kc, 0)
    v_cmp = compress(vc, 1)
    blk_start = jnp.arange(NC) * CMP_STRIDE
    visible = (blk_start + CMP_BLOCK - 1)[None, :] <= tpos[:, None]
    dist_c = (tpos[:, None] - (blk_start + (CMP_BLOCK - 1) / 2.0)[None, :]).astype(jnp.float32)
    s = jnp.einsum('btgrd,bngd->bgrtn', qg, k_cmp).astype(jnp.float32) * scale
    s = jnp.where(visible, s - sl[None, :, :, None, None] * dist_c, NEG_INF)
    m = jnp.max(s, axis=-1, keepdims=True)
    e = jnp.where(visible, jnp.exp(s - m), 0.0)
    p_cmp = e / jnp.maximum(jnp.sum(e, axis=-1, keepdims=True), 1e-30)
    o_cmp = jnp.einsum('bgrtn,bngd->btgrd', p_cmp.astype(v_cmp.dtype), v_cmp).reshape(B, S, H, dh)

    NS = S // SEL_BLOCK
    n_sel = min(N_SEL, NS)
    ci = np.arange(NC)[:, None]
    sj = np.arange(NS)[None, :]
    overlap = np.clip(np.minimum(ci * CMP_STRIDE + CMP_BLOCK, (sj + 1) * SEL_BLOCK)
                      - np.maximum(ci * CMP_STRIDE, sj * SEL_BLOCK), 0, None) / CMP_STRIDE
    overlap = jnp.asarray(overlap, dtype=jnp.float32)
    imp = jnp.einsum('bgtn,nj->bgtj', p_cmp.sum(axis=2), overlap)
    jblk = jnp.arange(NS)[None, :]
    cur = (tpos // SEL_BLOCK)[:, None]
    forced = (jblk == 0) | (jblk == cur) | (jblk == cur - 1)
    causal_blk = jblk * SEL_BLOCK <= tpos[:, None]
    score = jnp.where(forced, FORCE_SCORE, jnp.where(causal_blk, imp, -1.0))
    _, sel_idx = lax.top_k(score, n_sel)

    kblk = ks.reshape(B, NS, SEL_BLOCK, Hkv, dh).transpose(0, 3, 1, 2, 4)
    vblk = vs.reshape(B, NS, SEL_BLOCK, Hkv, dh).transpose(0, 3, 1, 2, 4)
    QB = SEL_QUERY_BLOCK
    nq = S // QB
    q_c = qg.reshape(B, nq, QB, Hkv, G, dh).transpose(1, 0, 2, 3, 4, 5)
    idx_c = sel_idx.reshape(B, Hkv, nq, QB, n_sel).transpose(2, 0, 1, 3, 4)
    bi = jnp.arange(B)[:, None, None, None]
    gi = jnp.arange(Hkv)[None, :, None, None]

    def sel_chunk(args):
        c_i, qc, ic = args
        kg = kblk[bi, gi, ic]
        vg = vblk[bi, gi, ic]
        sc = jnp.einsum('bqgrd,bgqnld->bgrqnl', qc, kg).astype(jnp.float32) * scale
        tq = c_i * QB + jnp.arange(QB)
        kpos = ic[..., None] * SEL_BLOCK + jnp.arange(SEL_BLOCK)
        dist = tq[None, None, :, None, None] - kpos
        sc = jnp.where((dist >= 0)[:, :, None],
                       sc - sl[None, :, :, None, None, None] * dist[:, :, None].astype(jnp.float32), NEG_INF)
        p = jax.nn.softmax(sc.reshape(B, Hkv, G, QB, n_sel * SEL_BLOCK), axis=-1)
        o = jnp.einsum('bgrqm,bgqmd->bqgrd', p.astype(vg.dtype), vg.reshape(B, Hkv, QB, n_sel * SEL_BLOCK, dh))
        return o.reshape(B, QB, H, dh)

    o_slc = lax.map(sel_chunk, (jnp.arange(nq), q_c, idx_c))
    o_slc = jnp.moveaxis(o_slc, 0, 1).reshape(B, S, H, dh)

    o_win = banded_attention(q, kw, vw, NSA_WINDOW - 1, 1, slopes, False)

    o = gates[..., 0:1] * o_cmp + gates[..., 1:2] * o_slc + gates[..., 2:3] * o_win
    return o.reshape(B, S, ATT_WIDTH) @ w_out


def dilated_mixer(h, w_in, w_out):
    B, S, _ = h.shape
    H, dh = N_HEADS, HEAD_DIM
    proj = h @ w_in
    q = proj[..., :ATT_WIDTH].reshape(B, S, H, dh)
    slopes = alibi_slopes(H)
    outs, lses = [], []
    for gidx, (win, r) in enumerate(DIL_PAIRS):
        off = ATT_WIDTH + gidx * 2 * ATT_WIDTH
        k = proj[..., off:off + ATT_WIDTH].reshape(B, S, H, dh)
        v = proj[..., off + ATT_WIDTH:off + 2 * ATT_WIDTH].reshape(B, S, H, dh)
        L = S // r

        def to_sub(t):
            return t.reshape(B, L, r, H, dh).transpose(0, 2, 1, 3, 4).reshape(B * r, L, H, dh)

        o, lse = banded_attention(to_sub(q), to_sub(k), to_sub(v), win // r, r, slopes, True)
        outs.append(o.reshape(B, r, L, H, dh).transpose(0, 2, 1, 3, 4).reshape(B, S, H, dh))
        lses.append(lse.reshape(B, r, L, H).transpose(0, 2, 1, 3).reshape(B, S, H))
    wts = jax.nn.softmax(jnp.stack(lses, axis=0), axis=0)
    o = sum(wts[gidx][..., None] * outs[gidx].astype(jnp.float32) for gidx in range(len(DIL_PAIRS)))
    return o.astype(h.dtype).reshape(B, S, ATT_WIDTH) @ w_out


def route(hf, router_w, router_b):
    T = hf.shape[0]
    scores = jax.nn.sigmoid((hf @ router_w).astype(jnp.float32))
    biased = scores + router_b.astype(jnp.float32)
    grp_score = lax.top_k(biased.reshape(T, N_EXPERT_GROUPS, EXPERTS_PER_GROUP), TOP_K)[0].sum(-1)
    best = jnp.argmax(grp_score, axis=-1)
    in_group = (jnp.arange(N_EXPERTS) // EXPERTS_PER_GROUP)[None, :] == best[:, None]
    _, idx = lax.top_k(jnp.where(in_group, biased, NEG_INF), TOP_K)
    w = jnp.take_along_axis(scores, idx, axis=-1)
    return idx, w / jnp.sum(w, axis=-1, keepdims=True)


def moe_ffn(h, router_w, router_b, w_gate, w_up, w_down):
    B, S, D = h.shape
    T = B * S
    hf = h.reshape(T, D)
    idx, wts = route(hf, router_w, router_b)
    A = T * TOP_K
    flat_e = idx.reshape(A)
    flat_w = wts.reshape(A)
    flat_tok = jnp.arange(A, dtype=jnp.int32) // TOP_K
    order = jnp.argsort(flat_e)
    se = flat_e[order]
    counts = jnp.bincount(flat_e, length=N_EXPERTS)
    padded = (counts + MOE_BLOCK - 1) // MOE_BLOCK * MOE_BLOCK
    pad_end = jnp.cumsum(padded)
    pad_start = pad_end - padded
    start = jnp.cumsum(counts) - counts
    dest = pad_start[se] + jnp.arange(A) - start[se]
    nblk = -(-(A + N_EXPERTS * MOE_BLOCK) // MOE_BLOCK)
    cap = nblk * MOE_BLOCK
    slot_tok = jnp.zeros((cap,), jnp.int32).at[dest].set(flat_tok[order])
    slot_w = jnp.zeros((cap,), jnp.float32).at[dest].set(flat_w[order])
    blk_e = jnp.minimum(jnp.searchsorted(pad_end, jnp.arange(nblk) * MOE_BLOCK, side='right'), N_EXPERTS - 1)
    xin = hf[slot_tok].reshape(nblk, MOE_BLOCK, D)

    def expert_block(args):
        xb, e = args
        return (jax.nn.silu(xb @ w_gate[e]) * (xb @ w_up[e])) @ w_down[e]

    yo = lax.map(expert_block, (xin, blk_e)).reshape(cap, D)
    y = jax.ops.segment_sum(yo * slot_w[:, None].astype(yo.dtype), slot_tok, num_segments=T)
    return y.reshape(B, S, D)


def setup_inputs(seed: int = 0) -> dict:
    key = jax.random.key(seed)
    ks = jax.random.split(key, 20)
    D = D_MODEL

    def nrm(k, shape, scale):
        return jax.random.normal(k, shape, jnp.float32) * scale

    return {
        'x': nrm(ks[0], (BATCH, SEQ, D), 1.0),
        'c': nrm(ks[1], (BATCH, D), 1.0),
        'ada_w': nrm(ks[2], (DEPTH, D, 6 * D), 0.5 * D ** -0.5),
        'ada_b': nrm(ks[3], (DEPTH, 6 * D), 0.02),
        'norm_mix': 1.0 + nrm(ks[4], (DEPTH, D), 0.02),
        'norm_ffn': 1.0 + nrm(ks[5], (DEPTH, D), 0.02),
        'norm_final': 1.0 + nrm(ks[6], (D,), 0.02),
        'nsa_w_in': nrm(ks[7], (N_NSA_LAYERS, D, NSA_PROJ), D ** -0.5),
        'nsa_w_phi1': nrm(ks[8], (N_NSA_LAYERS, 2, CMP_BLOCK, HEAD_DIM, HEAD_DIM), (CMP_BLOCK * HEAD_DIM) ** -0.5),
        'nsa_w_phi2': nrm(ks[9], (N_NSA_LAYERS, 2, HEAD_DIM, HEAD_DIM), HEAD_DIM ** -0.5),
        'nsa_phi_pos': nrm(ks[10], (N_NSA_LAYERS, 2, CMP_BLOCK, HEAD_DIM), 0.1),
        'nsa_w_out': nrm(ks[11], (N_NSA_LAYERS, ATT_WIDTH, D), ATT_WIDTH ** -0.5),
        'dil_w_in': nrm(ks[12], (N_DIL_LAYERS, D, DIL_PROJ), D ** -0.5),
        'dil_w_out': nrm(ks[13], (N_DIL_LAYERS, ATT_WIDTH, D), ATT_WIDTH ** -0.5),
        'router_w': nrm(ks[14], (D, N_EXPERTS), D ** -0.5),
        'router_b': nrm(ks[15], (N_EXPERTS,), 0.01),
        'exp_w_gate': nrm(ks[16], (DEPTH, N_EXPERTS, D, D_EXPERT), D ** -0.5),
        'exp_w_up': nrm(ks[17], (DEPTH, N_EXPERTS, D, D_EXPERT), D ** -0.5),
        'exp_w_down': nrm(ks[18], (DEPTH, N_EXPERTS, D_EXPERT, D), D_EXPERT ** -0.5),
    }


def reference(x, c, ada_w, ada_b, norm_mix, norm_ffn, norm_final, nsa_w_in, nsa_w_phi1, nsa_w_phi2,
              nsa_phi_pos, nsa_w_out, dil_w_in, dil_w_out, router_w, router_b, exp_w_gate, exp_w_up,
              exp_w_down):
    cond = jax.nn.silu(c)
    for i in range(DEPTH):
        mod = cond @ ada_w[i] + ada_b[i]
        sh_m, sc_m, g_m, sh_f, sc_f, g_f = jnp.split(mod, 6, axis=-1)
        h = rms_norm(x, norm_mix[i]) * (1.0 + sc_m[:, None]) + sh_m[:, None]
        j = i // N_MIXERS
        if i % N_MIXERS == 0:
            y = nsa_mixer(h, nsa_w_in[j], nsa_w_phi1[j], nsa_w_phi2[j], nsa_phi_pos[j], nsa_w_out[j])
        else:
            y = dilated_mixer(h, dil_w_in[j], dil_w_out[j])
        x = x + g_m[:, None] * y
        h = rms_norm(x, norm_ffn[i]) * (1.0 + sc_f[:, None]) + sh_f[:, None]
        x = x + g_f[:, None] * moe_ffn(h, router_w, router_b, exp_w_gate[i], exp_w_up[i], exp_w_down[i])
    return rms_norm(x, norm_final)
```

```cpp
#define MK_ONE_LAUNCH 1
#include <hip/hip_runtime.h>
#include <cstdio>
#include <cstdint>
#define XB_TMO      128
#define XB_XCNT(j)  (256  + 64 * (j))
#define XB_XSUB(j)  (1280 + 64 * (j))
#define XB_XGEN(j)  (2304 + 64 * (j))
#define XB_TOP      3328
#define XB_TOPGEN   3392
#define XCD_BAR_WORDS 3456
#define XB_SPIN_CAP (1u << 18)
#define LAS __attribute__((address_space(3)))

__device__ __forceinline__ unsigned xb_ld(unsigned* p)              { return __hip_atomic_load(p, __ATOMIC_RELAXED, __HIP_MEMORY_SCOPE_AGENT); }
__device__ __forceinline__ unsigned xb_add(unsigned* p, unsigned v) { return __hip_atomic_fetch_add(p, v, __ATOMIC_RELAXED, __HIP_MEMORY_SCOPE_AGENT); }
__device__ __forceinline__ unsigned xb_xcc_id() { return (unsigned)__builtin_amdgcn_s_getreg((3 << 11) | 20) & 0xFu; }
#define XB_SPIN(cond, bar) do { unsigned _sp = 0; while (cond) { __builtin_amdgcn_s_sleep(1); \
    if ((++_sp & 255u) == 0u) { if (xb_ld(&(bar)[XB_TMO])) break; if (_sp > XB_SPIN_CAP) { atomicAdd(&(bar)[XB_TMO], 1u); break; } } } } while (0)

struct XcdBarrier {
    unsigned* bar; unsigned x;
    volatile LAS unsigned* st;
};

__device__ __forceinline__ XcdBarrier xcd_barrier_post(unsigned* bar, volatile LAS unsigned* st) {
    XcdBarrier b; b.bar = bar; b.x = xb_xcc_id(); b.st = st;
    if (threadIdx.x == 0) (void)xb_add(&bar[XB_XCNT(b.x)], 1u);
    return b;
}
__device__ __forceinline__ void xcd_barrier_complete(unsigned* bar, unsigned x, unsigned& nloc, unsigned& nx) {
    const unsigned G = gridDim.x * gridDim.y * gridDim.z;
    unsigned sum, cnt, mine, sp = 0u;
    for (;;) {
        sum = 0u; cnt = 0u; mine = 0u;
#pragma unroll
        for (unsigned j = 0; j < 16; ++j) { const unsigned c = xb_ld(&bar[XB_XCNT(j)]); sum += c; cnt += (c > 0u) ? 1u : 0u; mine = (j == x) ? c : mine; }
        if (sum == G) break;
        __builtin_amdgcn_s_sleep(1);
        if ((++sp & 255u) == 0u) { if (xb_ld(&bar[XB_TMO])) break; if (sp > XB_SPIN_CAP) { atomicAdd(&bar[XB_TMO], 1u); break; } }
    }
    nloc = mine > 0u ? mine : 1u; nx = cnt > 0u ? cnt : 1u;
}

__device__ __forceinline__ void xcd_barrier(const XcdBarrier& b) {
    asm volatile("s_waitcnt vmcnt(0)" ::: "memory");
    __syncthreads();
    if (threadIdx.x == 0) {
        unsigned* bar = b.bar;
        __builtin_amdgcn_s_waitcnt(0);
        unsigned nloc = b.st[0], nx = b.st[1];
        if (nloc == 0u) { xcd_barrier_complete(bar, b.x, nloc, nx); b.st[0] = nloc; b.st[1] = nx; }
        const unsigned old = xb_add(&bar[XB_XSUB(b.x)], 1u);
        const unsigned gen = old / nloc;
        if (old + 1u == (gen + 1u) * nloc) {
            __builtin_amdgcn_fence(__ATOMIC_RELEASE, "agent");
            asm volatile("s_waitcnt vmcnt(0)" ::: "memory");
            const unsigned og = xb_add(&bar[XB_TOP], 1u);
            const unsigned tg = og / nx;
            if (og + 1u == (tg + 1u) * nx) xb_add(&bar[XB_TOPGEN], 1u);
            else XB_SPIN(xb_ld(&bar[XB_TOPGEN]) == tg, bar);
            __builtin_amdgcn_fence(__ATOMIC_ACQUIRE, "agent");
            xb_add(&bar[XB_XGEN(b.x)], 1u);
            asm volatile("s_waitcnt vmcnt(0)" ::: "memory");
        } else {
            XB_SPIN(xb_ld(&bar[XB_XGEN(b.x)]) == gen, bar);
            __builtin_amdgcn_fence(__ATOMIC_ACQUIRE, "agent");
            asm volatile("s_waitcnt vmcnt(0)" ::: "memory");
        }
    }
    __syncthreads();
}
namespace pg8 {
#define PG8_LAS __attribute__((address_space(3)))
typedef unsigned short bf16_t;
typedef short bf16x8 __attribute__((ext_vector_type(8)));
typedef float f32x4 __attribute__((ext_vector_type(4)));
typedef unsigned u32x4 __attribute__((ext_vector_type(4)));
constexpr int BM = 256, BK = 64, HALF = 128, HTB = HALF * BK * 2  , STAGE_BYTES = 8 * HTB, NXCD = 8, WGM = 8;

__host__ __device__ __forceinline__ int lds_byte(int r, int c) { const int st = (r >> 4) * 2 + (c >> 5), rr = r & 15, cc = c & 31, ob = rr * 64 + cc * 2; return st * 1024 + (ob ^ (((ob >> 9) & 1) << 5)); }
__host__ __device__ __forceinline__ void stage_rc(int b, int& R, int& C) { const int st = b / 1024, sb = b % 1024, swz = sb ^ (((sb >> 9) & 1) << 5); R = (st >> 1) * 16 + swz / 64; C = (st & 1) * 32 + (swz % 64) / 2; }
__host__ __device__ __forceinline__ int perm32(int rho) { const int n = rho >> 4, i = rho & 15; return 8 * (i >> 2) + 4 * n + (i & 3); }

struct Unit { int pm, pn; };
struct Gemm { const bf16_t* A; const bf16_t* Bt; int M, N, K; };

struct StaticOrder {
    int nM, nN, nwg, G, c;
    __host__ __device__ void init(int M, int N, int G_, int c_) { nM = M / BM; nN = N / BM; nwg = nM * nN; G = G_; c = c_; }
    __host__ __device__ bool next(int i, Unit& u) const {
        const long L = (long)i * G + c; if (L >= nwg) return false;
        int wgid = (int)L; { const int q = nwg / NXCD, r = nwg % NXCD, xcd = wgid % NXCD, off = wgid / NXCD; wgid = (xcd < r ? xcd * (q + 1) : r * (q + 1) + (xcd - r) * q) + off; }
        const int nig = WGM * nN, gid = wgid / nig, fm = gid * WGM, gsz = (nM - fm) < WGM ? (nM - fm) : WGM;
        u.pm = fm + ((wgid % nig) % gsz); u.pn = (wgid % nig) / gsz; return true;
    }
    __device__ __forceinline__ void a_ready(const Unit&) const {}
    __device__ __forceinline__ void done(const Unit&) const {}
};
struct CountedOrder : StaticOrder {
    const unsigned* ready; unsigned need; unsigned* tmo;
    __device__ __forceinline__ void a_ready(const Unit& u) const {
        if (threadIdx.x < 64) {
            const unsigned long long t0 = __builtin_amdgcn_s_memrealtime(); unsigned polls = 0;
            while ((unsigned)__builtin_amdgcn_readfirstlane(__hip_atomic_load(ready + 64 * u.pm, __ATOMIC_RELAXED, __HIP_MEMORY_SCOPE_AGENT)) < need) {
                if ((++polls & 255u) == 0u && __builtin_amdgcn_readfirstlane(__hip_atomic_load(tmo, __ATOMIC_RELAXED, __HIP_MEMORY_SCOPE_AGENT)) != 0u) break;
                if (__builtin_amdgcn_s_memrealtime() - t0 > 2000000ull) {
                    if (threadIdx.x == 0) { unsigned expect = 0u; __hip_atomic_compare_exchange_strong(tmo + 1, &expect, 0x600u | (unsigned)(u.pm & 0xff), __ATOMIC_RELAXED, __ATOMIC_RELAXED, __HIP_MEMORY_SCOPE_AGENT); __hip_atomic_store(tmo, 1u, __ATOMIC_RELAXED, __HIP_MEMORY_SCOPE_AGENT); }
                    break; }
                __builtin_amdgcn_s_sleep(2); }
            __builtin_amdgcn_fence(__ATOMIC_ACQUIRE, "agent");
            asm volatile("s_waitcnt vmcnt(0)" ::: "memory");
        }
#if !defined(BROKEN_HOOK_NO_BARRIER)
        asm volatile("" ::: "memory"); __builtin_amdgcn_s_barrier(); asm volatile("" ::: "memory");
#endif
    }
};

__device__ __forceinline__ unsigned cvt_pk_bf16(float lo, float hi) { unsigned r; asm volatile("v_cvt_pk_bf16_f32 %0, %1, %2" : "=v"(r) : "v"(lo), "v"(hi)); return r; }
typedef float f32x2 __attribute__((ext_vector_type(2)));
__device__ __forceinline__ f32x2 gelu_pk(f32x2 v) {
    const f32x2 av = __builtin_elementwise_abs(v), d = av * 0.2316418882f + 1.0f;
    f32x2 t; t.x = __builtin_amdgcn_rcpf(d.x); t.y = __builtin_amdgcn_rcpf(d.y);
    f32x2 q = t * 0.5307027145f + (-0.7265760135f); q = q * t + 0.7107068705f; q = q * t + (-0.142248368f); q = q * t + 0.127414796f; q = q * t;
    const f32x2 s = (v * v) * (-0.72134752044f);
    f32x2 e; e.x = __builtin_amdgcn_exp2f(s.x); e.y = __builtin_amdgcn_exp2f(s.y);
    const f32x2 m = v * (q * e), r = v - m;
    f32x2 o; o.x = v.x < 0.f ? m.x : r.x; o.y = v.y < 0.f ? m.y : r.y; return o;
}

struct EpiF32 {
    static constexpr bool PERM = false, AFTER_DRAIN = false;
    float* C; int ldc; const float* bias;
    __device__ __forceinline__ void operator()(const f32x4 (&acc)[2][2][4][2], const Unit& u, int wr, int wc, int fr, int fq) const {
        const int row0 = u.pm * BM + wr * 64 + fr, col0 = u.pn * BM + wc * 32 + 4 * fq;
        f32x4 bv[2][2];
#pragma unroll
        for (int bj = 0; bj < 2; ++bj)
#pragma unroll
            for (int n = 0; n < 2; ++n) bv[bj][n] = bias ? *(const f32x4*)(bias + col0 + bj * HALF + n * 16) : (f32x4){0.f, 0.f, 0.f, 0.f};
#pragma unroll
        for (int ai = 0; ai < 2; ++ai)
#pragma unroll
            for (int m = 0; m < 4; ++m) { float* rowp = C + (size_t)(row0 + ai * HALF + m * 16) * ldc + col0;
#pragma unroll
                for (int bj = 0; bj < 2; ++bj)
#pragma unroll
                    for (int n = 0; n < 2; ++n) *(f32x4*)(rowp + bj * HALF + n * 16) = acc[ai][bj][m][n] + bv[bj][n]; }
    }
};
template <int ACT  > struct EpiBf16 {
    static constexpr bool PERM = true, AFTER_DRAIN = false;
    bf16_t* O; int ldc; const float* bias; int split_cols; size_t split_stride;
    __device__ __forceinline__ void operator()(const f32x4 (&acc)[2][2][4][2], const Unit& u, int wr, int wc, int fr, int fq) const {
        const int row0 = u.pm * BM + wr * 64 + fr; int colt = u.pn * BM; bf16_t* base = O;
        if (split_cols) { const int t = colt / split_cols; base += (size_t)t * split_stride; colt -= t * split_cols; }
        const int col0 = colt + wc * 32 + 8 * fq, bcol0 = u.pn * BM + wc * 32 + 8 * fq;
        f32x4 bv[2][2];
#pragma unroll
        for (int bj = 0; bj < 2; ++bj)
#pragma unroll
            for (int n = 0; n < 2; ++n) bv[bj][n] = bias ? *(const f32x4*)(bias + bcol0 + bj * HALF + 4 * n) : (f32x4){0.f, 0.f, 0.f, 0.f};
#pragma unroll
        for (int ai = 0; ai < 2; ++ai)
#pragma unroll
            for (int m = 0; m < 4; ++m) { bf16_t* rowp = base + (size_t)(row0 + ai * HALF + m * 16) * ldc + col0;
#pragma unroll
                for (int bj = 0; bj < 2; ++bj) { f32x4 v0 = acc[ai][bj][m][0] + bv[bj][0], v1 = acc[ai][bj][m][1] + bv[bj][1];
                    if (ACT == 1) { f32x2 a = gelu_pk((f32x2){v0[0], v0[1]}), b = gelu_pk((f32x2){v0[2], v0[3]}), c = gelu_pk((f32x2){v1[0], v1[1]}), d = gelu_pk((f32x2){v1[2], v1[3]});
                        v0 = (f32x4){a.x, a.y, b.x, b.y}; v1 = (f32x4){c.x, c.y, d.x, d.y}; }
                    if (ACT == 2) {
#pragma unroll
                        for (int j = 0; j < 4; ++j) { v0[j] = 0.5f * v0[j] * (1.0f + erff(v0[j] * 0.70710678f)); v1[j] = 0.5f * v1[j] * (1.0f + erff(v1[j] * 0.70710678f)); } }
                    u32x4 w; w.x = cvt_pk_bf16(v0[0], v0[1]); w.y = cvt_pk_bf16(v0[2], v0[3]); w.z = cvt_pk_bf16(v1[0], v1[1]); w.w = cvt_pk_bf16(v1[2], v1[3]);
                    *(u32x4*)(rowp + bj * HALF) = w; } }
    }
};

template <class Epi, class Sched, bool STAMP = false>
__device__ __forceinline__ void gemm_phase(PG8_LAS unsigned char* lds, const Gemm g, const Sched& S, const Epi& E, unsigned long long* stamps) {
    const int tid = threadIdx.x, wid = __builtin_amdgcn_readfirstlane(tid >> 6), lane = tid & 63, wr = wid >> 2, wc = wid & 3, fr = lane & 15, fq = lane >> 4;
    const int K = g.K, nt = K / BK;
    int ts_lo = 0, ts_hi = 0, nts = 0; const unsigned long long rt_entry = STAMP ? (unsigned long long)wall_clock64() : 0ull;
#define PG8_STAMP() do { if (STAMP && wid == 0 && nts < 64) { const unsigned long long _c = (unsigned long long)clock64(); \
        ts_lo = (lane == nts) ? (int)(unsigned)_c : ts_lo; ts_hi = (lane == nts) ? (int)(unsigned)(_c >> 32) : ts_hi; ++nts; } } while (0)
    PG8_STAMP();
    unsigned voffA[2], voffB[2];
#pragma unroll
    for (int i = 0; i < 2; ++i) { int R, C; stage_rc(tid * 16 + i * 8192, R, C); const int Rb = Epi::PERM ? ((R & ~31) + perm32(R & 31)) : R;
        voffA[i] = (unsigned)(R * K + C) * 2u; voffB[i] = (unsigned)(Rb * K + C) * 2u; }
    const size_t kstep = (size_t)(BK * 2);
    const size_t hstep = (size_t)HALF * K * 2;
    const size_t tstep = 2 * hstep;
    const unsigned ldsw = (unsigned)wid * 1024u;
    const int aoff = lds_byte(wr * 64 + fr, fq * 8), boff = lds_byte(wc * 32 + fr, fq * 8);
#define PG8_SA(b, h) (((b) * 2 + (h)) * HTB)
#define PG8_SB(b, h) ((4 + (b) * 2 + (h)) * HTB)
#define PG8_STAGE(bufoff, gbase, voff) do { _Pragma("unroll") for (int _i = 0; _i < 2; ++_i) \
        __builtin_amdgcn_global_load_lds((const unsigned*)((const char*)(gbase) + (voff)[_i]), (PG8_LAS unsigned*)(lds + (bufoff) + ldsw + _i * 8192), 16, 0, 0); } while (0)
#define PG8_LDA(dst, b, h) do { _Pragma("unroll") for (int m = 0; m < 4; ++m) _Pragma("unroll") for (int k = 0; k < 2; ++k) dst[m][k] = *(const PG8_LAS bf16x8*)(lds + PG8_SA(b, h) + aoff + m * 2048 + k * 1024); } while (0)
#define PG8_LDB(dst, b, h) do { _Pragma("unroll") for (int n = 0; n < 2; ++n) _Pragma("unroll") for (int k = 0; k < 2; ++k) dst[n][k] = *(const PG8_LAS bf16x8*)(lds + PG8_SB(b, h) + boff + n * 2048 + k * 1024); } while (0)
#define PG8_MMA(ai, bj, At, Bt) do { __builtin_amdgcn_s_setprio(1); _Pragma("unroll") for (int m = 0; m < 4; ++m) _Pragma("unroll") for (int n = 0; n < 2; ++n) _Pragma("unroll") for (int k = 0; k < 2; ++k) \
        acc[ai][bj][m][n] = __builtin_amdgcn_mfma_f32_16x16x32_bf16(Bt[n][k], At[m][k], acc[ai][bj][m][n], 0, 0, 0); __builtin_amdgcn_s_setprio(0); } while (0)
#define PG8_WAIT_V(n) asm volatile("s_waitcnt vmcnt(" #n ")" ::: "memory")
#define PG8_WAIT_L(n) asm volatile("s_waitcnt lgkmcnt(" #n ")" ::: "memory")
#define PG8_BAR __builtin_amdgcn_s_barrier()
#define PG8_SCHED __builtin_amdgcn_sched_barrier(0)
    Unit cur, nxt; int ui = 0;
    if (!S.next(0, cur)) return;
    f32x4 acc[2][2][4][2];
#pragma unroll
    for (int a = 0; a < 2; ++a)
#pragma unroll
        for (int b = 0; b < 2; ++b)
#pragma unroll
            for (int m = 0; m < 4; ++m)
#pragma unroll
                for (int n = 0; n < 2; ++n) acc[a][b][m][n] = (f32x4){0.f, 0.f, 0.f, 0.f};
    bf16x8 At[4][2], B0[2][2], B1[2][2];
    const char* cA = (const char*)g.A + (size_t)cur.pm * tstep; const char* cB = (const char*)g.Bt + (size_t)cur.pn * tstep;
    S.a_ready(cur);
    PG8_STAGE(PG8_SB(0, 0), cB, voffB); PG8_STAGE(PG8_SA(0, 0), cA, voffA); PG8_STAGE(PG8_SB(0, 1), cB + hstep, voffB); PG8_STAGE(PG8_SA(0, 1), cA + hstep, voffA);
    if (wr == 1) PG8_BAR;
    PG8_WAIT_V(4); PG8_BAR;
    PG8_STAGE(PG8_SB(1, 0), cB + kstep, voffB); PG8_STAGE(PG8_SA(1, 0), cA + kstep, voffA); PG8_STAGE(PG8_SB(1, 1), cB + hstep + kstep, voffB);
    PG8_WAIT_V(6); PG8_BAR;
    PG8_STAMP();
    for (;;) {
        const bool has_next = S.next(ui + 1, nxt);
        const char* nA = has_next ? (const char*)g.A + (size_t)nxt.pm * tstep : cA; const char* nB = has_next ? (const char*)g.Bt + (size_t)nxt.pn * tstep : cB;
        for (int t = 0; t < nt; t += 2) {
            const bool last = (t == nt - 2);
            const char* a1 = cA + (size_t)(t + 1) * kstep;
            const char* a2 = last ? nA : cA + (size_t)(t + 2) * kstep; const char* b2 = last ? nB : cB + (size_t)(t + 2) * kstep;
            const char* a3 = a2 + kstep; const char* b3 = b2 + kstep;
            if (last && has_next) S.a_ready(nxt);
            PG8_LDB(B0, 0, 0); PG8_SCHED; PG8_LDA(At, 0, 0); PG8_STAGE(PG8_SA(1, 1), a1 + hstep, voffA);
            PG8_WAIT_L(8); PG8_BAR; PG8_WAIT_L(0); PG8_MMA(0, 0, At, B0); PG8_BAR; PG8_SCHED;
            PG8_LDB(B1, 0, 1); PG8_STAGE(PG8_SB(0, 0), b2, voffB);
            PG8_BAR; PG8_WAIT_L(0); PG8_MMA(0, 1, At, B1); PG8_BAR;
            PG8_LDA(At, 0, 1); PG8_STAGE(PG8_SA(0, 0), a2, voffA);
            PG8_BAR; PG8_WAIT_L(0); PG8_MMA(1, 0, At, B0); PG8_BAR; PG8_SCHED;
            PG8_STAGE(PG8_SB(0, 1), b2 + hstep, voffB);
            PG8_WAIT_V(6); PG8_BAR; PG8_MMA(1, 1, At, B1); PG8_BAR;
            PG8_LDB(B0, 1, 0); PG8_SCHED; PG8_LDA(At, 1, 0); PG8_STAGE(PG8_SA(0, 1), a2 + hstep, voffA);
            PG8_WAIT_L(8); PG8_BAR; PG8_WAIT_L(0); PG8_MMA(0, 0, At, B0); PG8_BAR; PG8_SCHED;
            PG8_LDB(B1, 1, 1); PG8_STAGE(PG8_SB(1, 0), b3, voffB);
            PG8_BAR; PG8_WAIT_L(0); PG8_MMA(0, 1, At, B1); PG8_BAR;
            PG8_LDA(At, 1, 1); PG8_STAGE(PG8_SA(1, 0), a3, voffA);
            PG8_BAR; PG8_WAIT_L(0); PG8_MMA(1, 0, At, B0); PG8_BAR; PG8_SCHED;
            PG8_STAGE(PG8_SB(1, 1), b3 + hstep, voffB);
            PG8_WAIT_V(6); PG8_BAR; PG8_MMA(1, 1, At, B1); PG8_BAR;
        }
        PG8_STAMP();
        if constexpr (!Epi::AFTER_DRAIN) { E(acc, cur, wr, wc, fr, fq); S.done(cur); }
        PG8_STAMP();
        if (!has_next) break;
#pragma unroll
        for (int a = 0; a < 2; ++a)
#pragma unroll
            for (int b = 0; b < 2; ++b)
#pragma unroll
                for (int m = 0; m < 4; ++m)
#pragma unroll
                    for (int n = 0; n < 2; ++n) acc[a][b][m][n] = (f32x4){0.f, 0.f, 0.f, 0.f};
        cur = nxt; cA = nA; cB = nB; ++ui;
    }
    PG8_WAIT_V(0);
    if (wr == 0) PG8_BAR;
    PG8_BAR;
    if constexpr (Epi::AFTER_DRAIN) { E.fused(acc, cur, wr, wc, fr, fq, lds, wid, lane); S.done(cur); }
    PG8_STAMP();
    if (STAMP && wid == 0) { stamps[lane] = lane < nts ? (((unsigned long long)(unsigned)ts_hi << 32) | (unsigned)ts_lo) : 0ull;
        if (lane == 62) stamps[62] = rt_entry; if (lane == 63) stamps[63] = (unsigned long long)wall_clock64(); }
#undef PG8_STAMP
#undef PG8_SA
#undef PG8_SB
#undef PG8_STAGE
#undef PG8_LDA
#undef PG8_LDB
#undef PG8_MMA
#undef PG8_WAIT_V
#undef PG8_WAIT_L
#undef PG8_BAR
#undef PG8_SCHED
}
}

#define LDSP __attribute__((address_space(3)))
typedef unsigned short bf16_t;
typedef float f32x4 __attribute__((ext_vector_type(4)));
typedef float f32x2 __attribute__((ext_vector_type(2)));
typedef unsigned u32x4 __attribute__((ext_vector_type(4)));
typedef unsigned u32x2 __attribute__((ext_vector_type(2)));

constexpr int T_ = 16384, D_ = 2048, S_ = 2048, B_ = 8;
constexpr int PW0 = 5376, PW1 = 14336, DE = 1408, CAP = 36864, MODW = 12288;
constexpr int NTHR = 512, NWAVE = 8;
constexpr int LDS_BYTES = 143360;
constexpr int LDS_MISC = 131072;

constexpr size_t al256(size_t x) { return (x + 255) & ~(size_t)255; }
constexpr size_t WS_BAR     = 0;
constexpr size_t WS_CTL_END = 16384;
constexpr size_t WS_TAB     = WS_CTL_END;
constexpr size_t WS_BLKCNT  = WS_TAB + 1024;
constexpr size_t WS_MOD     = al256(WS_BLKCNT + 256 * 16 * 4);
constexpr size_t WS_RIDX    = al256(WS_MOD + (size_t)2 * 8 * MODW * 4);
constexpr size_t WS_RW      = al256(WS_RIDX + (size_t)T_ * 2 * 4);
constexpr size_t WS_TOKSLOT = al256(WS_RW + (size_t)T_ * 2 * 4);
constexpr size_t WS_SLOTW   = al256(WS_TOKSLOT + (size_t)T_ * 2 * 4);
constexpr size_t WS_SEL     = al256(WS_SLOTW + (size_t)CAP * 4);
constexpr size_t WS_CMP     = al256(WS_SEL + (size_t)8 * 4 * 2048 * 4);
constexpr size_t WS_LSE     = al256(WS_CMP + (size_t)2 * 8 * 128 * 4 * 128 * 4);
constexpr size_t WS_WNSAIN  = al256(WS_LSE + (size_t)3 * T_ * 16 * 4);
constexpr size_t WS_WNSAOUT = al256(WS_WNSAIN + (size_t)PW0 * D_ * 2);
constexpr size_t WS_WDILIN  = al256(WS_WNSAOUT + (size_t)D_ * D_ * 2);
constexpr size_t WS_WDILOUT = al256(WS_WDILIN + (size_t)PW1 * D_ * 2);
constexpr size_t WS_WE1     = al256(WS_WDILOUT + (size_t)D_ * D_ * 2);
constexpr size_t WS_WE2     = al256(WS_WE1 + (size_t)16 * 2816 * D_ * 2);
constexpr size_t WS_X       = al256(WS_WE2 + (size_t)16 * D_ * DE * 2);
constexpr size_t WS_H       = al256(WS_X + (size_t)T_ * D_ * 4);
constexpr size_t WS_O       = al256(WS_H + (size_t)T_ * D_ * 2);
constexpr size_t WS_PROJ    = al256(WS_O + (size_t)T_ * D_ * 2);
constexpr size_t WS_XIN     = WS_PROJ;
constexpr size_t WS_HID     = al256(WS_XIN + (size_t)CAP * D_ * 2);
constexpr size_t WS_YO      = al256(WS_HID + (size_t)CAP * DE * 2);
constexpr size_t WS_END     = al256(WS_PROJ + (size_t)T_ * PW1 * 2);
static_assert(WS_YO + (size_t)CAP * D_ * 2 <= WS_END, "moe buffers must fit inside the proj region");

__device__ __forceinline__ float bf2f(bf16_t v) { return __uint_as_float(((unsigned)v) << 16); }
__device__ __forceinline__ bf16_t f2bf(float f) { unsigned u = __float_as_uint(f); u += 0x7FFFu + ((u >> 16) & 1u); return (bf16_t)(u >> 16); }
__device__ __forceinline__ unsigned pk2(float lo, float hi) { return (unsigned)f2bf(lo) | ((unsigned)f2bf(hi) << 16); }
__device__ __forceinline__ int ld_i(const int* p) { return __hip_atomic_load(p, __ATOMIC_RELAXED, __HIP_MEMORY_SCOPE_AGENT); }
__device__ __forceinline__ float ld_f(const float* p) { return __hip_atomic_load(p, __ATOMIC_RELAXED, __HIP_MEMORY_SCOPE_AGENT); }
__device__ __forceinline__ float wsum(float v) { for (int o = 32; o >= 1; o >>= 1) v += __shfl_xor(v, o); return v; }
__device__ __forceinline__ float wmax(float v) { for (int o = 32; o >= 1; o >>= 1) v = fmaxf(v, __shfl_xor(v, o)); return v; }
__device__ __forceinline__ void lds_fence() { asm volatile("s_waitcnt lgkmcnt(0)" ::: "memory"); }

struct Ctx {
    const float* in[19]; float* out; unsigned char* ws;
    LDSP unsigned char* lds;
    int tid, lane, wave, G, bid;
};

__device__ __forceinline__ void mod_units(const Ctx& c) {
    if (c.bid >= 192) return;
    LDSP float* cs = (LDSP float*)c.lds;
    LDSP float* red = (LDSP float*)(c.lds + 65536);
    const float* cin = c.in[1];
    for (int i = c.tid; i < 8 * 2048; i += NTHR) { const float v = cin[i]; cs[i] = v / (1.f + __expf(-v)); }
    __syncthreads();
    float* MOD = (float*)(c.ws + WS_MOD);
    for (int u = c.bid; u < 192; u += c.G) {
        const int layer = u / 96, cb = (u % 96) * 128;
        const int c4 = c.tid & 31, kc = c.tid >> 5;
        f32x4 acc[8];
#pragma unroll
        for (int b = 0; b < 8; ++b) acc[b] = (f32x4){0.f, 0.f, 0.f, 0.f};
        const float* wp = c.in[2] + ((size_t)layer * 2048 + kc * 128) * MODW + cb + 4 * c4;
#pragma unroll 4
        for (int kk = 0; kk < 128; ++kk) {
            const f32x4 w = *(const f32x4*)(wp + (size_t)kk * MODW);
            const int k = kc * 128 + kk;
#pragma unroll
            for (int b = 0; b < 8; ++b) acc[b] += cs[b * 2048 + k] * w;
        }
#pragma unroll
        for (int b = 0; b < 8; ++b) *(LDSP f32x4*)(red + (kc * 8 + b) * 128 + 4 * c4) = acc[b];
        __syncthreads();
        for (int idx = c.tid; idx < 1024; idx += NTHR) {
            const int b = idx >> 7, col = idx & 127; float s = c.in[3][layer * MODW + cb + col];
#pragma unroll
            for (int q = 0; q < 16; ++q) s += red[(q * 8 + b) * 128 + col];
            MOD[((size_t)layer * 8 + b) * MODW + cb + col] = s;
        }
        __syncthreads();
    }
}

__device__ __forceinline__ void tr_tile(const float* src, int ld, int nvalid, bf16_t* dst, int dld, LDSP float* tile, int lane) {
    const int cq = (lane & 15) * 4, r4 = lane >> 4;
    f32x4 v[16];
#pragma unroll
    for (int i = 0; i < 16; ++i) {
        const int k = i * 4 + r4;
        if (cq < nvalid) v[i] = *(const f32x4*)(src + (size_t)k * ld + cq); else v[i] = (f32x4){0.f, 0.f, 0.f, 0.f};
    }
#pragma unroll
    for (int i = 0; i < 16; ++i) {
        const int k = i * 4 + r4;
        tile[k * 65 + cq + 0] = v[i][0]; tile[k * 65 + cq + 1] = v[i][1]; tile[k * 65 + cq + 2] = v[i][2]; tile[k * 65 + cq + 3] = v[i][3];
    }
    lds_fence();
    const int k8 = (lane & 7) * 8, rr = lane >> 3;
#pragma unroll
    for (int i = 0; i < 8; ++i) {
        const int r = i * 8 + rr;
        u32x4 w;
        w.x = pk2(tile[(k8 + 0) * 65 + r], tile[(k8 + 1) * 65 + r]); w.y = pk2(tile[(k8 + 2) * 65 + r], tile[(k8 + 3) * 65 + r]);
        w.z = pk2(tile[(k8 + 4) * 65 + r], tile[(k8 + 5) * 65 + r]); w.w = pk2(tile[(k8 + 6) * 65 + r], tile[(k8 + 7) * 65 + r]);
        *(u32x4*)(dst + (size_t)r * dld + k8) = w;
    }
    lds_fence();
}
__device__ __forceinline__ void tr_matrix(const Ctx& c, const float* W, int K, int N, int nrows, bf16_t* Wt) {
    LDSP float* tile = (LDSP float*)(c.lds + c.wave * 16640);
    const int nrt = nrows / 64, nkt = K / 64, nw = c.G * NWAVE;
    for (int t = c.bid * NWAVE + c.wave; t < nrt * nkt; t += nw) {
        const int rt = t % nrt, kt = t / nrt;
        int nv = N - rt * 64; nv = nv > 64 ? 64 : (nv < 0 ? 0 : nv);
        tr_tile(W + (size_t)kt * 64 * N + rt * 64, N, nv, Wt + (size_t)rt * 64 * K + kt * 64, K, tile, c.lane);
    }
}
__device__ __forceinline__ void tr_experts(const Ctx& c, int layer) {
    LDSP float* tile = (LDSP float*)(c.lds + c.wave * 16640);
    const int nw = c.G * NWAVE, gw = c.bid * NWAVE + c.wave;
    bf16_t* WE1 = (bf16_t*)(c.ws + WS_WE1); bf16_t* WE2 = (bf16_t*)(c.ws + WS_WE2);
    for (int t = gw; t < 16 * 2 * 32 * 22; t += nw) {
        const int ct = t % 22, kt = (t / 22) % 32, half = (t / 704) & 1, e = t / 1408;
        const float* W = (half ? c.in[17] : c.in[16]) + (size_t)(layer * 16 + e) * D_ * DE;
        const int j = ct >> 1, rt = ct & 1;
        tr_tile(W + (size_t)kt * 64 * DE + ct * 64, DE, 64, WE1 + ((size_t)e * 2816 + j * 256 + half * 128 + rt * 64) * D_ + kt * 64, D_, tile, c.lane);
    }
    for (int t = gw; t < 16 * 22 * 32; t += nw) {
        const int rt = t % 32, kt = (t / 32) % 22, e = t / 704;
        const float* W = c.in[18] + (size_t)(layer * 16 + e) * DE * D_;
        tr_tile(W + (size_t)kt * 64 * D_ + rt * 64, D_, 64, WE2 + ((size_t)e * 2048 + rt * 64) * DE + kt * 64, DE, tile, c.lane);
    }
}

struct RouteOut { int i0, i1; float w0, w1; };
__device__ __forceinline__ RouteOut route16(const float (&lg)[16], const float* rb) {
    float sc[16], bi[16];
#pragma unroll
    for (int e = 0; e < 16; ++e) { sc[e] = 1.f / (1.f + __expf(-lg[e])); bi[e] = sc[e] + rb[e]; }
    float gs[4];
#pragma unroll
    for (int g = 0; g < 4; ++g) {
        float m1 = bi[4 * g], m2 = -3.0e38f;
#pragma unroll
        for (int i = 1; i < 4; ++i) { const float v = bi[4 * g + i]; if (v > m1) { m2 = m1; m1 = v; } else if (v > m2) m2 = v; }
        gs[g] = m1 + m2;
    }
    int bg = 0; float bv = gs[0];
#pragma unroll
    for (int g = 1; g < 4; ++g) if (gs[g] > bv) { bv = gs[g]; bg = g; }
    float cb[4], cs[4];
#pragma unroll
    for (int i = 0; i < 4; ++i) { cb[i] = bg == 0 ? bi[i] : bg == 1 ? bi[4 + i] : bg == 2 ? bi[8 + i] : bi[12 + i]; cs[i] = bg == 0 ? sc[i] : bg == 1 ? sc[4 + i] : bg == 2 ? sc[8 + i] : sc[12 + i]; }
    int a0 = 0; float v0 = cb[0], s0 = cs[0];
#pragma unroll
    for (int i = 1; i < 4; ++i) if (cb[i] > v0) { v0 = cb[i]; a0 = i; s0 = cs[i]; }
    int a1 = -1; float v1 = -3.0e38f, s1 = 0.f;
#pragma unroll
    for (int i = 0; i < 4; ++i) if (i != a0 && cb[i] > v1) { v1 = cb[i]; a1 = i; s1 = cs[i]; }
    RouteOut r; r.i0 = bg * 4 + a0; r.i1 = bg * 4 + a1; const float s = s0 + s1; r.w0 = s0 / s; r.w1 = s1 / s; return r;
}

template <int MODE>
__device__ __forceinline__ void norm_phase(const Ctx& c, const float* xsrc, float* xdst, const float* gain, const float* msh, const float* msc, const float* mgf, bf16_t* hdst) {
    LDSP float* rwT = (LDSP float*)c.lds;
    LDSP int* cnt = (LDSP int*)(c.lds + LDS_MISC);
    if (MODE == 1) {
        const float* rw = c.in[14];
        for (int i = c.tid; i < 32768; i += NTHR) rwT[(i & 15) * 2048 + (i >> 4)] = rw[i];
        if (c.tid < 16) cnt[c.tid] = 0;
        __syncthreads();
    }
    const int nw = c.G * NWAVE, gw = c.bid * NWAVE + c.wave, lane = c.lane;
    const bf16_t* YO = (const bf16_t*)(c.ws + WS_YO);
    const int* TOKSLOT = (const int*)(c.ws + WS_TOKSLOT);
    for (int row = gw; row < T_; row += nw) {
        const int b = row >> 11;
        f32x4 v[8];
#pragma unroll
        for (int i = 0; i < 8; ++i) v[i] = *(const f32x4*)(xsrc + (size_t)row * D_ + i * 256 + lane * 4);
        if (MODE >= 2) {
            const int s0 = ld_i(TOKSLOT + row * 2), s1 = ld_i(TOKSLOT + row * 2 + 1);
#pragma unroll
            for (int i = 0; i < 8; ++i) {
                const u32x2 a = *(const u32x2*)(YO + (size_t)s0 * D_ + i * 256 + lane * 4), bb = *(const u32x2*)(YO + (size_t)s1 * D_ + i * 256 + lane * 4);
                const f32x4 g = *(const f32x4*)(mgf + (size_t)b * MODW + i * 256 + lane * 4);
                f32x4 y;
                y[0] = __uint_as_float(a.x << 16) + __uint_as_float(bb.x << 16); y[1] = __uint_as_float(a.x & 0xffff0000u) + __uint_as_float(bb.x & 0xffff0000u);
                y[2] = __uint_as_float(a.y << 16) + __uint_as_float(bb.y << 16); y[3] = __uint_as_float(a.y & 0xffff0000u) + __uint_as_float(bb.y & 0xffff0000u);
                v[i] += g * y;
                if (MODE == 2) *(f32x4*)(xdst + (size_t)row * D_ + i * 256 + lane * 4) = v[i];
            }
        }
        float ss = 0.f;
#pragma unroll
        for (int i = 0; i < 8; ++i) ss += v[i][0] * v[i][0] + v[i][1] * v[i][1] + v[i][2] * v[i][2] + v[i][3] * v[i][3];
        ss = wsum(ss);
        const float rinv = 1.0f / sqrtf(ss * (1.0f / 2048.0f) + 1e-6f);
        if (MODE == 3) {
#pragma unroll
            for (int i = 0; i < 8; ++i) { const f32x4 g = *(const f32x4*)(gain + i * 256 + lane * 4); *(f32x4*)(c.out + (size_t)row * D_ + i * 256 + lane * 4) = v[i] * rinv * g; }
            continue;
        }
#pragma unroll
        for (int i = 0; i < 8; ++i) {
            const f32x4 g = *(const f32x4*)(gain + i * 256 + lane * 4);
            const f32x4 sh = *(const f32x4*)(msh + (size_t)b * MODW + i * 256 + lane * 4), sc = *(const f32x4*)(msc + (size_t)b * MODW + i * 256 + lane * 4);
            v[i] = (v[i] * rinv * g) * (1.0f + sc) + sh;
            u32x2 w; w.x = pk2(v[i][0], v[i][1]); w.y = pk2(v[i][2], v[i][3]);
            *(u32x2*)(hdst + (size_t)row * D_ + i * 256 + lane * 4) = w;
        }
        if (MODE == 1) {
            float lg[16];
#pragma unroll
            for (int e = 0; e < 16; ++e) {
                float a = 0.f;
#pragma unroll
                for (int i = 0; i < 8; ++i) { const f32x4 r = *(LDSP f32x4*)(rwT + e * 2048 + i * 256 + lane * 4); a += v[i][0] * r[0] + v[i][1] * r[1] + v[i][2] * r[2] + v[i][3] * r[3]; }
                lg[e] = wsum(a);
            }
            const RouteOut r = route16(lg, c.in[15]);
            if (lane == 0) {
                int* RIDX = (int*)(c.ws + WS_RIDX); float* RW = (float*)(c.ws + WS_RW);
                RIDX[row * 2] = r.i0; RIDX[row * 2 + 1] = r.i1; RW[row * 2] = r.w0; RW[row * 2 + 1] = r.w1;
                atomicAdd((int*)(cnt + r.i0), 1); atomicAdd((int*)(cnt + r.i1), 1);
            }
        }
    }
    if (MODE == 1) {
        __syncthreads();
        if (c.tid < 16) ((int*)(c.ws + WS_BLKCNT))[c.bid * 16 + c.tid] = cnt[c.tid];
    }
}

__device__ __forceinline__ void dispatch_phase(const Ctx& c) {
    LDSP int* tot = (LDSP int*)c.lds;
    LDSP int* pre = tot + 16;
    LDSP int* start = tot + 32;
    LDSP int* pstart = tot + 48;
    LDSP int* ea = tot + 80;
    LDSP int* sl = tot + 208;
    if (c.tid < 32) tot[c.tid] = 0;
    __syncthreads();
    const int* BLKCNT = (const int*)(c.ws + WS_BLKCNT);
    for (int idx = c.tid; idx < c.G * 16; idx += NTHR) {
        const int v = ld_i(BLKCNT + idx), e = idx & 15, bl = idx >> 4;
        atomicAdd((int*)(tot + e), v); if (bl < c.bid) atomicAdd((int*)(pre + e), v);
    }
    __syncthreads();
    if (c.tid == 0) {
        int run = 0;
        for (int e = 0; e < 16; ++e) { pstart[e] = run; start[e] = run + pre[e]; run += (tot[e] + 255) / 256 * 256; }
        pstart[16] = run;
    }
    __syncthreads();
    if (c.bid == 0 && c.tid < 17) ((int*)(c.ws + WS_TAB))[c.tid] = pstart[c.tid] >> 8;
    const int* RIDX = (const int*)(c.ws + WS_RIDX); const float* RW = (const float*)(c.ws + WS_RW);
    const int nw = c.G * NWAVE;
    if (c.tid < 128) { const int a = c.tid, wv = a >> 4, i = (a >> 1) & 7, k = a & 1; const int row = (c.bid * NWAVE + wv) + i * nw; ea[a] = ld_i(RIDX + row * 2 + k); }
    __syncthreads();
    if (c.tid < 128) {
        const int a = c.tid, wv = a >> 4, i = (a >> 1) & 7, k = a & 1; const int row = (c.bid * NWAVE + wv) + i * nw;
        const int e = ea[a]; int rank = 0;
        for (int j = 0; j < a; ++j) rank += (ea[j] == e) ? 1 : 0;
        const int slot = start[e] + rank; sl[a] = slot;
        ((int*)(c.ws + WS_TOKSLOT))[row * 2 + k] = slot;
        ((float*)(c.ws + WS_SLOTW))[slot] = ld_f(RW + row * 2 + k);
    }
    if (c.bid == 0) {
        for (int e = 0; e < 16; ++e) for (int s = pstart[e] + tot[e] + c.tid; s < pstart[e + 1]; s += NTHR) ((float*)(c.ws + WS_SLOTW))[s] = 0.f;
    }
    __syncthreads();
    const bf16_t* Hb = (const bf16_t*)(c.ws + WS_H); bf16_t* XIN = (bf16_t*)(c.ws + WS_XIN);
    for (int a = c.wave; a < 128; a += NWAVE) {
        const int wv = a >> 4, i = (a >> 1) & 7; const int row = (c.bid * NWAVE + wv) + i * nw; const int slot = sl[a];
        const u32x4* s = (const u32x4*)(Hb + (size_t)row * D_); u32x4* d = (u32x4*)(XIN + (size_t)slot * D_);
#pragma unroll
        for (int q = 0; q < 4; ++q) d[q * 64 + c.lane] = s[q * 64 + c.lane];
    }
}

struct EpiResid {
    static constexpr bool PERM = false, AFTER_DRAIN = false;
    const float* base; float* out; const float* gate;
    __device__ __forceinline__ void operator()(const pg8::f32x4 (&acc)[2][2][4][2], const pg8::Unit& u, int wr, int wc, int fr, int fq) const {
        const int row0 = u.pm * 256 + wr * 64 + fr, col0 = u.pn * 256 + wc * 32 + 4 * fq, b = u.pm >> 3;
        pg8::f32x4 gv[2][2];
#pragma unroll
        for (int bj = 0; bj < 2; ++bj)
#pragma unroll
            for (int n = 0; n < 2; ++n) gv[bj][n] = *(const pg8::f32x4*)(gate + (size_t)b * MODW + col0 + bj * 128 + n * 16);
#pragma unroll
        for (int ai = 0; ai < 2; ++ai)
#pragma unroll
            for (int m = 0; m < 4; ++m) { const size_t off = (size_t)(row0 + ai * 128 + m * 16) * D_ + col0;
#pragma unroll
                for (int bj = 0; bj < 2; ++bj)
#pragma unroll
                    for (int n = 0; n < 2; ++n) { const pg8::f32x4 bs = *(const pg8::f32x4*)(base + off + bj * 128 + n * 16); *(pg8::f32x4*)(out + off + bj * 128 + n * 16) = bs + gv[bj][n] * acc[ai][bj][m][n]; } }
    }
};
struct EpiSwiglu {
    static constexpr bool PERM = true, AFTER_DRAIN = false;
    bf16_t* Hd;
    __device__ __forceinline__ void operator()(const pg8::f32x4 (&acc)[2][2][4][2], const pg8::Unit& u, int wr, int wc, int fr, int fq) const {
        const int row0 = u.pm * 256 + wr * 64 + fr, j = u.pn % 11, col = j * 128 + wc * 32 + 8 * fq;
#pragma unroll
        for (int ai = 0; ai < 2; ++ai)
#pragma unroll
            for (int m = 0; m < 4; ++m) {
                float o[8];
#pragma unroll
                for (int n = 0; n < 2; ++n)
#pragma unroll
                    for (int i = 0; i < 4; ++i) { const float g = acc[ai][0][m][n][i], up = acc[ai][1][m][n][i]; o[n * 4 + i] = g / (1.f + __expf(-g)) * up; }
                pg8::u32x4 w; w.x = pg8::cvt_pk_bf16(o[0], o[1]); w.y = pg8::cvt_pk_bf16(o[2], o[3]); w.z = pg8::cvt_pk_bf16(o[4], o[5]); w.w = pg8::cvt_pk_bf16(o[6], o[7]);
                *(pg8::u32x4*)(Hd + (size_t)(row0 + ai * 128 + m * 16) * DE + col) = w;
            }
    }
};
struct EpiDown {
    static constexpr bool PERM = true, AFTER_DRAIN = false;
    bf16_t* Y; const float* sw;
    __device__ __forceinline__ void operator()(const pg8::f32x4 (&acc)[2][2][4][2], const pg8::Unit& u, int wr, int wc, int fr, int fq) const {
        const int row0 = u.pm * 256 + wr * 64 + fr, col0 = (u.pn & 7) * 256 + wc * 32 + 8 * fq;
#pragma unroll
        for (int ai = 0; ai < 2; ++ai)
#pragma unroll
            for (int m = 0; m < 4; ++m) { const int row = row0 + ai * 128 + m * 16; const float w = ld_f(sw + row);
#pragma unroll
                for (int bj = 0; bj < 2; ++bj) { const pg8::f32x4 v0 = acc[ai][bj][m][0] * w, v1 = acc[ai][bj][m][1] * w;
                    pg8::u32x4 q; q.x = pg8::cvt_pk_bf16(v0[0], v0[1]); q.y = pg8::cvt_pk_bf16(v0[2], v0[3]); q.z = pg8::cvt_pk_bf16(v1[0], v1[1]); q.w = pg8::cvt_pk_bf16(v1[2], v1[3]);
                    *(pg8::u32x4*)(Y + (size_t)row * D_ + col0 + bj * 128) = q; } }
    }
};
struct MoeOrder {
    LDSP const int* bs;
    int G, vc, ncol;
    __device__ __forceinline__ bool next(int i, pg8::Unit& u) const {
        const int L = i * G + vc; if (L >= bs[16] * ncol) return false;
        int e = 0;
#pragma unroll
        for (int k = 1; k < 16; ++k) e += (L >= bs[k] * ncol) ? 1 : 0;
        const int b0 = bs[e], nb = bs[e + 1] - b0, r = L - b0 * ncol;
        const int j = r / nb, bi = r - j * nb;
        u.pm = b0 + bi; u.pn = e * ncol + j; return true;
    }
    __device__ __forceinline__ void a_ready(const pg8::Unit&) const {}
    __device__ __forceinline__ void done(const pg8::Unit&) const {}
};
__device__ __forceinline__ void moe_tab_to_lds(const Ctx& c) {
    LDSP int* bs = (LDSP int*)(c.lds + LDS_MISC);
    if (c.tid < 17) bs[c.tid] = ld_i((const int*)(c.ws + WS_TAB) + c.tid);
    __syncthreads();
}

__device__ __forceinline__ float gelu_tanh(float x) { const float u = 0.7978845608028654f * (x + 0.044715f * x * x * x); return 0.5f * x * (1.f + tanhf(u)); }
__device__ __forceinline__ void compress_phase(const Ctx& c) {
    LDSP float* tok = (LDSP float*)c.lds;
    LDSP float* pos = (LDSP float*)(c.lds + 73728);
    LDSP float* part = (LDSP float*)(c.lds + 73728 + 16384);
    LDSP float* hid = (LDSP float*)(c.lds + 73728 + 32768);
    const bf16_t* proj = (const bf16_t*)(c.ws + WS_PROJ);
    float* CMP = (float*)(c.ws + WS_CMP);
    for (int u = c.bid; u < 1024; u += c.G) {
        const int ch = u & 15, j = (u >> 4) & 1, g = (u >> 5) & 3, b = u >> 7, n0 = ch * 8;
        for (int idx = c.tid; idx < 144 * 16; idx += NTHR) {
            const int tl = idx >> 4, d8 = (idx & 15) * 8, t = n0 * 16 + tl;
            u32x4 w = (u32x4){0u, 0u, 0u, 0u};
            if (t < S_) w = *(const u32x4*)(proj + (size_t)(b * S_ + t) * PW0 + 2048 + j * 512 + g * 128 + d8);
            LDSP float* dp = tok + tl * 128 + d8;
            dp[0] = __uint_as_float(w.x << 16); dp[1] = __uint_as_float(w.x & 0xffff0000u); dp[2] = __uint_as_float(w.y << 16); dp[3] = __uint_as_float(w.y & 0xffff0000u);
            dp[4] = __uint_as_float(w.z << 16); dp[5] = __uint_as_float(w.z & 0xffff0000u); dp[6] = __uint_as_float(w.w << 16); dp[7] = __uint_as_float(w.w & 0xffff0000u);
        }
        for (int idx = c.tid; idx < 4096; idx += NTHR) pos[idx] = c.in[10][j * 4096 + idx];
        __syncthreads();
        const int e = c.tid & 127, q = c.tid >> 7;
        float acc[8];
#pragma unroll
        for (int i = 0; i < 8; ++i) acc[i] = 0.f;
        const float* w1 = c.in[8] + (size_t)j * 32 * 128 * 128;
        for (int l = q * 8; l < q * 8 + 8; ++l) {
#pragma unroll 4
            for (int d = 0; d < 128; ++d) {
                const float w = w1[((size_t)l * 128 + d) * 128 + e]; const float p = pos[l * 128 + d];
#pragma unroll
                for (int i = 0; i < 8; ++i) acc[i] += (tok[(16 * i + l) * 128 + d] + p) * w;
            }
        }
#pragma unroll
        for (int i = 0; i < 8; ++i) part[(q * 8 + i) * 128 + e] = acc[i];
        __syncthreads();
        for (int idx = c.tid; idx < 1024; idx += NTHR) { const int i = idx >> 7, ee = idx & 127; hid[idx] = gelu_tanh(part[(0 * 8 + i) * 128 + ee] + part[(1 * 8 + i) * 128 + ee] + part[(2 * 8 + i) * 128 + ee] + part[(3 * 8 + i) * 128 + ee]); }
        __syncthreads();
        const float* w2 = c.in[9] + (size_t)j * 128 * 128;
        for (int idx = c.tid; idx < 1024; idx += NTHR) {
            const int i = idx >> 7, f = idx & 127, n = n0 + i; float s = 0.f;
            for (int ee = 0; ee < 128; ++ee) s += hid[i * 128 + ee] * w2[ee * 128 + f];
            if (n < 127) CMP[((((size_t)j * 8 + b) * 128 + n) * 4 + g) * 128 + f] = s;
        }
        __syncthreads();
    }
}

__device__ __forceinline__ void dots_bf16(const bf16_t* krow, bool ok, LDSP const float* qs, float (&s)[4]) {
    s[0] = s[1] = s[2] = s[3] = 0.f;
    if (!ok) return;
#pragma unroll 4
    for (int d8 = 0; d8 < 16; ++d8) {
        const u32x4 w = *(const u32x4*)(krow + d8 * 8);
        float k[8] = {__uint_as_float(w.x << 16), __uint_as_float(w.x & 0xffff0000u), __uint_as_float(w.y << 16), __uint_as_float(w.y & 0xffff0000u),
                      __uint_as_float(w.z << 16), __uint_as_float(w.z & 0xffff0000u), __uint_as_float(w.w << 16), __uint_as_float(w.w & 0xffff0000u)};
#pragma unroll
        for (int h = 0; h < 4; ++h) {
            const f32x4 qa = *(LDSP const f32x4*)(qs + h * 128 + d8 * 8), qb = *(LDSP const f32x4*)(qs + h * 128 + d8 * 8 + 4);
            s[h] += k[0] * qa[0] + k[1] * qa[1] + k[2] * qa[2] + k[3] * qa[3] + k[4] * qb[0] + k[5] * qb[1] + k[6] * qb[2] + k[7] * qb[3];
        }
    }
}
__device__ __forceinline__ void online_tile(const float (&s)[4], const bool valid, float (&m)[4], float (&l)[4], f32x2 (&acc)[4], LDSP float* pl,
                                            const bf16_t* vbase, size_t vstride, int kcount, int lane) {
#pragma unroll
    for (int h = 0; h < 4; ++h) {
        const float sv = valid ? s[h] : -__builtin_inff();
        const float tm = wmax(sv); const float mn = fmaxf(m[h], tm);
        float alpha = 1.f, p = 0.f;
        if (mn > -__builtin_inff()) { alpha = __expf(m[h] - mn); p = valid ? __expf(sv - mn) : 0.f; }
        l[h] = l[h] * alpha + wsum(p); acc[h] *= alpha; m[h] = mn;
        pl[h * 64 + lane] = p;
    }
    lds_fence();
    for (int k = 0; k < kcount; ++k) {
        const unsigned w = *(const unsigned*)(vbase + (size_t)k * vstride + 2 * lane);
        const f32x2 v = {__uint_as_float(w << 16), __uint_as_float(w & 0xffff0000u)};
#pragma unroll
        for (int h = 0; h < 4; ++h) acc[h] += pl[h * 64 + k] * v;
    }
    lds_fence();
}
__device__ __forceinline__ void nsa_attn_ref_phase(const Ctx& c) {
    LDSP float* wl = (LDSP float*)(c.lds + c.wave * 8192);
    LDSP float* qs = wl;
    LDSP float* pl = wl + 512;
    LDSP float* ps = wl + 1024;
    const bf16_t* proj = (const bf16_t*)(c.ws + WS_PROJ);
    const float* CMP = (const float*)(c.ws + WS_CMP);
    bf16_t* O = (bf16_t*)(c.ws + WS_O);
    const int lane = c.lane, nw = c.G * NWAVE;
    const float scale = 0.08838834764831845f;
    for (int u = c.bid * NWAVE + c.wave; u < B_ * S_ * 4; u += nw) {
        const int g = u & 3, t = (u >> 2) & 2047, b = u >> 13;
        const bf16_t* prow = proj + (size_t)(b * S_ + t) * PW0;
        { const u32x4 w = *(const u32x4*)(prow + g * 512 + lane * 8); LDSP float* qd = qs + lane * 8;
          qd[0] = __uint_as_float(w.x << 16) * scale; qd[1] = __uint_as_float(w.x & 0xffff0000u) * scale; qd[2] = __uint_as_float(w.y << 16) * scale; qd[3] = __uint_as_float(w.y & 0xffff0000u) * scale;
          qd[4] = __uint_as_float(w.z << 16) * scale; qd[5] = __uint_as_float(w.z & 0xffff0000u) * scale; qd[6] = __uint_as_float(w.w << 16) * scale; qd[7] = __uint_as_float(w.w & 0xffff0000u) * scale; }
        lds_fence();
        float slope[4], gate[4][3];
#pragma unroll
        for (int h = 0; h < 4; ++h) { slope[h] = exp2f(-0.5f * (float)(4 * g + h + 1));
#pragma unroll
            for (int j = 0; j < 3; ++j) { const float x = bf2f(prow[5120 + (4 * g + h) * 3 + j]); gate[h][j] = 1.f / (1.f + __expf(-x)); } }
        f32x2 ofin[4];
        {
            float s0[4], s1[4]; bool v0, v1;
            { const int n = lane; v0 = (16 * n + 31 <= t); const float* kp = CMP + (((size_t)b * 128 + n) * 4 + g) * 128;
              s0[0] = s0[1] = s0[2] = s0[3] = 0.f;
              if (v0) for (int d = 0; d < 128; d += 4) { const f32x4 k = *(const f32x4*)(kp + d);
#pragma unroll
                  for (int h = 0; h < 4; ++h) { const f32x4 q = *(LDSP const f32x4*)(qs + h * 128 + d); s0[h] += k[0] * q[0] + k[1] * q[1] + k[2] * q[2] + k[3] * q[3]; } } }
            { const int n = lane + 64; v1 = (n < 127) && (16 * n + 31 <= t); const float* kp = CMP + (((size_t)b * 128 + n) * 4 + g) * 128;
              s1[0] = s1[1] = s1[2] = s1[3] = 0.f;
              if (v1) for (int d = 0; d < 128; d += 4) { const f32x4 k = *(const f32x4*)(kp + d);
#pragma unroll
                  for (int h = 0; h < 4; ++h) { const f32x4 q = *(LDSP const f32x4*)(qs + h * 128 + d); s1[h] += k[0] * q[0] + k[1] * q[1] + k[2] * q[2] + k[3] * q[3]; } } }
            float psum0 = 0.f, psum1 = 0.f;
#pragma unroll
            for (int h = 0; h < 4; ++h) {
                const float a0 = v0 ? s0[h] - slope[h] * ((float)t - (16.f * lane + 15.5f)) : -__builtin_inff();
                const float a1 = v1 ? s1[h] - slope[h] * ((float)t - (16.f * (lane + 64) + 15.5f)) : -__builtin_inff();
                const float mx = wmax(fmaxf(a0, a1));
                const float e0 = v0 ? __expf(a0 - mx) : 0.f, e1 = v1 ? __expf(a1 - mx) : 0.f;
                const float sum = wsum(e0 + e1), inv = 1.f / fmaxf(sum, 1e-30f);
                const float p0 = e0 * inv, p1 = e1 * inv;
                pl[h * 128 + lane] = p0; pl[h * 128 + 64 + lane] = p1; psum0 += p0; psum1 += p1;
            }
            ps[1 + lane] = psum0; ps[65 + lane] = psum1; if (lane == 0) { ps[0] = 0.f; ps[129] = 0.f; }
            lds_fence();
            f32x2 acc[4];
#pragma unroll
            for (int h = 0; h < 4; ++h) acc[h] = (f32x2){0.f, 0.f};
            const int nvis = t >= 31 ? ((t - 31) >> 4) + 1 : 0;
            const float* vp = CMP + ((((size_t)8 + b) * 128) * 4 + g) * 128 + 2 * lane;
            for (int n = 0; n < nvis; ++n) { const f32x2 v = *(const f32x2*)(vp + (size_t)n * 512);
#pragma unroll
                for (int h = 0; h < 4; ++h) acc[h] += pl[h * 128 + n] * v; }
#pragma unroll
            for (int h = 0; h < 4; ++h) ofin[h] = gate[h][0] * acc[h];
        }
        unsigned selmask;
        {
            const int j = lane & 31, cur = t >> 6;
            const float imp = ps[4 * j] + 2.f * (ps[1 + 4 * j] + ps[2 + 4 * j] + ps[3 + 4 * j]) + ps[4 + 4 * j];
            const bool forced = (j == 0) || (j == cur) || (j == cur - 1), causal = (64 * j <= t);
            const float score = forced ? 1.0e6f : (causal ? imp : -1.0f);
            int rank = 0;
            for (int i = 0; i < 32; ++i) { const float si = __shfl(score, i); rank += ((si > score) || (si == score && i < j)) ? 1 : 0; }
            selmask = (unsigned)__ballot(rank < 16 && lane < 32);
            if (lane == 0) ((unsigned*)(c.ws + WS_SEL))[((size_t)b * 4 + g) * 2048 + t] = selmask;
        }
        lds_fence();
        {
            float m[4], l[4]; f32x2 acc[4];
#pragma unroll
            for (int h = 0; h < 4; ++h) { m[h] = -__builtin_inff(); l[h] = 0.f; acc[h] = (f32x2){0.f, 0.f}; }
            for (int j = 0; j < 32; ++j) {
                if (!((selmask >> j) & 1u)) continue;
                if (64 * j > t) continue;
                const int kpos = 64 * j + lane, dist = t - kpos; const bool valid = dist >= 0;
                const bf16_t* kb = proj + (size_t)(b * S_ + kpos) * PW0 + 2048 + 1024 + g * 128;
                float s[4]; dots_bf16(kb, valid, qs, s);
#pragma unroll
                for (int h = 0; h < 4; ++h) s[h] -= slope[h] * (float)dist;
                online_tile(s, valid, m, l, acc, pl, proj + (size_t)(b * S_ + 64 * j) * PW0 + 2048 + 1536 + g * 128, PW0, min(64, t - 64 * j + 1), lane);
            }
#pragma unroll
            for (int h = 0; h < 4; ++h) ofin[h] += (gate[h][1] / l[h]) * acc[h];
        }
        {
            float m[4], l[4]; f32x2 acc[4];
#pragma unroll
            for (int h = 0; h < 4; ++h) { m[h] = -__builtin_inff(); l[h] = 0.f; acc[h] = (f32x2){0.f, 0.f}; }
            for (int i = 0; i < 8; ++i) {
                const int k0 = t - 511 + 64 * i; if (k0 + 63 < 0) continue;
                const int kpos = k0 + lane, dist = t - kpos; const bool valid = kpos >= 0;
                const bf16_t* kb = proj + (size_t)(b * S_ + (valid ? kpos : 0)) * PW0 + 2048 + 2048 + g * 128;
                float s[4]; dots_bf16(kb, valid, qs, s);
#pragma unroll
                for (int h = 0; h < 4; ++h) s[h] -= slope[h] * (float)dist;
                const int kfirst = k0 < 0 ? -k0 : 0;
#pragma unroll
                for (int h = 0; h < 4; ++h) {
                    const float sv = valid ? s[h] : -__builtin_inff();
                    const float tm = wmax(sv); const float mn = fmaxf(m[h], tm);
                    float alpha = 1.f, p = 0.f;
                    if (mn > -__builtin_inff()) { alpha = __expf(m[h] - mn); p = valid ? __expf(sv - mn) : 0.f; }
                    l[h] = l[h] * alpha + wsum(p); acc[h] *= alpha; m[h] = mn; pl[h * 64 + lane] = p;
                }
                lds_fence();
                const bf16_t* vb = proj + 2048 + 2560 + g * 128 + 2 * lane;
                for (int k = kfirst; k < 64; ++k) {
                    const unsigned w = *(const unsigned*)(vb + (size_t)(b * S_ + k0 + k) * PW0);
                    const f32x2 v = {__uint_as_float(w << 16), __uint_as_float(w & 0xffff0000u)};
#pragma unroll
                    for (int h = 0; h < 4; ++h) acc[h] += pl[h * 64 + k] * v;
                }
                lds_fence();
            }
#pragma unroll
            for (int h = 0; h < 4; ++h) ofin[h] += (gate[h][2] / l[h]) * acc[h];
        }
#pragma unroll
        for (int h = 0; h < 4; ++h) *(unsigned*)(O + (size_t)(b * S_ + t) * D_ + (4 * g + h) * 128 + 2 * lane) = pk2(ofin[h][0], ofin[h][1]);
        lds_fence();
    }
}

__device__ __forceinline__ void dil_attn_ref_phase(const Ctx& c) {
    LDSP float* wl = (LDSP float*)(c.lds + c.wave * 8192);
    LDSP float* qs = wl;
    LDSP float* pl = wl + 128;
    const bf16_t* proj = (const bf16_t*)(c.ws + WS_PROJ);
    bf16_t* O = (bf16_t*)(c.ws + WS_O);
    const int lane = c.lane, nw = c.G * NWAVE;
    const float scale = 0.08838834764831845f;
    for (int u = c.bid * NWAVE + c.wave; u < B_ * S_ * 16; u += nw) {
        const int h = u & 15, t = (u >> 4) & 2047, b = u >> 15;
        const bf16_t* prow = proj + (size_t)(b * S_ + t) * PW1;
        { const unsigned w = *(const unsigned*)(prow + h * 128 + 2 * lane); qs[2 * lane] = __uint_as_float(w << 16) * scale; qs[2 * lane + 1] = __uint_as_float(w & 0xffff0000u) * scale; }
        lds_fence();
        const float slope = exp2f(-0.5f * (float)(h + 1));
        float lse[3]; f32x2 og[3];
#pragma unroll
        for (int gi = 0; gi < 3; ++gi) {
            const int r = gi == 0 ? 1 : gi == 1 ? 4 : 16;
            const int uq = t / r; const int imax = uq < 128 ? uq : 128;
            const size_t koff = 2048 + (size_t)gi * 4096 + h * 128, voff = koff + 2048;
            float m = -__builtin_inff(), l = 0.f; f32x2 acc = {0.f, 0.f};
            for (int tile = 0; tile * 64 <= imax; ++tile) {
                const int i = tile * 64 + lane; const bool valid = i <= imax;
                float s = 0.f;
                if (valid) { const bf16_t* kr = proj + (size_t)(b * S_ + t - r * i) * PW1 + koff;
                    for (int d8 = 0; d8 < 16; ++d8) { const u32x4 w = *(const u32x4*)(kr + d8 * 8);
                        const f32x4 qa = *(LDSP const f32x4*)(qs + d8 * 8), qb = *(LDSP const f32x4*)(qs + d8 * 8 + 4);
                        s += __uint_as_float(w.x << 16) * qa[0] + __uint_as_float(w.x & 0xffff0000u) * qa[1] + __uint_as_float(w.y << 16) * qa[2] + __uint_as_float(w.y & 0xffff0000u) * qa[3]
                           + __uint_as_float(w.z << 16) * qb[0] + __uint_as_float(w.z & 0xffff0000u) * qb[1] + __uint_as_float(w.w << 16) * qb[2] + __uint_as_float(w.w & 0xffff0000u) * qb[3]; }
                    s -= slope * (float)(r * i); }
                const float sv = valid ? s : -__builtin_inff();
                const float mn = fmaxf(m, wmax(sv));
                const float alpha = __expf(m - mn), p = valid ? __expf(sv - mn) : 0.f;
                l = l * alpha + wsum(p); acc *= alpha; m = mn; pl[lane] = p;
                lds_fence();
                const int kc = min(64, imax - tile * 64 + 1);
                for (int k = 0; k < kc; ++k) { const unsigned w = *(const unsigned*)(proj + (size_t)(b * S_ + t - r * (tile * 64 + k)) * PW1 + voff + 2 * lane);
                    acc += pl[k] * (f32x2){__uint_as_float(w << 16), __uint_as_float(w & 0xffff0000u)}; }
                lds_fence();
            }
            lse[gi] = m + __logf(l); og[gi] = acc * (1.f / l);
        }
        const float mx = fmaxf(lse[0], fmaxf(lse[1], lse[2]));
        const float w0 = __expf(lse[0] - mx), w1 = __expf(lse[1] - mx), w2 = __expf(lse[2] - mx), inv = 1.f / (w0 + w1 + w2);
        const f32x2 o = (w0 * inv) * og[0] + (w1 * inv) * og[1] + (w2 * inv) * og[2];
        *(unsigned*)(O + (size_t)(b * S_ + t) * D_ + h * 128 + 2 * lane) = pk2(o[0], o[1]);
        lds_fence();
    }
}

struct Args { const float* in[19]; float* out; unsigned char* ws; int ph_lo, ph_hi; };
constexpr int N_PHASES = 19;

__global__ void __launch_bounds__(NTHR, 2) fwd(Args args) {
    extern __shared__ __attribute__((aligned(16))) unsigned char lds_raw[];
    Ctx c;
#pragma unroll
    for (int i = 0; i < 19; ++i) c.in[i] = args.in[i];
    c.out = args.out; c.ws = args.ws; c.lds = (LDSP unsigned char*)lds_raw;
    c.tid = threadIdx.x; c.lane = c.tid & 63; c.wave = __builtin_amdgcn_readfirstlane(c.tid >> 6); c.G = gridDim.x; c.bid = blockIdx.x;
    const int lo = args.ph_lo, hi = args.ph_hi;
    LDSP unsigned* xbw = (LDSP unsigned*)(c.lds + LDS_BYTES - 16);
    XcdBarrier bar; bar.bar = (unsigned*)(c.ws + WS_BAR); bar.x = 0; bar.st = nullptr;
    if (hi - lo > 1) {
        if (c.tid == 0) { xbw[0] = 0u; xbw[1] = 0u; xbw[2] = 0u; xbw[3] = 0u; }
        __syncthreads();
        bar = xcd_barrier_post((unsigned*)(c.ws + WS_BAR), (volatile LAS unsigned*)xbw);
    }
#define IN(k) (lo <= (k) && (k) < hi)
#define SEAM(k) do { if (IN(k) && IN((k) + 1)) xcd_barrier(bar); else __syncthreads(); } while (0)
    const int vcu = (c.G % 8 == 0) ? (c.bid % 8) * (c.G / 8) + c.bid / 8 : c.bid;
    float* MOD = (float*)(c.ws + WS_MOD);
    float* X = (float*)(c.ws + WS_X); bf16_t* Hb = (bf16_t*)(c.ws + WS_H); bf16_t* Ob = (bf16_t*)(c.ws + WS_O); bf16_t* PROJ = (bf16_t*)(c.ws + WS_PROJ);
    bf16_t* XIN = (bf16_t*)(c.ws + WS_XIN); bf16_t* HID = (bf16_t*)(c.ws + WS_HID); bf16_t* YO = (bf16_t*)(c.ws + WS_YO);
    bf16_t* WE1 = (bf16_t*)(c.ws + WS_WE1); bf16_t* WE2 = (bf16_t*)(c.ws + WS_WE2);

    if (IN(0)) {
        mod_units(c); __syncthreads();
        tr_matrix(c, c.in[7], D_, 5168, PW0, (bf16_t*)(c.ws + WS_WNSAIN));
        tr_matrix(c, c.in[11], D_, D_, D_, (bf16_t*)(c.ws + WS_WNSAOUT));
        tr_matrix(c, c.in[12], D_, PW1, PW1, (bf16_t*)(c.ws + WS_WDILIN));
        tr_matrix(c, c.in[13], D_, D_, D_, (bf16_t*)(c.ws + WS_WDILOUT));
        tr_experts(c, 0);
        SEAM(0);
    }
    if (IN(1)) { norm_phase<0>(c, c.in[0], nullptr, c.in[4], MOD + 0 * 2048, MOD + 1 * 2048, nullptr, Hb); SEAM(1); }
    if (IN(2)) {
        pg8::Gemm g{Hb, (const bf16_t*)(c.ws + WS_WNSAIN), T_, PW0, D_}; pg8::StaticOrder S; S.init(T_, PW0, c.G, c.bid);
        pg8::EpiBf16<0> E{PROJ, PW0, nullptr, 0, 0};
        pg8::gemm_phase<pg8::EpiBf16<0>, pg8::StaticOrder, false>((PG8_LAS unsigned char*)c.lds, g, S, E, nullptr);
        SEAM(2);
    }
    if (IN(3)) { compress_phase(c); SEAM(3); }
    if (IN(4)) { nsa_attn_ref_phase(c); SEAM(4); }
    if (IN(5)) {
        pg8::Gemm g{Ob, (const bf16_t*)(c.ws + WS_WNSAOUT), T_, D_, D_}; pg8::StaticOrder S; S.init(T_, D_, c.G, c.bid);
        EpiResid E{c.in[0], X, MOD + 2 * 2048};
        pg8::gemm_phase<EpiResid, pg8::StaticOrder, false>((PG8_LAS unsigned char*)c.lds, g, S, E, nullptr);
        SEAM(5);
    }
    if (IN(6)) { norm_phase<1>(c, X, nullptr, c.in[5], MOD + 3 * 2048, MOD + 4 * 2048, nullptr, Hb); SEAM(6); }
    if (IN(7)) { dispatch_phase(c); SEAM(7); }
    if (IN(8)) {
        moe_tab_to_lds(c);
        pg8::Gemm g{XIN, WE1, CAP, 16 * 2816, D_}; MoeOrder S{(LDSP const int*)(c.lds + LDS_MISC), c.G, vcu, 11};
        EpiSwiglu E{HID};
        pg8::gemm_phase<EpiSwiglu, MoeOrder, false>((PG8_LAS unsigned char*)c.lds, g, S, E, nullptr);
        SEAM(8);
    }
    if (IN(9)) {
        moe_tab_to_lds(c);
        pg8::Gemm g{HID, WE2, CAP, 16 * 2048, DE}; MoeOrder S{(LDSP const int*)(c.lds + LDS_MISC), c.G, vcu, 8};
        EpiDown E{YO, (const float*)(c.ws + WS_SLOTW)};
        pg8::gemm_phase<EpiDown, MoeOrder, false>((PG8_LAS unsigned char*)c.lds, g, S, E, nullptr);
        SEAM(9);
    }
    if (IN(10)) {
        norm_phase<2>(c, X, X, c.in[4] + 2048, MOD + (size_t)8 * MODW + 0 * 2048, MOD + (size_t)8 * MODW + 1 * 2048, MOD + 5 * 2048, Hb);
        __syncthreads();
        tr_experts(c, 1);
        SEAM(10);
    }
    if (IN(11)) {
        pg8::Gemm g{Hb, (const bf16_t*)(c.ws + WS_WDILIN), T_, PW1, D_}; pg8::StaticOrder S; S.init(T_, PW1, c.G, c.bid);
        pg8::EpiBf16<0> E{PROJ, PW1, nullptr, 0, 0};
        pg8::gemm_phase<pg8::EpiBf16<0>, pg8::StaticOrder, false>((PG8_LAS unsigned char*)c.lds, g, S, E, nullptr);
        SEAM(11);
    }
    if (IN(12)) { dil_attn_ref_phase(c); SEAM(12); }
    if (IN(13)) {
        pg8::Gemm g{Ob, (const bf16_t*)(c.ws + WS_WDILOUT), T_, D_, D_}; pg8::StaticOrder S; S.init(T_, D_, c.G, c.bid);
        EpiResid E{X, X, MOD + (size_t)8 * MODW + 2 * 2048};
        pg8::gemm_phase<EpiResid, pg8::StaticOrder, false>((PG8_LAS unsigned char*)c.lds, g, S, E, nullptr);
        SEAM(13);
    }
    if (IN(14)) { norm_phase<1>(c, X, nullptr, c.in[5] + 2048, MOD + (size_t)8 * MODW + 3 * 2048, MOD + (size_t)8 * MODW + 4 * 2048, nullptr, Hb); SEAM(14); }
    if (IN(15)) { dispatch_phase(c); SEAM(15); }
    if (IN(16)) {
        moe_tab_to_lds(c);
        pg8::Gemm g{XIN, WE1, CAP, 16 * 2816, D_}; MoeOrder S{(LDSP const int*)(c.lds + LDS_MISC), c.G, vcu, 11};
        EpiSwiglu E{HID};
        pg8::gemm_phase<EpiSwiglu, MoeOrder, false>((PG8_LAS unsigned char*)c.lds, g, S, E, nullptr);
        SEAM(16);
    }
    if (IN(17)) {
        moe_tab_to_lds(c);
        pg8::Gemm g{HID, WE2, CAP, 16 * 2048, DE}; MoeOrder S{(LDSP const int*)(c.lds + LDS_MISC), c.G, vcu, 8};
        EpiDown E{YO, (const float*)(c.ws + WS_SLOTW)};
        pg8::gemm_phase<EpiDown, MoeOrder, false>((PG8_LAS unsigned char*)c.lds, g, S, E, nullptr);
        SEAM(17);
    }
    if (IN(18)) { norm_phase<3>(c, X, nullptr, c.in[6], nullptr, nullptr, MOD + (size_t)8 * MODW + 5 * 2048, nullptr); }
#undef IN
#undef SEAM
}

extern "C" void kernel_launch(void* const* d_in, const int* in_sizes, int n_in, void* d_out, int out_size, void* d_ws, size_t ws_size, hipStream_t stream) {
    static int grid = 0;
    if (grid == 0) {
        if (n_in != 19 || out_size != T_ * D_ || ws_size < WS_END) { fprintf(stderr, "kernel_launch: unexpected shapes (n_in %d out %d ws %zu need %zu)\n", n_in, out_size, ws_size, (size_t)WS_END); grid = -1; return; }
        int dev = 0, cus = 0;
        if (hipGetDevice(&dev) != hipSuccess || hipDeviceGetAttribute(&cus, hipDeviceAttributeMultiprocessorCount, dev) != hipSuccess) { grid = -1; return; }
        if (hipFuncSetAttribute((const void*)fwd, hipFuncAttributeMaxDynamicSharedMemorySize, LDS_BYTES) != hipSuccess) { fprintf(stderr, "kernel_launch: hipFuncSetAttribute failed\n"); grid = -1; return; }
        int per_cu = 0;
        if (hipOccupancyMaxActiveBlocksPerMultiprocessor(&per_cu, (const void*)fwd, NTHR, LDS_BYTES) != hipSuccess || per_cu < 1) fprintf(stderr, "kernel_launch: occupancy query says %d\n", per_cu);
        (void)hipGetLastError();
        grid = cus > 256 ? 256 : cus;
    }
    if (grid < 0) return;
    (void)hipMemsetAsync((char*)d_ws + WS_BAR, 0, WS_CTL_END, stream);
    Args a{};
    for (int i = 0; i < 19; ++i) a.in[i] = (const float*)d_in[i];
    a.out = (float*)d_out; a.ws = (unsigned char*)d_ws;
#if MK_ONE_LAUNCH
    a.ph_lo = 0; a.ph_hi = N_PHASES;
    hipLaunchKernelGGL(fwd, dim3(grid), dim3(NTHR), LDS_BYTES, stream, a);
#else
    for (int p = 0; p < N_PHASES; ++p) { a.ph_lo = p; a.ph_hi = p + 1; hipLaunchKernelGGL(fwd, dim3(grid), dim3(NTHR), LDS_BYTES, stream, a); }
#endif
}
```

```cpp
#define MK_ONE_LAUNCH 1
#define NSA_REF 0
#define DIL_REF 0
#define DUP_PH 0
#define CMP_REF 0
#define DIL_STAGGER 0
#define DIL_STREAM 1
#include <hip/hip_runtime.h>
#include <cstdio>
#include <cstdint>
#define XB_TMO      128
#define XB_XCNT(j)  (256  + 64 * (j))
#define XB_XSUB(j)  (1280 + 64 * (j))
#define XB_XGEN(j)  (2304 + 64 * (j))
#define XB_TOP      3328
#define XB_TOPGEN   3392
#define XCD_BAR_WORDS 3456
#define XB_SPIN_CAP (1u << 18)
#define LAS __attribute__((address_space(3)))

__device__ __forceinline__ unsigned xb_ld(unsigned* p)              { return __hip_atomic_load(p, __ATOMIC_RELAXED, __HIP_MEMORY_SCOPE_AGENT); }
__device__ __forceinline__ unsigned xb_add(unsigned* p, unsigned v) { return __hip_atomic_fetch_add(p, v, __ATOMIC_RELAXED, __HIP_MEMORY_SCOPE_AGENT); }
__device__ __forceinline__ unsigned xb_xcc_id() { return (unsigned)__builtin_amdgcn_s_getreg((3 << 11) | 20) & 0xFu; }
#define XB_SPIN(cond, bar) do { unsigned _sp = 0; while (cond) { __builtin_amdgcn_s_sleep(1); \
    if ((++_sp & 255u) == 0u) { if (xb_ld(&(bar)[XB_TMO])) break; if (_sp > XB_SPIN_CAP) { atomicAdd(&(bar)[XB_TMO], 1u); break; } } } } while (0)

struct XcdBarrier {
    unsigned* bar; unsigned x;
    volatile LAS unsigned* st;
};

__device__ __forceinline__ XcdBarrier xcd_barrier_post(unsigned* bar, volatile LAS unsigned* st) {
    XcdBarrier b; b.bar = bar; b.x = xb_xcc_id(); b.st = st;
    if (threadIdx.x == 0) (void)xb_add(&bar[XB_XCNT(b.x)], 1u);
    return b;
}
__device__ __forceinline__ void xcd_barrier_complete(unsigned* bar, unsigned x, unsigned& nloc, unsigned& nx) {
    const unsigned G = gridDim.x * gridDim.y * gridDim.z;
    unsigned sum, cnt, mine, sp = 0u;
    for (;;) {
        sum = 0u; cnt = 0u; mine = 0u;
#pragma unroll
        for (unsigned j = 0; j < 16; ++j) { const unsigned c = xb_ld(&bar[XB_XCNT(j)]); sum += c; cnt += (c > 0u) ? 1u : 0u; mine = (j == x) ? c : mine; }
        if (sum == G) break;
        __builtin_amdgcn_s_sleep(1);
        if ((++sp & 255u) == 0u) { if (xb_ld(&bar[XB_TMO])) break; if (sp > XB_SPIN_CAP) { atomicAdd(&bar[XB_TMO], 1u); break; } }
    }
    nloc = mine > 0u ? mine : 1u; nx = cnt > 0u ? cnt : 1u;
}

__device__ __forceinline__ void xcd_barrier(const XcdBarrier& b) {
    asm volatile("s_waitcnt vmcnt(0)" ::: "memory");
    __syncthreads();
    if (threadIdx.x == 0) {
        unsigned* bar = b.bar;
        __builtin_amdgcn_s_waitcnt(0);
        unsigned nloc = b.st[0], nx = b.st[1];
        if (nloc == 0u) { xcd_barrier_complete(bar, b.x, nloc, nx); b.st[0] = nloc; b.st[1] = nx; }
        const unsigned old = xb_add(&bar[XB_XSUB(b.x)], 1u);
        const unsigned gen = old / nloc;
        if (old + 1u == (gen + 1u) * nloc) {
            __builtin_amdgcn_fence(__ATOMIC_RELEASE, "agent");
            asm volatile("s_waitcnt vmcnt(0)" ::: "memory");
            const unsigned og = xb_add(&bar[XB_TOP], 1u);
            const unsigned tg = og / nx;
            if (og + 1u == (tg + 1u) * nx) xb_add(&bar[XB_TOPGEN], 1u);
            else XB_SPIN(xb_ld(&bar[XB_TOPGEN]) == tg, bar);
            __builtin_amdgcn_fence(__ATOMIC_ACQUIRE, "agent");
            xb_add(&bar[XB_XGEN(b.x)], 1u);
            asm volatile("s_waitcnt vmcnt(0)" ::: "memory");
        } else {
            XB_SPIN(xb_ld(&bar[XB_XGEN(b.x)]) == gen, bar);
            __builtin_amdgcn_fence(__ATOMIC_ACQUIRE, "agent");
            asm volatile("s_waitcnt vmcnt(0)" ::: "memory");
        }
    }
    __syncthreads();
}
namespace pg8 {
#define PG8_LAS __attribute__((address_space(3)))
typedef unsigned short bf16_t;
typedef short bf16x8 __attribute__((ext_vector_type(8)));
typedef float f32x4 __attribute__((ext_vector_type(4)));
typedef unsigned u32x4 __attribute__((ext_vector_type(4)));
constexpr int BM = 256, BK = 64, HALF = 128, HTB = HALF * BK * 2  , STAGE_BYTES = 8 * HTB, NXCD = 8, WGM = 8;

__host__ __device__ __forceinline__ int lds_byte(int r, int c) { const int st = (r >> 4) * 2 + (c >> 5), rr = r & 15, cc = c & 31, ob = rr * 64 + cc * 2; return st * 1024 + (ob ^ (((ob >> 9) & 1) << 5)); }
__host__ __device__ __forceinline__ void stage_rc(int b, int& R, int& C) { const int st = b / 1024, sb = b % 1024, swz = sb ^ (((sb >> 9) & 1) << 5); R = (st >> 1) * 16 + swz / 64; C = (st & 1) * 32 + (swz % 64) / 2; }
__host__ __device__ __forceinline__ int perm32(int rho) { const int n = rho >> 4, i = rho & 15; return 8 * (i >> 2) + 4 * n + (i & 3); }

struct Unit { int pm, pn; };
struct Gemm { const bf16_t* A; const bf16_t* Bt; int M, N, K; };

struct StaticOrder {
    int nM, nN, nwg, G, c;
    __host__ __device__ void init(int M, int N, int G_, int c_) { nM = M / BM; nN = N / BM; nwg = nM * nN; G = G_; c = c_; }
    __host__ __device__ bool next(int i, Unit& u) const {
        const long L = (long)i * G + c; if (L >= nwg) return false;
        int wgid = (int)L; { const int q = nwg / NXCD, r = nwg % NXCD, xcd = wgid % NXCD, off = wgid / NXCD; wgid = (xcd < r ? xcd * (q + 1) : r * (q + 1) + (xcd - r) * q) + off; }
        const int nig = WGM * nN, gid = wgid / nig, fm = gid * WGM, gsz = (nM - fm) < WGM ? (nM - fm) : WGM;
        u.pm = fm + ((wgid % nig) % gsz); u.pn = (wgid % nig) / gsz; return true;
    }
    __device__ __forceinline__ void a_ready(const Unit&) const {}
    __device__ __forceinline__ void done(const Unit&) const {}
};
struct CountedOrder : StaticOrder {
    const unsigned* ready; unsigned need; unsigned* tmo;
    __device__ __forceinline__ void a_ready(const Unit& u) const {
        if (threadIdx.x < 64) {
            const unsigned long long t0 = __builtin_amdgcn_s_memrealtime(); unsigned polls = 0;
            while ((unsigned)__builtin_amdgcn_readfirstlane(__hip_atomic_load(ready + 64 * u.pm, __ATOMIC_RELAXED, __HIP_MEMORY_SCOPE_AGENT)) < need) {
                if ((++polls & 255u) == 0u && __builtin_amdgcn_readfirstlane(__hip_atomic_load(tmo, __ATOMIC_RELAXED, __HIP_MEMORY_SCOPE_AGENT)) != 0u) break;
                if (__builtin_amdgcn_s_memrealtime() - t0 > 2000000ull) {
                    if (threadIdx.x == 0) { unsigned expect = 0u; __hip_atomic_compare_exchange_strong(tmo + 1, &expect, 0x600u | (unsigned)(u.pm & 0xff), __ATOMIC_RELAXED, __ATOMIC_RELAXED, __HIP_MEMORY_SCOPE_AGENT); __hip_atomic_store(tmo, 1u, __ATOMIC_RELAXED, __HIP_MEMORY_SCOPE_AGENT); }
                    break; }
                __builtin_amdgcn_s_sleep(2); }
            __builtin_amdgcn_fence(__ATOMIC_ACQUIRE, "agent");
            asm volatile("s_waitcnt vmcnt(0)" ::: "memory");
        }
#if !defined(BROKEN_HOOK_NO_BARRIER)
        asm volatile("" ::: "memory"); __builtin_amdgcn_s_barrier(); asm volatile("" ::: "memory");
#endif
    }
};

__device__ __forceinline__ unsigned cvt_pk_bf16(float lo, float hi) { unsigned r; asm volatile("v_cvt_pk_bf16_f32 %0, %1, %2" : "=v"(r) : "v"(lo), "v"(hi)); return r; }
typedef float f32x2 __attribute__((ext_vector_type(2)));
__device__ __forceinline__ f32x2 gelu_pk(f32x2 v) {
    const f32x2 av = __builtin_elementwise_abs(v), d = av * 0.2316418882f + 1.0f;
    f32x2 t; t.x = __builtin_amdgcn_rcpf(d.x); t.y = __builtin_amdgcn_rcpf(d.y);
    f32x2 q = t * 0.5307027145f + (-0.7265760135f); q = q * t + 0.7107068705f; q = q * t + (-0.142248368f); q = q * t + 0.127414796f; q = q * t;
    const f32x2 s = (v * v) * (-0.72134752044f);
    f32x2 e; e.x = __builtin_amdgcn_exp2f(s.x); e.y = __builtin_amdgcn_exp2f(s.y);
    const f32x2 m = v * (q * e), r = v - m;
    f32x2 o; o.x = v.x < 0.f ? m.x : r.x; o.y = v.y < 0.f ? m.y : r.y; return o;
}

struct EpiF32 {
    static constexpr bool PERM = false, AFTER_DRAIN = false;
    float* C; int ldc; const float* bias;
    __device__ __forceinline__ void operator()(const f32x4 (&acc)[2][2][4][2], const Unit& u, int wr, int wc, int fr, int fq) const {
        const int row0 = u.pm * BM + wr * 64 + fr, col0 = u.pn * BM + wc * 32 + 4 * fq;
        f32x4 bv[2][2];
#pragma unroll
        for (int bj = 0; bj < 2; ++bj)
#pragma unroll
            for (int n = 0; n < 2; ++n) bv[bj][n] = bias ? *(const f32x4*)(bias + col0 + bj * HALF + n * 16) : (f32x4){0.f, 0.f, 0.f, 0.f};
#pragma unroll
        for (int ai = 0; ai < 2; ++ai)
#pragma unroll
            for (int m = 0; m < 4; ++m) { float* rowp = C + (size_t)(row0 + ai * HALF + m * 16) * ldc + col0;
#pragma unroll
                for (int bj = 0; bj < 2; ++bj)
#pragma unroll
                    for (int n = 0; n < 2; ++n) *(f32x4*)(rowp + bj * HALF + n * 16) = acc[ai][bj][m][n] + bv[bj][n]; }
    }
};
template <int ACT  > struct EpiBf16 {
    static constexpr bool PERM = true, AFTER_DRAIN = false;
    bf16_t* O; int ldc; const float* bias; int split_cols; size_t split_stride;
    __device__ __forceinline__ void operator()(const f32x4 (&acc)[2][2][4][2], const Unit& u, int wr, int wc, int fr, int fq) const {
        const int row0 = u.pm * BM + wr * 64 + fr; int colt = u.pn * BM; bf16_t* base = O;
        if (split_cols) { const int t = colt / split_cols; base += (size_t)t * split_stride; colt -= t * split_cols; }
        const int col0 = colt + wc * 32 + 8 * fq, bcol0 = u.pn * BM + wc * 32 + 8 * fq;
        f32x4 bv[2][2];
#pragma unroll
        for (int bj = 0; bj < 2; ++bj)
#pragma unroll
            for (int n = 0; n < 2; ++n) bv[bj][n] = bias ? *(const f32x4*)(bias + bcol0 + bj * HALF + 4 * n) : (f32x4){0.f, 0.f, 0.f, 0.f};
#pragma unroll
        for (int ai = 0; ai < 2; ++ai)
#pragma unroll
            for (int m = 0; m < 4; ++m) { bf16_t* rowp = base + (size_t)(row0 + ai * HALF + m * 16) * ldc + col0;
#pragma unroll
                for (int bj = 0; bj < 2; ++bj) { f32x4 v0 = acc[ai][bj][m][0] + bv[bj][0], v1 = acc[ai][bj][m][1] + bv[bj][1];
                    if (ACT == 1) { f32x2 a = gelu_pk((f32x2){v0[0], v0[1]}), b = gelu_pk((f32x2){v0[2], v0[3]}), c = gelu_pk((f32x2){v1[0], v1[1]}), d = gelu_pk((f32x2){v1[2], v1[3]});
                        v0 = (f32x4){a.x, a.y, b.x, b.y}; v1 = (f32x4){c.x, c.y, d.x, d.y}; }
                    if (ACT == 2) {
#pragma unroll
                        for (int j = 0; j < 4; ++j) { v0[j] = 0.5f * v0[j] * (1.0f + erff(v0[j] * 0.70710678f)); v1[j] = 0.5f * v1[j] * (1.0f + erff(v1[j] * 0.70710678f)); } }
                    u32x4 w; w.x = cvt_pk_bf16(v0[0], v0[1]); w.y = cvt_pk_bf16(v0[2], v0[3]); w.z = cvt_pk_bf16(v1[0], v1[1]); w.w = cvt_pk_bf16(v1[2], v1[3]);
                    *(u32x4*)(rowp + bj * HALF) = w; } }
    }
};

template <class Epi, class Sched, bool STAMP = false>
__device__ __forceinline__ void gemm_phase(PG8_LAS unsigned char* lds, const Gemm g, const Sched& S, const Epi& E, unsigned long long* stamps) {
    const int tid = threadIdx.x, wid = __builtin_amdgcn_readfirstlane(tid >> 6), lane = tid & 63, wr = wid >> 2, wc = wid & 3, fr = lane & 15, fq = lane >> 4;
    const int K = g.K, nt = K / BK;
    int ts_lo = 0, ts_hi = 0, nts = 0; const unsigned long long rt_entry = STAMP ? (unsigned long long)wall_clock64() : 0ull;
#define PG8_STAMP() do { if (STAMP && wid == 0 && nts < 64) { const unsigned long long _c = (unsigned long long)clock64(); \
        ts_lo = (lane == nts) ? (int)(unsigned)_c : ts_lo; ts_hi = (lane == nts) ? (int)(unsigned)(_c >> 32) : ts_hi; ++nts; } } while (0)
    PG8_STAMP();
    unsigned voffA[2], voffB[2];
#pragma unroll
    for (int i = 0; i < 2; ++i) { int R, C; stage_rc(tid * 16 + i * 8192, R, C); const int Rb = Epi::PERM ? ((R & ~31) + perm32(R & 31)) : R;
        voffA[i] = (unsigned)(R * K + C) * 2u; voffB[i] = (unsigned)(Rb * K + C) * 2u; }
    const size_t kstep = (size_t)(BK * 2);
    const size_t hstep = (size_t)HALF * K * 2;
    const size_t tstep = 2 * hstep;
    const unsigned ldsw = (unsigned)wid * 1024u;
    const int aoff = lds_byte(wr * 64 + fr, fq * 8), boff = lds_byte(wc * 32 + fr, fq * 8);
#define PG8_SA(b, h) (((b) * 2 + (h)) * HTB)
#define PG8_SB(b, h) ((4 + (b) * 2 + (h)) * HTB)
#define PG8_STAGE(bufoff, gbase, voff) do { _Pragma("unroll") for (int _i = 0; _i < 2; ++_i) \
        __builtin_amdgcn_global_load_lds((const unsigned*)((const char*)(gbase) + (voff)[_i]), (PG8_LAS unsigned*)(lds + (bufoff) + ldsw + _i * 8192), 16, 0, 0); } while (0)
#define PG8_LDA(dst, b, h) do { _Pragma("unroll") for (int m = 0; m < 4; ++m) _Pragma("unroll") for (int k = 0; k < 2; ++k) dst[m][k] = *(const PG8_LAS bf16x8*)(lds + PG8_SA(b, h) + aoff + m * 2048 + k * 1024); } while (0)
#define PG8_LDB(dst, b, h) do { _Pragma("unroll") for (int n = 0; n < 2; ++n) _Pragma("unroll") for (int k = 0; k < 2; ++k) dst[n][k] = *(const PG8_LAS bf16x8*)(lds + PG8_SB(b, h) + boff + n * 2048 + k * 1024); } while (0)
#define PG8_MMA(ai, bj, At, Bt) do { __builtin_amdgcn_s_setprio(1); _Pragma("unroll") for (int m = 0; m < 4; ++m) _Pragma("unroll") for (int n = 0; n < 2; ++n) _Pragma("unroll") for (int k = 0; k < 2; ++k) \
        acc[ai][bj][m][n] = __builtin_amdgcn_mfma_f32_16x16x32_bf16(Bt[n][k], At[m][k], acc[ai][bj][m][n], 0, 0, 0); __builtin_amdgcn_s_setprio(0); } while (0)
#define PG8_WAIT_V(n) asm volatile("s_waitcnt vmcnt(" #n ")" ::: "memory")
#define PG8_WAIT_L(n) asm volatile("s_waitcnt lgkmcnt(" #n ")" ::: "memory")
#define PG8_BAR __builtin_amdgcn_s_barrier()
#define PG8_SCHED __builtin_amdgcn_sched_barrier(0)
    Unit cur, nxt; int ui = 0;
    if (!S.next(0, cur)) return;
    f32x4 acc[2][2][4][2];
#pragma unroll
    for (int a = 0; a < 2; ++a)
#pragma unroll
        for (int b = 0; b < 2; ++b)
#pragma unroll
            for (int m = 0; m < 4; ++m)
#pragma unroll
                for (int n = 0; n < 2; ++n) acc[a][b][m][n] = (f32x4){0.f, 0.f, 0.f, 0.f};
    bf16x8 At[4][2], B0[2][2], B1[2][2];
    const char* cA = (const char*)g.A + (size_t)cur.pm * tstep; const char* cB = (const char*)g.Bt + (size_t)cur.pn * tstep;
    S.a_ready(cur);
    PG8_STAGE(PG8_SB(0, 0), cB, voffB); PG8_STAGE(PG8_SA(0, 0), cA, voffA); PG8_STAGE(PG8_SB(0, 1), cB + hstep, voffB); PG8_STAGE(PG8_SA(0, 1), cA + hstep, voffA);
    if (wr == 1) PG8_BAR;
    PG8_WAIT_V(4); PG8_BAR;
    PG8_STAGE(PG8_SB(1, 0), cB + kstep, voffB); PG8_STAGE(PG8_SA(1, 0), cA + kstep, voffA); PG8_STAGE(PG8_SB(1, 1), cB + hstep + kstep, voffB);
    PG8_WAIT_V(6); PG8_BAR;
    PG8_STAMP();
    for (;;) {
        const bool has_next = S.next(ui + 1, nxt);
        const char* nA = has_next ? (const char*)g.A + (size_t)nxt.pm * tstep : cA; const char* nB = has_next ? (const char*)g.Bt + (size_t)nxt.pn * tstep : cB;
        for (int t = 0; t < nt; t += 2) {
            const bool last = (t == nt - 2);
            const char* a1 = cA + (size_t)(t + 1) * kstep;
            const char* a2 = last ? nA : cA + (size_t)(t + 2) * kstep; const char* b2 = last ? nB : cB + (size_t)(t + 2) * kstep;
            const char* a3 = a2 + kstep; const char* b3 = b2 + kstep;
            if (last && has_next) S.a_ready(nxt);
            PG8_LDB(B0, 0, 0); PG8_SCHED; PG8_LDA(At, 0, 0); PG8_STAGE(PG8_SA(1, 1), a1 + hstep, voffA);
            PG8_WAIT_L(8); PG8_BAR; PG8_WAIT_L(0); PG8_MMA(0, 0, At, B0); PG8_BAR; PG8_SCHED;
            PG8_LDB(B1, 0, 1); PG8_STAGE(PG8_SB(0, 0), b2, voffB);
            PG8_BAR; PG8_WAIT_L(0); PG8_MMA(0, 1, At, B1); PG8_BAR;
            PG8_LDA(At, 0, 1); PG8_STAGE(PG8_SA(0, 0), a2, voffA);
            PG8_BAR; PG8_WAIT_L(0); PG8_MMA(1, 0, At, B0); PG8_BAR; PG8_SCHED;
            PG8_STAGE(PG8_SB(0, 1), b2 + hstep, voffB);
            PG8_WAIT_V(6); PG8_BAR; PG8_MMA(1, 1, At, B1); PG8_BAR;
            PG8_LDB(B0, 1, 0); PG8_SCHED; PG8_LDA(At, 1, 0); PG8_STAGE(PG8_SA(0, 1), a2 + hstep, voffA);
            PG8_WAIT_L(8); PG8_BAR; PG8_WAIT_L(0); PG8_MMA(0, 0, At, B0); PG8_BAR; PG8_SCHED;
            PG8_LDB(B1, 1, 1); PG8_STAGE(PG8_SB(1, 0), b3, voffB);
            PG8_BAR; PG8_WAIT_L(0); PG8_MMA(0, 1, At, B1); PG8_BAR;
            PG8_LDA(At, 1, 1); PG8_STAGE(PG8_SA(1, 0), a3, voffA);
            PG8_BAR; PG8_WAIT_L(0); PG8_MMA(1, 0, At, B0); PG8_BAR; PG8_SCHED;
            PG8_STAGE(PG8_SB(1, 1), b3 + hstep, voffB);
            PG8_WAIT_V(6); PG8_BAR; PG8_MMA(1, 1, At, B1); PG8_BAR;
        }
        PG8_STAMP();
        if constexpr (!Epi::AFTER_DRAIN) { E(acc, cur, wr, wc, fr, fq); S.done(cur); }
        PG8_STAMP();
        if (!has_next) break;
#pragma unroll
        for (int a = 0; a < 2; ++a)
#pragma unroll
            for (int b = 0; b < 2; ++b)
#pragma unroll
                for (int m = 0; m < 4; ++m)
#pragma unroll
                    for (int n = 0; n < 2; ++n) acc[a][b][m][n] = (f32x4){0.f, 0.f, 0.f, 0.f};
        cur = nxt; cA = nA; cB = nB; ++ui;
    }
    PG8_WAIT_V(0);
    if (wr == 0) PG8_BAR;
    PG8_BAR;
    if constexpr (Epi::AFTER_DRAIN) { E.fused(acc, cur, wr, wc, fr, fq, lds, wid, lane); S.done(cur); }
    PG8_STAMP();
    if (STAMP && wid == 0) { stamps[lane] = lane < nts ? (((unsigned long long)(unsigned)ts_hi << 32) | (unsigned)ts_lo) : 0ull;
        if (lane == 62) stamps[62] = rt_entry; if (lane == 63) stamps[63] = (unsigned long long)wall_clock64(); }
#undef PG8_STAMP
#undef PG8_SA
#undef PG8_SB
#undef PG8_STAGE
#undef PG8_LDA
#undef PG8_LDB
#undef PG8_MMA
#undef PG8_WAIT_V
#undef PG8_WAIT_L
#undef PG8_BAR
#undef PG8_SCHED
}
template <class Epi, class Sched, bool STAMP = false>
__device__ __forceinline__ void gemm_phase_g(const int* rowmap, PG8_LAS unsigned char* lds, const Gemm g, const Sched& S, const Epi& E, unsigned long long* stamps) {
    const int tid = threadIdx.x, wid = __builtin_amdgcn_readfirstlane(tid >> 6), lane = tid & 63, wr = wid >> 2, wc = wid & 3, fr = lane & 15, fq = lane >> 4;
    const int K = g.K, nt = K / BK;
    int ts_lo = 0, ts_hi = 0, nts = 0; const unsigned long long rt_entry = STAMP ? (unsigned long long)wall_clock64() : 0ull;
#define PG8_STAMP() do { if (STAMP && wid == 0 && nts < 64) { const unsigned long long _c = (unsigned long long)clock64(); \
        ts_lo = (lane == nts) ? (int)(unsigned)_c : ts_lo; ts_hi = (lane == nts) ? (int)(unsigned)(_c >> 32) : ts_hi; ++nts; } } while (0)
    PG8_STAMP();
    unsigned voffB[2], cpartA[2]; int rowA[2];
#pragma unroll
    for (int i = 0; i < 2; ++i) { int R, C; stage_rc(tid * 16 + i * 8192, R, C); const int Rb = Epi::PERM ? ((R & ~31) + perm32(R & 31)) : R;
        rowA[i] = R; cpartA[i] = (unsigned)C * 2u; voffB[i] = (unsigned)(Rb * K + C) * 2u; }
    unsigned cvoff[2][2], nvoff[2][2];
#define PG8_ROWS(dst, u_) do { _Pragma("unroll") for (int h_ = 0; h_ < 2; ++h_) _Pragma("unroll") for (int i_ = 0; i_ < 2; ++i_) { \
        const int tok_ = __hip_atomic_load(rowmap + (u_).pm * 256 + h_ * 128 + rowA[i_], __ATOMIC_RELAXED, __HIP_MEMORY_SCOPE_AGENT); dst[h_][i_] = (unsigned)tok_ * (unsigned)(K * 2) + cpartA[i_]; } } while (0)
    const size_t kstep = (size_t)(BK * 2);
    const size_t hstep = (size_t)HALF * K * 2;
    const size_t tstep = 2 * hstep;
    const unsigned ldsw = (unsigned)wid * 1024u;
    const int aoff = lds_byte(wr * 64 + fr, fq * 8), boff = lds_byte(wc * 32 + fr, fq * 8);
#define PG8_SA(b, h) (((b) * 2 + (h)) * HTB)
#define PG8_SB(b, h) ((4 + (b) * 2 + (h)) * HTB)
#define PG8_STAGE(bufoff, gbase, voff) do { _Pragma("unroll") for (int _i = 0; _i < 2; ++_i) \
        __builtin_amdgcn_global_load_lds((const unsigned*)((const char*)(gbase) + (voff)[_i]), (PG8_LAS unsigned*)(lds + (bufoff) + ldsw + _i * 8192), 16, 0, 0); } while (0)
#define PG8_LDA(dst, b, h) do { _Pragma("unroll") for (int m = 0; m < 4; ++m) _Pragma("unroll") for (int k = 0; k < 2; ++k) dst[m][k] = *(const PG8_LAS bf16x8*)(lds + PG8_SA(b, h) + aoff + m * 2048 + k * 1024); } while (0)
#define PG8_LDB(dst, b, h) do { _Pragma("unroll") for (int n = 0; n < 2; ++n) _Pragma("unroll") for (int k = 0; k < 2; ++k) dst[n][k] = *(const PG8_LAS bf16x8*)(lds + PG8_SB(b, h) + boff + n * 2048 + k * 1024); } while (0)
#define PG8_MMA(ai, bj, At, Bt) do { __builtin_amdgcn_s_setprio(1); _Pragma("unroll") for (int m = 0; m < 4; ++m) _Pragma("unroll") for (int n = 0; n < 2; ++n) _Pragma("unroll") for (int k = 0; k < 2; ++k) \
        acc[ai][bj][m][n] = __builtin_amdgcn_mfma_f32_16x16x32_bf16(Bt[n][k], At[m][k], acc[ai][bj][m][n], 0, 0, 0); __builtin_amdgcn_s_setprio(0); } while (0)
#define PG8_WAIT_V(n) asm volatile("s_waitcnt vmcnt(" #n ")" ::: "memory")
#define PG8_WAIT_L(n) asm volatile("s_waitcnt lgkmcnt(" #n ")" ::: "memory")
#define PG8_BAR __builtin_amdgcn_s_barrier()
#define PG8_SCHED __builtin_amdgcn_sched_barrier(0)
    Unit cur, nxt; int ui = 0;
    if (!S.next(0, cur)) return;
    f32x4 acc[2][2][4][2];
#pragma unroll
    for (int a = 0; a < 2; ++a)
#pragma unroll
        for (int b = 0; b < 2; ++b)
#pragma unroll
            for (int m = 0; m < 4; ++m)
#pragma unroll
                for (int n = 0; n < 2; ++n) acc[a][b][m][n] = (f32x4){0.f, 0.f, 0.f, 0.f};
    bf16x8 At[4][2], B0[2][2], B1[2][2];
    const char* gA0 = (const char*)g.A; const char* cB = (const char*)g.Bt + (size_t)cur.pn * tstep;
    S.a_ready(cur);
    PG8_ROWS(cvoff, cur);
    PG8_STAGE(PG8_SB(0, 0), cB, voffB); PG8_STAGE(PG8_SA(0, 0), gA0, cvoff[0]); PG8_STAGE(PG8_SB(0, 1), cB + hstep, voffB); PG8_STAGE(PG8_SA(0, 1), gA0, cvoff[1]);
    if (wr == 1) PG8_BAR;
    PG8_WAIT_V(4); PG8_BAR;
    PG8_STAGE(PG8_SB(1, 0), cB + kstep, voffB); PG8_STAGE(PG8_SA(1, 0), gA0 + kstep, cvoff[0]); PG8_STAGE(PG8_SB(1, 1), cB + hstep + kstep, voffB);
    PG8_WAIT_V(6); PG8_BAR;
    PG8_STAMP();
    for (;;) {
        const bool has_next = S.next(ui + 1, nxt);
        const char* nB = has_next ? (const char*)g.Bt + (size_t)nxt.pn * tstep : cB;
        if (has_next) PG8_ROWS(nvoff, nxt); else { nvoff[0][0] = cvoff[0][0]; nvoff[0][1] = cvoff[0][1]; nvoff[1][0] = cvoff[1][0]; nvoff[1][1] = cvoff[1][1]; }
        for (int t = 0; t < nt; t += 2) {
            const bool last = (t == nt - 2);
            const char* a1 = gA0 + (size_t)(t + 1) * kstep;
            const char* a2 = last ? gA0 : gA0 + (size_t)(t + 2) * kstep; const char* b2 = last ? nB : cB + (size_t)(t + 2) * kstep;
            const char* a3 = a2 + kstep; const char* b3 = b2 + kstep;
            unsigned v2[2][2];
#pragma unroll
            for (int h_ = 0; h_ < 2; ++h_) { v2[h_][0] = last ? nvoff[h_][0] : cvoff[h_][0]; v2[h_][1] = last ? nvoff[h_][1] : cvoff[h_][1]; }
            if (last && has_next) S.a_ready(nxt);
            PG8_LDB(B0, 0, 0); PG8_SCHED; PG8_LDA(At, 0, 0); PG8_STAGE(PG8_SA(1, 1), a1, cvoff[1]);
            PG8_WAIT_L(8); PG8_BAR; PG8_WAIT_L(0); PG8_MMA(0, 0, At, B0); PG8_BAR; PG8_SCHED;
            PG8_LDB(B1, 0, 1); PG8_STAGE(PG8_SB(0, 0), b2, voffB);
            PG8_BAR; PG8_WAIT_L(0); PG8_MMA(0, 1, At, B1); PG8_BAR;
            PG8_LDA(At, 0, 1); PG8_STAGE(PG8_SA(0, 0), a2, v2[0]);
            PG8_BAR; PG8_WAIT_L(0); PG8_MMA(1, 0, At, B0); PG8_BAR; PG8_SCHED;
            PG8_STAGE(PG8_SB(0, 1), b2 + hstep, voffB);
            PG8_WAIT_V(6); PG8_BAR; PG8_MMA(1, 1, At, B1); PG8_BAR;
            PG8_LDB(B0, 1, 0); PG8_SCHED; PG8_LDA(At, 1, 0); PG8_STAGE(PG8_SA(0, 1), a2, v2[1]);
            PG8_WAIT_L(8); PG8_BAR; PG8_WAIT_L(0); PG8_MMA(0, 0, At, B0); PG8_BAR; PG8_SCHED;
            PG8_LDB(B1, 1, 1); PG8_STAGE(PG8_SB(1, 0), b3, voffB);
            PG8_BAR; PG8_WAIT_L(0); PG8_MMA(0, 1, At, B1); PG8_BAR;
            PG8_LDA(At, 1, 1); PG8_STAGE(PG8_SA(1, 0), a3, v2[0]);
            PG8_BAR; PG8_WAIT_L(0); PG8_MMA(1, 0, At, B0); PG8_BAR; PG8_SCHED;
            PG8_STAGE(PG8_SB(1, 1), b3 + hstep, voffB);
            PG8_WAIT_V(6); PG8_BAR; PG8_MMA(1, 1, At, B1); PG8_BAR;
        }
        PG8_STAMP();
        if constexpr (!Epi::AFTER_DRAIN) { E(acc, cur, wr, wc, fr, fq); S.done(cur); }
        PG8_STAMP();
        if (!has_next) break;
#pragma unroll
        for (int a = 0; a < 2; ++a)
#pragma unroll
            for (int b = 0; b < 2; ++b)
#pragma unroll
                for (int m = 0; m < 4; ++m)
#pragma unroll
                    for (int n = 0; n < 2; ++n) acc[a][b][m][n] = (f32x4){0.f, 0.f, 0.f, 0.f};
        cur = nxt; cB = nB; ++ui; cvoff[0][0] = nvoff[0][0]; cvoff[0][1] = nvoff[0][1]; cvoff[1][0] = nvoff[1][0]; cvoff[1][1] = nvoff[1][1];
    }
    PG8_WAIT_V(0);
    if (wr == 0) PG8_BAR;
    PG8_BAR;
    if constexpr (Epi::AFTER_DRAIN) { E.fused(acc, cur, wr, wc, fr, fq, lds, wid, lane); S.done(cur); }
    PG8_STAMP();
    if (STAMP && wid == 0) { stamps[lane] = lane < nts ? (((unsigned long long)(unsigned)ts_hi << 32) | (unsigned)ts_lo) : 0ull;
        if (lane == 62) stamps[62] = rt_entry; if (lane == 63) stamps[63] = (unsigned long long)wall_clock64(); }
#undef PG8_STAMP
#undef PG8_ROWS
#undef PG8_SA
#undef PG8_SB
#undef PG8_STAGE
#undef PG8_LDA
#undef PG8_LDB
#undef PG8_MMA
#undef PG8_WAIT_V
#undef PG8_WAIT_L
#undef PG8_BAR
#undef PG8_SCHED
}
}

#define LDSP __attribute__((address_space(3)))
typedef unsigned short bf16_t;
typedef float f32x4 __attribute__((ext_vector_type(4)));
typedef float f32x2 __attribute__((ext_vector_type(2)));
typedef unsigned u32x4 __attribute__((ext_vector_type(4)));
typedef unsigned u32x2 __attribute__((ext_vector_type(2)));

constexpr int T_ = 16384, D_ = 2048, S_ = 2048, B_ = 8;
constexpr int PW0 = 5376, PW1 = 14336, DE = 1408, CAP = 36864, MODW = 12288;
constexpr int NTHR = 512, NWAVE = 8;
constexpr int LDS_BYTES = 147456;
constexpr int LDS_MISC = 131072;

constexpr size_t al256(size_t x) { return (x + 255) & ~(size_t)255; }
constexpr size_t WS_BAR     = 0;
constexpr size_t WS_CTL_END = 16384;
constexpr size_t WS_TAB     = WS_CTL_END;
constexpr size_t WS_BLKCNT  = WS_TAB + 1024;
constexpr size_t WS_MOD     = al256(WS_BLKCNT + 256 * 16 * 4);
constexpr size_t WS_RIDX    = al256(WS_MOD + (size_t)2 * 8 * MODW * 4);
constexpr size_t WS_RW      = al256(WS_RIDX + (size_t)T_ * 2 * 4);
constexpr size_t WS_TOKSLOT = al256(WS_RW + (size_t)T_ * 2 * 4);
constexpr size_t WS_SLOTW   = al256(WS_TOKSLOT + (size_t)T_ * 2 * 4);
constexpr size_t WS_SLOTTOK = al256(WS_SLOTW + (size_t)CAP * 4);
constexpr size_t WS_SEL     = al256(WS_SLOTTOK + (size_t)CAP * 4);
constexpr size_t WS_CMP     = al256(WS_SEL + (size_t)8 * 4 * 2048 * 4);
constexpr size_t WS_LSE     = al256(WS_CMP + (size_t)2 * 8 * 128 * 4 * 128 * 4);
constexpr size_t WS_WNSAIN  = al256(WS_LSE + (size_t)3 * T_ * 16 * 4);
constexpr size_t WS_WNSAOUT = al256(WS_WNSAIN + (size_t)PW0 * D_ * 2);
constexpr size_t WS_WDILIN  = al256(WS_WNSAOUT + (size_t)D_ * D_ * 2);
constexpr size_t WS_WDILOUT = al256(WS_WDILIN + (size_t)PW1 * D_ * 2);
constexpr size_t WS_WE1     = al256(WS_WDILOUT + (size_t)D_ * D_ * 2);
constexpr size_t WS_WE2     = al256(WS_WE1 + (size_t)16 * 2816 * D_ * 2);
constexpr size_t WS_X       = al256(WS_WE2 + (size_t)16 * D_ * DE * 2);
constexpr size_t WS_H       = al256(WS_X + (size_t)T_ * D_ * 2);
constexpr size_t WS_O       = al256(WS_H + (size_t)T_ * D_ * 2);
constexpr size_t WS_PROJ    = al256(WS_O + (size_t)T_ * D_ * 2);
constexpr size_t WS_XIN     = WS_PROJ;
constexpr size_t WS_HID     = al256(WS_XIN + (size_t)CAP * D_ * 2);
constexpr size_t WS_YO      = al256(WS_HID + (size_t)CAP * DE * 2);
constexpr size_t WS_OG      = al256(WS_PROJ + (size_t)T_ * PW1 * 2);
constexpr size_t WS_ACC     = WS_OG;
constexpr size_t WS_CMPB    = al256(WS_OG + (size_t)3 * T_ * D_ * 2);
constexpr size_t WS_W1T     = al256(WS_CMPB + (size_t)2 * 8 * 128 * 4 * 128 * 2);
constexpr size_t WS_POSB    = al256(WS_W1T + (size_t)2 * 128 * 4096 * 2);
constexpr size_t WS_END     = al256(WS_POSB + 2 * 32 * 128 * 4);
static_assert(WS_END < (size_t)1560000000, "workspace budget");
static_assert(WS_YO + (size_t)CAP * D_ * 2 <= WS_END, "moe buffers must fit inside the proj region");

__device__ __forceinline__ float bf2f(bf16_t v) { return __uint_as_float(((unsigned)v) << 16); }
__device__ __forceinline__ bf16_t f2bf(float f) { unsigned u = __float_as_uint(f); u += 0x7FFFu + ((u >> 16) & 1u); return (bf16_t)(u >> 16); }
__device__ __forceinline__ unsigned pk2(float lo, float hi) { return (unsigned)f2bf(lo) | ((unsigned)f2bf(hi) << 16); }
__device__ __forceinline__ int ld_i(const int* p) { return __hip_atomic_load(p, __ATOMIC_RELAXED, __HIP_MEMORY_SCOPE_AGENT); }
__device__ __forceinline__ float ld_f(const float* p) { return __hip_atomic_load(p, __ATOMIC_RELAXED, __HIP_MEMORY_SCOPE_AGENT); }
__device__ __forceinline__ float wsum(float v) { for (int o = 32; o >= 1; o >>= 1) v += __shfl_xor(v, o); return v; }
__device__ __forceinline__ float wmax(float v) { for (int o = 32; o >= 1; o >>= 1) v = fmaxf(v, __shfl_xor(v, o)); return v; }
__device__ __forceinline__ void lds_fence() { asm volatile("s_waitcnt lgkmcnt(0)" ::: "memory"); }

struct Args { const float* in[19]; float* out; unsigned char* ws; int ph_lo, ph_hi; };
struct Ctx {
    const Args& A; unsigned char* ws;
    LDSP unsigned char* lds;
    int tid, lane, wave, G, bid;
};
__device__ __forceinline__ Ctx fresh(const Ctx& c0) {
    int l = (int)__builtin_amdgcn_mbcnt_hi(~0u, __builtin_amdgcn_mbcnt_lo(~0u, 0u)); asm volatile("" : "+v"(l));
    const int t = c0.wave * 64 + l;
    Ctx c{c0.A, c0.ws, c0.lds, t, l, c0.wave, c0.G, c0.bid};
    return c;
}

__device__ __forceinline__ void mod_units(const Ctx& c) {
    if (c.bid >= 192) {
        {
            const int i = c.bid - 192, j = i & 1, p = i >> 1, e = c.tid & 127, q = c.tid >> 7;
            LDSP float* red = (LDSP float*)c.lds;
            const float* w1 = c.A.in[8] + ((size_t)j * 4096 + p * 128 + q * 32) * 128 + e; const float* pos = c.A.in[10] + j * 4096 + p * 128 + q * 32;
            float s = 0.f;
#pragma unroll
            for (int k = 0; k < 32; ++k) s += pos[k] * w1[(size_t)k * 128];
            red[q * 128 + e] = s;
            __syncthreads();
            if (c.tid < 128) ((float*)(c.ws + WS_POSB))[(j * 32 + p) * 128 + c.tid] = red[c.tid] + red[128 + c.tid] + red[256 + c.tid] + red[384 + c.tid];
        }
        return;
    }
    LDSP float* cs = (LDSP float*)c.lds;
    LDSP float* red = (LDSP float*)(c.lds + 65536);
    const float* cin = c.A.in[1];
    for (int i = c.tid; i < 8 * 2048; i += NTHR) { const float v = cin[i]; cs[i] = v / (1.f + __expf(-v)); }
    __syncthreads();
    float* MOD = (float*)(c.ws + WS_MOD);
    for (int u = c.bid; u < 192; u += c.G) {
        const int layer = u / 96, cb = (u % 96) * 128;
        const int c4 = c.tid & 31, kc = c.tid >> 5;
        f32x4 acc[8];
#pragma unroll
        for (int b = 0; b < 8; ++b) acc[b] = (f32x4){0.f, 0.f, 0.f, 0.f};
        const float* wp = c.A.in[2] + ((size_t)layer * 2048 + kc * 128) * MODW + cb + 4 * c4;
        for (int k0 = 0; k0 < 128; k0 += 8) {
            f32x4 w[8];
#pragma unroll
            for (int q = 0; q < 8; ++q) w[q] = __builtin_nontemporal_load((const f32x4*)(wp + (size_t)(k0 + q) * MODW));
#pragma unroll
            for (int q = 0; q < 8; ++q) { const int k = kc * 128 + k0 + q;
#pragma unroll
                for (int b = 0; b < 8; ++b) acc[b] += cs[b * 2048 + k] * w[q]; }
        }
#pragma unroll
        for (int b = 0; b < 8; ++b) *(LDSP f32x4*)(red + (kc * 8 + b) * 128 + 4 * c4) = acc[b];
        __syncthreads();
        for (int idx = c.tid; idx < 1024; idx += NTHR) {
            const int b = idx >> 7, col = idx & 127; float s = c.A.in[3][layer * MODW + cb + col];
#pragma unroll
            for (int q = 0; q < 16; ++q) s += red[(q * 8 + b) * 128 + col];
            MOD[((size_t)layer * 8 + b) * MODW + cb + col] = s;
        }
        __syncthreads();
    }
}

__device__ __forceinline__ void tr_tile(const float* src, int ld, int nvalid, bf16_t* dst, int dld, LDSP float* tile, int lane) {
    const int cq = (lane & 15) * 4, r4 = lane >> 4;
    f32x4 v[16];
#pragma unroll
    for (int i = 0; i < 16; ++i) {
        const int k = i * 4 + r4;
        if (cq < nvalid) v[i] = __builtin_nontemporal_load((const f32x4*)(src + (size_t)k * ld + cq)); else v[i] = (f32x4){0.f, 0.f, 0.f, 0.f};
    }
#pragma unroll
    for (int i = 0; i < 16; ++i) {
        const int k = i * 4 + r4;
        tile[k * 65 + cq + 0] = v[i][0]; tile[k * 65 + cq + 1] = v[i][1]; tile[k * 65 + cq + 2] = v[i][2]; tile[k * 65 + cq + 3] = v[i][3];
    }
    lds_fence();
    const int k8 = (lane & 7) * 8, rr = lane >> 3;
#pragma unroll
    for (int i = 0; i < 8; ++i) {
        const int r = i * 8 + rr;
        u32x4 w;
        w.x = pk2(tile[(k8 + 0) * 65 + r], tile[(k8 + 1) * 65 + r]); w.y = pk2(tile[(k8 + 2) * 65 + r], tile[(k8 + 3) * 65 + r]);
        w.z = pk2(tile[(k8 + 4) * 65 + r], tile[(k8 + 5) * 65 + r]); w.w = pk2(tile[(k8 + 6) * 65 + r], tile[(k8 + 7) * 65 + r]);
        *(u32x4*)(dst + (size_t)r * dld + k8) = w;
    }
    lds_fence();
}
__device__ __forceinline__ void tr_matrix(const Ctx& c, const float* W, int K, int N, int nrows, bf16_t* Wt) {
    LDSP float* tile = (LDSP float*)(c.lds + c.wave * 16640);
    const int nrt = nrows / 64, nkt = K / 64, nw = c.G * NWAVE;
    for (int t = c.bid * NWAVE + c.wave; t < nrt * nkt; t += nw) {
        const int rt = t % nrt, kt = t / nrt;
        int nv = N - rt * 64; nv = nv > 64 ? 64 : (nv < 0 ? 0 : nv);
        tr_tile(W + (size_t)kt * 64 * N + rt * 64, N, nv, Wt + (size_t)rt * 64 * K + kt * 64, K, tile, c.lane);
    }
}
constexpr int TRX_WE1 = 16 * 2 * 32 * 22, TRX_ALL = TRX_WE1 + 16 * 22 * 32;
__device__ __forceinline__ void tr_experts(const Ctx& c, int layer, int lo, int hi, int gw, int nw) {
    LDSP float* tile = (LDSP float*)(c.lds + c.wave * 16640);
    bf16_t* WE1 = (bf16_t*)(c.ws + WS_WE1); bf16_t* WE2 = (bf16_t*)(c.ws + WS_WE2);
    for (int tt = lo + gw; tt < hi; tt += nw) {
        if (tt < TRX_WE1) {
            const int t = tt, ct = t % 22, kt = (t / 22) % 32, half = (t / 704) & 1, e = t / 1408;
            const float* W = (half ? c.A.in[17] : c.A.in[16]) + (size_t)(layer * 16 + e) * D_ * DE;
            const int j = ct >> 1, rt = ct & 1;
            tr_tile(W + (size_t)kt * 64 * DE + ct * 64, DE, 64, WE1 + ((size_t)e * 2816 + j * 256 + half * 128 + rt * 64) * D_ + kt * 64, D_, tile, c.lane);
        } else {
            const int t = tt - TRX_WE1, rt = t % 32, kt = (t / 32) % 22, e = t / 704;
            const float* W = c.A.in[18] + (size_t)(layer * 16 + e) * DE * D_;
            tr_tile(W + (size_t)kt * 64 * D_ + rt * 64, D_, 64, WE2 + ((size_t)e * 2048 + rt * 64) * DE + kt * 64, DE, tile, c.lane);
        }
    }
}
constexpr int TRX_T0 = 11264;
constexpr int TRX_T1 = 8192;

struct RouteOut { int i0, i1; float w0, w1; };
__device__ __forceinline__ RouteOut route16(const float (&lg)[16], const float* rb) {
    float sc[16], bi[16];
#pragma unroll
    for (int e = 0; e < 16; ++e) { sc[e] = 1.f / (1.f + __expf(-lg[e])); bi[e] = sc[e] + rb[e]; }
    float gs[4];
#pragma unroll
    for (int g = 0; g < 4; ++g) {
        float m1 = bi[4 * g], m2 = -3.0e38f;
#pragma unroll
        for (int i = 1; i < 4; ++i) { const float v = bi[4 * g + i]; if (v > m1) { m2 = m1; m1 = v; } else if (v > m2) m2 = v; }
        gs[g] = m1 + m2;
    }
    int bg = 0; float bv = gs[0];
#pragma unroll
    for (int g = 1; g < 4; ++g) if (gs[g] > bv) { bv = gs[g]; bg = g; }
    float cb[4], cs[4];
#pragma unroll
    for (int i = 0; i < 4; ++i) { cb[i] = bg == 0 ? bi[i] : bg == 1 ? bi[4 + i] : bg == 2 ? bi[8 + i] : bi[12 + i]; cs[i] = bg == 0 ? sc[i] : bg == 1 ? sc[4 + i] : bg == 2 ? sc[8 + i] : sc[12 + i]; }
    int a0 = 0; float v0 = cb[0], s0 = cs[0];
#pragma unroll
    for (int i = 1; i < 4; ++i) if (cb[i] > v0) { v0 = cb[i]; a0 = i; s0 = cs[i]; }
    int a1 = -1; float v1 = -3.0e38f, s1 = 0.f;
#pragma unroll
    for (int i = 0; i < 4; ++i) if (i != a0 && cb[i] > v1) { v1 = cb[i]; a1 = i; s1 = cs[i]; }
    RouteOut r; r.i0 = bg * 4 + a0; r.i1 = bg * 4 + a1; const float s = s0 + s1; r.w0 = s0 / s; r.w1 = s1 / s; return r;
}

__device__ __forceinline__ f32x4 up4(u32x2 a) { f32x4 y; y[0] = __uint_as_float(a.x << 16); y[1] = __uint_as_float(a.x & 0xffff0000u); y[2] = __uint_as_float(a.y << 16); y[3] = __uint_as_float(a.y & 0xffff0000u); return y; }
template <int MODE> struct RowRaw { f32x4 xf[MODE == 0 ? 8 : 1]; u32x2 xb[MODE == 0 ? 1 : 8]; u32x2 ya[MODE >= 2 ? 8 : 1], yb[MODE >= 2 ? 8 : 1]; };
template <int MODE>
__device__ __forceinline__ void norm_load(RowRaw<MODE>& R, const void* xsrc_, const bf16_t* YO, int row, int s0, int s1, int lane) {
#pragma unroll
    for (int i = 0; i < 8; ++i) {
        if (MODE == 0) R.xf[i] = *(const f32x4*)((const float*)xsrc_ + (size_t)row * D_ + i * 256 + lane * 4);
        else R.xb[i] = *(const u32x2*)((const bf16_t*)xsrc_ + (size_t)row * D_ + i * 256 + lane * 4);
        if (MODE >= 2) { R.ya[i] = *(const u32x2*)(YO + (size_t)s0 * D_ + i * 256 + lane * 4); R.yb[i] = *(const u32x2*)(YO + (size_t)s1 * D_ + i * 256 + lane * 4); }
    }
}
template <int MODE>
__device__ __forceinline__ void norm_phase(const Ctx& c, const void* xsrc_, bf16_t* xdst, const float* gain, const float* msh, const float* msc, const float* mgf, bf16_t* hdst) {
    LDSP float* rwT = (LDSP float*)c.lds;
    LDSP int* cnt = (LDSP int*)(c.lds + LDS_MISC);
    if (MODE == 1) {
        const float* rw = c.A.in[14];
        for (int i0 = c.tid; i0 < 32768; i0 += NTHR * 16) {
            float t_[16];
#pragma unroll
            for (int k = 0; k < 16; ++k) t_[k] = rw[i0 + k * NTHR];
#pragma unroll
            for (int k = 0; k < 16; ++k) { const int i = i0 + k * NTHR; rwT[(i & 15) * 2048 + (i >> 4)] = t_[k]; }
        }
        if (c.tid < 16) cnt[c.tid] = 0;
        __syncthreads();
    }
    const int nw = c.G * NWAVE, gw = c.bid * NWAVE + c.wave, lane = c.lane;
    const bf16_t* YO = (const bf16_t*)(c.ws + WS_YO);
    const int* TOKSLOT = (const int*)(c.ws + WS_TOKSLOT);
    int sl0[8], sl1[8];
#pragma unroll
    for (int k = 0; k < 8; ++k) { sl0[k] = 0; sl1[k] = 0; if (MODE >= 2) { const int r_ = gw + k * nw; if (r_ < T_) { sl0[k] = ld_i(TOKSLOT + r_ * 2); sl1[k] = ld_i(TOKSLOT + r_ * 2 + 1); } } }
    RowRaw<MODE> cur, nxt;
    if (gw < T_) norm_load<MODE>(cur, xsrc_, YO, gw, sl0[0], sl1[0], lane);
    int kk = 0;
    for (int row = gw; row < T_; row += nw, ++kk) {
        const int b = row >> 11;
        {
            const int rn = row + nw; int n0 = 0, n1 = 0;
            if (MODE >= 2) {
                if (kk + 1 < 8) {
#pragma unroll
                    for (int k = 1; k < 8; ++k) if (k == kk + 1) { n0 = sl0[k]; n1 = sl1[k]; }
                } else if (rn < T_) { n0 = ld_i(TOKSLOT + rn * 2); n1 = ld_i(TOKSLOT + rn * 2 + 1); }
            }
            if (rn < T_) norm_load<MODE>(nxt, xsrc_, YO, rn, n0, n1, lane);
        }
        f32x4 v[8];
#pragma unroll
        for (int i = 0; i < 8; ++i) { if (MODE == 0) v[i] = cur.xf[i]; else v[i] = up4(cur.xb[i]); }
        if (MODE >= 2) {
            f32x4 mg[8];
#pragma unroll
            for (int i = 0; i < 8; ++i) mg[i] = *(const f32x4*)(mgf + (size_t)b * MODW + i * 256 + lane * 4);
            asm volatile("" ::: "memory");
#pragma unroll
            for (int i = 0; i < 8; ++i) {
                const f32x4 y = up4(cur.ya[i]) + up4(cur.yb[i]);
                v[i] += mg[i] * y;
                if (MODE == 2) { u32x2 w; w.x = pk2(v[i][0], v[i][1]); w.y = pk2(v[i][2], v[i][3]); *(u32x2*)(xdst + (size_t)row * D_ + i * 256 + lane * 4) = w; }
            }
        }
        float ss = 0.f;
#pragma unroll
        for (int i = 0; i < 8; ++i) ss += v[i][0] * v[i][0] + v[i][1] * v[i][1] + v[i][2] * v[i][2] + v[i][3] * v[i][3];
        ss = wsum(ss);
        const float rinv = 1.0f / sqrtf(ss * (1.0f / 2048.0f) + 1e-6f);
        f32x4 ga[8];
#pragma unroll
        for (int i = 0; i < 8; ++i) ga[i] = *(const f32x4*)(gain + i * 256 + lane * 4);
        if (MODE == 3) {
            asm volatile("" ::: "memory");
#pragma unroll
            for (int i = 0; i < 8; ++i) *(f32x4*)(c.A.out + (size_t)row * D_ + i * 256 + lane * 4) = v[i] * rinv * ga[i];
        } else {
            f32x4 sha[8], sca[8];
#pragma unroll
            for (int i = 0; i < 8; ++i) { sha[i] = *(const f32x4*)(msh + (size_t)b * MODW + i * 256 + lane * 4); sca[i] = *(const f32x4*)(msc + (size_t)b * MODW + i * 256 + lane * 4); }
            asm volatile("" ::: "memory");
#pragma unroll
            for (int i = 0; i < 8; ++i) {
                const f32x4 g = ga[i], sh = sha[i], sc = sca[i];
                v[i] = (v[i] * rinv * g) * (1.0f + sc) + sh;
                u32x2 w; w.x = pk2(v[i][0], v[i][1]); w.y = pk2(v[i][2], v[i][3]);
                *(u32x2*)(hdst + (size_t)row * D_ + i * 256 + lane * 4) = w;
            }
            if (MODE == 1) {
                float pa_[16];
                f32x4 rA[8], rB[8];
#define RT_RD(dst, e_) do { _Pragma("unroll") for (int i = 0; i < 8; ++i) dst[i] = *(LDSP f32x4*)(rwT + (e_) * 2048 + i * 256 + lane * 4); asm volatile("" ::: "memory"); } while (0)
#define RT_DOT(src, e_) do { float a = 0.f; _Pragma("unroll") for (int i = 0; i < 8; ++i) a += v[i][0] * src[i][0] + v[i][1] * src[i][1] + v[i][2] * src[i][2] + v[i][3] * src[i][3]; pa_[e_] = a; } while (0)
                RT_RD(rA, 0);
#pragma unroll
                for (int e = 0; e < 16; e += 2) { RT_RD(rB, e + 1); RT_DOT(rA, e); if (e + 2 < 16) RT_RD(rA, e + 2); RT_DOT(rB, e + 1); }
#undef RT_RD
#undef RT_DOT
                float lg[16];
                { const bool b5 = lane & 32, b4 = lane & 16, b3 = lane & 8, b2 = lane & 4;
                  float b_[8], c_[4], d_[2];
#pragma unroll
                  for (int i = 0; i < 8; ++i) { const float snd = b5 ? pa_[i] : pa_[i + 8]; b_[i] = (b5 ? pa_[i + 8] : pa_[i]) + __shfl_xor(snd, 32); }
#pragma unroll
                  for (int i = 0; i < 4; ++i) { const float snd = b4 ? b_[i] : b_[i + 4]; c_[i] = (b4 ? b_[i + 4] : b_[i]) + __shfl_xor(snd, 16); }
#pragma unroll
                  for (int i = 0; i < 2; ++i) { const float snd = b3 ? c_[i] : c_[i + 2]; d_[i] = (b3 ? c_[i + 2] : c_[i]) + __shfl_xor(snd, 8); }
                  float e_ = (b2 ? d_[1] : d_[0]) + __shfl_xor(b2 ? d_[0] : d_[1], 4);
                  e_ += __shfl_xor(e_, 2); e_ += __shfl_xor(e_, 1);
#pragma unroll
                  for (int e = 0; e < 16; ++e) lg[e] = __int_as_float(__builtin_amdgcn_readlane(__float_as_int(e_), 4 * e)); }
                const RouteOut r = route16(lg, c.A.in[15]);
                if (lane == 0) {
                    int* RIDX = (int*)(c.ws + WS_RIDX); float* RW = (float*)(c.ws + WS_RW);
                    RIDX[row * 2] = r.i0; RIDX[row * 2 + 1] = r.i1; RW[row * 2] = r.w0; RW[row * 2 + 1] = r.w1;
                    atomicAdd((int*)(cnt + r.i0), 1); atomicAdd((int*)(cnt + r.i1), 1);
                }
            }
        }
        cur = nxt;
    }
    if (MODE == 1) {
        __syncthreads();
        if (c.tid < 16) ((int*)(c.ws + WS_BLKCNT))[c.bid * 16 + c.tid] = cnt[c.tid];
    }
}

__device__ __forceinline__ void dispatch_phase(const Ctx& c) {
    LDSP int* tot = (LDSP int*)c.lds;
    LDSP int* pre = tot + 16;
    LDSP int* start = tot + 32;
    LDSP int* pstart = tot + 48;
    LDSP int* ea = tot + 80;
    LDSP int* sl = tot + 208;
    if (c.tid < 32) tot[c.tid] = 0;
    __syncthreads();
    const int* BLKCNT = (const int*)(c.ws + WS_BLKCNT);
    for (int idx = c.tid; idx < c.G * 16; idx += NTHR) {
        const int v = ld_i(BLKCNT + idx), e = idx & 15, bl = idx >> 4;
        atomicAdd((int*)(tot + e), v); if (bl < c.bid) atomicAdd((int*)(pre + e), v);
    }
    __syncthreads();
    if (c.tid == 0) {
        int run = 0;
        for (int e = 0; e < 16; ++e) { pstart[e] = run; start[e] = run + pre[e]; run += (tot[e] + 255) / 256 * 256; }
        pstart[16] = run;
    }
    __syncthreads();
    if (c.bid == 0 && c.tid < 17) ((int*)(c.ws + WS_TAB))[c.tid] = pstart[c.tid] >> 8;
    const int* RIDX = (const int*)(c.ws + WS_RIDX); const float* RW = (const float*)(c.ws + WS_RW);
    const int nw = c.G * NWAVE;
    if (c.tid < 128) { const int a = c.tid, wv = a >> 4, i = (a >> 1) & 7, k = a & 1; const int row = (c.bid * NWAVE + wv) + i * nw; ea[a] = ld_i(RIDX + row * 2 + k); }
    __syncthreads();
    if (c.tid < 128) {
        const int a = c.tid, wv = a >> 4, i = (a >> 1) & 7, k = a & 1; const int row = (c.bid * NWAVE + wv) + i * nw;
        const int e = ea[a]; int rank = 0;
        for (int j = 0; j < a; ++j) rank += (ea[j] == e) ? 1 : 0;
        const int slot = start[e] + rank; sl[a] = slot;
        ((int*)(c.ws + WS_TOKSLOT))[row * 2 + k] = slot;
        ((float*)(c.ws + WS_SLOTW))[slot] = ld_f(RW + row * 2 + k);
        ((int*)(c.ws + WS_SLOTTOK))[slot] = row;
    }
    if (c.bid == 0) {
        for (int e = 0; e < 16; ++e) for (int s = pstart[e] + tot[e] + c.tid; s < pstart[e + 1]; s += NTHR) { ((float*)(c.ws + WS_SLOTW))[s] = 0.f; ((int*)(c.ws + WS_SLOTTOK))[s] = 0; }
    }
}

template <bool BASE_F32> struct EpiResid {
    static constexpr bool PERM = true, AFTER_DRAIN = false;
    const void* base; bf16_t* out; const float* gate;
    __device__ __forceinline__ void operator()(const pg8::f32x4 (&acc)[2][2][4][2], const pg8::Unit& u, int wr, int wc, int fr, int fq) const {
        const int row0 = u.pm * 256 + wr * 64 + fr, col0 = u.pn * 256 + wc * 32 + 8 * fq, b = u.pm >> 3;
        pg8::f32x4 gv[2][2];
#pragma unroll
        for (int bj = 0; bj < 2; ++bj)
#pragma unroll
            for (int n = 0; n < 2; ++n) gv[bj][n] = *(const pg8::f32x4*)(gate + (size_t)b * MODW + col0 + bj * 128 + n * 4);
#pragma unroll
        for (int ai = 0; ai < 2; ++ai) {
            pg8::f32x4 b0[4][2], b1[4][2];
#pragma unroll
            for (int m = 0; m < 4; ++m) { const size_t off = (size_t)(row0 + ai * 128 + m * 16) * D_ + col0;
#pragma unroll
                for (int bj = 0; bj < 2; ++bj) {
                    if (BASE_F32) { b0[m][bj] = *(const pg8::f32x4*)((const float*)base + off + bj * 128); b1[m][bj] = *(const pg8::f32x4*)((const float*)base + off + bj * 128 + 4); }
                    else { const pg8::u32x4 w = *(const pg8::u32x4*)((const bf16_t*)base + off + bj * 128);
                        b0[m][bj] = (pg8::f32x4){__uint_as_float(w.x << 16), __uint_as_float(w.x & 0xffff0000u), __uint_as_float(w.y << 16), __uint_as_float(w.y & 0xffff0000u)};
                        b1[m][bj] = (pg8::f32x4){__uint_as_float(w.z << 16), __uint_as_float(w.z & 0xffff0000u), __uint_as_float(w.w << 16), __uint_as_float(w.w & 0xffff0000u)}; } } }
            asm volatile("" ::: "memory");
#pragma unroll
            for (int m = 0; m < 4; ++m) { const size_t off = (size_t)(row0 + ai * 128 + m * 16) * D_ + col0;
#pragma unroll
                for (int bj = 0; bj < 2; ++bj) {
                    const pg8::f32x4 v0 = b0[m][bj] + gv[bj][0] * acc[ai][bj][m][0], v1 = b1[m][bj] + gv[bj][1] * acc[ai][bj][m][1];
                    pg8::u32x4 q; q.x = pg8::cvt_pk_bf16(v0[0], v0[1]); q.y = pg8::cvt_pk_bf16(v0[2], v0[3]); q.z = pg8::cvt_pk_bf16(v1[0], v1[1]); q.w = pg8::cvt_pk_bf16(v1[2], v1[3]);
                    *(pg8::u32x4*)(out + off + bj * 128) = q; } }
            asm volatile("" ::: "memory");
        }
    }
};
struct EpiDilProj {
    static constexpr bool PERM = true, AFTER_DRAIN = false;
    bf16_t* O;
    __device__ __forceinline__ void operator()(const pg8::f32x4 (&acc)[2][2][4][2], const pg8::Unit& u, int wr, int wc, int fr, int fq) const {
        const int sec = u.pn >> 3, b = u.pm >> 3, lg = sec < 3 ? 0 : (sec < 5 ? 2 : 4), d = wc * 32 + 8 * fq;
        const int t0 = (u.pm & 7) * 256 + wr * 64 + fr;
#pragma unroll
        for (int ai = 0; ai < 2; ++ai)
#pragma unroll
            for (int m = 0; m < 4; ++m) { const int t = t0 + ai * 128 + m * 16; const int pos = ((t & ((1 << lg) - 1)) << (11 - lg)) + (t >> lg);
#pragma unroll
                for (int bj = 0; bj < 2; ++bj) { const int h = (u.pn & 7) * 2 + bj;
                    const pg8::f32x4 v0 = acc[ai][bj][m][0], v1 = acc[ai][bj][m][1];
                    pg8::u32x4 w; w.x = pg8::cvt_pk_bf16(v0[0], v0[1]); w.y = pg8::cvt_pk_bf16(v0[2], v0[3]); w.z = pg8::cvt_pk_bf16(v1[0], v1[1]); w.w = pg8::cvt_pk_bf16(v1[2], v1[3]);
                    *(pg8::u32x4*)(O + ((((size_t)sec * 8 + b) * 16 + h) * 2048 + pos) * 128 + d) = w; } }
    }
};
struct EpiSwiglu {
    static constexpr bool PERM = true, AFTER_DRAIN = false;
    bf16_t* Hd;
    __device__ __forceinline__ void operator()(const pg8::f32x4 (&acc)[2][2][4][2], const pg8::Unit& u, int wr, int wc, int fr, int fq) const {
        const int row0 = u.pm * 256 + wr * 64 + fr, j = u.pn % 11, col = j * 128 + wc * 32 + 8 * fq;
#pragma unroll
        for (int ai = 0; ai < 2; ++ai)
#pragma unroll
            for (int m = 0; m < 4; ++m) {
                float o[8];
#pragma unroll
                for (int n = 0; n < 2; ++n)
#pragma unroll
                    for (int i = 0; i < 4; ++i) { const float g = acc[ai][0][m][n][i], up = acc[ai][1][m][n][i]; o[n * 4 + i] = g / (1.f + __expf(-g)) * up; }
                pg8::u32x4 w; w.x = pg8::cvt_pk_bf16(o[0], o[1]); w.y = pg8::cvt_pk_bf16(o[2], o[3]); w.z = pg8::cvt_pk_bf16(o[4], o[5]); w.w = pg8::cvt_pk_bf16(o[6], o[7]);
                *(pg8::u32x4*)(Hd + (size_t)(row0 + ai * 128 + m * 16) * DE + col) = w;
            }
    }
};
struct EpiDown {
    static constexpr bool PERM = true, AFTER_DRAIN = false;
    bf16_t* Y; const float* sw;
    __device__ __forceinline__ void operator()(const pg8::f32x4 (&acc)[2][2][4][2], const pg8::Unit& u, int wr, int wc, int fr, int fq) const {
        const int row0 = u.pm * 256 + wr * 64 + fr, col0 = (u.pn & 7) * 256 + wc * 32 + 8 * fq;
        float wv[2][4];
#pragma unroll
        for (int ai = 0; ai < 2; ++ai)
#pragma unroll
            for (int m = 0; m < 4; ++m) wv[ai][m] = sw[row0 + ai * 128 + m * 16];
        asm volatile("" ::: "memory");
#pragma unroll
        for (int ai = 0; ai < 2; ++ai)
#pragma unroll
            for (int m = 0; m < 4; ++m) { const int row = row0 + ai * 128 + m * 16; const float w = wv[ai][m];
#pragma unroll
                for (int bj = 0; bj < 2; ++bj) { const pg8::f32x4 v0 = acc[ai][bj][m][0] * w, v1 = acc[ai][bj][m][1] * w;
                    pg8::u32x4 q; q.x = pg8::cvt_pk_bf16(v0[0], v0[1]); q.y = pg8::cvt_pk_bf16(v0[2], v0[3]); q.z = pg8::cvt_pk_bf16(v1[0], v1[1]); q.w = pg8::cvt_pk_bf16(v1[2], v1[3]);
                    *(pg8::u32x4*)(Y + (size_t)row * D_ + col0 + bj * 128) = q; } }
    }
};
struct MoeOrder {
    LDSP const int* bs;
    int G, vc, ncol;
    __device__ __forceinline__ bool next(int i, pg8::Unit& u) const {
        const int L = i * G + vc; if (L >= bs[16] * ncol) return false;
        int e = 0;
#pragma unroll
        for (int k = 1; k < 16; ++k) e += (L >= bs[k] * ncol) ? 1 : 0;
        const int b0 = bs[e], nb = bs[e + 1] - b0, r = L - b0 * ncol;
        const int j = r / nb, bi = r - j * nb;
        u.pm = b0 + bi; u.pn = e * ncol + j; return true;
    }
    __device__ __forceinline__ void a_ready(const pg8::Unit&) const {}
    __device__ __forceinline__ void done(const pg8::Unit&) const {}
};
__device__ __forceinline__ void moe_tab_to_lds(const Ctx& c) {
    LDSP int* bs = (LDSP int*)(c.lds + LDS_MISC);
    if (c.tid < 17) bs[c.tid] = ld_i((const int*)(c.ws + WS_TAB) + c.tid);
    __syncthreads();
}

__device__ __forceinline__ float gelu_tanh(float x) { const float u = 0.7978845608028654f * (x + 0.044715f * x * x * x); return 0.5f * x * (1.f + tanhf(u)); }
__device__ __forceinline__ void compress_phase(const Ctx& c) {
    LDSP float* tok = (LDSP float*)c.lds;
    LDSP float* pos = (LDSP float*)(c.lds + 73728);
    LDSP float* part = (LDSP float*)(c.lds + 73728 + 16384);
    LDSP float* hid = (LDSP float*)(c.lds + 73728 + 32768);
    const bf16_t* proj = (const bf16_t*)(c.ws + WS_PROJ);
    float* CMP = (float*)(c.ws + WS_CMP);
    for (int uu = c.bid; uu < (DUP_PH == 103 ? 2048 : 1024); uu += c.G) {
        const int u = uu & 1023, ch = u & 15, j = (u >> 4) & 1, g = (u >> 5) & 3, b = u >> 7, n0 = ch * 8;
        for (int idx = c.tid; idx < 144 * 16; idx += NTHR) {
            const int tl = idx >> 4, d8 = (idx & 15) * 8, t = n0 * 16 + tl;
            u32x4 w = (u32x4){0u, 0u, 0u, 0u};
            if (t < S_) w = *(const u32x4*)(proj + (size_t)(b * S_ + t) * PW0 + 2048 + j * 512 + g * 128 + d8);
            LDSP float* dp = tok + tl * 128 + d8;
            dp[0] = __uint_as_float(w.x << 16); dp[1] = __uint_as_float(w.x & 0xffff0000u); dp[2] = __uint_as_float(w.y << 16); dp[3] = __uint_as_float(w.y & 0xffff0000u);
            dp[4] = __uint_as_float(w.z << 16); dp[5] = __uint_as_float(w.z & 0xffff0000u); dp[6] = __uint_as_float(w.w << 16); dp[7] = __uint_as_float(w.w & 0xffff0000u);
        }
        for (int idx = c.tid; idx < 4096; idx += NTHR) pos[idx] = c.A.in[10][j * 4096 + idx];
        __syncthreads();
        const int e = c.tid & 127, q = c.tid >> 7;
        float acc[8];
#pragma unroll
        for (int i = 0; i < 8; ++i) acc[i] = 0.f;
        const float* w1 = c.A.in[8] + (size_t)j * 32 * 128 * 128;
        for (int l = q * 8; l < q * 8 + 8; ++l) {
#pragma unroll 4
            for (int d = 0; d < 128; ++d) {
                const float w = w1[((size_t)l * 128 + d) * 128 + e]; const float p = pos[l * 128 + d];
#pragma unroll
                for (int i = 0; i < 8; ++i) acc[i] += (tok[(16 * i + l) * 128 + d] + p) * w;
            }
        }
#pragma unroll
        for (int i = 0; i < 8; ++i) part[(q * 8 + i) * 128 + e] = acc[i];
        __syncthreads();
        for (int idx = c.tid; idx < 1024; idx += NTHR) { const int i = idx >> 7, ee = idx & 127; hid[idx] = gelu_tanh(part[(0 * 8 + i) * 128 + ee] + part[(1 * 8 + i) * 128 + ee] + part[(2 * 8 + i) * 128 + ee] + part[(3 * 8 + i) * 128 + ee]); }
        __syncthreads();
        const float* w2 = c.A.in[9] + (size_t)j * 128 * 128;
        for (int idx = c.tid; idx < 1024; idx += NTHR) {
            const int i = idx >> 7, f = idx & 127, n = n0 + i; float s = 0.f;
            for (int ee = 0; ee < 128; ++ee) s += hid[i * 128 + ee] * w2[ee * 128 + f];
            if (n < 127) CMP[((((size_t)j * 8 + b) * 128 + n) * 4 + g) * 128 + f] = s;
            ((bf16_t*)(c.ws + WS_CMPB))[((((size_t)j * 8 + b) * 128 + n) * 4 + g) * 128 + f] = (n < 127) ? f2bf(s) : (bf16_t)0;
        }
        __syncthreads();
    }
}

__device__ __forceinline__ void compress_mfma_phase(const Ctx& c) {
    typedef short bf16x8 __attribute__((ext_vector_type(8)));
    LDSP char* lds = (LDSP char*)c.lds;
    LDSP float* red = (LDSP float*)c.lds;
    LDSP float* hid = (LDSP float*)(c.lds + 69632);
    const bf16_t* proj = (const bf16_t*)(c.ws + WS_PROJ);
    const bf16_t* W1T = (const bf16_t*)(c.ws + WS_W1T);
    const float* POSB = (const float*)(c.ws + WS_POSB);
    float* CMP = (float*)(c.ws + WS_CMP); bf16_t* CMPB = (bf16_t*)(c.ws + WS_CMPB);
    const int lane = c.lane, wid = c.wave;
    for (int uu = c.bid; uu < (DUP_PH == 103 ? 1024 : 512); uu += c.G) {
        const int u = uu & 511, nb = u & 7, j = (u >> 3) & 1, g = (u >> 4) & 3, b = u >> 6, n0 = nb * 16;
        __syncthreads();
        for (int idx = c.tid; idx < 272 * 16; idx += NTHR) {
            const int tl = idx >> 4, ch = idx & 15, t = n0 * 16 + tl;
            u32x4 w = (u32x4){0u, 0u, 0u, 0u};
            if (t < S_) w = *(const u32x4*)(proj + (size_t)(b * S_ + t) * PW0 + 2048 + j * 512 + g * 128 + ch * 8);
            *(LDSP u32x4*)(lds + tl * 256 + ((ch ^ ((tl >> 4) & 15)) << 4)) = w;
        }
        __syncthreads();
        f32x4 acc[8];
#pragma unroll
        for (int cb = 0; cb < 8; ++cb) acc[cb] = (f32x4){0.f, 0.f, 0.f, 0.f};
        const int r = lane & 15, kg = lane >> 4;
        const bf16_t* wb = W1T + ((size_t)(j * 128 + r) * 4096 + kg * 8);
#pragma unroll 2
        for (int s = 0; s < 16; ++s) {
            const int ks = wid * 16 + s, l = ks >> 2, ch = (ks & 3) * 4 + kg, tl = 16 * r + l;
            const bf16x8 a = *(LDSP const bf16x8*)(lds + tl * 256 + ((ch ^ ((tl >> 4) & 15)) << 4));
            bf16x8 bf[8];
#pragma unroll
            for (int cb = 0; cb < 8; ++cb) bf[cb] = *(const bf16x8*)(wb + (size_t)cb * 16 * 4096 + ks * 32);
#pragma unroll
            for (int cb = 0; cb < 8; ++cb) acc[cb] = __builtin_amdgcn_mfma_f32_16x16x32_bf16(a, bf[cb], acc[cb], 0, 0, 0);
        }
        __syncthreads();
#pragma unroll
        for (int cb = 0; cb < 8; ++cb)
#pragma unroll
            for (int i = 0; i < 4; ++i) red[(wid * 16 + kg * 4 + i) * 128 + cb * 16 + r] = acc[cb][i];
        __syncthreads();
        { const int row = c.tid >> 5, e4 = (c.tid & 31) * 4;
          f32x4 s = (f32x4){0.f, 0.f, 0.f, 0.f};
#pragma unroll 8
          for (int p = 0; p < 32; ++p) s += *(const f32x4*)(POSB + (j * 32 + p) * 128 + e4);
#pragma unroll
          for (int w = 0; w < 8; ++w) s += *(LDSP const f32x4*)(red + (w * 16 + row) * 128 + e4);
          f32x4 h; h[0] = gelu_tanh(s[0]); h[1] = gelu_tanh(s[1]); h[2] = gelu_tanh(s[2]); h[3] = gelu_tanh(s[3]);
          *(LDSP f32x4*)(hid + row * 128 + e4) = h; }
        __syncthreads();
        { const int row = c.tid >> 5, f4 = (c.tid & 31) * 4, n = n0 + row;
          const float* w2 = c.A.in[9] + (size_t)j * 128 * 128 + f4;
          f32x4 s = (f32x4){0.f, 0.f, 0.f, 0.f};
#pragma unroll 8
          for (int e = 0; e < 128; ++e) s += hid[row * 128 + e] * *(const f32x4*)(w2 + e * 128);
          const size_t o = ((((size_t)j * 8 + b) * 128 + n) * 4 + g) * 128 + f4;
          if (n < 127) *(f32x4*)(CMP + o) = s; else s = (f32x4){0.f, 0.f, 0.f, 0.f};
          u32x2 w; w.x = pk2(s[0], s[1]); w.y = pk2(s[2], s[3]); *(u32x2*)(CMPB + o) = w; }
    }
}

__device__ __forceinline__ void dots_bf16(const bf16_t* krow, bool ok, LDSP const float* qs, float (&s)[4]) {
    s[0] = s[1] = s[2] = s[3] = 0.f;
    if (!ok) return;
#pragma unroll 4
    for (int d8 = 0; d8 < 16; ++d8) {
        const u32x4 w = *(const u32x4*)(krow + d8 * 8);
        float k[8] = {__uint_as_float(w.x << 16), __uint_as_float(w.x & 0xffff0000u), __uint_as_float(w.y << 16), __uint_as_float(w.y & 0xffff0000u),
                      __uint_as_float(w.z << 16), __uint_as_float(w.z & 0xffff0000u), __uint_as_float(w.w << 16), __uint_as_float(w.w & 0xffff0000u)};
#pragma unroll
        for (int h = 0; h < 4; ++h) {
            const f32x4 qa = *(LDSP const f32x4*)(qs + h * 128 + d8 * 8), qb = *(LDSP const f32x4*)(qs + h * 128 + d8 * 8 + 4);
            s[h] += k[0] * qa[0] + k[1] * qa[1] + k[2] * qa[2] + k[3] * qa[3] + k[4] * qb[0] + k[5] * qb[1] + k[6] * qb[2] + k[7] * qb[3];
        }
    }
}
__device__ __forceinline__ void online_tile(const float (&s)[4], const bool valid, float (&m)[4], float (&l)[4], f32x2 (&acc)[4], LDSP float* pl,
                                            const bf16_t* vbase, size_t vstride, int kcount, int lane) {
#pragma unroll
    for (int h = 0; h < 4; ++h) {
        const float sv = valid ? s[h] : -__builtin_inff();
        const float tm = wmax(sv); const float mn = fmaxf(m[h], tm);
        float alpha = 1.f, p = 0.f;
        if (mn > -__builtin_inff()) { alpha = __expf(m[h] - mn); p = valid ? __expf(sv - mn) : 0.f; }
        l[h] = l[h] * alpha + wsum(p); acc[h] *= alpha; m[h] = mn;
        pl[h * 64 + lane] = p;
    }
    lds_fence();
    for (int k = 0; k < kcount; ++k) {
        const unsigned w = *(const unsigned*)(vbase + (size_t)k * vstride + 2 * lane);
        const f32x2 v = {__uint_as_float(w << 16), __uint_as_float(w & 0xffff0000u)};
#pragma unroll
        for (int h = 0; h < 4; ++h) acc[h] += pl[h * 64 + k] * v;
    }
    lds_fence();
}
__device__ __forceinline__ void nsa_attn_ref_phase(const Ctx& c) {
    LDSP float* wl = (LDSP float*)(c.lds + c.wave * 8192);
    LDSP float* qs = wl;
    LDSP float* pl = wl + 512;
    LDSP float* ps = wl + 1024;
    const bf16_t* proj = (const bf16_t*)(c.ws + WS_PROJ);
    const float* CMP = (const float*)(c.ws + WS_CMP);
    bf16_t* O = (bf16_t*)(c.ws + WS_O);
    const int lane = c.lane, nw = c.G * NWAVE;
    const float scale = 0.08838834764831845f;
    for (int u = c.bid * NWAVE + c.wave; u < B_ * S_ * 4; u += nw) {
        const int g = u & 3, t = (u >> 2) & 2047, b = u >> 13;
        const bf16_t* prow = proj + (size_t)(b * S_ + t) * PW0;
        { const u32x4 w = *(const u32x4*)(prow + g * 512 + lane * 8); LDSP float* qd = qs + lane * 8;
          qd[0] = __uint_as_float(w.x << 16) * scale; qd[1] = __uint_as_float(w.x & 0xffff0000u) * scale; qd[2] = __uint_as_float(w.y << 16) * scale; qd[3] = __uint_as_float(w.y & 0xffff0000u) * scale;
          qd[4] = __uint_as_float(w.z << 16) * scale; qd[5] = __uint_as_float(w.z & 0xffff0000u) * scale; qd[6] = __uint_as_float(w.w << 16) * scale; qd[7] = __uint_as_float(w.w & 0xffff0000u) * scale; }
        lds_fence();
        float slope[4], gate[4][3];
#pragma unroll
        for (int h = 0; h < 4; ++h) { slope[h] = exp2f(-0.5f * (float)(4 * g + h + 1));
#pragma unroll
            for (int j = 0; j < 3; ++j) { const float x = bf2f(prow[5120 + (4 * g + h) * 3 + j]); gate[h][j] = 1.f / (1.f + __expf(-x)); } }
        f32x2 ofin[4];
        {
            float s0[4], s1[4]; bool v0, v1;
            { const int n = lane; v0 = (16 * n + 31 <= t); const float* kp = CMP + (((size_t)b * 128 + n) * 4 + g) * 128;
              s0[0] = s0[1] = s0[2] = s0[3] = 0.f;
              if (v0) for (int d = 0; d < 128; d += 4) { const f32x4 k = *(const f32x4*)(kp + d);
#pragma unroll
                  for (int h = 0; h < 4; ++h) { const f32x4 q = *(LDSP const f32x4*)(qs + h * 128 + d); s0[h] += k[0] * q[0] + k[1] * q[1] + k[2] * q[2] + k[3] * q[3]; } } }
            { const int n = lane + 64; v1 = (n < 127) && (16 * n + 31 <= t); const float* kp = CMP + (((size_t)b * 128 + n) * 4 + g) * 128;
              s1[0] = s1[1] = s1[2] = s1[3] = 0.f;
              if (v1) for (int d = 0; d < 128; d += 4) { const f32x4 k = *(const f32x4*)(kp + d);
#pragma unroll
                  for (int h = 0; h < 4; ++h) { const f32x4 q = *(LDSP const f32x4*)(qs + h * 128 + d); s1[h] += k[0] * q[0] + k[1] * q[1] + k[2] * q[2] + k[3] * q[3]; } } }
            float psum0 = 0.f, psum1 = 0.f;
#pragma unroll
            for (int h = 0; h < 4; ++h) {
                const float a0 = v0 ? s0[h] - slope[h] * ((float)t - (16.f * lane + 15.5f)) : -__builtin_inff();
                const float a1 = v1 ? s1[h] - slope[h] * ((float)t - (16.f * (lane + 64) + 15.5f)) : -__builtin_inff();
                const float mx = wmax(fmaxf(a0, a1));
                const float e0 = v0 ? __expf(a0 - mx) : 0.f, e1 = v1 ? __expf(a1 - mx) : 0.f;
                const float sum = wsum(e0 + e1), inv = 1.f / fmaxf(sum, 1e-30f);
                const float p0 = e0 * inv, p1 = e1 * inv;
                pl[h * 128 + lane] = p0; pl[h * 128 + 64 + lane] = p1; psum0 += p0; psum1 += p1;
            }
            ps[1 + lane] = psum0; ps[65 + lane] = psum1; if (lane == 0) { ps[0] = 0.f; ps[129] = 0.f; }
            lds_fence();
            f32x2 acc[4];
#pragma unroll
            for (int h = 0; h < 4; ++h) acc[h] = (f32x2){0.f, 0.f};
            const int nvis = t >= 31 ? ((t - 31) >> 4) + 1 : 0;
            const float* vp = CMP + ((((size_t)8 + b) * 128) * 4 + g) * 128 + 2 * lane;
            for (int n = 0; n < nvis; ++n) { const f32x2 v = *(const f32x2*)(vp + (size_t)n * 512);
#pragma unroll
                for (int h = 0; h < 4; ++h) acc[h] += pl[h * 128 + n] * v; }
#pragma unroll
            for (int h = 0; h < 4; ++h) ofin[h] = gate[h][0] * acc[h];
        }
        unsigned selmask;
        {
            const int j = lane & 31, cur = t >> 6;
            const float imp = ps[4 * j] + 2.f * (ps[1 + 4 * j] + ps[2 + 4 * j] + ps[3 + 4 * j]) + ps[4 + 4 * j];
            const bool forced = (j == 0) || (j == cur) || (j == cur - 1), causal = (64 * j <= t);
            const float score = forced ? 1.0e6f : (causal ? imp : -1.0f);
            int rank = 0;
            for (int i = 0; i < 32; ++i) { const float si = __shfl(score, i); rank += ((si > score) || (si == score && i < j)) ? 1 : 0; }
            selmask = (unsigned)__ballot(rank < 16 && lane < 32);
            if (lane == 0) ((unsigned*)(c.ws + WS_SEL))[((size_t)b * 4 + g) * 2048 + t] = selmask;
        }
        lds_fence();
        {
            float m[4], l[4]; f32x2 acc[4];
#pragma unroll
            for (int h = 0; h < 4; ++h) { m[h] = -__builtin_inff(); l[h] = 0.f; acc[h] = (f32x2){0.f, 0.f}; }
            for (int j = 0; j < 32; ++j) {
                if (!((selmask >> j) & 1u)) continue;
                if (64 * j > t) continue;
                const int kpos = 64 * j + lane, dist = t - kpos; const bool valid = dist >= 0;
                const bf16_t* kb = proj + (size_t)(b * S_ + kpos) * PW0 + 2048 + 1024 + g * 128;
                float s[4]; dots_bf16(kb, valid, qs, s);
#pragma unroll
                for (int h = 0; h < 4; ++h) s[h] -= slope[h] * (float)dist;
                online_tile(s, valid, m, l, acc, pl, proj + (size_t)(b * S_ + 64 * j) * PW0 + 2048 + 1536 + g * 128, PW0, min(64, t - 64 * j + 1), lane);
            }
#pragma unroll
            for (int h = 0; h < 4; ++h) ofin[h] += (gate[h][1] / l[h]) * acc[h];
        }
        {
            float m[4], l[4]; f32x2 acc[4];
#pragma unroll
            for (int h = 0; h < 4; ++h) { m[h] = -__builtin_inff(); l[h] = 0.f; acc[h] = (f32x2){0.f, 0.f}; }
            for (int i = 0; i < 8; ++i) {
                const int k0 = t - 511 + 64 * i; if (k0 + 63 < 0) continue;
                const int kpos = k0 + lane, dist = t - kpos; const bool valid = kpos >= 0;
                const bf16_t* kb = proj + (size_t)(b * S_ + (valid ? kpos : 0)) * PW0 + 2048 + 2048 + g * 128;
                float s[4]; dots_bf16(kb, valid, qs, s);
#pragma unroll
                for (int h = 0; h < 4; ++h) s[h] -= slope[h] * (float)dist;
                const int kfirst = k0 < 0 ? -k0 : 0;
#pragma unroll
                for (int h = 0; h < 4; ++h) {
                    const float sv = valid ? s[h] : -__builtin_inff();
                    const float tm = wmax(sv); const float mn = fmaxf(m[h], tm);
                    float alpha = 1.f, p = 0.f;
                    if (mn > -__builtin_inff()) { alpha = __expf(m[h] - mn); p = valid ? __expf(sv - mn) : 0.f; }
                    l[h] = l[h] * alpha + wsum(p); acc[h] *= alpha; m[h] = mn; pl[h * 64 + lane] = p;
                }
                lds_fence();
                const bf16_t* vb = proj + 2048 + 2560 + g * 128 + 2 * lane;
                for (int k = kfirst; k < 64; ++k) {
                    const unsigned w = *(const unsigned*)(vb + (size_t)(b * S_ + k0 + k) * PW0);
                    const f32x2 v = {__uint_as_float(w << 16), __uint_as_float(w & 0xffff0000u)};
#pragma unroll
                    for (int h = 0; h < 4; ++h) acc[h] += pl[h * 64 + k] * v;
                }
                lds_fence();
            }
#pragma unroll
            for (int h = 0; h < 4; ++h) ofin[h] += (gate[h][2] / l[h]) * acc[h];
        }
#pragma unroll
        for (int h = 0; h < 4; ++h) *(unsigned*)(O + (size_t)(b * S_ + t) * D_ + (4 * g + h) * 128 + 2 * lane) = pk2(ofin[h][0], ofin[h][1]);
        lds_fence();
    }
}

__device__ __forceinline__ void dil_attn_ref_phase(const Ctx& c) {
    LDSP float* wl = (LDSP float*)(c.lds + c.wave * 8192);
    LDSP float* qs = wl;
    LDSP float* pl = wl + 128;
    const bf16_t* proj = (const bf16_t*)(c.ws + WS_PROJ);
    bf16_t* O = (bf16_t*)(c.ws + WS_O);
    const int lane = c.lane, nw = c.G * NWAVE;
    const float scale = 0.08838834764831845f;
    for (int u = c.bid * NWAVE + c.wave; u < B_ * S_ * 16; u += nw) {
        const int h = u & 15, t = (u >> 4) & 2047, b = u >> 15;
        const bf16_t* prow = proj + (size_t)(b * S_ + t) * PW1;
        { const unsigned w = *(const unsigned*)(prow + h * 128 + 2 * lane); qs[2 * lane] = __uint_as_float(w << 16) * scale; qs[2 * lane + 1] = __uint_as_float(w & 0xffff0000u) * scale; }
        lds_fence();
        const float slope = exp2f(-0.5f * (float)(h + 1));
        float lse[3]; f32x2 og[3];
#pragma unroll
        for (int gi = 0; gi < 3; ++gi) {
            const int r = gi == 0 ? 1 : gi == 1 ? 4 : 16;
            const int uq = t / r; const int imax = uq < 128 ? uq : 128;
            const size_t koff = 2048 + (size_t)gi * 4096 + h * 128, voff = koff + 2048;
            float m = -__builtin_inff(), l = 0.f; f32x2 acc = {0.f, 0.f};
            for (int tile = 0; tile * 64 <= imax; ++tile) {
                const int i = tile * 64 + lane; const bool valid = i <= imax;
                float s = 0.f;
                if (valid) { const bf16_t* kr = proj + (size_t)(b * S_ + t - r * i) * PW1 + koff;
                    for (int d8 = 0; d8 < 16; ++d8) { const u32x4 w = *(const u32x4*)(kr + d8 * 8);
                        const f32x4 qa = *(LDSP const f32x4*)(qs + d8 * 8), qb = *(LDSP const f32x4*)(qs + d8 * 8 + 4);
                        s += __uint_as_float(w.x << 16) * qa[0] + __uint_as_float(w.x & 0xffff0000u) * qa[1] + __uint_as_float(w.y << 16) * qa[2] + __uint_as_float(w.y & 0xffff0000u) * qa[3]
                           + __uint_as_float(w.z << 16) * qb[0] + __uint_as_float(w.z & 0xffff0000u) * qb[1] + __uint_as_float(w.w << 16) * qb[2] + __uint_as_float(w.w & 0xffff0000u) * qb[3]; }
                    s -= slope * (float)(r * i); }
                const float sv = valid ? s : -__builtin_inff();
                const float mn = fmaxf(m, wmax(sv));
                const float alpha = __expf(m - mn), p = valid ? __expf(sv - mn) : 0.f;
                l = l * alpha + wsum(p); acc *= alpha; m = mn; pl[lane] = p;
                lds_fence();
                const int kc = min(64, imax - tile * 64 + 1);
                for (int k = 0; k < kc; ++k) { const unsigned w = *(const unsigned*)(proj + (size_t)(b * S_ + t - r * (tile * 64 + k)) * PW1 + voff + 2 * lane);
                    acc += pl[k] * (f32x2){__uint_as_float(w << 16), __uint_as_float(w & 0xffff0000u)}; }
                lds_fence();
            }
            lse[gi] = m + __logf(l); og[gi] = acc * (1.f / l);
        }
        const float mx = fmaxf(lse[0], fmaxf(lse[1], lse[2]));
        const float w0 = __expf(lse[0] - mx), w1 = __expf(lse[1] - mx), w2 = __expf(lse[2] - mx), inv = 1.f / (w0 + w1 + w2);
        const f32x2 o = (w0 * inv) * og[0] + (w1 * inv) * og[1] + (w2 * inv) * og[2];
        *(unsigned*)(O + (size_t)(b * S_ + t) * D_ + h * 128 + 2 * lane) = pk2(o[0], o[1]);
        lds_fence();
    }
}


namespace att {
typedef __attribute__((address_space(1))) char gchar;
typedef __attribute__((address_space(1))) float gfloat;
typedef __attribute__((address_space(1))) unsigned gunsigned;
typedef short bf16x8 __attribute__((ext_vector_type(8)));
typedef short s16x4 __attribute__((ext_vector_type(4)));
typedef float f32x16 __attribute__((ext_vector_type(16)));
constexpr int SHM = 16384;
constexpr int OFF_V = 0, OFF_K = 3 * SHM, OFF_WS = 6 * SHM, OFF_MISC = 6 * SHM + 8 * 256;
constexpr int OFF_PS = OFF_MISC + 256, OFF_SC = OFF_PS + 8 * (8 * 129 * 4), OFF_GT = OFF_SC + 8 * 1024;
constexpr int OFF_AT = OFF_GT + 8 * 512;
constexpr int OFF_PS_ = 0;
constexpr float C2 = 0.08838834764831845f * 1.4426950408889634f;
constexpr float LOG2E = 1.4426950408889634f;
constexpr float THR = 6.0f;

#define ATT_KSWZ(row, colB) ((row) * 256 + ((colB) ^ (((row) & 7) << 4)))
#define ATT_SBAR() __builtin_amdgcn_sched_barrier(0)
__device__ __forceinline__ int v_st(int k, int c) { const int kk = (k & ~0xC) | ((k & 4) << 1) | ((k & 8) >> 1); return ((kk >> 3) * 4 + (c >> 5)) * 512 + ((kk & 7) * 32 + (c & 31)) * 2; }
__device__ __forceinline__ int v_rd_base(int lane) { return ((lane & 3) << 3) | (((lane >> 2) & 3) << 6) | (((lane >> 4) & 1) << 5) | (((lane >> 5) & 1) << 8); }
__device__ __forceinline__ int crow(int r, int hi) { return (r & 3) + 8 * (r >> 2) + 4 * hi; }
extern "C" __device__ float fmul_legacy_(float, float) __asm("llvm.amdgcn.fmul.legacy");
__device__ __forceinline__ unsigned cvtpk(float lo, float hi) { unsigned r; asm volatile("v_cvt_pk_bf16_f32 %0, %1, %2" : "=v"(r) : "v"(lo), "v"(hi)); return r; }

struct Lane { int lane, r32, hi, wid, tid; LDSP const char* at; int atmul; };

template <bool INIT = false>
__device__ __forceinline__ void qkt(f32x16& p0, f32x16& p1, LDSP const char* Kt, int r32, int hi, const bf16x8* qr, LDSP const char* at = nullptr) {
    if (INIT) {
        bf16x8 t_[8];
#pragma unroll
        for (int i = 0; i < 8; ++i) t_[i] = *reinterpret_cast<LDSP const bf16x8*>(at + 16 * i);
#pragma unroll
        for (int i = 0; i < 4; ++i) { const f32x4 a_ = *reinterpret_cast<const f32x4*>(&t_[i]), b_ = *reinterpret_cast<const f32x4*>(&t_[4 + i]);
            p0[4 * i] = a_[0]; p0[4 * i + 1] = a_[1]; p0[4 * i + 2] = a_[2]; p0[4 * i + 3] = a_[3]; p1[4 * i] = b_[0]; p1[4 * i + 1] = b_[1]; p1[4 * i + 2] = b_[2]; p1[4 * i + 3] = b_[3]; } }
    else { p0 = f32x16{}; p1 = f32x16{}; }
    LDSP const char* kb[4];
    int k0_ = ATT_KSWZ(r32, hi * 16); asm volatile("" : "+v"(k0_));
#pragma unroll
    for (int dd = 0; dd < 4; ++dd) kb[dd] = Kt + (k0_ ^ (dd << 5));
    bf16x8 f[8][2];
#define ATT_KRD(d0) do { LDSP const char* a_ = kb[(d0) & 3] + ((d0) >> 2) * 128; f[d0][0] = *reinterpret_cast<LDSP const bf16x8*>(a_); f[d0][1] = *reinterpret_cast<LDSP const bf16x8*>(a_ + 32 * 256); } while (0)
    ATT_KRD(0); ATT_KRD(1); ATT_KRD(2);
#pragma unroll
    for (int d0 = 0; d0 < 8; ++d0) {
        ATT_SBAR();
        if (d0 + 3 < 8) { if (d0 == 0) ATT_KRD(3); else if (d0 == 1) ATT_KRD(4); else if (d0 == 2) ATT_KRD(5); else if (d0 == 3) ATT_KRD(6); else ATT_KRD(7); }
        p0 = __builtin_amdgcn_mfma_f32_32x32x16_bf16(f[d0][0], qr[d0], p0, 0, 0, 0);
        p1 = __builtin_amdgcn_mfma_f32_32x32x16_bf16(f[d0][1], qr[d0], p1, 0, 0, 0);
    }
#undef ATT_KRD
}
__device__ __forceinline__ void pv_tile(f32x16* o, int vb, bf16x8 pa0, bf16x8 pa1, bf16x8 pa2, bf16x8 pa3) {
#define ATT_TRRD(dst, off) asm volatile("ds_read_b64_tr_b16 %0, %1 offset:%2" : "=&v"(dst) : "v"(vb), "i"(off) : "memory")
#define ATT_RD8(S, d0) do { constexpr int b_ = (d0) * 512; ATT_TRRD(S##l0, b_); ATT_TRRD(S##h0, b_ + 2048); ATT_TRRD(S##l1, b_ + 4096); ATT_TRRD(S##h1, b_ + 6144); \
        ATT_TRRD(S##l2, b_ + 8192); ATT_TRRD(S##h2, b_ + 10240); ATT_TRRD(S##l3, b_ + 12288); ATT_TRRD(S##h3, b_ + 14336); } while (0)
#define ATT_MM4(S, d0) do { \
        o[d0] = __builtin_amdgcn_mfma_f32_32x32x16_bf16(pa0, (bf16x8){S##l0[0], S##l0[1], S##l0[2], S##l0[3], S##h0[0], S##h0[1], S##h0[2], S##h0[3]}, o[d0], 0, 0, 0); \
        o[d0] = __builtin_amdgcn_mfma_f32_32x32x16_bf16(pa1, (bf16x8){S##l1[0], S##l1[1], S##l1[2], S##l1[3], S##h1[0], S##h1[1], S##h1[2], S##h1[3]}, o[d0], 0, 0, 0); \
        o[d0] = __builtin_amdgcn_mfma_f32_32x32x16_bf16(pa2, (bf16x8){S##l2[0], S##l2[1], S##l2[2], S##l2[3], S##h2[0], S##h2[1], S##h2[2], S##h2[3]}, o[d0], 0, 0, 0); \
        o[d0] = __builtin_amdgcn_mfma_f32_32x32x16_bf16(pa3, (bf16x8){S##l3[0], S##l3[1], S##l3[2], S##l3[3], S##h3[0], S##h3[1], S##h3[2], S##h3[3]}, o[d0], 0, 0, 0); } while (0)
    s16x4 Al0, Al1, Al2, Al3, Ah0, Ah1, Ah2, Ah3, Bl0, Bl1, Bl2, Bl3, Bh0, Bh1, Bh2, Bh3;
    asm volatile("s_waitcnt lgkmcnt(0)" ::: "memory"); ATT_SBAR();
    ATT_RD8(A, 0); ATT_RD8(B, 1);
    asm volatile("s_waitcnt lgkmcnt(8)" ::: "memory"); ATT_SBAR(); ATT_MM4(A, 0); ATT_SBAR();
    ATT_RD8(A, 2);
    asm volatile("s_waitcnt lgkmcnt(8)" ::: "memory"); ATT_SBAR(); ATT_MM4(B, 1); ATT_SBAR();
    ATT_RD8(B, 3);
    asm volatile("s_waitcnt lgkmcnt(8)" ::: "memory"); ATT_SBAR(); ATT_MM4(A, 2); ATT_SBAR();
    asm volatile("s_waitcnt lgkmcnt(0)" ::: "memory"); ATT_SBAR(); ATT_MM4(B, 3);
#undef ATT_MM4
#undef ATT_RD8
#undef ATT_TRRD
}
__device__ __forceinline__ void mask_tile(f32x16& p0, f32x16& p1, int dq, unsigned W) {
    const float NEG = -__builtin_inff();
#pragma unroll
    for (int r = 0; r < 16; ++r) { const int cc = (r & 3) + 8 * (r >> 2);
        if ((unsigned)(dq - cc) >= W) p0[r] = NEG;
        if ((unsigned)(dq - cc - 32) >= W) p1[r] = NEG; }
}
__device__ __forceinline__ void alibi_tile(f32x16& p0, f32x16& p1, float sl2) {
#pragma unroll
    for (int r = 0; r < 16; ++r) { const float cc = (float)((r & 3) + 8 * (r >> 2)); p0[r] = fmaf(sl2, cc, p0[r]); p1[r] = fmaf(sl2, cc + 32.f, p1[r]); }
}
__device__ __forceinline__ void alibi_table_write(LDSP char* lds, int slot, int i, float sl2) {
    const int r = i & 15; ((LDSP float*)(lds + OFF_AT))[slot * 32 + i] = sl2 * (float)((r & 3) + 8 * (r >> 2) + (i & 16) * 2);
}
__device__ __forceinline__ void softmax_a(f32x16& p0, f32x16& p1, float base, float& m_reg, float& alpha) {
    float pmax = p0[0];
#pragma unroll
    for (int r = 1; r < 16; ++r) pmax = fmaxf(pmax, p0[r]);
#pragma unroll
    for (int r = 0; r < 16; ++r) pmax = fmaxf(pmax, p1[r]);
    pmax += base;
    { auto rr = __builtin_amdgcn_permlane32_swap(__float_as_uint(pmax), __float_as_uint(pmax), false, false); pmax = fmaxf(__uint_as_float(rr[0]), __uint_as_float(rr[1])); }
    float mn;
    if (__all(pmax - m_reg <= THR)) { mn = m_reg; alpha = 1.f; }
    else { mn = fmaxf(m_reg, pmax); alpha = __builtin_amdgcn_exp2f(m_reg - mn); m_reg = mn; }
    const float sub = mn - base;
#pragma unroll
    for (int r = 0; r < 16; ++r) p0[r] = __builtin_amdgcn_exp2f(p0[r] - sub);
#pragma unroll
    for (int r = 0; r < 16; ++r) p1[r] = __builtin_amdgcn_exp2f(p1[r] - sub);
}
__device__ __forceinline__ float rowsum2(const f32x16& p0, const f32x16& p1) {
    float ps = 0;
#pragma unroll
    for (int r = 0; r < 16; ++r) ps += p0[r];
#pragma unroll
    for (int r = 0; r < 16; ++r) ps += p1[r];
    auto rr = __builtin_amdgcn_permlane32_swap(__float_as_uint(ps), __float_as_uint(ps), false, false);
    return __uint_as_float(rr[0]) + __uint_as_float(rr[1]);
}
__device__ __forceinline__ void pack_p(const f32x16& p0, const f32x16& p1, bf16x8& pa0, bf16x8& pa1, bf16x8& pa2, bf16x8& pa3) {
#define ATT_PK4(P, B_, OUT) do { unsigned a0 = cvtpk(P[B_ + 0], P[B_ + 1]), a1 = cvtpk(P[B_ + 2], P[B_ + 3]); \
        unsigned b0 = cvtpk(P[B_ + 4], P[B_ + 5]), b1 = cvtpk(P[B_ + 6], P[B_ + 7]); \
        auto r0 = __builtin_amdgcn_permlane32_swap(a0, b0, false, false); auto r1 = __builtin_amdgcn_permlane32_swap(a1, b1, false, false); \
        u32x4 w = {r0[0], r1[0], r0[1], r1[1]}; OUT = *reinterpret_cast<bf16x8*>(&w); } while (0)
    ATT_PK4(p0, 0, pa0); ATT_PK4(p0, 8, pa1); ATT_PK4(p1, 0, pa2); ATT_PK4(p1, 8, pa3);
#undef ATT_PK4
}
__device__ __forceinline__ void scale_rows(f32x16* o, float f, LDSP float* xl, int r32, int hi) {
    if (hi == 0) xl[r32] = f;
    asm volatile("s_waitcnt lgkmcnt(0)" ::: "memory");
    float fr[16];
#pragma unroll
    for (int r = 0; r < 16; ++r) fr[r] = xl[crow(r, hi)];
#pragma unroll
    for (int d = 0; d < 4; ++d)
#pragma unroll
        for (int r = 0; r < 16; ++r) o[d][r] = fmul_legacy_(o[d][r], fr[r]);
    asm volatile("s_waitcnt lgkmcnt(0)" ::: "memory");
}
__device__ __forceinline__ bf16x8 scale8(u32x4 w, float s) {
    u32x4 o;
    o.x = cvtpk(__uint_as_float(w.x << 16) * s, __uint_as_float(w.x & 0xffff0000u) * s); o.y = cvtpk(__uint_as_float(w.y << 16) * s, __uint_as_float(w.y & 0xffff0000u) * s);
    o.z = cvtpk(__uint_as_float(w.z << 16) * s, __uint_as_float(w.z & 0xffff0000u) * s); o.w = cvtpk(__uint_as_float(w.w << 16) * s, __uint_as_float(w.w & 0xffff0000u) * s);
    return *reinterpret_cast<bf16x8*>(&o);
}
__device__ __forceinline__ bf16x8 aug_frag(unsigned dword0, int hi) { u32x4 w = {hi ? 0u : dword0, 0u, 0u, 0u}; return *reinterpret_cast<bf16x8*>(&w); }
__device__ __forceinline__ unsigned split_bf16(float x) {
    const unsigned hb = (unsigned)f2bf(x); const float rem = x - __uint_as_float(hb << 16); return hb | ((unsigned)f2bf(rem) << 16);
}

struct DmaMap { int m0, m1; };
__device__ __forceinline__ int dma_map1(int q) {
    const int krow = q >> 4, kcol = ((q & 15) ^ (krow & 7)) * 8;
    const int sub = q >> 5, kk = (sub >> 2) * 8 + ((q & 31) >> 2), vrow = (kk & ~0xC) | ((kk & 4) << 1) | ((kk & 8) >> 1), vcol = (sub & 3) * 32 + (q & 3) * 8;
    return krow | (kcol << 6) | (vrow << 13) | (vcol << 19);
}
__device__ __forceinline__ DmaMap dma_map(int wid, int lane) { DmaMap d; d.m0 = dma_map1(wid * 64 + lane); d.m1 = dma_map1(512 + wid * 64 + lane); return d; }
__device__ __forceinline__ void stage_dma(const DmaMap& dm, const bf16_t* Kb, const bf16_t* Vb, size_t stride, int row0, int rmax, LDSP char* lds, int buf, int wid, int which = 3) {
#pragma unroll
    for (int i = 0; i < 2; ++i) {
        const int m = i ? dm.m1 : dm.m0;
        if (which & 1) { int kr = row0 + (m & 63); kr = kr < 0 ? 0 : (kr > rmax ? rmax : kr);
            const bf16_t* ks = Kb + (size_t)kr * stride + ((m >> 6) & 127);
            __builtin_amdgcn_global_load_lds((const unsigned*)ks, (LDSP unsigned*)(lds + OFF_K + buf * SHM + i * 8192 + wid * 1024), 16, 0, 0); }
        if (which & 2) { int vr = row0 + ((m >> 13) & 63); vr = vr < 0 ? 0 : (vr > rmax ? rmax : vr);
            const bf16_t* vs = Vb + (size_t)vr * stride + ((m >> 19) & 127);
            __builtin_amdgcn_global_load_lds((const unsigned*)vs, (LDSP unsigned*)(lds + OFF_V + buf * SHM + i * 8192 + wid * 1024), 16, 0, 0); }
    }
}
struct Stage { u32x4 k0, k1, v0, v1; };
__device__ __forceinline__ void stage_load(Stage& s, const bf16_t* Kb, const bf16_t* Vb, size_t stride, int row0, int rmax, int tid) {
    const int sr = tid >> 4, sc = (tid & 15) * 8;
    int ra = row0 + sr, rb = row0 + 32 + sr; ra = ra < 0 ? 0 : (ra > rmax ? rmax : ra); rb = rb < 0 ? 0 : (rb > rmax ? rmax : rb);
    s.v0 = *(const u32x4*)(Vb + (size_t)ra * stride + sc); s.v1 = *(const u32x4*)(Vb + (size_t)rb * stride + sc);
    s.k0 = *(const u32x4*)(Kb + (size_t)ra * stride + sc); s.k1 = *(const u32x4*)(Kb + (size_t)rb * stride + sc);
}
__device__ __forceinline__ void stage_write(const Stage& s, LDSP char* lds, int buf, int tid) {
    const int sr = tid >> 4, sc = (tid & 15) * 8;
    *(LDSP u32x4*)(lds + OFF_K + buf * SHM + ATT_KSWZ(sr, sc * 2)) = s.k0; *(LDSP u32x4*)(lds + OFF_K + buf * SHM + ATT_KSWZ(sr, sc * 2) + 32 * 256) = s.k1;
    *(LDSP u32x4*)(lds + OFF_V + buf * SHM + v_st(sr, sc)) = s.v0; *(LDSP u32x4*)(lds + OFF_V + buf * SHM + v_st(32 + sr, sc)) = s.v1;
}
__device__ __forceinline__ void stage_dma_at(const DmaMap& dm, const bf16_t* Kb, const bf16_t* Vb, size_t stride, int row0, int rmax, LDSP char* kdst, LDSP char* vdst, int wid) {
#pragma unroll
    for (int i = 0; i < 2; ++i) {
        const int m = i ? dm.m1 : dm.m0;
        int kr = row0 + (m & 63), vr = row0 + ((m >> 13) & 63); kr = kr < 0 ? 0 : (kr > rmax ? rmax : kr); vr = vr < 0 ? 0 : (vr > rmax ? rmax : vr);
        const bf16_t* ks = Kb + (size_t)kr * stride + ((m >> 6) & 127); const bf16_t* vs = Vb + (size_t)vr * stride + ((m >> 19) & 127);
        __builtin_amdgcn_global_load_lds((const unsigned*)ks, (LDSP unsigned*)(kdst + i * 8192 + wid * 1024), 16, 0, 0);
        __builtin_amdgcn_global_load_lds((const unsigned*)vs, (LDSP unsigned*)(vdst + i * 8192 + wid * 1024), 16, 0, 0);
    }
}
#define ATT_DMA_SYNC() do { asm volatile("s_waitcnt vmcnt(0)" ::: "memory"); __syncthreads(); } while (0)
#define ATT_RING_SYNC(more) do { if (more) asm volatile("s_waitcnt vmcnt(4)" ::: "memory"); else asm volatile("s_waitcnt vmcnt(0)" ::: "memory"); \
        asm volatile("s_waitcnt lgkmcnt(0)" ::: "memory"); __builtin_amdgcn_s_barrier(); asm volatile("" ::: "memory"); } while (0)

struct Pass { float m, l; f32x16 o[4]; };
__device__ __forceinline__ void pass_init(Pass& P) { P.m = -1e30f; P.l = 0.f;
#pragma unroll
    for (int d = 0; d < 4; ++d) P.o[d] = f32x16{}; }

struct PFrag { bf16x8 a0, a1, a2, a3; };
__device__ __forceinline__ void tile_sm(Pass& P, PFrag& F, f32x16& p0, f32x16& p1, LDSP float* xl, const Lane& L, float sl2, bool need_mask, int dq0, unsigned W, float base);
__device__ __forceinline__ void tile_qk_at(Pass& P, PFrag& F, LDSP const char* Kt, LDSP float* xl, const Lane& L, const bf16x8* qr, float sl2, bool need_mask, int dq0, unsigned W, float base) {
    f32x16 p0, p1;
    qkt<true>(p0, p1, Kt, L.r32, L.hi, qr, L.at + (L.r32 >> 3) * L.atmul);
    tile_sm(P, F, p0, p1, xl, L, sl2, need_mask, dq0, W, base);
}
__device__ __forceinline__ void tile_sm(Pass& P, PFrag& F, f32x16& p0, f32x16& p1, LDSP float* xl, const Lane& L, float sl2, bool need_mask, int dq0, unsigned W, float base) {
    if (need_mask) mask_tile(p0, p1, dq0 - 4 * L.hi, W);
    float alpha;
    const float m_prev = P.m;
    softmax_a(p0, p1, base + sl2 * (float)(4 * L.hi), P.m, alpha);
    if (__any(alpha < 1.f && m_prev > -1e29f)) scale_rows(P.o, alpha, xl, L.r32, L.hi);
    P.l = P.l * alpha + rowsum2(p0, p1);
    pack_p(p0, p1, F.a0, F.a1, F.a2, F.a3);
}
__device__ __forceinline__ void tile_qk(Pass& P, PFrag& F, LDSP char* lds, int buf, const Lane& L, const bf16x8* qr, float sl2, bool need_mask, int dq0, unsigned W, float base) {
    tile_qk_at(P, F, lds + OFF_K + buf * SHM, (LDSP float*)(lds + OFF_WS + L.wid * 256), L, qr, sl2, need_mask, dq0, W, base);
}
__device__ __forceinline__ void tile_pv_at(Pass& P, const PFrag& F, LDSP char* Vt, const Lane& L) {
    ATT_SBAR();
    const int vb = (int)(unsigned)(uintptr_t)Vt + v_rd_base(L.lane);
    pv_tile(P.o, vb, F.a0, F.a1, F.a2, F.a3);
}
__device__ __forceinline__ void tile_pv(Pass& P, const PFrag& F, LDSP char* lds, int buf, const Lane& L) {
    ATT_SBAR();
    const int vb = (int)(unsigned)(uintptr_t)(lds + OFF_V + buf * SHM) + v_rd_base(L.lane);
    pv_tile(P.o, vb, F.a0, F.a1, F.a2, F.a3);
}
#define ATT_EV_EVEN(k_) do { if ((k_) == 0 || (k_) >= n) asm volatile("s_waitcnt vmcnt(0)" ::: "memory"); else if ((k_) + 1 < n) asm volatile("s_waitcnt vmcnt(4)" ::: "memory"); else asm volatile("s_waitcnt vmcnt(2)" ::: "memory"); \
        asm volatile("s_waitcnt lgkmcnt(0)" ::: "memory"); __builtin_amdgcn_s_barrier(); asm volatile("" ::: "memory"); } while (0)
#define ATT_ISSUE(k_) do { if ((k_) + 2 < n) pol.dma(pol.tile((k_) + 2), ((k_) + 2) % 3, 1); if ((k_) + 1 < n) pol.dma(pol.tile((k_) + 1), ((k_) + 1) % 3, 2); } while (0)
#define ATT_EV_ODD() do { asm volatile("s_waitcnt lgkmcnt(0)" ::: "memory"); __builtin_amdgcn_s_barrier(); asm volatile("" ::: "memory"); } while (0)
template <class Pol, bool STAGGER = true>
__device__ __forceinline__ void ring_pass(Pass& P, const Pol& pol, LDSP char* lds, const Lane& L, const bf16x8* qr, float sl2, bool pre = false) {
    const int n = pol.n;
    const bool lag = STAGGER && L.wid >= 4;
    LDSP float* xl = (LDSP float*)(lds + OFF_WS + L.wid * 256);
    if (!pre) { pol.dma(pol.tile(0), 0, 3); if (n > 1) pol.dma(pol.tile(1), 1, 1); }
    ATT_EV_EVEN(0); ATT_ISSUE(0);
    if (lag) ATT_EV_ODD();
    PFrag F;
    bool actp = false; int buf = 0, bufp = 0;
    for (int i = 0; i < n; ++i) {
        if (actp) tile_pv(P, F, lds, bufp, L);
        ATT_SBAR();
        const int j = pol.tile(i);
        bool act; f32x16 p0, p1;
        { bool nm_; int dq_; unsigned W_; float base_; pol.prep(j, act, nm_, dq_, W_, base_); }
        if (act) { int rr_ = L.r32; if (L.atmul) asm volatile("" : "+v"(rr_)); qkt<true>(p0, p1, lds + OFF_K + buf * SHM, L.r32, L.hi, qr, L.at + (rr_ >> 3) * L.atmul); }
        if (!lag) { if (STAGGER) ATT_EV_ODD(); } else ATT_EV_EVEN(i + 1);
        if (act) { int j2 = j; asm volatile("" : "+s"(j2));
            bool a2_, need_mask; int dq0; unsigned W; float base; pol.prep(j2, a2_, need_mask, dq0, W, base);
            tile_sm(P, F, p0, p1, xl, L, sl2, need_mask, dq0, W, base); }
        else { const bf16x8 z_ = {}; F.a0 = z_; F.a1 = z_; F.a2 = z_; F.a3 = z_; }
        if (!lag) ATT_EV_EVEN(i + 1); else ATT_EV_ODD();
        ATT_ISSUE(i + 1);
        actp = act; bufp = buf; buf = buf == 2 ? 0 : buf + 1;
    }
    if (actp) tile_pv(P, F, lds, bufp, L);
    if (STAGGER && !lag) ATT_EV_ODD();
}
}

__device__ __forceinline__ void nsa_attn_mfma_phase(const Ctx& c) {
    using namespace att;
    LDSP char* lds = (LDSP char*)c.lds;
    const bf16_t* proj = (const bf16_t*)(c.ws + WS_PROJ);
    const bf16_t* CMPB = (const bf16_t*)(c.ws + WS_CMPB);
    float* ACC = (float*)(c.ws + WS_ACC);
    bf16_t* O = (bf16_t*)(c.ws + WS_O);
    Lane L; L.tid = c.tid; L.lane = c.lane; L.r32 = c.lane & 31; L.hi = c.lane >> 5; L.wid = c.wave; L.at = lds + OFF_AT; L.atmul = 128;
    const DmaMap dm = dma_map(L.wid, L.lane);
    LDSP float* xl = (LDSP float*)(lds + OFF_WS + L.wid * 256);
    LDSP unsigned* misc = (LDSP unsigned*)(lds + OFF_MISC);
    { LDSP float* psw0 = (LDSP float*)(lds + OFF_PS + L.wid * (8 * 129 * 4));
#pragma unroll
      for (int i = 0; i < 17; ++i) { const int w = L.lane + 64 * i; if (w < 8 * 129) psw0[w] = 0.f; } }
    for (int uu = c.bid; uu < (DUP_PH == 104 ? 2048 : 1024); uu += c.G) {
        const int u = uu & 1023, cc_ = u & 255, ri_ = u >> 8, bg = (cc_ >> 4) + 16 * (ri_ >> 1), q0_ = (ri_ >> 1) ? 15 - (cc_ & 15) : (cc_ & 15), qb = (ri_ & 1) ? 31 - q0_ : q0_, b = bg >> 2, g = bg & 3;
        const int qi = L.r32 & 7, hl = L.r32 >> 3, t = 64 * qb + 8 * L.wid + qi, h = 4 * g + hl;
        const bf16_t* prow = proj + (size_t)(b * S_ + t) * PW0;
        __syncthreads();
        { int tw = c.tid; asm volatile("" : "+v"(tw));
          if (tw < 128) alibi_table_write(lds, tw >> 5, tw & 31, exp2f(-0.5f * (float)(4 * g + (tw >> 5) + 1)) * LOG2E); }
        { const bf16_t* Kc0 = CMPB + ((size_t)(0 * 8 + b) * 128 * 4 + g) * 128; const bf16_t* Vc0 = CMPB + ((size_t)(1 * 8 + b) * 128 * 4 + g) * 128;
          stage_dma(dm, Kc0, Vc0, 512, 0, 127, lds, 0, L.wid); stage_dma(dm, Kc0, Vc0, 512, 64, 127, lds, 1, L.wid); }
        bf16x8 qr[8];
        { u32x4 qraw_[8];
#pragma unroll
          for (int d0 = 0; d0 < 8; ++d0) qraw_[d0] = *(const u32x4*)(prow + h * 128 + d0 * 16 + L.hi * 8);
#pragma unroll
          for (int d0 = 0; d0 < 8; ++d0) qr[d0] = scale8(qraw_[d0], C2); }
        const float slope = exp2f(-0.5f * (float)(h + 1));
        LDSP float* gtw = (LDSP float*)(lds + OFF_GT + L.wid * 512);
        if (L.hi == 0) {
#pragma unroll
            for (int j = 0; j < 3; ++j) gtw[L.r32 * 3 + j] = 1.f / (1.f + __expf(-bf2f(prow[5120 + h * 3 + j])));
        }
#define NSA_GATE(j) (gtw[L.r32 * 3 + (j)])
        char* accb = (char*)ACC + ((size_t)c.bid * NWAVE + L.wid) * 16384;
        const unsigned avo = (unsigned)(L.lane * 4);
        unsigned selmask;
#if !defined(NSA_NO_CMP)
        for (int repc_ = 0; repc_ < (DUP_PH == 301 ? 2 : 1); ++repc_) { if (repc_) __syncthreads();
            const bf16_t* Kc = CMPB + ((size_t)(0 * 8 + b) * 128 * 4 + g) * 128; const bf16_t* Vc = CMPB + ((size_t)(1 * 8 + b) * 128 * 4 + g) * 128;
            ATT_DMA_SYNC();
            const float sl2 = slope * 16.f * LOG2E, qf = ((float)t - 15.5f) * 0.0625f;
            const int nq = (t - 31) >> 4;
            f32x16 pA0, pA1, pB0, pB1;
            qkt(pA0, pA1, lds + OFF_K, L.r32, L.hi, qr); alibi_tile(pA0, pA1, sl2);
            qkt(pB0, pB1, lds + OFF_K + SHM, L.r32, L.hi, qr); alibi_tile(pB0, pB1, sl2);
            mask_tile(pA0, pA1, nq - 4 * L.hi, 0x40000000u); mask_tile(pB0, pB1, nq - 64 - 4 * L.hi, 0x40000000u);
            const float baseA = -sl2 * (qf - (float)(4 * L.hi)), baseB = -sl2 * (qf - 64.f - (float)(4 * L.hi));
            float mA = pA0[0], mB = pB0[0];
#pragma unroll
            for (int r = 1; r < 16; ++r) { mA = fmaxf(mA, pA0[r]); mB = fmaxf(mB, pB0[r]); }
#pragma unroll
            for (int r = 0; r < 16; ++r) { mA = fmaxf(mA, pA1[r]); mB = fmaxf(mB, pB1[r]); }
            float mx = fmaxf(mA + baseA, mB + baseB);
            { auto rr = __builtin_amdgcn_permlane32_swap(__float_as_uint(mx), __float_as_uint(mx), false, false); mx = fmaxf(__uint_as_float(rr[0]), __uint_as_float(rr[1])); }
            if (mx == -__builtin_inff()) mx = 0.f;
            const float subA = mx - baseA, subB = mx - baseB;
#pragma unroll
            for (int r = 0; r < 16; ++r) { pA0[r] = __builtin_amdgcn_exp2f(pA0[r] - subA); pA1[r] = __builtin_amdgcn_exp2f(pA1[r] - subA); pB0[r] = __builtin_amdgcn_exp2f(pB0[r] - subB); pB1[r] = __builtin_amdgcn_exp2f(pB1[r] - subB); }
            const float lsum = rowsum2(pA0, pA1) + rowsum2(pB0, pB1);
            const float inv = 1.f / fmaxf(lsum, 1e-30f);
#pragma unroll
            for (int r = 0; r < 16; ++r) { pA0[r] *= inv; pA1[r] *= inv; pB0[r] *= inv; pB1[r] *= inv; }
            bf16x8 paA0, paA1, paA2, paA3, paB0, paB1, paB2, paB3;
            pack_p(pA0, pA1, paA0, paA1, paA2, paA3); pack_p(pB0, pB1, paB0, paB1, paB2, paB3);
            LDSP float* psw = (LDSP float*)(lds + OFF_PS + L.wid * (8 * 129 * 4));
#pragma unroll
            for (int r = 0; r < 16; ++r) {
                float a = pA0[r], b2 = pA1[r], c2 = pB0[r], d2 = pB1[r];
                a += __shfl_xor(a, 8); b2 += __shfl_xor(b2, 8); c2 += __shfl_xor(c2, 8); d2 += __shfl_xor(d2, 8);
                a += __shfl_xor(a, 16); b2 += __shfl_xor(b2, 16); c2 += __shfl_xor(c2, 16); d2 += __shfl_xor(d2, 16);
                if (hl == 0) { const int n0 = crow(r, L.hi); LDSP float* pp = psw + qi * 129 + n0; pp[0] = a; pp[32] = b2; pp[64] = c2; pp[96] = d2; }
                if ((r & 3) == 3) asm volatile("" ::: "memory");
            }
            asm volatile("s_waitcnt lgkmcnt(0)" ::: "memory");
            {
                LDSP float* scw = (LDSP float*)(lds + OFF_SC + L.wid * 1024);
                int sq = L.lane & 7, jb = L.lane >> 3; asm volatile("" : "+v"(sq), "+v"(jb));
                const int tq = 64 * qb + 8 * L.wid + sq;
                const LDSP float* pq = psw + sq * 129;
                float sj[4];
#pragma unroll
                for (int i = 0; i < 4; ++i) { const int j = jb + 8 * i;
                    const float imp = (j ? pq[4 * j - 1] : 0.f) + 2.f * (pq[4 * j] + pq[4 * j + 1] + pq[4 * j + 2]) + pq[4 * j + 3];
                    const bool forced = (j == 0) || (j == qb) || (j == qb - 1), causal = (64 * j <= tq);
                    sj[i] = forced ? 1.0e6f : (causal ? imp : -1.0f); scw[sq * 32 + j] = sj[i]; }
                asm volatile("s_waitcnt lgkmcnt(0)" ::: "memory");
                int rk[4] = {0, 0, 0, 0};
                for (int i2 = 0; i2 < 32; ++i2) { const float si = scw[sq * 32 + i2];
#pragma unroll
                    for (int i = 0; i < 4; ++i) rk[i] += ((si > sj[i]) || (si == sj[i] && i2 < jb + 8 * i)) ? 1 : 0; }
                unsigned bits = 0u;
#pragma unroll
                for (int i = 0; i < 4; ++i) if (rk[i] < 16) bits |= 1u << (jb + 8 * i);
                bits |= (unsigned)__shfl_xor((int)bits, 8); bits |= (unsigned)__shfl_xor((int)bits, 16); bits |= (unsigned)__shfl_xor((int)bits, 32);
                selmask = bits;
                if (L.lane < 8) ((unsigned*)(c.ws + WS_SEL))[((size_t)b * 4 + g) * 2048 + tq] = selmask;
            }
            f32x16 o[4];
#pragma unroll
            for (int d = 0; d < 4; ++d) o[d] = f32x16{};
            ATT_SBAR();
            pv_tile(o, (int)(unsigned)(uintptr_t)(lds + OFF_V) + v_rd_base(L.lane), paA0, paA1, paA2, paA3);
            pv_tile(o, (int)(unsigned)(uintptr_t)(lds + OFF_V + SHM) + v_rd_base(L.lane), paB0, paB1, paB2, paB3);
            scale_rows(o, NSA_GATE(0), xl, L.r32, L.hi);
#pragma unroll
            for (int q = 0; q < 4; ++q) { gchar* pq = (gchar*)(accb + avo + q * 4096); asm volatile("" : "+v"(pq));
#pragma unroll
                for (int k = 0; k < 16; ++k) *(gfloat*)(pq + k * 256) = o[k & 3][q * 4 + (k >> 2)]; }
        }
#else
        selmask = 0xffffffffu;
#endif
#if !defined(NSA_NO_SEL)
        {
            const unsigned causal_bits = (qb == 31) ? 0xffffffffu : ((1u << (qb + 1)) - 1u);
            unsigned wmask = selmask & causal_bits;
#pragma unroll
            for (int o_ = 1; o_ < 64; o_ <<= 1) wmask |= (unsigned)__shfl_xor((int)wmask, o_);
            if (c.tid == 0) misc[0] = 0u;
            __syncthreads();
            if (L.lane == 0) atomicOr((unsigned*)(misc + 0), wmask);
            __syncthreads();
            unsigned rem = (unsigned)__builtin_amdgcn_readfirstlane((int)misc[0]);
            wmask = (unsigned)__builtin_amdgcn_readfirstlane((int)wmask);
            const float sl2 = slope * LOG2E;
            const bf16_t* Kb = proj + (size_t)b * S_ * PW0 + 2048 + 1024 + g * 128; const bf16_t* Vb = Kb + 512;
            Pass P; pass_init(P);
            const int ntl = __builtin_popcount(rem);
            if (c.tid == 0) { unsigned rr_ = rem; int k_ = 0; while (rr_) { const int jj_ = 31 - __builtin_clz(rr_); rr_ &= ~(1u << jj_); misc[8 + k_] = (unsigned)jj_; ++k_; } }
            __syncthreads();
            struct SelPol { int n; LDSP const unsigned* list; const DmaMap& dm; const bf16_t* Kb; const bf16_t* Vb; LDSP char* lds; int wid; unsigned wmask, selmask; int t; float sl2;
                __device__ __forceinline__ int tile(int i) const { return (int)__builtin_amdgcn_readfirstlane((int)list[(DUP_PH == 311) ? (i >= (n >> 1) ? i - (n >> 1) : i) : i]); }
                __device__ __forceinline__ void dma(int j, int buf, int which) const { DmaMap d2 = dm; asm volatile("" : "+v"(d2.m0), "+v"(d2.m1));   stage_dma(d2, Kb, Vb, PW0, 64 * j, S_ - 1, lds, buf, wid, which); }
                __device__ __forceinline__ void prep(int j, bool& act, bool& need_mask, int& dq0, unsigned& W, float& base) const {
                    act = (wmask >> j) & 1u; const bool mine = (selmask >> j) & 1u;
                    dq0 = mine ? t - 64 * j : -1; need_mask = !__all(mine && (t - 64 * j >= 63)); W = 0x40000000u; base = -sl2 * (float)(t - 64 * j); }
            } pol{(DUP_PH == 311) ? 2 * ntl : ntl, (LDSP const unsigned*)(misc + 8), dm, Kb, Vb, lds, L.wid, wmask, selmask, t, sl2};
            ring_pass<decltype(pol), false>(P, pol, lds, L, qr, sl2);
            scale_rows(P.o, NSA_GATE(1) / P.l, xl, L.r32, L.hi);
#pragma unroll
            for (int q2 = 0; q2 < 2; ++q2) {
                gchar* pa_ = (gchar*)(accb + avo + (2 * q2) * 4096); asm volatile("" : "+v"(pa_)); gchar* pb_ = (gchar*)(accb + avo + (2 * q2 + 1) * 4096); asm volatile("" : "+v"(pb_));
                float va[16], vb_[16];
#pragma unroll
                for (int k = 0; k < 16; ++k) { va[k] = *(const gfloat*)(pa_ + k * 256); vb_[k] = *(const gfloat*)(pb_ + k * 256); }
#pragma unroll
                for (int k = 0; k < 16; ++k) { *(gfloat*)(pa_ + k * 256) = va[k] + P.o[k & 3][(2 * q2) * 4 + (k >> 2)]; *(gfloat*)(pb_ + k * 256) = vb_[k] + P.o[k & 3][(2 * q2 + 1) * 4 + (k >> 2)]; }
                asm volatile("" ::: "memory"); }
        }
#endif
#if !defined(NSA_NO_WIN)
        for (int repw_ = 0; repw_ < (DUP_PH == 302 ? 2 : 1); ++repw_) {
            __syncthreads();
            const float sl2 = slope * LOG2E;
            const bf16_t* Kb = proj + (size_t)b * S_ * PW0 + 2048 + 2048 + g * 128; const bf16_t* Vb = Kb + 512;
            Pass P; pass_init(P);
            const int jlo = qb - 8 > 0 ? qb - 8 : 0;
            struct WinPol { int n, jhi; const DmaMap& dm; const bf16_t* Kb; const bf16_t* Vb; LDSP char* lds; int wid, t; float sl2;
                __device__ __forceinline__ int tile(int i) const { return (DUP_PH == 312) ? jhi - (i >= (n >> 1) ? i - (n >> 1) : i) : jhi - i; }
                __device__ __forceinline__ void dma(int j, int buf, int which) const { DmaMap d2 = dm; asm volatile("" : "+v"(d2.m0), "+v"(d2.m1));   stage_dma(d2, Kb, Vb, PW0, 64 * j, S_ - 1, lds, buf, wid, which); }
                __device__ __forceinline__ void prep(int j, bool& act, bool& need_mask, int& dq0, unsigned& W, float& base) const {
                    dq0 = t - 64 * j; act = __any((dq0 >= 0) && (dq0 - 63 < 512)); need_mask = !__all(dq0 - 63 >= 0 && dq0 < 512); W = 512u; base = -sl2 * (float)dq0; }
            } pol{(DUP_PH == 312) ? 2 * (qb - jlo + 1) : (qb - jlo + 1), qb, dm, Kb, Vb, lds, L.wid, t, sl2};
            ring_pass<decltype(pol), false>(P, pol, lds, L, qr, sl2);
            scale_rows(P.o, NSA_GATE(2) / P.l, xl, L.r32, L.hi);
            char* ob = (char*)O + ((size_t)(b * S_ + 64 * qb + 8 * L.wid) * D_ + (size_t)(4 * g) * 128) * 2;
            const unsigned ovo = (unsigned)(L.hi * 4 * D_ * 2 + L.r32 * 2);
#pragma unroll
            for (int q2 = 0; q2 < 2; ++q2) {
                gchar* pa_ = (gchar*)(accb + avo + (2 * q2) * 4096); asm volatile("" : "+v"(pa_)); gchar* pb_ = (gchar*)(accb + avo + (2 * q2 + 1) * 4096); asm volatile("" : "+v"(pb_));
                float va[16], vb_[16];
#pragma unroll
                for (int k = 0; k < 16; ++k) { va[k] = *(const gfloat*)(pa_ + k * 256); vb_[k] = *(const gfloat*)(pb_ + k * 256); }
#pragma unroll
                for (int hh = 0; hh < 2; ++hh) { const int q = 2 * q2 + hh;
#pragma unroll
                    for (int rl = 0; rl < 4; ++rl) { gchar* po = (gchar*)(ob + ovo + (rl * D_ + q * 128) * 2); asm volatile("" : "+v"(po));
#pragma unroll
                        for (int d = 0; d < 4; ++d) { const float v = (hh ? vb_[rl * 4 + d] : va[rl * 4 + d]) + P.o[d][q * 4 + rl];
                            const float vn = __int_as_float(__builtin_amdgcn_update_dpp(0, __float_as_int(v), 0xB1, 0xF, 0xF, false));
                            if ((L.r32 & 1) == 0) *(gunsigned*)(po + d * 64) = cvtpk(v, vn); } } }
                asm volatile("" ::: "memory"); }
        }
#endif
    }
}

struct DilUnit { int gi, r, b, rho, h, blk, rows, jhi, jlo, Lst; };
__device__ __forceinline__ DilUnit dil_decode(int u) {
    DilUnit d;
    if (u < 2048) { d.gi = u >> 10; const int v = u & 1023; d.h = v & 15; d.r = d.gi ? 4 : 1;
        if (d.gi == 0) { d.rho = 0; d.b = v >> 7; d.blk = ((v >> 4) + (d.b >> 1)) & 7; } else { d.rho = (v >> 5) & 3; d.b = v >> 7; d.blk = ((v >> 4) + (d.b >> 1)) & 1; } d.rows = 256; }
    else { d.gi = 2; const int v = u - 2048; d.h = v & 15; d.rho = (v >> 4) & 15; d.b = v >> 8; d.blk = 0; d.r = 16; d.rows = 128; }
    d.Lst = S_ / d.r; d.jhi = (d.blk * 256 + d.rows - 1) >> 6; d.jlo = (d.blk * 256 - 128) > 0 ? (d.blk * 256 - 128) >> 6 : 0;
    return d;
}
__device__ __forceinline__ void dil_attn_mfma_phase(const Ctx& c) {
    using namespace att;
    LDSP char* lds = (LDSP char*)c.lds;
    const bf16_t* proj = (const bf16_t*)(c.ws + WS_PROJ);
    bf16_t* OG = (bf16_t*)(c.ws + WS_OG); float* LSE = (float*)(c.ws + WS_LSE);
    Lane L; L.tid = c.tid; L.lane = c.lane; L.r32 = c.lane & 31; L.hi = c.lane >> 5; L.wid = c.wave; L.at = lds + OFF_AT; L.atmul = 0;
    const DmaMap dm = dma_map(L.wid, L.lane);
    LDSP float* xl = (LDSP float*)(lds + OFF_WS + L.wid * 256);
    const int NU = 2048;
    int uu = c.bid;
    if (uu >= NU) return;
    DilUnit U = dil_decode(uu);
    u32x4 qraw[8];
#define DIL_ADDR(sec_, b_, h_, pos_) ((((size_t)(sec_) * 8 + (b_)) * 16 + (h_)) * 2048 + (pos_)) * 128
#define DIL_KB(U_) (proj + DIL_ADDR(1 + 2 * (U_).gi, (U_).b, (U_).h, (U_).rho * (U_).Lst))
#define DIL_SEC ((size_t)8 * 16 * 2048 * 128)
#define DIL_ISSUE(U_) do { const bf16_t* kb_ = DIL_KB(U_); \
        stage_dma(dm, kb_, kb_ + DIL_SEC, 128, 64 * (U_).jhi, (U_).Lst - 1, lds, 0, L.wid); \
        if ((U_).jhi > (U_).jlo) stage_dma(dm, kb_, kb_ + DIL_SEC, 128, 64 * ((U_).jhi - 1), (U_).Lst - 1, lds, 1, L.wid, 1); \
        const int uq_ = (U_).blk * 256 + L.wid * 32 + L.r32; const int tq_ = ((L.wid * 32 < (U_).rows) ? uq_ : 0) * (U_).r + (U_).rho; \
        const bf16_t* prow_ = proj + DIL_ADDR(0, (U_).b, (U_).h, tq_); int hiq_ = L.hi; asm volatile("" : "+v"(hiq_));   \
        _Pragma("unroll") for (int d0 = 0; d0 < 8; ++d0) qraw[d0] = *(const u32x4*)(prow_ + d0 * 16 + hiq_ * 8); } while (0)
    __syncthreads();
    DIL_ISSUE(U);
    while (true) {
        const int gi = U.gi, r = U.r, b = U.b, rho = U.rho, h = U.h, blk = U.blk, rows = U.rows;
        const int uq = blk * 256 + L.wid * 32 + L.r32;
        const bool wave_on = L.wid * 32 < rows;
        const int tq = (wave_on ? uq : 0) * r + rho;
        const float slope = exp2f(-0.5f * (float)(h + 1));
        const float sl2 = slope * (float)r * LOG2E;
        { int tw = c.tid; asm volatile("" : "+v"(tw)); if (tw < 32) alibi_table_write(lds, 0, tw, sl2); }
        const bf16_t* Kb = DIL_KB(U); const bf16_t* Vb = Kb + DIL_SEC;
        const size_t kstride = 128;
        bf16x8 qr[8];
#pragma unroll
        for (int d0 = 0; d0 < 8; ++d0) qr[d0] = scale8(qraw[d0], C2);
        Pass P; pass_init(P);
        const int jhi = U.jhi, jlo = U.jlo;
        struct DilPol { int n, jhi; const DmaMap& dm; const bf16_t* Kb; const bf16_t* Vb; size_t kstride; int rmax; LDSP char* lds; int wid, uq; bool wave_on; float sl2;
            __device__ __forceinline__ int tile(int i) const { return jhi - i; }
            __device__ __forceinline__ void dma(int j, int buf, int which) const { stage_dma(dm, Kb, Vb, kstride, 64 * j, rmax, lds, buf, wid, which); }
            __device__ __forceinline__ void prep(int j, bool& act, bool& need_mask, int& dq0, unsigned& W, float& base) const {
                dq0 = uq - 64 * j; act = wave_on && __any((dq0 >= 0) && (dq0 - 63 < 129)); need_mask = !__all(dq0 - 63 >= 0 && dq0 < 129); W = 129u; base = -sl2 * (float)dq0; }
        } pol{jhi - jlo + 1, jhi, dm, Kb, Vb, kstride, U.Lst - 1, lds, L.wid, uq, wave_on, sl2};
        ring_pass<DilPol, (DIL_STAGGER != 0)>(P, pol, lds, L, qr, sl2, true);
        const int un = uu + c.G; const bool more = un < NU;
        __syncthreads();
        if (more) { U = dil_decode(un); DIL_ISSUE(U); }
        if (wave_on) {
            scale_rows(P.o, 1.f / P.l, xl, L.r32, L.hi);
            if (L.hi == 0) LSE[((size_t)gi * T_ + (size_t)b * S_ + tq) * 16 + h] = P.m + __log2f(P.l);
            int r32e = L.r32; asm volatile("" : "+v"(r32e));
#pragma unroll
            for (int rr = 0; rr < 16; ++rr) { const int rw = crow(rr, L.hi); const int tt = (blk * 256 + L.wid * 32 + rw) * r + rho;
                bf16_t* op = OG + ((size_t)gi * T_ + (size_t)b * S_ + tt) * D_ + h * 128 + r32e;
#pragma unroll
                for (int d = 0; d < 4; ++d) { const float v = P.o[d][rr]; const float vn = __int_as_float(__builtin_amdgcn_update_dpp(0, __float_as_int(v), 0xB1, 0xF, 0xF, false));
                    if ((L.r32 & 1) == 0) *(unsigned*)(op + d * 32) = cvtpk(v, vn); } }
        }
        if (!more) break;
        uu = un;
    }
    {
        int widp = L.wid; asm volatile("" : "+v"(widp));
        asm volatile("" : "+v"(L.r32), "+v"(L.hi), "+v"(L.lane));
        LDSP float* xl2 = (LDSP float*)(lds + 8 * SHM + widp * 256);
        const int half = L.wid >> 2, wl = L.wid & 3;
        L.at = lds + OFF_AT + half * 128;
        for (int v = c.bid; v < 1024; v += c.G) {
            const int hp = v & 7, rho = (v >> 3) & 15, b = v >> 7, h = hp + 8 * half;
            __syncthreads();
            { int tw = c.tid; asm volatile("" : "+v"(tw)); if (tw < 64) alibi_table_write(lds, tw >> 5, tw & 31, exp2f(-0.5f * (float)(hp + 8 * (tw >> 5) + 1)) * 16.f * LOG2E); }
#pragma unroll
            for (int hh = 0; hh < 2; ++hh) {
                const bf16_t* kb_ = proj + DIL_ADDR(5, b, hp + 8 * hh, rho * 128);
                stage_dma_at(dm, kb_, kb_ + DIL_SEC, 128, 64, 127, lds + 4 * SHM + (2 * hh + 1) * SHM, lds + (2 * hh + 1) * SHM, L.wid);
                stage_dma_at(dm, kb_, kb_ + DIL_SEC, 128, 0, 127, lds + 4 * SHM + (2 * hh) * SHM, lds + (2 * hh) * SHM, L.wid);
            }
            const int uq = wl * 32 + L.r32, tq = uq * 16 + rho;
            bf16x8 qr[8];
            { u32x4 qraw_[8]; const bf16_t* prow_ = proj + DIL_ADDR(0, b, h, tq);
#pragma unroll
              for (int d0 = 0; d0 < 8; ++d0) qraw_[d0] = *(const u32x4*)(prow_ + d0 * 16 + L.hi * 8);
#pragma unroll
              for (int d0 = 0; d0 < 8; ++d0) qr[d0] = scale8(qraw_[d0], C2); }
            const float sl2 = exp2f(-0.5f * (float)(h + 1)) * 16.f * LOG2E;
            Pass P; pass_init(P);
            ATT_DMA_SYNC();
#pragma unroll
            for (int jj = 1; jj >= 0; --jj) {
                const int dq0 = uq - 64 * jj;
                if (__any(dq0 >= 0)) {
                    PFrag F;
                    tile_qk_at(P, F, lds + 4 * SHM + (2 * half + jj) * SHM, xl2, L, qr, sl2, !__all(dq0 - 63 >= 0), dq0, 129u, -sl2 * (float)dq0);
                    tile_pv_at(P, F, lds + (2 * half + jj) * SHM, L);
                }
            }
            scale_rows(P.o, 1.f / P.l, xl2, L.r32, L.hi);
            if (L.hi == 0) LSE[((size_t)2 * T_ + (size_t)b * S_ + tq) * 16 + h] = P.m + __log2f(P.l);
#pragma unroll
            for (int rr = 0; rr < 16; ++rr) { const int rw = crow(rr, L.hi); const int tt = (wl * 32 + rw) * 16 + rho;
                bf16_t* op = OG + ((size_t)2 * T_ + (size_t)b * S_ + tt) * D_ + h * 128 + L.r32;
#pragma unroll
                for (int d = 0; d < 4; ++d) { const float v_ = P.o[d][rr]; const float vn = __int_as_float(__builtin_amdgcn_update_dpp(0, __float_as_int(v_), 0xB1, 0xF, 0xF, false));
                    if ((L.r32 & 1) == 0) *(unsigned*)(op + d * 32) = cvtpk(v_, vn); } }
        }
    }
#undef DIL_ISSUE
#undef DIL_KB
#undef DIL_ADDR
#undef DIL_SEC
}
__device__ __forceinline__ void dil_merge_phase(const Ctx& c) {
    const bf16_t* OG = (const bf16_t*)(c.ws + WS_OG); const float* LSE = (const float*)(c.ws + WS_LSE); bf16_t* O = (bf16_t*)(c.ws + WS_O);
    const int nw = c.G * NWAVE, lane = c.lane, h = lane >> 2;
    for (int row0 = c.bid * NWAVE + c.wave; row0 < T_; row0 += 2 * nw) {
        const int row1 = row0 + nw < T_ ? row0 + nw : row0;
        u32x4 a[2][4], bq[2][4], cq[2][4]; float l0[2], l1[2], l2[2];
#pragma unroll
        for (int rr = 0; rr < 2; ++rr) { const int row = rr ? row1 : row0;
            l0[rr] = LSE[((size_t)0 * T_ + row) * 16 + h]; l1[rr] = LSE[((size_t)1 * T_ + row) * 16 + h]; l2[rr] = LSE[((size_t)2 * T_ + row) * 16 + h];
#pragma unroll
            for (int q = 0; q < 4; ++q) { const size_t off = (size_t)row * D_ + lane * 32 + q * 8;
                a[rr][q] = *(const u32x4*)(OG + off); bq[rr][q] = *(const u32x4*)(OG + (size_t)T_ * D_ + off); cq[rr][q] = *(const u32x4*)(OG + (size_t)2 * T_ * D_ + off); } }
#pragma unroll
        for (int rr = 0; rr < 2; ++rr) { const int row = rr ? row1 : row0;
            const float mx = fmaxf(l0[rr], fmaxf(l1[rr], l2[rr]));
            float w0 = exp2f(l0[rr] - mx), w1 = exp2f(l1[rr] - mx), w2 = exp2f(l2[rr] - mx); const float inv = 1.f / (w0 + w1 + w2); w0 *= inv; w1 *= inv; w2 *= inv;
#pragma unroll
            for (int q = 0; q < 4; ++q) { const size_t off = (size_t)row * D_ + lane * 32 + q * 8;
                u32x4 o;
#define MRG(f) o.f = att::cvtpk(w0 * __uint_as_float(a[rr][q].f << 16) + w1 * __uint_as_float(bq[rr][q].f << 16) + w2 * __uint_as_float(cq[rr][q].f << 16), \
                                w0 * __uint_as_float(a[rr][q].f & 0xffff0000u) + w1 * __uint_as_float(bq[rr][q].f & 0xffff0000u) + w2 * __uint_as_float(cq[rr][q].f & 0xffff0000u))
                MRG(x); MRG(y); MRG(z); MRG(w);
#undef MRG
                *(u32x4*)(O + off) = o; } }
    }
}

constexpr int N_PHASES = 20;

__global__ void __launch_bounds__(NTHR, 2) fwd(Args args) {
    extern __shared__ __attribute__((aligned(16))) unsigned char lds_raw[];
    const Ctx c0{args, args.ws, (LDSP unsigned char*)lds_raw, 0, 0, __builtin_amdgcn_readfirstlane((int)threadIdx.x >> 6), (int)gridDim.x, (int)blockIdx.x};
    const int tid0 = (int)threadIdx.x;
    const int lo = args.ph_lo, hi = args.ph_hi;
    LDSP unsigned* xbw = (LDSP unsigned*)(c0.lds + LDS_BYTES - 16);
    XcdBarrier bar; bar.bar = (unsigned*)(c0.ws + WS_BAR); bar.x = 0; bar.st = nullptr;
    if (hi - lo > 1) {
        if (tid0 == 0) { xbw[0] = 0u; xbw[1] = 0u; xbw[2] = 0u; xbw[3] = 0u; }
        __syncthreads();
        bar = xcd_barrier_post((unsigned*)(c0.ws + WS_BAR), (volatile LAS unsigned*)xbw);
    }
#define IN(k) (lo <= (k) && (k) < hi)
#define SEAM(k) do { if (IN(k) && IN((k) + 1)) xcd_barrier(bar); else __syncthreads(); } while (0)
    const int vcu = (c0.G % 8 == 0) ? (c0.bid % 8) * (c0.G / 8) + c0.bid / 8 : c0.bid;
    float* MOD = (float*)(c0.ws + WS_MOD);
    bf16_t* X = (bf16_t*)(c0.ws + WS_X); bf16_t* Hb = (bf16_t*)(c0.ws + WS_H); bf16_t* Ob = (bf16_t*)(c0.ws + WS_O); bf16_t* PROJ = (bf16_t*)(c0.ws + WS_PROJ);
    bf16_t* HID = (bf16_t*)(c0.ws + WS_HID); bf16_t* YO = (bf16_t*)(c0.ws + WS_YO);
    bf16_t* WE1 = (bf16_t*)(c0.ws + WS_WE1); bf16_t* WE2 = (bf16_t*)(c0.ws + WS_WE2);

    enum { PH_PRO = 0, PH_NORM0, PH_PROJ0, PH_CMP, PH_ATT0, PH_OUT0, PH_RT0, PH_DSP0, PH_E1_0, PH_E2_0, PH_CN1, PH_PROJ1, PH_ATT1, PH_MRG1, PH_OUT1, PH_RT1, PH_DSP1, PH_E1_1, PH_E2_1, PH_FIN, PH_COUNT };
    static_assert(PH_COUNT == N_PHASES, "phase count");
    if (IN(PH_PRO)) for (int rep_ = 0; rep_ < ((DUP_PH == 200 + PH_PRO) ? 2 : 1); ++rep_) { const Ctx c = fresh(c0); if (rep_) __syncthreads();
#if DUP_PH == 100
        for (int rep_ = 0; rep_ < 2; ++rep_) {
#endif
        mod_units(c); __syncthreads();
        tr_matrix(c, c.A.in[7], D_, 5168, PW0, (bf16_t*)(c.ws + WS_WNSAIN));
        tr_matrix(c, c.A.in[11], D_, D_, D_, (bf16_t*)(c.ws + WS_WNSAOUT));
        tr_matrix(c, c.A.in[12], D_, PW1, PW1, (bf16_t*)(c.ws + WS_WDILIN));
        tr_matrix(c, c.A.in[13], D_, D_, D_, (bf16_t*)(c.ws + WS_WDILOUT));
        tr_matrix(c, c.A.in[8], 4096, 128, 128, (bf16_t*)(c.ws + WS_W1T));
        tr_matrix(c, c.A.in[8] + (size_t)4096 * 128, 4096, 128, 128, (bf16_t*)(c.ws + WS_W1T) + (size_t)128 * 4096);
        tr_experts(c, 0, TRX_T0, TRX_ALL, c.bid * NWAVE + c.wave, c.G * NWAVE);
#if DUP_PH == 100
        __syncthreads(); }
#endif
        SEAM(PH_PRO);
    }
    if (IN(PH_NORM0)) for (int rep_ = 0; rep_ < ((DUP_PH == 200 + PH_NORM0) ? 2 : 1); ++rep_) { const Ctx c = fresh(c0); if (rep_) __syncthreads(); norm_phase<0>(c, c.A.in[0], nullptr, c.A.in[4], MOD + 0 * 2048, MOD + 1 * 2048, nullptr, Hb); SEAM(PH_NORM0); }
    if (IN(PH_PROJ0)) for (int rep_ = 0; rep_ < ((DUP_PH == 200 + PH_PROJ0) ? 2 : 1); ++rep_) { const Ctx c = fresh(c0); if (rep_) __syncthreads();
        pg8::Gemm g{Hb, (const bf16_t*)(c.ws + WS_WNSAIN), T_, PW0, D_}; pg8::StaticOrder S; S.init(T_, PW0, c.G, c.bid);
        pg8::EpiBf16<0> E{PROJ, PW0, nullptr, 0, 0};
        pg8::gemm_phase<pg8::EpiBf16<0>, pg8::StaticOrder, false>((PG8_LAS unsigned char*)c.lds, g, S, E, nullptr);
        { const int nwg = (T_ / 256) * (PW0 / 256), rounds = (nwg + c.G - 1) / c.G; int first_idle = nwg - (rounds - 1) * c.G; if (first_idle >= c.G) first_idle = 0;
          if (c.bid >= first_idle) tr_experts(c, 0, 0, TRX_T0, (c.bid - first_idle) * NWAVE + c.wave, (c.G - first_idle) * NWAVE); }
        SEAM(PH_PROJ0);
    }
    if (IN(PH_CMP)) for (int rep_ = 0; rep_ < ((DUP_PH == 200 + PH_CMP) ? 2 : 1); ++rep_) { const Ctx c = fresh(c0); if (rep_) __syncthreads();
#if CMP_REF
        compress_phase(c);
#else
        compress_mfma_phase(c);
#endif
        SEAM(PH_CMP); }
    if (IN(PH_ATT0)) for (int rep_ = 0; rep_ < ((DUP_PH == 200 + PH_ATT0) ? 2 : 1); ++rep_) { const Ctx c = fresh(c0); if (rep_) __syncthreads();
#if NSA_REF
        nsa_attn_ref_phase(c);
#else
        nsa_attn_mfma_phase(c);
#endif
        SEAM(PH_ATT0);
    }
    if (IN(PH_OUT0)) for (int rep_ = 0; rep_ < ((DUP_PH == 200 + PH_OUT0) ? 2 : 1); ++rep_) { const Ctx c = fresh(c0); if (rep_) __syncthreads();
        pg8::Gemm g{Ob, (const bf16_t*)(c.ws + WS_WNSAOUT), T_, D_, D_}; pg8::StaticOrder S; S.init(T_, D_, c.G, c.bid);
        EpiResid<true> E{c.A.in[0], X, MOD + 2 * 2048};
        pg8::gemm_phase<EpiResid<true>, pg8::StaticOrder, false>((PG8_LAS unsigned char*)c.lds, g, S, E, nullptr);
        SEAM(PH_OUT0);
    }
    if (IN(PH_RT0)) for (int rep_ = 0; rep_ < ((DUP_PH == 200 + PH_RT0) ? 2 : 1); ++rep_) { const Ctx c = fresh(c0); if (rep_) __syncthreads(); norm_phase<1>(c, X, nullptr, c.A.in[5], MOD + 3 * 2048, MOD + 4 * 2048, nullptr, Hb); SEAM(PH_RT0); }
    if (IN(PH_DSP0)) for (int rep_ = 0; rep_ < ((DUP_PH == 200 + PH_DSP0) ? 2 : 1); ++rep_) { const Ctx c = fresh(c0); if (rep_) __syncthreads(); dispatch_phase(c); SEAM(PH_DSP0); }
    if (IN(PH_E1_0)) for (int rep_ = 0; rep_ < ((DUP_PH == 200 + PH_E1_0) ? 2 : 1); ++rep_) { const Ctx c = fresh(c0); if (rep_) __syncthreads();
        moe_tab_to_lds(c);
        pg8::Gemm g{Hb, WE1, CAP, 16 * 2816, D_}; MoeOrder S{(LDSP const int*)(c.lds + LDS_MISC), c.G, vcu, 11};
        EpiSwiglu E{HID};
        pg8::gemm_phase_g<EpiSwiglu, MoeOrder, false>((const int*)(c.ws + WS_SLOTTOK), (PG8_LAS unsigned char*)c.lds, g, S, E, nullptr);
        SEAM(PH_E1_0);
    }
    if (IN(PH_E2_0)) for (int rep_ = 0; rep_ < ((DUP_PH == 200 + PH_E2_0) ? 2 : 1); ++rep_) { const Ctx c = fresh(c0); if (rep_) __syncthreads();
        moe_tab_to_lds(c);
        pg8::Gemm g{HID, WE2, CAP, 16 * 2048, DE}; MoeOrder S{(LDSP const int*)(c.lds + LDS_MISC), c.G, vcu, 8};
        EpiDown E{YO, (const float*)(c.ws + WS_SLOTW)};
        pg8::gemm_phase<EpiDown, MoeOrder, false>((PG8_LAS unsigned char*)c.lds, g, S, E, nullptr);
        { const int total = ld_i((const int*)(c.ws + WS_TAB) + 16) * 8, rounds = (total + c.G - 1) / c.G; int first_idle = total - (rounds - 1) * c.G; if (first_idle >= c.G || first_idle < 0) first_idle = 0;
          if (vcu >= first_idle) tr_experts(c, 1, 0, TRX_T1, (vcu - first_idle) * NWAVE + c.wave, (c.G - first_idle) * NWAVE); }
        SEAM(PH_E2_0);
    }
    if (IN(PH_CN1)) for (int rep_ = 0; rep_ < ((DUP_PH == 200 + PH_CN1) ? 2 : 1); ++rep_) { const Ctx c = fresh(c0); if (rep_) __syncthreads();
        norm_phase<2>(c, X, X, c.A.in[4] + 2048, MOD + (size_t)8 * MODW + 0 * 2048, MOD + (size_t)8 * MODW + 1 * 2048, MOD + 5 * 2048, Hb);
        __syncthreads();
        tr_experts(c, 1, TRX_T1, TRX_ALL, c.bid * NWAVE + c.wave, c.G * NWAVE);
        SEAM(PH_CN1);
    }
    if (IN(PH_PROJ1)) for (int rep_ = 0; rep_ < ((DUP_PH == 200 + PH_PROJ1) ? 2 : 1); ++rep_) { const Ctx c = fresh(c0); if (rep_) __syncthreads();
        pg8::Gemm g{Hb, (const bf16_t*)(c.ws + WS_WDILIN), T_, PW1, D_}; pg8::StaticOrder S; S.init(T_, PW1, c.G, c.bid);
        EpiDilProj E{PROJ};
        pg8::gemm_phase<EpiDilProj, pg8::StaticOrder, false>((PG8_LAS unsigned char*)c.lds, g, S, E, nullptr);
        SEAM(PH_PROJ1);
    }
    if (IN(PH_ATT1)) for (int rep_ = 0; rep_ < ((DUP_PH == 200 + PH_ATT1) ? 2 : 1); ++rep_) { const Ctx c = fresh(c0); if (rep_) __syncthreads();
#if DIL_REF
        dil_attn_ref_phase(c);
#else
        dil_attn_mfma_phase(c);
#endif
        SEAM(PH_ATT1);
    }
    if (IN(PH_MRG1)) for (int rep_ = 0; rep_ < ((DUP_PH == 200 + PH_MRG1) ? 2 : 1); ++rep_) { const Ctx c = fresh(c0); if (rep_) __syncthreads();
#if !DIL_REF
        dil_merge_phase(c);
#endif
        SEAM(PH_MRG1);
    }
    if (IN(PH_OUT1)) for (int rep_ = 0; rep_ < ((DUP_PH == 200 + PH_OUT1) ? 2 : 1); ++rep_) { const Ctx c = fresh(c0); if (rep_) __syncthreads();
        pg8::Gemm g{Ob, (const bf16_t*)(c.ws + WS_WDILOUT), T_, D_, D_}; pg8::StaticOrder S; S.init(T_, D_, c.G, c.bid);
        EpiResid<false> E{X, X, MOD + (size_t)8 * MODW + 2 * 2048};
        pg8::gemm_phase<EpiResid<false>, pg8::StaticOrder, false>((PG8_LAS unsigned char*)c.lds, g, S, E, nullptr);
        SEAM(PH_OUT1);
    }
    if (IN(PH_RT1)) for (int rep_ = 0; rep_ < ((DUP_PH == 200 + PH_RT1) ? 2 : 1); ++rep_) { const Ctx c = fresh(c0); if (rep_) __syncthreads(); norm_phase<1>(c, X, nullptr, c.A.in[5] + 2048, MOD + (size_t)8 * MODW + 3 * 2048, MOD + (size_t)8 * MODW + 4 * 2048, nullptr, Hb); SEAM(PH_RT1); }
    if (IN(PH_DSP1)) for (int rep_ = 0; rep_ < ((DUP_PH == 200 + PH_DSP1) ? 2 : 1); ++rep_) { const Ctx c = fresh(c0); if (rep_) __syncthreads(); dispatch_phase(c); SEAM(PH_DSP1); }
    if (IN(PH_E1_1)) for (int rep_ = 0; rep_ < ((DUP_PH == 200 + PH_E1_1) ? 2 : 1); ++rep_) { const Ctx c = fresh(c0); if (rep_) __syncthreads();
        moe_tab_to_lds(c);
        pg8::Gemm g{Hb, WE1, CAP, 16 * 2816, D_}; MoeOrder S{(LDSP const int*)(c.lds + LDS_MISC), c.G, vcu, 11};
        EpiSwiglu E{HID};
        pg8::gemm_phase_g<EpiSwiglu, MoeOrder, false>((const int*)(c.ws + WS_SLOTTOK), (PG8_LAS unsigned char*)c.lds, g, S, E, nullptr);
        SEAM(PH_E1_1);
    }
    if (IN(PH_E2_1)) for (int rep_ = 0; rep_ < ((DUP_PH == 200 + PH_E2_1) ? 2 : 1); ++rep_) { const Ctx c = fresh(c0); if (rep_) __syncthreads();
        moe_tab_to_lds(c);
        pg8::Gemm g{HID, WE2, CAP, 16 * 2048, DE}; MoeOrder S{(LDSP const int*)(c.lds + LDS_MISC), c.G, vcu, 8};
        EpiDown E{YO, (const float*)(c.ws + WS_SLOTW)};
        pg8::gemm_phase<EpiDown, MoeOrder, false>((PG8_LAS unsigned char*)c.lds, g, S, E, nullptr);
        SEAM(PH_E2_1);
    }
#if DUP_PH == 250
    if (hi - lo > 1) { for (int k_ = 0; k_ < 10; ++k_) xcd_barrier(bar); }
#endif
    if (IN(PH_FIN)) for (int rep_ = 0; rep_ < ((DUP_PH == 200 + PH_FIN) ? 2 : 1); ++rep_) { const Ctx c = fresh(c0); if (rep_) __syncthreads(); norm_phase<3>(c, X, nullptr, c.A.in[6], nullptr, nullptr, MOD + (size_t)8 * MODW + 5 * 2048, nullptr); }
#undef IN
#undef SEAM
}

extern "C" void kernel_launch(void* const* d_in, const int* in_sizes, int n_in, void* d_out, int out_size, void* d_ws, size_t ws_size, hipStream_t stream) {
    static int grid = 0;
    if (grid == 0) {
        if (n_in != 19 || out_size != T_ * D_ || ws_size < WS_END) { fprintf(stderr, "kernel_launch: unexpected shapes (n_in %d out %d ws %zu need %zu)\n", n_in, out_size, ws_size, (size_t)WS_END); grid = -1; return; }
        int dev = 0, cus = 0;
        if (hipGetDevice(&dev) != hipSuccess || hipDeviceGetAttribute(&cus, hipDeviceAttributeMultiprocessorCount, dev) != hipSuccess) { grid = -1; return; }
        if (hipFuncSetAttribute((const void*)fwd, hipFuncAttributeMaxDynamicSharedMemorySize, LDS_BYTES) != hipSuccess) { fprintf(stderr, "kernel_launch: hipFuncSetAttribute failed\n"); grid = -1; return; }
        int per_cu = 0;
        if (hipOccupancyMaxActiveBlocksPerMultiprocessor(&per_cu, (const void*)fwd, NTHR, LDS_BYTES) != hipSuccess || per_cu < 1) fprintf(stderr, "kernel_launch: occupancy query says %d\n", per_cu);
        (void)hipGetLastError();
        grid = cus > 256 ? 256 : cus;
    }
    if (grid < 0) return;
    (void)hipMemsetAsync((char*)d_ws + WS_BAR, 0, WS_CTL_END, stream);
    Args a{};
    for (int i = 0; i < 19; ++i) a.in[i] = (const float*)d_in[i];
    a.out = (float*)d_out; a.ws = (unsigned char*)d_ws;
#if MK_ONE_LAUNCH
    a.ph_lo = 0; a.ph_hi = N_PHASES;
    hipLaunchKernelGGL(fwd, dim3(grid), dim3(NTHR), LDS_BYTES, stream, a);
#else
    for (int p = 0; p < N_PHASES; ++p) { a.ph_lo = p; a.ph_hi = p + 1; hipLaunchKernelGGL(fwd, dim3(grid), dim3(NTHR), LDS_BYTES, stream, a); }
#endif
}
```

```cpp
#define MK_ONE_LAUNCH 1
#define NSA_REF 0
#define DIL_REF 0
#define DUP_PH 0
#define CMP_REF 0
#define DIL_STAGGER 1
#define DIL_STREAM 1
#include <hip/hip_runtime.h>
#include <cstdio>
#include <cstdint>
#define XB_TMO      128
#define XB_XCNT(j)  (256  + 64 * (j))
#define XB_XSUB(j)  (1280 + 64 * (j))
#define XB_XGEN(j)  (2304 + 64 * (j))
#define XB_TOP      3328
#define XB_TOPGEN   3392
#define XCD_BAR_WORDS 3456
#define XB_SPIN_CAP (1u << 18)
#define LAS __attribute__((address_space(3)))

__device__ __forceinline__ unsigned xb_ld(unsigned* p)              { return __hip_atomic_load(p, __ATOMIC_RELAXED, __HIP_MEMORY_SCOPE_AGENT); }
__device__ __forceinline__ unsigned xb_add(unsigned* p, unsigned v) { return __hip_atomic_fetch_add(p, v, __ATOMIC_RELAXED, __HIP_MEMORY_SCOPE_AGENT); }
__device__ __forceinline__ unsigned xb_xcc_id() { return (unsigned)__builtin_amdgcn_s_getreg((3 << 11) | 20) & 0xFu; }
#define XB_SPIN(cond, bar) do { unsigned _sp = 0; while (cond) { __builtin_amdgcn_s_sleep(1); \
    if ((++_sp & 255u) == 0u) { if (xb_ld(&(bar)[XB_TMO])) break; if (_sp > XB_SPIN_CAP) { atomicAdd(&(bar)[XB_TMO], 1u); break; } } } } while (0)

struct XcdBarrier {
    unsigned* bar; unsigned x;
    volatile LAS unsigned* st;
};

__device__ __forceinline__ XcdBarrier xcd_barrier_post(unsigned* bar, volatile LAS unsigned* st) {
    XcdBarrier b; b.bar = bar; b.x = xb_xcc_id(); b.st = st;
    if (threadIdx.x == 0) (void)xb_add(&bar[XB_XCNT(b.x)], 1u);
    return b;
}
__device__ __forceinline__ void xcd_barrier_complete(unsigned* bar, unsigned x, unsigned& nloc, unsigned& nx) {
    const unsigned G = gridDim.x * gridDim.y * gridDim.z;
    unsigned sum, cnt, mine, sp = 0u;
    for (;;) {
        sum = 0u; cnt = 0u; mine = 0u;
#pragma unroll
        for (unsigned j = 0; j < 16; ++j) { const unsigned c = xb_ld(&bar[XB_XCNT(j)]); sum += c; cnt += (c > 0u) ? 1u : 0u; mine = (j == x) ? c : mine; }
        if (sum == G) break;
        __builtin_amdgcn_s_sleep(1);
        if ((++sp & 255u) == 0u) { if (xb_ld(&bar[XB_TMO])) break; if (sp > XB_SPIN_CAP) { atomicAdd(&bar[XB_TMO], 1u); break; } }
    }
    nloc = mine > 0u ? mine : 1u; nx = cnt > 0u ? cnt : 1u;
}

__device__ __forceinline__ void xcd_barrier(const XcdBarrier& b) {
    asm volatile("s_waitcnt vmcnt(0)" ::: "memory");
    __syncthreads();
    if (threadIdx.x == 0) {
        unsigned* bar = b.bar;
        __builtin_amdgcn_s_waitcnt(0);
        unsigned nloc = b.st[0], nx = b.st[1];
        if (nloc == 0u) { xcd_barrier_complete(bar, b.x, nloc, nx); b.st[0] = nloc; b.st[1] = nx; }
        const unsigned old = xb_add(&bar[XB_XSUB(b.x)], 1u);
        const unsigned gen = old / nloc;
        if (old + 1u == (gen + 1u) * nloc) {
            __builtin_amdgcn_fence(__ATOMIC_RELEASE, "agent");
            asm volatile("s_waitcnt vmcnt(0)" ::: "memory");
            const unsigned og = xb_add(&bar[XB_TOP], 1u);
            const unsigned tg = og / nx;
            if (og + 1u == (tg + 1u) * nx) xb_add(&bar[XB_TOPGEN], 1u);
            else XB_SPIN(xb_ld(&bar[XB_TOPGEN]) == tg, bar);
            __builtin_amdgcn_fence(__ATOMIC_ACQUIRE, "agent");
            xb_add(&bar[XB_XGEN(b.x)], 1u);
            asm volatile("s_waitcnt vmcnt(0)" ::: "memory");
        } else {
            XB_SPIN(xb_ld(&bar[XB_XGEN(b.x)]) == gen, bar);
            __builtin_amdgcn_fence(__ATOMIC_ACQUIRE, "agent");
            asm volatile("s_waitcnt vmcnt(0)" ::: "memory");
        }
    }
    __syncthreads();
}
namespace pg8 {
#define PG8_LAS __attribute__((address_space(3)))
typedef unsigned short bf16_t;
typedef short bf16x8 __attribute__((ext_vector_type(8)));
typedef float f32x4 __attribute__((ext_vector_type(4)));
typedef unsigned u32x4 __attribute__((ext_vector_type(4)));
constexpr int BM = 256, BK = 64, HALF = 128, HTB = HALF * BK * 2  , STAGE_BYTES = 8 * HTB, NXCD = 8, WGM = 8;

__host__ __device__ __forceinline__ int lds_byte(int r, int c) { const int st = (r >> 4) * 2 + (c >> 5), rr = r & 15, cc = c & 31, ob = rr * 64 + cc * 2; return st * 1024 + (ob ^ (((ob >> 9) & 1) << 5)); }
__host__ __device__ __forceinline__ void stage_rc(int b, int& R, int& C) { const int st = b / 1024, sb = b % 1024, swz = sb ^ (((sb >> 9) & 1) << 5); R = (st >> 1) * 16 + swz / 64; C = (st & 1) * 32 + (swz % 64) / 2; }
__host__ __device__ __forceinline__ int perm32(int rho) { const int n = rho >> 4, i = rho & 15; return 8 * (i >> 2) + 4 * n + (i & 3); }

struct Unit { int pm, pn; };
struct Gemm { const bf16_t* A; const bf16_t* Bt; int M, N, K; };

struct StaticOrder {
    int nM, nN, nwg, G, c;
    __host__ __device__ void init(int M, int N, int G_, int c_) { nM = M / BM; nN = N / BM; nwg = nM * nN; G = G_; c = c_; }
    __host__ __device__ bool next(int i, Unit& u) const {
        const long L = (long)i * G + c; if (L >= nwg) return false;
        int wgid = (int)L; { const int q = nwg / NXCD, r = nwg % NXCD, xcd = wgid % NXCD, off = wgid / NXCD; wgid = (xcd < r ? xcd * (q + 1) : r * (q + 1) + (xcd - r) * q) + off; }
        const int nig = WGM * nN, gid = wgid / nig, fm = gid * WGM, gsz = (nM - fm) < WGM ? (nM - fm) : WGM;
        u.pm = fm + ((wgid % nig) % gsz); u.pn = (wgid % nig) / gsz; return true;
    }
    __device__ __forceinline__ void a_ready(const Unit&) const {}
    __device__ __forceinline__ void done(const Unit&) const {}
};
struct CountedOrder : StaticOrder {
    const unsigned* ready; unsigned need; unsigned* tmo;
    __device__ __forceinline__ void a_ready(const Unit& u) const {
        if (threadIdx.x < 64) {
            const unsigned long long t0 = __builtin_amdgcn_s_memrealtime(); unsigned polls = 0;
            while ((unsigned)__builtin_amdgcn_readfirstlane(__hip_atomic_load(ready + 64 * u.pm, __ATOMIC_RELAXED, __HIP_MEMORY_SCOPE_AGENT)) < need) {
                if ((++polls & 255u) == 0u && __builtin_amdgcn_readfirstlane(__hip_atomic_load(tmo, __ATOMIC_RELAXED, __HIP_MEMORY_SCOPE_AGENT)) != 0u) break;
                if (__builtin_amdgcn_s_memrealtime() - t0 > 2000000ull) {
                    if (threadIdx.x == 0) { unsigned expect = 0u; __hip_atomic_compare_exchange_strong(tmo + 1, &expect, 0x600u | (unsigned)(u.pm & 0xff), __ATOMIC_RELAXED, __ATOMIC_RELAXED, __HIP_MEMORY_SCOPE_AGENT); __hip_atomic_store(tmo, 1u, __ATOMIC_RELAXED, __HIP_MEMORY_SCOPE_AGENT); }
                    break; }
                __builtin_amdgcn_s_sleep(2); }
            __builtin_amdgcn_fence(__ATOMIC_ACQUIRE, "agent");
            asm volatile("s_waitcnt vmcnt(0)" ::: "memory");
        }
#if !defined(BROKEN_HOOK_NO_BARRIER)
        asm volatile("" ::: "memory"); __builtin_amdgcn_s_barrier(); asm volatile("" ::: "memory");
#endif
    }
};

__device__ __forceinline__ unsigned cvt_pk_bf16(float lo, float hi) { unsigned r; asm volatile("v_cvt_pk_bf16_f32 %0, %1, %2" : "=v"(r) : "v"(lo), "v"(hi)); return r; }
typedef float f32x2 __attribute__((ext_vector_type(2)));
__device__ __forceinline__ f32x2 gelu_pk(f32x2 v) {
    const f32x2 av = __builtin_elementwise_abs(v), d = av * 0.2316418882f + 1.0f;
    f32x2 t; t.x = __builtin_amdgcn_rcpf(d.x); t.y = __builtin_amdgcn_rcpf(d.y);
    f32x2 q = t * 0.5307027145f + (-0.7265760135f); q = q * t + 0.7107068705f; q = q * t + (-0.142248368f); q = q * t + 0.127414796f; q = q * t;
    const f32x2 s = (v * v) * (-0.72134752044f);
    f32x2 e; e.x = __builtin_amdgcn_exp2f(s.x); e.y = __builtin_amdgcn_exp2f(s.y);
    const f32x2 m = v * (q * e), r = v - m;
    f32x2 o; o.x = v.x < 0.f ? m.x : r.x; o.y = v.y < 0.f ? m.y : r.y; return o;
}

struct EpiF32 {
    static constexpr bool PERM = false, AFTER_DRAIN = false;
    float* C; int ldc; const float* bias;
    __device__ __forceinline__ void operator()(const f32x4 (&acc)[2][2][4][2], const Unit& u, int wr, int wc, int fr, int fq) const {
        const int row0 = u.pm * BM + wr * 64 + fr, col0 = u.pn * BM + wc * 32 + 4 * fq;
        f32x4 bv[2][2];
#pragma unroll
        for (int bj = 0; bj < 2; ++bj)
#pragma unroll
            for (int n = 0; n < 2; ++n) bv[bj][n] = bias ? *(const f32x4*)(bias + col0 + bj * HALF + n * 16) : (f32x4){0.f, 0.f, 0.f, 0.f};
#pragma unroll
        for (int ai = 0; ai < 2; ++ai)
#pragma unroll
            for (int m = 0; m < 4; ++m) { float* rowp = C + (size_t)(row0 + ai * HALF + m * 16) * ldc + col0;
#pragma unroll
                for (int bj = 0; bj < 2; ++bj)
#pragma unroll
                    for (int n = 0; n < 2; ++n) *(f32x4*)(rowp + bj * HALF + n * 16) = acc[ai][bj][m][n] + bv[bj][n]; }
    }
};
template <int ACT  > struct EpiBf16 {
    static constexpr bool PERM = true, AFTER_DRAIN = false;
    bf16_t* O; int ldc; const float* bias; int split_cols; size_t split_stride;
    __device__ __forceinline__ void operator()(const f32x4 (&acc)[2][2][4][2], const Unit& u, int wr, int wc, int fr, int fq) const {
        const int row0 = u.pm * BM + wr * 64 + fr; int colt = u.pn * BM; bf16_t* base = O;
        if (split_cols) { const int t = colt / split_cols; base += (size_t)t * split_stride; colt -= t * split_cols; }
        const int col0 = colt + wc * 32 + 8 * fq, bcol0 = u.pn * BM + wc * 32 + 8 * fq;
        f32x4 bv[2][2];
#pragma unroll
        for (int bj = 0; bj < 2; ++bj)
#pragma unroll
            for (int n = 0; n < 2; ++n) bv[bj][n] = bias ? *(const f32x4*)(bias + bcol0 + bj * HALF + 4 * n) : (f32x4){0.f, 0.f, 0.f, 0.f};
#pragma unroll
        for (int ai = 0; ai < 2; ++ai)
#pragma unroll
            for (int m = 0; m < 4; ++m) { bf16_t* rowp = base + (size_t)(row0 + ai * HALF + m * 16) * ldc + col0;
#pragma unroll
                for (int bj = 0; bj < 2; ++bj) { f32x4 v0 = acc[ai][bj][m][0] + bv[bj][0], v1 = acc[ai][bj][m][1] + bv[bj][1];
                    if (ACT == 1) { f32x2 a = gelu_pk((f32x2){v0[0], v0[1]}), b = gelu_pk((f32x2){v0[2], v0[3]}), c = gelu_pk((f32x2){v1[0], v1[1]}), d = gelu_pk((f32x2){v1[2], v1[3]});
                        v0 = (f32x4){a.x, a.y, b.x, b.y}; v1 = (f32x4){c.x, c.y, d.x, d.y}; }
                    if (ACT == 2) {
#pragma unroll
                        for (int j = 0; j < 4; ++j) { v0[j] = 0.5f * v0[j] * (1.0f + erff(v0[j] * 0.70710678f)); v1[j] = 0.5f * v1[j] * (1.0f + erff(v1[j] * 0.70710678f)); } }
                    u32x4 w; w.x = cvt_pk_bf16(v0[0], v0[1]); w.y = cvt_pk_bf16(v0[2], v0[3]); w.z = cvt_pk_bf16(v1[0], v1[1]); w.w = cvt_pk_bf16(v1[2], v1[3]);
                    *(u32x4*)(rowp + bj * HALF) = w; } }
    }
};

template <class Epi, class Sched, bool STAMP = false>
__device__ __forceinline__ void gemm_phase(PG8_LAS unsigned char* lds, const Gemm g, const Sched& S, const Epi& E, unsigned long long* stamps) {
    const int tid = threadIdx.x, wid = __builtin_amdgcn_readfirstlane(tid >> 6), lane = tid & 63, wr = wid >> 2, wc = wid & 3, fr = lane & 15, fq = lane >> 4;
    const int K = g.K, nt = K / BK;
    int ts_lo = 0, ts_hi = 0, nts = 0; const unsigned long long rt_entry = STAMP ? (unsigned long long)wall_clock64() : 0ull;
#define PG8_STAMP() do { if (STAMP && wid == 0 && nts < 64) { const unsigned long long _c = (unsigned long long)clock64(); \
        ts_lo = (lane == nts) ? (int)(unsigned)_c : ts_lo; ts_hi = (lane == nts) ? (int)(unsigned)(_c >> 32) : ts_hi; ++nts; } } while (0)
    PG8_STAMP();
    unsigned voffA[2], voffB[2];
#pragma unroll
    for (int i = 0; i < 2; ++i) { int R, C; stage_rc(tid * 16 + i * 8192, R, C); const int Rb = Epi::PERM ? ((R & ~31) + perm32(R & 31)) : R;
        voffA[i] = (unsigned)(R * K + C) * 2u; voffB[i] = (unsigned)(Rb * K + C) * 2u; }
    const size_t kstep = (size_t)(BK * 2);
    const size_t hstep = (size_t)HALF * K * 2;
    const size_t tstep = 2 * hstep;
    const unsigned ldsw = (unsigned)wid * 1024u;
    const int aoff = lds_byte(wr * 64 + fr, fq * 8), boff = lds_byte(wc * 32 + fr, fq * 8);
#define PG8_SA(b, h) (((b) * 2 + (h)) * HTB)
#define PG8_SB(b, h) ((4 + (b) * 2 + (h)) * HTB)
#define PG8_STAGE(bufoff, gbase, voff) do { _Pragma("unroll") for (int _i = 0; _i < 2; ++_i) \
        __builtin_amdgcn_global_load_lds((const unsigned*)((const char*)(gbase) + (voff)[_i]), (PG8_LAS unsigned*)(lds + (bufoff) + ldsw + _i * 8192), 16, 0, 0); } while (0)
#define PG8_LDA(dst, b, h) do { _Pragma("unroll") for (int m = 0; m < 4; ++m) _Pragma("unroll") for (int k = 0; k < 2; ++k) dst[m][k] = *(const PG8_LAS bf16x8*)(lds + PG8_SA(b, h) + aoff + m * 2048 + k * 1024); } while (0)
#define PG8_LDB(dst, b, h) do { _Pragma("unroll") for (int n = 0; n < 2; ++n) _Pragma("unroll") for (int k = 0; k < 2; ++k) dst[n][k] = *(const PG8_LAS bf16x8*)(lds + PG8_SB(b, h) + boff + n * 2048 + k * 1024); } while (0)
#define PG8_MMA(ai, bj, At, Bt) do { __builtin_amdgcn_s_setprio(1); _Pragma("unroll") for (int m = 0; m < 4; ++m) _Pragma("unroll") for (int n = 0; n < 2; ++n) _Pragma("unroll") for (int k = 0; k < 2; ++k) \
        acc[ai][bj][m][n] = __builtin_amdgcn_mfma_f32_16x16x32_bf16(Bt[n][k], At[m][k], acc[ai][bj][m][n], 0, 0, 0); __builtin_amdgcn_s_setprio(0); } while (0)
#define PG8_WAIT_V(n) asm volatile("s_waitcnt vmcnt(" #n ")" ::: "memory")
#define PG8_WAIT_L(n) asm volatile("s_waitcnt lgkmcnt(" #n ")" ::: "memory")
#define PG8_BAR __builtin_amdgcn_s_barrier()
#define PG8_SCHED __builtin_amdgcn_sched_barrier(0)
    Unit cur, nxt; int ui = 0;
    if (!S.next(0, cur)) return;
    f32x4 acc[2][2][4][2];
#pragma unroll
    for (int a = 0; a < 2; ++a)
#pragma unroll
        for (int b = 0; b < 2; ++b)
#pragma unroll
            for (int m = 0; m < 4; ++m)
#pragma unroll
                for (int n = 0; n < 2; ++n) acc[a][b][m][n] = (f32x4){0.f, 0.f, 0.f, 0.f};
    bf16x8 At[4][2], B0[2][2], B1[2][2];
    const char* cA = (const char*)g.A + (size_t)cur.pm * tstep; const char* cB = (const char*)g.Bt + (size_t)cur.pn * tstep;
    S.a_ready(cur);
    PG8_STAGE(PG8_SB(0, 0), cB, voffB); PG8_STAGE(PG8_SA(0, 0), cA, voffA); PG8_STAGE(PG8_SB(0, 1), cB + hstep, voffB); PG8_STAGE(PG8_SA(0, 1), cA + hstep, voffA);
    if (wr == 1) PG8_BAR;
    PG8_WAIT_V(4); PG8_BAR;
    PG8_STAGE(PG8_SB(1, 0), cB + kstep, voffB); PG8_STAGE(PG8_SA(1, 0), cA + kstep, voffA); PG8_STAGE(PG8_SB(1, 1), cB + hstep + kstep, voffB);
    PG8_WAIT_V(6); PG8_BAR;
    PG8_STAMP();
    for (;;) {
        const bool has_next = S.next(ui + 1, nxt);
        const char* nA = has_next ? (const char*)g.A + (size_t)nxt.pm * tstep : cA; const char* nB = has_next ? (const char*)g.Bt + (size_t)nxt.pn * tstep : cB;
        for (int t = 0; t < nt; t += 2) {
            const bool last = (t == nt - 2);
            const char* a1 = cA + (size_t)(t + 1) * kstep;
            const char* a2 = last ? nA : cA + (size_t)(t + 2) * kstep; const char* b2 = last ? nB : cB + (size_t)(t + 2) * kstep;
            const char* a3 = a2 + kstep; const char* b3 = b2 + kstep;
            if (last && has_next) S.a_ready(nxt);
            PG8_LDB(B0, 0, 0); PG8_SCHED; PG8_LDA(At, 0, 0); PG8_STAGE(PG8_SA(1, 1), a1 + hstep, voffA);
            PG8_WAIT_L(8); PG8_BAR; PG8_WAIT_L(0); PG8_MMA(0, 0, At, B0); PG8_BAR; PG8_SCHED;
            PG8_LDB(B1, 0, 1); PG8_STAGE(PG8_SB(0, 0), b2, voffB);
            PG8_BAR; PG8_WAIT_L(0); PG8_MMA(0, 1, At, B1); PG8_BAR;
            PG8_LDA(At, 0, 1); PG8_STAGE(PG8_SA(0, 0), a2, voffA);
            PG8_BAR; PG8_WAIT_L(0); PG8_MMA(1, 0, At, B0); PG8_BAR; PG8_SCHED;
            PG8_STAGE(PG8_SB(0, 1), b2 + hstep, voffB);
            PG8_WAIT_V(6); PG8_BAR; PG8_MMA(1, 1, At, B1); PG8_BAR;
            PG8_LDB(B0, 1, 0); PG8_SCHED; PG8_LDA(At, 1, 0); PG8_STAGE(PG8_SA(0, 1), a2 + hstep, voffA);
            PG8_WAIT_L(8); PG8_BAR; PG8_WAIT_L(0); PG8_MMA(0, 0, At, B0); PG8_BAR; PG8_SCHED;
            PG8_LDB(B1, 1, 1); PG8_STAGE(PG8_SB(1, 0), b3, voffB);
            PG8_BAR; PG8_WAIT_L(0); PG8_MMA(0, 1, At, B1); PG8_BAR;
            PG8_LDA(At, 1, 1); PG8_STAGE(PG8_SA(1, 0), a3, voffA);
            PG8_BAR; PG8_WAIT_L(0); PG8_MMA(1, 0, At, B0); PG8_BAR; PG8_SCHED;
            PG8_STAGE(PG8_SB(1, 1), b3 + hstep, voffB);
            PG8_WAIT_V(6); PG8_BAR; PG8_MMA(1, 1, At, B1); PG8_BAR;
        }
        PG8_STAMP();
        if constexpr (!Epi::AFTER_DRAIN) { E(acc, cur, wr, wc, fr, fq); S.done(cur); }
        PG8_STAMP();
        if (!has_next) break;
#pragma unroll
        for (int a = 0; a < 2; ++a)
#pragma unroll
            for (int b = 0; b < 2; ++b)
#pragma unroll
                for (int m = 0; m < 4; ++m)
#pragma unroll
                    for (int n = 0; n < 2; ++n) acc[a][b][m][n] = (f32x4){0.f, 0.f, 0.f, 0.f};
        cur = nxt; cA = nA; cB = nB; ++ui;
    }
    PG8_WAIT_V(0);
    if (wr == 0) PG8_BAR;
    PG8_BAR;
    if constexpr (Epi::AFTER_DRAIN) { E.fused(acc, cur, wr, wc, fr, fq, lds, wid, lane); S.done(cur); }
    PG8_STAMP();
    if (STAMP && wid == 0) { stamps[lane] = lane < nts ? (((unsigned long long)(unsigned)ts_hi << 32) | (unsigned)ts_lo) : 0ull;
        if (lane == 62) stamps[62] = rt_entry; if (lane == 63) stamps[63] = (unsigned long long)wall_clock64(); }
#undef PG8_STAMP
#undef PG8_SA
#undef PG8_SB
#undef PG8_STAGE
#undef PG8_LDA
#undef PG8_LDB
#undef PG8_MMA
#undef PG8_WAIT_V
#undef PG8_WAIT_L
#undef PG8_BAR
#undef PG8_SCHED
}
template <class Epi, class Sched, bool STAMP = false>
__device__ __forceinline__ void gemm_phase_g(const int* rowmap, PG8_LAS unsigned char* lds, const Gemm g, const Sched& S, const Epi& E, unsigned long long* stamps) {
    const int tid = threadIdx.x, wid = __builtin_amdgcn_readfirstlane(tid >> 6), lane = tid & 63, wr = wid >> 2, wc = wid & 3, fr = lane & 15, fq = lane >> 4;
    const int K = g.K, nt = K / BK;
    int ts_lo = 0, ts_hi = 0, nts = 0; const unsigned long long rt_entry = STAMP ? (unsigned long long)wall_clock64() : 0ull;
#define PG8_STAMP() do { if (STAMP && wid == 0 && nts < 64) { const unsigned long long _c = (unsigned long long)clock64(); \
        ts_lo = (lane == nts) ? (int)(unsigned)_c : ts_lo; ts_hi = (lane == nts) ? (int)(unsigned)(_c >> 32) : ts_hi; ++nts; } } while (0)
    PG8_STAMP();
    unsigned voffB[2], cpartA[2]; int rowA[2];
#pragma unroll
    for (int i = 0; i < 2; ++i) { int R, C; stage_rc(tid * 16 + i * 8192, R, C); const int Rb = Epi::PERM ? ((R & ~31) + perm32(R & 31)) : R;
        rowA[i] = R; cpartA[i] = (unsigned)C * 2u; voffB[i] = (unsigned)(Rb * K + C) * 2u; }
    unsigned cvoff[2][2], nvoff[2][2];
#define PG8_ROWS(dst, u_) do { _Pragma("unroll") for (int h_ = 0; h_ < 2; ++h_) _Pragma("unroll") for (int i_ = 0; i_ < 2; ++i_) { \
        const int tok_ = __hip_atomic_load(rowmap + (u_).pm * 256 + h_ * 128 + rowA[i_], __ATOMIC_RELAXED, __HIP_MEMORY_SCOPE_AGENT); dst[h_][i_] = (unsigned)tok_ * (unsigned)(K * 2) + cpartA[i_]; } } while (0)
    const size_t kstep = (size_t)(BK * 2);
    const size_t hstep = (size_t)HALF * K * 2;
    const size_t tstep = 2 * hstep;
    const unsigned ldsw = (unsigned)wid * 1024u;
    const int aoff = lds_byte(wr * 64 + fr, fq * 8), boff = lds_byte(wc * 32 + fr, fq * 8);
#define PG8_SA(b, h) (((b) * 2 + (h)) * HTB)
#define PG8_SB(b, h) ((4 + (b) * 2 + (h)) * HTB)
#define PG8_STAGE(bufoff, gbase, voff) do { _Pragma("unroll") for (int _i = 0; _i < 2; ++_i) \
        __builtin_amdgcn_global_load_lds((const unsigned*)((const char*)(gbase) + (voff)[_i]), (PG8_LAS unsigned*)(lds + (bufoff) + ldsw + _i * 8192), 16, 0, 0); } while (0)
#define PG8_LDA(dst, b, h) do { _Pragma("unroll") for (int m = 0; m < 4; ++m) _Pragma("unroll") for (int k = 0; k < 2; ++k) dst[m][k] = *(const PG8_LAS bf16x8*)(lds + PG8_SA(b, h) + aoff + m * 2048 + k * 1024); } while (0)
#define PG8_LDB(dst, b, h) do { _Pragma("unroll") for (int n = 0; n < 2; ++n) _Pragma("unroll") for (int k = 0; k < 2; ++k) dst[n][k] = *(const PG8_LAS bf16x8*)(lds + PG8_SB(b, h) + boff + n * 2048 + k * 1024); } while (0)
#define PG8_MMA(ai, bj, At, Bt) do { __builtin_amdgcn_s_setprio(1); _Pragma("unroll") for (int m = 0; m < 4; ++m) _Pragma("unroll") for (int n = 0; n < 2; ++n) _Pragma("unroll") for (int k = 0; k < 2; ++k) \
        acc[ai][bj][m][n] = __builtin_amdgcn_mfma_f32_16x16x32_bf16(Bt[n][k], At[m][k], acc[ai][bj][m][n], 0, 0, 0); __builtin_amdgcn_s_setprio(0); } while (0)
#define PG8_WAIT_V(n) asm volatile("s_waitcnt vmcnt(" #n ")" ::: "memory")
#define PG8_WAIT_L(n) asm volatile("s_waitcnt lgkmcnt(" #n ")" ::: "memory")
#define PG8_BAR __builtin_amdgcn_s_barrier()
#define PG8_SCHED __builtin_amdgcn_sched_barrier(0)
    Unit cur, nxt; int ui = 0;
    if (!S.next(0, cur)) return;
    f32x4 acc[2][2][4][2];
#pragma unroll
    for (int a = 0; a < 2; ++a)
#pragma unroll
        for (int b = 0; b < 2; ++b)
#pragma unroll
            for (int m = 0; m < 4; ++m)
#pragma unroll
                for (int n = 0; n < 2; ++n) acc[a][b][m][n] = (f32x4){0.f, 0.f, 0.f, 0.f};
    bf16x8 At[4][2], B0[2][2], B1[2][2];
    const char* gA0 = (const char*)g.A; const char* cB = (const char*)g.Bt + (size_t)cur.pn * tstep;
    S.a_ready(cur);
    PG8_ROWS(cvoff, cur);
    PG8_STAGE(PG8_SB(0, 0), cB, voffB); PG8_STAGE(PG8_SA(0, 0), gA0, cvoff[0]); PG8_STAGE(PG8_SB(0, 1), cB + hstep, voffB); PG8_STAGE(PG8_SA(0, 1), gA0, cvoff[1]);
    if (wr == 1) PG8_BAR;
    PG8_WAIT_V(4); PG8_BAR;
    PG8_STAGE(PG8_SB(1, 0), cB + kstep, voffB); PG8_STAGE(PG8_SA(1, 0), gA0 + kstep, cvoff[0]); PG8_STAGE(PG8_SB(1, 1), cB + hstep + kstep, voffB);
    PG8_WAIT_V(6); PG8_BAR;
    PG8_STAMP();
    for (;;) {
        const bool has_next = S.next(ui + 1, nxt);
        const char* nB = has_next ? (const char*)g.Bt + (size_t)nxt.pn * tstep : cB;
        if (has_next) PG8_ROWS(nvoff, nxt); else { nvoff[0][0] = cvoff[0][0]; nvoff[0][1] = cvoff[0][1]; nvoff[1][0] = cvoff[1][0]; nvoff[1][1] = cvoff[1][1]; }
        for (int t = 0; t < nt; t += 2) {
            const bool last = (t == nt - 2);
            const char* a1 = gA0 + (size_t)(t + 1) * kstep;
            const char* a2 = last ? gA0 : gA0 + (size_t)(t + 2) * kstep; const char* b2 = last ? nB : cB + (size_t)(t + 2) * kstep;
            const char* a3 = a2 + kstep; const char* b3 = b2 + kstep;
            unsigned v2[2][2];
#pragma unroll
            for (int h_ = 0; h_ < 2; ++h_) { v2[h_][0] = last ? nvoff[h_][0] : cvoff[h_][0]; v2[h_][1] = last ? nvoff[h_][1] : cvoff[h_][1]; }
            if (last && has_next) S.a_ready(nxt);
            PG8_LDB(B0, 0, 0); PG8_SCHED; PG8_LDA(At, 0, 0); PG8_STAGE(PG8_SA(1, 1), a1, cvoff[1]);
            PG8_WAIT_L(8); PG8_BAR; PG8_WAIT_L(0); PG8_MMA(0, 0, At, B0); PG8_BAR; PG8_SCHED;
            PG8_LDB(B1, 0, 1); PG8_STAGE(PG8_SB(0, 0), b2, voffB);
            PG8_BAR; PG8_WAIT_L(0); PG8_MMA(0, 1, At, B1); PG8_BAR;
            PG8_LDA(At, 0, 1); PG8_STAGE(PG8_SA(0, 0), a2, v2[0]);
            PG8_BAR; PG8_WAIT_L(0); PG8_MMA(1, 0, At, B0); PG8_BAR; PG8_SCHED;
            PG8_STAGE(PG8_SB(0, 1), b2 + hstep, voffB);
            PG8_WAIT_V(6); PG8_BAR; PG8_MMA(1, 1, At, B1); PG8_BAR;
            PG8_LDB(B0, 1, 0); PG8_SCHED; PG8_LDA(At, 1, 0); PG8_STAGE(PG8_SA(0, 1), a2, v2[1]);
            PG8_WAIT_L(8); PG8_BAR; PG8_WAIT_L(0); PG8_MMA(0, 0, At, B0); PG8_BAR; PG8_SCHED;
            PG8_LDB(B1, 1, 1); PG8_STAGE(PG8_SB(1, 0), b3, voffB);
            PG8_BAR; PG8_WAIT_L(0); PG8_MMA(0, 1, At, B1); PG8_BAR;
            PG8_LDA(At, 1, 1); PG8_STAGE(PG8_SA(1, 0), a3, v2[0]);
            PG8_BAR; PG8_WAIT_L(0); PG8_MMA(1, 0, At, B0); PG8_BAR; PG8_SCHED;
            PG8_STAGE(PG8_SB(1, 1), b3 + hstep, voffB);
            PG8_WAIT_V(6); PG8_BAR; PG8_MMA(1, 1, At, B1); PG8_BAR;
        }
        PG8_STAMP();
        if constexpr (!Epi::AFTER_DRAIN) { E(acc, cur, wr, wc, fr, fq); S.done(cur); }
        PG8_STAMP();
        if (!has_next) break;
#pragma unroll
        for (int a = 0; a < 2; ++a)
#pragma unroll
            for (int b = 0; b < 2; ++b)
#pragma unroll
                for (int m = 0; m < 4; ++m)
#pragma unroll
                    for (int n = 0; n < 2; ++n) acc[a][b][m][n] = (f32x4){0.f, 0.f, 0.f, 0.f};
        cur = nxt; cB = nB; ++ui; cvoff[0][0] = nvoff[0][0]; cvoff[0][1] = nvoff[0][1]; cvoff[1][0] = nvoff[1][0]; cvoff[1][1] = nvoff[1][1];
    }
    PG8_WAIT_V(0);
    if (wr == 0) PG8_BAR;
    PG8_BAR;
    if constexpr (Epi::AFTER_DRAIN) { E.fused(acc, cur, wr, wc, fr, fq, lds, wid, lane); S.done(cur); }
    PG8_STAMP();
    if (STAMP && wid == 0) { stamps[lane] = lane < nts ? (((unsigned long long)(unsigned)ts_hi << 32) | (unsigned)ts_lo) : 0ull;
        if (lane == 62) stamps[62] = rt_entry; if (lane == 63) stamps[63] = (unsigned long long)wall_clock64(); }
#undef PG8_STAMP
#undef PG8_ROWS
#undef PG8_SA
#undef PG8_SB
#undef PG8_STAGE
#undef PG8_LDA
#undef PG8_LDB
#undef PG8_MMA
#undef PG8_WAIT_V
#undef PG8_WAIT_L
#undef PG8_BAR
#undef PG8_SCHED
}
}

#define LDSP __attribute__((address_space(3)))
typedef unsigned short bf16_t;
typedef float f32x4 __attribute__((ext_vector_type(4)));
typedef float f32x2 __attribute__((ext_vector_type(2)));
typedef unsigned u32x4 __attribute__((ext_vector_type(4)));
typedef unsigned u32x2 __attribute__((ext_vector_type(2)));

constexpr int T_ = 16384, D_ = 2048, S_ = 2048, B_ = 8;
constexpr int PW0 = 5376, PW1 = 14336, DE = 1408, CAP = 36864, MODW = 12288;
constexpr int NTHR = 512, NWAVE = 8;
constexpr int LDS_BYTES = 147456;
constexpr int LDS_MISC = 131072;

constexpr size_t al256(size_t x) { return (x + 255) & ~(size_t)255; }
constexpr size_t WS_BAR     = 0;
constexpr size_t WS_CTL_END = 16384;
constexpr size_t WS_TAB     = WS_CTL_END;
constexpr size_t WS_BLKCNT  = WS_TAB + 1024;
constexpr size_t WS_MOD     = al256(WS_BLKCNT + 256 * 16 * 4);
constexpr size_t WS_RIDX    = al256(WS_MOD + (size_t)2 * 8 * MODW * 4);
constexpr size_t WS_RW      = al256(WS_RIDX + (size_t)T_ * 2 * 4);
constexpr size_t WS_TOKSLOT = al256(WS_RW + (size_t)T_ * 2 * 4);
constexpr size_t WS_SLOTW   = al256(WS_TOKSLOT + (size_t)T_ * 2 * 4);
constexpr size_t WS_SLOTTOK = al256(WS_SLOTW + (size_t)CAP * 4);
constexpr size_t WS_SEL     = al256(WS_SLOTTOK + (size_t)CAP * 4);
constexpr size_t WS_CMP     = al256(WS_SEL + (size_t)8 * 4 * 2048 * 4);
constexpr size_t WS_LSE     = al256(WS_CMP + (size_t)2 * 8 * 128 * 4 * 128 * 4);
constexpr size_t WS_WNSAIN  = al256(WS_LSE + (size_t)3 * T_ * 16 * 4);
constexpr size_t WS_WNSAOUT = al256(WS_WNSAIN + (size_t)PW0 * D_ * 2);
constexpr size_t WS_WDILIN  = al256(WS_WNSAOUT + (size_t)D_ * D_ * 2);
constexpr size_t WS_WDILOUT = al256(WS_WDILIN + (size_t)PW1 * D_ * 2);
constexpr size_t WS_WE1     = al256(WS_WDILOUT + (size_t)D_ * D_ * 2);
constexpr size_t WS_WE2     = al256(WS_WE1 + (size_t)16 * 2816 * D_ * 2);
constexpr size_t WS_X       = al256(WS_WE2 + (size_t)16 * D_ * DE * 2);
constexpr size_t WS_H       = al256(WS_X + (size_t)T_ * D_ * 2);
constexpr size_t WS_O       = al256(WS_H + (size_t)T_ * D_ * 2);
constexpr size_t WS_PROJ    = al256(WS_O + (size_t)T_ * D_ * 2);
constexpr size_t WS_XIN     = WS_PROJ;
constexpr size_t WS_HID     = al256(WS_XIN + (size_t)CAP * D_ * 2);
constexpr size_t WS_YO      = al256(WS_HID + (size_t)CAP * DE * 2);
constexpr size_t WS_OG      = al256(WS_PROJ + (size_t)T_ * PW1 * 2);
constexpr size_t WS_ACC     = WS_OG;
constexpr size_t WS_CMPB    = al256(WS_OG + (size_t)3 * T_ * D_ * 2);
constexpr size_t WS_W1T     = al256(WS_CMPB + (size_t)2 * 8 * 128 * 4 * 128 * 2);
constexpr size_t WS_POSB    = al256(WS_W1T + (size_t)2 * 128 * 4096 * 2);
constexpr size_t WS_END     = al256(WS_POSB + 2 * 32 * 128 * 4);
static_assert(WS_END < (size_t)1560000000, "workspace budget");
static_assert(WS_YO + (size_t)CAP * D_ * 2 <= WS_END, "moe buffers must fit inside the proj region");

__device__ __forceinline__ float bf2f(bf16_t v) { return __uint_as_float(((unsigned)v) << 16); }
__device__ __forceinline__ bf16_t f2bf(float f) { unsigned u = __float_as_uint(f); u += 0x7FFFu + ((u >> 16) & 1u); return (bf16_t)(u >> 16); }
__device__ __forceinline__ unsigned pk2(float lo, float hi) { return (unsigned)f2bf(lo) | ((unsigned)f2bf(hi) << 16); }
__device__ __forceinline__ int ld_i(const int* p) { return __hip_atomic_load(p, __ATOMIC_RELAXED, __HIP_MEMORY_SCOPE_AGENT); }
__device__ __forceinline__ float ld_f(const float* p) { return __hip_atomic_load(p, __ATOMIC_RELAXED, __HIP_MEMORY_SCOPE_AGENT); }
__device__ __forceinline__ float wsum(float v) { for (int o = 32; o >= 1; o >>= 1) v += __shfl_xor(v, o); return v; }
__device__ __forceinline__ float wmax(float v) { for (int o = 32; o >= 1; o >>= 1) v = fmaxf(v, __shfl_xor(v, o)); return v; }
__device__ __forceinline__ void lds_fence() { asm volatile("s_waitcnt lgkmcnt(0)" ::: "memory"); }

struct Args { const float* in[19]; float* out; unsigned char* ws; int ph_lo, ph_hi; };
struct Ctx {
    const Args& A; unsigned char* ws;
    LDSP unsigned char* lds;
    int tid, lane, wave, G, bid;
};
__device__ __forceinline__ Ctx fresh(const Ctx& c0) {
    int l = (int)__builtin_amdgcn_mbcnt_hi(~0u, __builtin_amdgcn_mbcnt_lo(~0u, 0u)); asm volatile("" : "+v"(l));
    const int t = c0.wave * 64 + l;
    Ctx c{c0.A, c0.ws, c0.lds, t, l, c0.wave, c0.G, c0.bid};
    return c;
}

__device__ __forceinline__ void mod_units(const Ctx& c) {
    if (c.bid >= 192) {
        {
            const int i = c.bid - 192, j = i & 1, p = i >> 1, e = c.tid & 127, q = c.tid >> 7;
            LDSP float* red = (LDSP float*)c.lds;
            const float* w1 = c.A.in[8] + ((size_t)j * 4096 + p * 128 + q * 32) * 128 + e; const float* pos = c.A.in[10] + j * 4096 + p * 128 + q * 32;
            float s = 0.f;
#pragma unroll
            for (int k = 0; k < 32; ++k) s += pos[k] * w1[(size_t)k * 128];
            red[q * 128 + e] = s;
            __syncthreads();
            if (c.tid < 128) ((float*)(c.ws + WS_POSB))[(j * 32 + p) * 128 + c.tid] = red[c.tid] + red[128 + c.tid] + red[256 + c.tid] + red[384 + c.tid];
        }
        return;
    }
    LDSP float* cs = (LDSP float*)c.lds;
    LDSP float* red = (LDSP float*)(c.lds + 65536);
    const float* cin = c.A.in[1];
    for (int i = c.tid; i < 8 * 2048; i += NTHR) { const float v = cin[i]; cs[i] = v / (1.f + __expf(-v)); }
    __syncthreads();
    float* MOD = (float*)(c.ws + WS_MOD);
    for (int u = c.bid; u < 192; u += c.G) {
        const int layer = u / 96, cb = (u % 96) * 128;
        const int c4 = c.tid & 31, kc = c.tid >> 5;
        f32x4 acc[8];
#pragma unroll
        for (int b = 0; b < 8; ++b) acc[b] = (f32x4){0.f, 0.f, 0.f, 0.f};
        const float* wp = c.A.in[2] + ((size_t)layer * 2048 + kc * 128) * MODW + cb + 4 * c4;
        for (int k0 = 0; k0 < 128; k0 += 8) {
            f32x4 w[8];
#pragma unroll
            for (int q = 0; q < 8; ++q) w[q] = __builtin_nontemporal_load((const f32x4*)(wp + (size_t)(k0 + q) * MODW));
#pragma unroll
            for (int q = 0; q < 8; ++q) { const int k = kc * 128 + k0 + q;
#pragma unroll
                for (int b = 0; b < 8; ++b) acc[b] += cs[b * 2048 + k] * w[q]; }
        }
#pragma unroll
        for (int b = 0; b < 8; ++b) *(LDSP f32x4*)(red + (kc * 8 + b) * 128 + 4 * c4) = acc[b];
        __syncthreads();
        for (int idx = c.tid; idx < 1024; idx += NTHR) {
            const int b = idx >> 7, col = idx & 127; float s = c.A.in[3][layer * MODW + cb + col];
#pragma unroll
            for (int q = 0; q < 16; ++q) s += red[(q * 8 + b) * 128 + col];
            MOD[((size_t)layer * 8 + b) * MODW + cb + col] = s;
        }
        __syncthreads();
    }
}

__device__ __forceinline__ void tr_tile(const float* src, int ld, int nvalid, bf16_t* dst, int dld, LDSP float* tile, int lane) {
    const int cq = (lane & 15) * 4, r4 = lane >> 4;
    f32x4 v[16];
#pragma unroll
    for (int i = 0; i < 16; ++i) {
        const int k = i * 4 + r4;
        if (cq < nvalid) v[i] = __builtin_nontemporal_load((const f32x4*)(src + (size_t)k * ld + cq)); else v[i] = (f32x4){0.f, 0.f, 0.f, 0.f};
    }
#pragma unroll
    for (int i = 0; i < 16; ++i) {
        const int k = i * 4 + r4;
        tile[k * 65 + cq + 0] = v[i][0]; tile[k * 65 + cq + 1] = v[i][1]; tile[k * 65 + cq + 2] = v[i][2]; tile[k * 65 + cq + 3] = v[i][3];
    }
    lds_fence();
    const int k8 = (lane & 7) * 8, rr = lane >> 3;
#pragma unroll
    for (int i = 0; i < 8; ++i) {
        const int r = i * 8 + rr;
        u32x4 w;
        w.x = pk2(tile[(k8 + 0) * 65 + r], tile[(k8 + 1) * 65 + r]); w.y = pk2(tile[(k8 + 2) * 65 + r], tile[(k8 + 3) * 65 + r]);
        w.z = pk2(tile[(k8 + 4) * 65 + r], tile[(k8 + 5) * 65 + r]); w.w = pk2(tile[(k8 + 6) * 65 + r], tile[(k8 + 7) * 65 + r]);
        *(u32x4*)(dst + (size_t)r * dld + k8) = w;
    }
    lds_fence();
}
__device__ __forceinline__ void tr_matrix(const Ctx& c, const float* W, int K, int N, int nrows, bf16_t* Wt) {
    LDSP float* tile = (LDSP float*)(c.lds + c.wave * 16640);
    const int nrt = nrows / 64, nkt = K / 64, nw = c.G * NWAVE;
    for (int t = c.bid * NWAVE + c.wave; t < nrt * nkt; t += nw) {
        const int rt = t % nrt, kt = t / nrt;
        int nv = N - rt * 64; nv = nv > 64 ? 64 : (nv < 0 ? 0 : nv);
        tr_tile(W + (size_t)kt * 64 * N + rt * 64, N, nv, Wt + (size_t)rt * 64 * K + kt * 64, K, tile, c.lane);
    }
}
constexpr int TRX_WE1 = 16 * 2 * 32 * 22, TRX_ALL = TRX_WE1 + 16 * 22 * 32;
__device__ __forceinline__ void tr_experts(const Ctx& c, int layer, int lo, int hi, int gw, int nw) {
    LDSP float* tile = (LDSP float*)(c.lds + c.wave * 16640);
    bf16_t* WE1 = (bf16_t*)(c.ws + WS_WE1); bf16_t* WE2 = (bf16_t*)(c.ws + WS_WE2);
    for (int tt = lo + gw; tt < hi; tt += nw) {
        if (tt < TRX_WE1) {
            const int t = tt, ct = t % 22, kt = (t / 22) % 32, half = (t / 704) & 1, e = t / 1408;
            const float* W = (half ? c.A.in[17] : c.A.in[16]) + (size_t)(layer * 16 + e) * D_ * DE;
            const int j = ct >> 1, rt = ct & 1;
            tr_tile(W + (size_t)kt * 64 * DE + ct * 64, DE, 64, WE1 + ((size_t)e * 2816 + j * 256 + half * 128 + rt * 64) * D_ + kt * 64, D_, tile, c.lane);
        } else {
            const int t = tt - TRX_WE1, rt = t % 32, kt = (t / 32) % 22, e = t / 704;
            const float* W = c.A.in[18] + (size_t)(layer * 16 + e) * DE * D_;
            tr_tile(W + (size_t)kt * 64 * D_ + rt * 64, D_, 64, WE2 + ((size_t)e * 2048 + rt * 64) * DE + kt * 64, DE, tile, c.lane);
        }
    }
}
constexpr int TRX_T0 = 11264;
constexpr int TRX_T1 = 8192;

struct RouteOut { int i0, i1; float w0, w1; };
__device__ __forceinline__ RouteOut route16(const float (&lg)[16], const float* rb) {
    float sc[16], bi[16];
#pragma unroll
    for (int e = 0; e < 16; ++e) { sc[e] = 1.f / (1.f + __expf(-lg[e])); bi[e] = sc[e] + rb[e]; }
    float gs[4];
#pragma unroll
    for (int g = 0; g < 4; ++g) {
        float m1 = bi[4 * g], m2 = -3.0e38f;
#pragma unroll
        for (int i = 1; i < 4; ++i) { const float v = bi[4 * g + i]; if (v > m1) { m2 = m1; m1 = v; } else if (v > m2) m2 = v; }
        gs[g] = m1 + m2;
    }
    int bg = 0; float bv = gs[0];
#pragma unroll
    for (int g = 1; g < 4; ++g) if (gs[g] > bv) { bv = gs[g]; bg = g; }
    float cb[4], cs[4];
#pragma unroll
    for (int i = 0; i < 4; ++i) { cb[i] = bg == 0 ? bi[i] : bg == 1 ? bi[4 + i] : bg == 2 ? bi[8 + i] : bi[12 + i]; cs[i] = bg == 0 ? sc[i] : bg == 1 ? sc[4 + i] : bg == 2 ? sc[8 + i] : sc[12 + i]; }
    int a0 = 0; float v0 = cb[0], s0 = cs[0];
#pragma unroll
    for (int i = 1; i < 4; ++i) if (cb[i] > v0) { v0 = cb[i]; a0 = i; s0 = cs[i]; }
    int a1 = -1; float v1 = -3.0e38f, s1 = 0.f;
#pragma unroll
    for (int i = 0; i < 4; ++i) if (i != a0 && cb[i] > v1) { v1 = cb[i]; a1 = i; s1 = cs[i]; }
    RouteOut r; r.i0 = bg * 4 + a0; r.i1 = bg * 4 + a1; const float s = s0 + s1; r.w0 = s0 / s; r.w1 = s1 / s; return r;
}

__device__ __forceinline__ f32x4 up4(u32x2 a) { f32x4 y; y[0] = __uint_as_float(a.x << 16); y[1] = __uint_as_float(a.x & 0xffff0000u); y[2] = __uint_as_float(a.y << 16); y[3] = __uint_as_float(a.y & 0xffff0000u); return y; }
template <int MODE> struct RowRaw { f32x4 xf[MODE == 0 ? 8 : 1]; u32x2 xb[MODE == 0 ? 1 : 8]; u32x2 ya[MODE >= 2 ? 8 : 1], yb[MODE >= 2 ? 8 : 1]; };
template <int MODE>
__device__ __forceinline__ void norm_load(RowRaw<MODE>& R, const void* xsrc_, const bf16_t* YO, int row, int s0, int s1, int lane) {
#pragma unroll
    for (int i = 0; i < 8; ++i) {
        if (MODE == 0) R.xf[i] = *(const f32x4*)((const float*)xsrc_ + (size_t)row * D_ + i * 256 + lane * 4);
        else R.xb[i] = *(const u32x2*)((const bf16_t*)xsrc_ + (size_t)row * D_ + i * 256 + lane * 4);
        if (MODE >= 2) { R.ya[i] = *(const u32x2*)(YO + (size_t)s0 * D_ + i * 256 + lane * 4); R.yb[i] = *(const u32x2*)(YO + (size_t)s1 * D_ + i * 256 + lane * 4); }
    }
}
template <int MODE>
__device__ __forceinline__ void norm_phase(const Ctx& c, const void* xsrc_, bf16_t* xdst, const float* gain, const float* msh, const float* msc, const float* mgf, bf16_t* hdst) {
    LDSP float* rwT = (LDSP float*)c.lds;
    LDSP int* cnt = (LDSP int*)(c.lds + LDS_MISC);
    if (MODE == 1) {
        const float* rw = c.A.in[14];
        for (int i0 = c.tid; i0 < 32768; i0 += NTHR * 16) {
            float t_[16];
#pragma unroll
            for (int k = 0; k < 16; ++k) t_[k] = rw[i0 + k * NTHR];
#pragma unroll
            for (int k = 0; k < 16; ++k) { const int i = i0 + k * NTHR; rwT[(i & 15) * 2048 + (i >> 4)] = t_[k]; }
        }
        if (c.tid < 16) cnt[c.tid] = 0;
        __syncthreads();
    }
    const int nw = c.G * NWAVE, gw = c.bid * NWAVE + c.wave, lane = c.lane;
    const bf16_t* YO = (const bf16_t*)(c.ws + WS_YO);
    const int* TOKSLOT = (const int*)(c.ws + WS_TOKSLOT);
    int sl0[8], sl1[8];
#pragma unroll
    for (int k = 0; k < 8; ++k) { sl0[k] = 0; sl1[k] = 0; if (MODE >= 2) { const int r_ = gw + k * nw; if (r_ < T_) { sl0[k] = ld_i(TOKSLOT + r_ * 2); sl1[k] = ld_i(TOKSLOT + r_ * 2 + 1); } } }
    RowRaw<MODE> cur, nxt;
    if (gw < T_) norm_load<MODE>(cur, xsrc_, YO, gw, sl0[0], sl1[0], lane);
    int kk = 0;
    for (int row = gw; row < T_; row += nw, ++kk) {
        const int b = row >> 11;
        {
            const int rn = row + nw; int n0 = 0, n1 = 0;
            if (MODE >= 2) {
                if (kk + 1 < 8) {
#pragma unroll
                    for (int k = 1; k < 8; ++k) if (k == kk + 1) { n0 = sl0[k]; n1 = sl1[k]; }
                } else if (rn < T_) { n0 = ld_i(TOKSLOT + rn * 2); n1 = ld_i(TOKSLOT + rn * 2 + 1); }
            }
            if (rn < T_) norm_load<MODE>(nxt, xsrc_, YO, rn, n0, n1, lane);
        }
        f32x4 v[8];
#pragma unroll
        for (int i = 0; i < 8; ++i) { if (MODE == 0) v[i] = cur.xf[i]; else v[i] = up4(cur.xb[i]); }
        if (MODE >= 2) {
            f32x4 mg[8];
#pragma unroll
            for (int i = 0; i < 8; ++i) mg[i] = *(const f32x4*)(mgf + (size_t)b * MODW + i * 256 + lane * 4);
            asm volatile("" ::: "memory");
#pragma unroll
            for (int i = 0; i < 8; ++i) {
                const f32x4 y = up4(cur.ya[i]) + up4(cur.yb[i]);
                v[i] += mg[i] * y;
                if (MODE == 2) { u32x2 w; w.x = pk2(v[i][0], v[i][1]); w.y = pk2(v[i][2], v[i][3]); *(u32x2*)(xdst + (size_t)row * D_ + i * 256 + lane * 4) = w; }
            }
        }
        float ss = 0.f;
#pragma unroll
        for (int i = 0; i < 8; ++i) ss += v[i][0] * v[i][0] + v[i][1] * v[i][1] + v[i][2] * v[i][2] + v[i][3] * v[i][3];
        ss = wsum(ss);
        const float rinv = 1.0f / sqrtf(ss * (1.0f / 2048.0f) + 1e-6f);
        f32x4 ga[8];
#pragma unroll
        for (int i = 0; i < 8; ++i) ga[i] = *(const f32x4*)(gain + i * 256 + lane * 4);
        if (MODE == 3) {
            asm volatile("" ::: "memory");
#pragma unroll
            for (int i = 0; i < 8; ++i) *(f32x4*)(c.A.out + (size_t)row * D_ + i * 256 + lane * 4) = v[i] * rinv * ga[i];
        } else {
            f32x4 sha[8], sca[8];
#pragma unroll
            for (int i = 0; i < 8; ++i) { sha[i] = *(const f32x4*)(msh + (size_t)b * MODW + i * 256 + lane * 4); sca[i] = *(const f32x4*)(msc + (size_t)b * MODW + i * 256 + lane * 4); }
            asm volatile("" ::: "memory");
#pragma unroll
            for (int i = 0; i < 8; ++i) {
                const f32x4 g = ga[i], sh = sha[i], sc = sca[i];
                v[i] = (v[i] * rinv * g) * (1.0f + sc) + sh;
                u32x2 w; w.x = pk2(v[i][0], v[i][1]); w.y = pk2(v[i][2], v[i][3]);
                *(u32x2*)(hdst + (size_t)row * D_ + i * 256 + lane * 4) = w;
            }
            if (MODE == 1) {
                float pa_[16];
                f32x4 rA[8], rB[8];
#define RT_RD(dst, e_) do { _Pragma("unroll") for (int i = 0; i < 8; ++i) dst[i] = *(LDSP f32x4*)(rwT + (e_) * 2048 + i * 256 + lane * 4); asm volatile("" ::: "memory"); } while (0)
#define RT_DOT(src, e_) do { float a = 0.f; _Pragma("unroll") for (int i = 0; i < 8; ++i) a += v[i][0] * src[i][0] + v[i][1] * src[i][1] + v[i][2] * src[i][2] + v[i][3] * src[i][3]; pa_[e_] = a; } while (0)
                RT_RD(rA, 0);
#pragma unroll
                for (int e = 0; e < 16; e += 2) { RT_RD(rB, e + 1); RT_DOT(rA, e); if (e + 2 < 16) RT_RD(rA, e + 2); RT_DOT(rB, e + 1); }
#undef RT_RD
#undef RT_DOT
                float lg[16];
                { const bool b5 = lane & 32, b4 = lane & 16, b3 = lane & 8, b2 = lane & 4;
                  float b_[8], c_[4], d_[2];
#pragma unroll
                  for (int i = 0; i < 8; ++i) { const float snd = b5 ? pa_[i] : pa_[i + 8]; b_[i] = (b5 ? pa_[i + 8] : pa_[i]) + __shfl_xor(snd, 32); }
#pragma unroll
                  for (int i = 0; i < 4; ++i) { const float snd = b4 ? b_[i] : b_[i + 4]; c_[i] = (b4 ? b_[i + 4] : b_[i]) + __shfl_xor(snd, 16); }
#pragma unroll
                  for (int i = 0; i < 2; ++i) { const float snd = b3 ? c_[i] : c_[i + 2]; d_[i] = (b3 ? c_[i + 2] : c_[i]) + __shfl_xor(snd, 8); }
                  float e_ = (b2 ? d_[1] : d_[0]) + __shfl_xor(b2 ? d_[0] : d_[1], 4);
                  e_ += __shfl_xor(e_, 2); e_ += __shfl_xor(e_, 1);
#pragma unroll
                  for (int e = 0; e < 16; ++e) lg[e] = __int_as_float(__builtin_amdgcn_readlane(__float_as_int(e_), 4 * e)); }
                const RouteOut r = route16(lg, c.A.in[15]);
                if (lane == 0) {
                    int* RIDX = (int*)(c.ws + WS_RIDX); float* RW = (float*)(c.ws + WS_RW);
                    RIDX[row * 2] = r.i0; RIDX[row * 2 + 1] = r.i1; RW[row * 2] = r.w0; RW[row * 2 + 1] = r.w1;
                    atomicAdd((int*)(cnt + r.i0), 1); atomicAdd((int*)(cnt + r.i1), 1);
                }
            }
        }
        cur = nxt;
    }
    if (MODE == 1) {
        __syncthreads();
        if (c.tid < 16) ((int*)(c.ws + WS_BLKCNT))[c.bid * 16 + c.tid] = cnt[c.tid];
    }
}

__device__ __forceinline__ void dispatch_phase(const Ctx& c) {
    LDSP int* tot = (LDSP int*)c.lds;
    LDSP int* pre = tot + 16;
    LDSP int* start = tot + 32;
    LDSP int* pstart = tot + 48;
    LDSP int* ea = tot + 80;
    LDSP int* sl = tot + 208;
    if (c.tid < 32) tot[c.tid] = 0;
    __syncthreads();
    const int* BLKCNT = (const int*)(c.ws + WS_BLKCNT);
    for (int idx = c.tid; idx < c.G * 16; idx += NTHR) {
        const int v = ld_i(BLKCNT + idx), e = idx & 15, bl = idx >> 4;
        atomicAdd((int*)(tot + e), v); if (bl < c.bid) atomicAdd((int*)(pre + e), v);
    }
    __syncthreads();
    if (c.tid == 0) {
        int run = 0;
        for (int e = 0; e < 16; ++e) { pstart[e] = run; start[e] = run + pre[e]; run += (tot[e] + 255) / 256 * 256; }
        pstart[16] = run;
    }
    __syncthreads();
    if (c.bid == 0 && c.tid < 17) ((int*)(c.ws + WS_TAB))[c.tid] = pstart[c.tid] >> 8;
    const int* RIDX = (const int*)(c.ws + WS_RIDX); const float* RW = (const float*)(c.ws + WS_RW);
    const int nw = c.G * NWAVE;
    if (c.tid < 128) { const int a = c.tid, wv = a >> 4, i = (a >> 1) & 7, k = a & 1; const int row = (c.bid * NWAVE + wv) + i * nw; ea[a] = ld_i(RIDX + row * 2 + k); }
    __syncthreads();
    if (c.tid < 128) {
        const int a = c.tid, wv = a >> 4, i = (a >> 1) & 7, k = a & 1; const int row = (c.bid * NWAVE + wv) + i * nw;
        const int e = ea[a]; int rank = 0;
        for (int j = 0; j < a; ++j) rank += (ea[j] == e) ? 1 : 0;
        const int slot = start[e] + rank; sl[a] = slot;
        ((int*)(c.ws + WS_TOKSLOT))[row * 2 + k] = slot;
        ((float*)(c.ws + WS_SLOTW))[slot] = ld_f(RW + row * 2 + k);
        ((int*)(c.ws + WS_SLOTTOK))[slot] = row;
    }
    if (c.bid == 0) {
        for (int e = 0; e < 16; ++e) for (int s = pstart[e] + tot[e] + c.tid; s < pstart[e + 1]; s += NTHR) { ((float*)(c.ws + WS_SLOTW))[s] = 0.f; ((int*)(c.ws + WS_SLOTTOK))[s] = 0; }
    }
}

template <bool BASE_F32> struct EpiResid {
    static constexpr bool PERM = true, AFTER_DRAIN = false;
    const void* base; bf16_t* out; const float* gate;
    __device__ __forceinline__ void operator()(const pg8::f32x4 (&acc)[2][2][4][2], const pg8::Unit& u, int wr, int wc, int fr, int fq) const {
        const int row0 = u.pm * 256 + wr * 64 + fr, col0 = u.pn * 256 + wc * 32 + 8 * fq, b = u.pm >> 3;
        pg8::f32x4 gv[2][2];
#pragma unroll
        for (int bj = 0; bj < 2; ++bj)
#pragma unroll
            for (int n = 0; n < 2; ++n) gv[bj][n] = *(const pg8::f32x4*)(gate + (size_t)b * MODW + col0 + bj * 128 + n * 4);
#pragma unroll
        for (int ai = 0; ai < 2; ++ai) {
            pg8::f32x4 b0[4][2], b1[4][2];
#pragma unroll
            for (int m = 0; m < 4; ++m) { const size_t off = (size_t)(row0 + ai * 128 + m * 16) * D_ + col0;
#pragma unroll
                for (int bj = 0; bj < 2; ++bj) {
                    if (BASE_F32) { b0[m][bj] = *(const pg8::f32x4*)((const float*)base + off + bj * 128); b1[m][bj] = *(const pg8::f32x4*)((const float*)base + off + bj * 128 + 4); }
                    else { const pg8::u32x4 w = *(const pg8::u32x4*)((const bf16_t*)base + off + bj * 128);
                        b0[m][bj] = (pg8::f32x4){__uint_as_float(w.x << 16), __uint_as_float(w.x & 0xffff0000u), __uint_as_float(w.y << 16), __uint_as_float(w.y & 0xffff0000u)};
                        b1[m][bj] = (pg8::f32x4){__uint_as_float(w.z << 16), __uint_as_float(w.z & 0xffff0000u), __uint_as_float(w.w << 16), __uint_as_float(w.w & 0xffff0000u)}; } } }
            asm volatile("" ::: "memory");
#pragma unroll
            for (int m = 0; m < 4; ++m) { const size_t off = (size_t)(row0 + ai * 128 + m * 16) * D_ + col0;
#pragma unroll
                for (int bj = 0; bj < 2; ++bj) {
                    const pg8::f32x4 v0 = b0[m][bj] + gv[bj][0] * acc[ai][bj][m][0], v1 = b1[m][bj] + gv[bj][1] * acc[ai][bj][m][1];
                    pg8::u32x4 q; q.x = pg8::cvt_pk_bf16(v0[0], v0[1]); q.y = pg8::cvt_pk_bf16(v0[2], v0[3]); q.z = pg8::cvt_pk_bf16(v1[0], v1[1]); q.w = pg8::cvt_pk_bf16(v1[2], v1[3]);
                    *(pg8::u32x4*)(out + off + bj * 128) = q; } }
            asm volatile("" ::: "memory");
        }
    }
};
struct EpiDilProj {
    static constexpr bool PERM = true, AFTER_DRAIN = false;
    bf16_t* O;
    __device__ __forceinline__ void operator()(const pg8::f32x4 (&acc)[2][2][4][2], const pg8::Unit& u, int wr, int wc, int fr, int fq) const {
        const int sec = u.pn >> 3, b = u.pm >> 3, lg = sec < 3 ? 0 : (sec < 5 ? 2 : 4), d = wc * 32 + 8 * fq;
        const int t0 = (u.pm & 7) * 256 + wr * 64 + fr;
#pragma unroll
        for (int ai = 0; ai < 2; ++ai)
#pragma unroll
            for (int m = 0; m < 4; ++m) { const int t = t0 + ai * 128 + m * 16; const int pos = ((t & ((1 << lg) - 1)) << (11 - lg)) + (t >> lg);
#pragma unroll
                for (int bj = 0; bj < 2; ++bj) { const int h = (u.pn & 7) * 2 + bj;
                    const pg8::f32x4 v0 = acc[ai][bj][m][0], v1 = acc[ai][bj][m][1];
                    pg8::u32x4 w; w.x = pg8::cvt_pk_bf16(v0[0], v0[1]); w.y = pg8::cvt_pk_bf16(v0[2], v0[3]); w.z = pg8::cvt_pk_bf16(v1[0], v1[1]); w.w = pg8::cvt_pk_bf16(v1[2], v1[3]);
                    *(pg8::u32x4*)(O + ((((size_t)sec * 8 + b) * 16 + h) * 2048 + pos) * 128 + d) = w; } }
    }
};
struct EpiSwiglu {
    static constexpr bool PERM = true, AFTER_DRAIN = false;
    bf16_t* Hd;
    __device__ __forceinline__ void operator()(const pg8::f32x4 (&acc)[2][2][4][2], const pg8::Unit& u, int wr, int wc, int fr, int fq) const {
        const int row0 = u.pm * 256 + wr * 64 + fr, j = u.pn % 11, col = j * 128 + wc * 32 + 8 * fq;
#pragma unroll
        for (int ai = 0; ai < 2; ++ai)
#pragma unroll
            for (int m = 0; m < 4; ++m) {
                float o[8];
#pragma unroll
                for (int n = 0; n < 2; ++n)
#pragma unroll
                    for (int i = 0; i < 4; ++i) { const float g = acc[ai][0][m][n][i], up = acc[ai][1][m][n][i]; o[n * 4 + i] = g / (1.f + __expf(-g)) * up; }
                pg8::u32x4 w; w.x = pg8::cvt_pk_bf16(o[0], o[1]); w.y = pg8::cvt_pk_bf16(o[2], o[3]); w.z = pg8::cvt_pk_bf16(o[4], o[5]); w.w = pg8::cvt_pk_bf16(o[6], o[7]);
                *(pg8::u32x4*)(Hd + (size_t)(row0 + ai * 128 + m * 16) * DE + col) = w;
            }
    }
};
struct EpiDown {
    static constexpr bool PERM = true, AFTER_DRAIN = false;
    bf16_t* Y; const float* sw;
    __device__ __forceinline__ void operator()(const pg8::f32x4 (&acc)[2][2][4][2], const pg8::Unit& u, int wr, int wc, int fr, int fq) const {
        const int row0 = u.pm * 256 + wr * 64 + fr, col0 = (u.pn & 7) * 256 + wc * 32 + 8 * fq;
        float wv[2][4];
#pragma unroll
        for (int ai = 0; ai < 2; ++ai)
#pragma unroll
            for (int m = 0; m < 4; ++m) wv[ai][m] = sw[row0 + ai * 128 + m * 16];
        asm volatile("" ::: "memory");
#pragma unroll
        for (int ai = 0; ai < 2; ++ai)
#pragma unroll
            for (int m = 0; m < 4; ++m) { const int row = row0 + ai * 128 + m * 16; const float w = wv[ai][m];
#pragma unroll
                for (int bj = 0; bj < 2; ++bj) { const pg8::f32x4 v0 = acc[ai][bj][m][0] * w, v1 = acc[ai][bj][m][1] * w;
                    pg8::u32x4 q; q.x = pg8::cvt_pk_bf16(v0[0], v0[1]); q.y = pg8::cvt_pk_bf16(v0[2], v0[3]); q.z = pg8::cvt_pk_bf16(v1[0], v1[1]); q.w = pg8::cvt_pk_bf16(v1[2], v1[3]);
                    *(pg8::u32x4*)(Y + (size_t)row * D_ + col0 + bj * 128) = q; } }
    }
};
struct MoeOrder {
    LDSP const int* bs;
    int G, vc, ncol;
    __device__ __forceinline__ bool next(int i, pg8::Unit& u) const {
        const int L = i * G + vc; if (L >= bs[16] * ncol) return false;
        int e = 0;
#pragma unroll
        for (int k = 1; k < 16; ++k) e += (L >= bs[k] * ncol) ? 1 : 0;
        const int b0 = bs[e], nb = bs[e + 1] - b0, r = L - b0 * ncol;
        const int j = r / nb, bi = r - j * nb;
        u.pm = b0 + bi; u.pn = e * ncol + j; return true;
    }
    __device__ __forceinline__ void a_ready(const pg8::Unit&) const {}
    __device__ __forceinline__ void done(const pg8::Unit&) const {}
};
__device__ __forceinline__ void moe_tab_to_lds(const Ctx& c) {
    LDSP int* bs = (LDSP int*)(c.lds + LDS_MISC);
    if (c.tid < 17) bs[c.tid] = ld_i((const int*)(c.ws + WS_TAB) + c.tid);
    __syncthreads();
}

__device__ __forceinline__ float gelu_tanh(float x) { const float u = 0.7978845608028654f * (x + 0.044715f * x * x * x); return 0.5f * x * (1.f + tanhf(u)); }
__device__ __forceinline__ void compress_phase(const Ctx& c) {
    LDSP float* tok = (LDSP float*)c.lds;
    LDSP float* pos = (LDSP float*)(c.lds + 73728);
    LDSP float* part = (LDSP float*)(c.lds + 73728 + 16384);
    LDSP float* hid = (LDSP float*)(c.lds + 73728 + 32768);
    const bf16_t* proj = (const bf16_t*)(c.ws + WS_PROJ);
    float* CMP = (float*)(c.ws + WS_CMP);
    for (int uu = c.bid; uu < (DUP_PH == 103 ? 2048 : 1024); uu += c.G) {
        const int u = uu & 1023, ch = u & 15, j = (u >> 4) & 1, g = (u >> 5) & 3, b = u >> 7, n0 = ch * 8;
        for (int idx = c.tid; idx < 144 * 16; idx += NTHR) {
            const int tl = idx >> 4, d8 = (idx & 15) * 8, t = n0 * 16 + tl;
            u32x4 w = (u32x4){0u, 0u, 0u, 0u};
            if (t < S_) w = *(const u32x4*)(proj + (size_t)(b * S_ + t) * PW0 + 2048 + j * 512 + g * 128 + d8);
            LDSP float* dp = tok + tl * 128 + d8;
            dp[0] = __uint_as_float(w.x << 16); dp[1] = __uint_as_float(w.x & 0xffff0000u); dp[2] = __uint_as_float(w.y << 16); dp[3] = __uint_as_float(w.y & 0xffff0000u);
            dp[4] = __uint_as_float(w.z << 16); dp[5] = __uint_as_float(w.z & 0xffff0000u); dp[6] = __uint_as_float(w.w << 16); dp[7] = __uint_as_float(w.w & 0xffff0000u);
        }
        for (int idx = c.tid; idx < 4096; idx += NTHR) pos[idx] = c.A.in[10][j * 4096 + idx];
        __syncthreads();
        const int e = c.tid & 127, q = c.tid >> 7;
        float acc[8];
#pragma unroll
        for (int i = 0; i < 8; ++i) acc[i] = 0.f;
        const float* w1 = c.A.in[8] + (size_t)j * 32 * 128 * 128;
        for (int l = q * 8; l < q * 8 + 8; ++l) {
#pragma unroll 4
            for (int d = 0; d < 128; ++d) {
                const float w = w1[((size_t)l * 128 + d) * 128 + e]; const float p = pos[l * 128 + d];
#pragma unroll
                for (int i = 0; i < 8; ++i) acc[i] += (tok[(16 * i + l) * 128 + d] + p) * w;
            }
        }
#pragma unroll
        for (int i = 0; i < 8; ++i) part[(q * 8 + i) * 128 + e] = acc[i];
        __syncthreads();
        for (int idx = c.tid; idx < 1024; idx += NTHR) { const int i = idx >> 7, ee = idx & 127; hid[idx] = gelu_tanh(part[(0 * 8 + i) * 128 + ee] + part[(1 * 8 + i) * 128 + ee] + part[(2 * 8 + i) * 128 + ee] + part[(3 * 8 + i) * 128 + ee]); }
        __syncthreads();
        const float* w2 = c.A.in[9] + (size_t)j * 128 * 128;
        for (int idx = c.tid; idx < 1024; idx += NTHR) {
            const int i = idx >> 7, f = idx & 127, n = n0 + i; float s = 0.f;
            for (int ee = 0; ee < 128; ++ee) s += hid[i * 128 + ee] * w2[ee * 128 + f];
            if (n < 127) CMP[((((size_t)j * 8 + b) * 128 + n) * 4 + g) * 128 + f] = s;
            ((bf16_t*)(c.ws + WS_CMPB))[((((size_t)j * 8 + b) * 128 + n) * 4 + g) * 128 + f] = (n < 127) ? f2bf(s) : (bf16_t)0;
        }
        __syncthreads();
    }
}

__device__ __forceinline__ void compress_mfma_phase(const Ctx& c) {
    typedef short bf16x8 __attribute__((ext_vector_type(8)));
    LDSP char* lds = (LDSP char*)c.lds;
    LDSP float* red = (LDSP float*)c.lds;
    LDSP float* hid = (LDSP float*)(c.lds + 69632);
    const bf16_t* proj = (const bf16_t*)(c.ws + WS_PROJ);
    const bf16_t* W1T = (const bf16_t*)(c.ws + WS_W1T);
    const float* POSB = (const float*)(c.ws + WS_POSB);
    float* CMP = (float*)(c.ws + WS_CMP); bf16_t* CMPB = (bf16_t*)(c.ws + WS_CMPB);
    const int lane = c.lane, wid = c.wave;
    for (int uu = c.bid; uu < (DUP_PH == 103 ? 1024 : 512); uu += c.G) {
        const int u = uu & 511, nb = u & 7, j = (u >> 3) & 1, g = (u >> 4) & 3, b = u >> 6, n0 = nb * 16;
        __syncthreads();
        for (int idx = c.tid; idx < 272 * 16; idx += NTHR) {
            const int tl = idx >> 4, ch = idx & 15, t = n0 * 16 + tl;
            u32x4 w = (u32x4){0u, 0u, 0u, 0u};
            if (t < S_) w = *(const u32x4*)(proj + (size_t)(b * S_ + t) * PW0 + 2048 + j * 512 + g * 128 + ch * 8);
            *(LDSP u32x4*)(lds + tl * 256 + ((ch ^ ((tl >> 4) & 15)) << 4)) = w;
        }
        __syncthreads();
        f32x4 acc[8];
#pragma unroll
        for (int cb = 0; cb < 8; ++cb) acc[cb] = (f32x4){0.f, 0.f, 0.f, 0.f};
        const int r = lane & 15, kg = lane >> 4;
        const bf16_t* wb = W1T + ((size_t)(j * 128 + r) * 4096 + kg * 8);
#pragma unroll 2
        for (int s = 0; s < 16; ++s) {
            const int ks = wid * 16 + s, l = ks >> 2, ch = (ks & 3) * 4 + kg, tl = 16 * r + l;
            const bf16x8 a = *(LDSP const bf16x8*)(lds + tl * 256 + ((ch ^ ((tl >> 4) & 15)) << 4));
            bf16x8 bf[8];
#pragma unroll
            for (int cb = 0; cb < 8; ++cb) bf[cb] = *(const bf16x8*)(wb + (size_t)cb * 16 * 4096 + ks * 32);
#pragma unroll
            for (int cb = 0; cb < 8; ++cb) acc[cb] = __builtin_amdgcn_mfma_f32_16x16x32_bf16(a, bf[cb], acc[cb], 0, 0, 0);
        }
        __syncthreads();
#pragma unroll
        for (int cb = 0; cb < 8; ++cb)
#pragma unroll
            for (int i = 0; i < 4; ++i) red[(wid * 16 + kg * 4 + i) * 128 + cb * 16 + r] = acc[cb][i];
        __syncthreads();
        { const int row = c.tid >> 5, e4 = (c.tid & 31) * 4;
          f32x4 s = (f32x4){0.f, 0.f, 0.f, 0.f};
#pragma unroll 8
          for (int p = 0; p < 32; ++p) s += *(const f32x4*)(POSB + (j * 32 + p) * 128 + e4);
#pragma unroll
          for (int w = 0; w < 8; ++w) s += *(LDSP const f32x4*)(red + (w * 16 + row) * 128 + e4);
          f32x4 h; h[0] = gelu_tanh(s[0]); h[1] = gelu_tanh(s[1]); h[2] = gelu_tanh(s[2]); h[3] = gelu_tanh(s[3]);
          *(LDSP f32x4*)(hid + row * 128 + e4) = h; }
        __syncthreads();
        { const int row = c.tid >> 5, f4 = (c.tid & 31) * 4, n = n0 + row;
          const float* w2 = c.A.in[9] + (size_t)j * 128 * 128 + f4;
          f32x4 s = (f32x4){0.f, 0.f, 0.f, 0.f};
#pragma unroll 8
          for (int e = 0; e < 128; ++e) s += hid[row * 128 + e] * *(const f32x4*)(w2 + e * 128);
          const size_t o = ((((size_t)j * 8 + b) * 128 + n) * 4 + g) * 128 + f4;
          if (n < 127) *(f32x4*)(CMP + o) = s; else s = (f32x4){0.f, 0.f, 0.f, 0.f};
          u32x2 w; w.x = pk2(s[0], s[1]); w.y = pk2(s[2], s[3]); *(u32x2*)(CMPB + o) = w; }
    }
}

__device__ __forceinline__ void dots_bf16(const bf16_t* krow, bool ok, LDSP const float* qs, float (&s)[4]) {
    s[0] = s[1] = s[2] = s[3] = 0.f;
    if (!ok) return;
#pragma unroll 4
    for (int d8 = 0; d8 < 16; ++d8) {
        const u32x4 w = *(const u32x4*)(krow + d8 * 8);
        float k[8] = {__uint_as_float(w.x << 16), __uint_as_float(w.x & 0xffff0000u), __uint_as_float(w.y << 16), __uint_as_float(w.y & 0xffff0000u),
                      __uint_as_float(w.z << 16), __uint_as_float(w.z & 0xffff0000u), __uint_as_float(w.w << 16), __uint_as_float(w.w & 0xffff0000u)};
#pragma unroll
        for (int h = 0; h < 4; ++h) {
            const f32x4 qa = *(LDSP const f32x4*)(qs + h * 128 + d8 * 8), qb = *(LDSP const f32x4*)(qs + h * 128 + d8 * 8 + 4);
            s[h] += k[0] * qa[0] + k[1] * qa[1] + k[2] * qa[2] + k[3] * qa[3] + k[4] * qb[0] + k[5] * qb[1] + k[6] * qb[2] + k[7] * qb[3];
        }
    }
}
__device__ __forceinline__ void online_tile(const float (&s)[4], const bool valid, float (&m)[4], float (&l)[4], f32x2 (&acc)[4], LDSP float* pl,
                                            const bf16_t* vbase, size_t vstride, int kcount, int lane) {
#pragma unroll
    for (int h = 0; h < 4; ++h) {
        const float sv = valid ? s[h] : -__builtin_inff();
        const float tm = wmax(sv); const float mn = fmaxf(m[h], tm);
        float alpha = 1.f, p = 0.f;
        if (mn > -__builtin_inff()) { alpha = __expf(m[h] - mn); p = valid ? __expf(sv - mn) : 0.f; }
        l[h] = l[h] * alpha + wsum(p); acc[h] *= alpha; m[h] = mn;
        pl[h * 64 + lane] = p;
    }
    lds_fence();
    for (int k = 0; k < kcount; ++k) {
        const unsigned w = *(const unsigned*)(vbase + (size_t)k * vstride + 2 * lane);
        const f32x2 v = {__uint_as_float(w << 16), __uint_as_float(w & 0xffff0000u)};
#pragma unroll
        for (int h = 0; h < 4; ++h) acc[h] += pl[h * 64 + k] * v;
    }
    lds_fence();
}
__device__ __forceinline__ void nsa_attn_ref_phase(const Ctx& c) {
    LDSP float* wl = (LDSP float*)(c.lds + c.wave * 8192);
    LDSP float* qs = wl;
    LDSP float* pl = wl + 512;
    LDSP float* ps = wl + 1024;
    const bf16_t* proj = (const bf16_t*)(c.ws + WS_PROJ);
    const float* CMP = (const float*)(c.ws + WS_CMP);
    bf16_t* O = (bf16_t*)(c.ws + WS_O);
    const int lane = c.lane, nw = c.G * NWAVE;
    const float scale = 0.08838834764831845f;
    for (int u = c.bid * NWAVE + c.wave; u < B_ * S_ * 4; u += nw) {
        const int g = u & 3, t = (u >> 2) & 2047, b = u >> 13;
        const bf16_t* prow = proj + (size_t)(b * S_ + t) * PW0;
        { const u32x4 w = *(const u32x4*)(prow + g * 512 + lane * 8); LDSP float* qd = qs + lane * 8;
          qd[0] = __uint_as_float(w.x << 16) * scale; qd[1] = __uint_as_float(w.x & 0xffff0000u) * scale; qd[2] = __uint_as_float(w.y << 16) * scale; qd[3] = __uint_as_float(w.y & 0xffff0000u) * scale;
          qd[4] = __uint_as_float(w.z << 16) * scale; qd[5] = __uint_as_float(w.z & 0xffff0000u) * scale; qd[6] = __uint_as_float(w.w << 16) * scale; qd[7] = __uint_as_float(w.w & 0xffff0000u) * scale; }
        lds_fence();
        float slope[4], gate[4][3];
#pragma unroll
        for (int h = 0; h < 4; ++h) { slope[h] = exp2f(-0.5f * (float)(4 * g + h + 1));
#pragma unroll
            for (int j = 0; j < 3; ++j) { const float x = bf2f(prow[5120 + (4 * g + h) * 3 + j]); gate[h][j] = 1.f / (1.f + __expf(-x)); } }
        f32x2 ofin[4];
        {
            float s0[4], s1[4]; bool v0, v1;
            { const int n = lane; v0 = (16 * n + 31 <= t); const float* kp = CMP + (((size_t)b * 128 + n) * 4 + g) * 128;
              s0[0] = s0[1] = s0[2] = s0[3] = 0.f;
              if (v0) for (int d = 0; d < 128; d += 4) { const f32x4 k = *(const f32x4*)(kp + d);
#pragma unroll
                  for (int h = 0; h < 4; ++h) { const f32x4 q = *(LDSP const f32x4*)(qs + h * 128 + d); s0[h] += k[0] * q[0] + k[1] * q[1] + k[2] * q[2] + k[3] * q[3]; } } }
            { const int n = lane + 64; v1 = (n < 127) && (16 * n + 31 <= t); const float* kp = CMP + (((size_t)b * 128 + n) * 4 + g) * 128;
              s1[0] = s1[1] = s1[2] = s1[3] = 0.f;
              if (v1) for (int d = 0; d < 128; d += 4) { const f32x4 k = *(const f32x4*)(kp + d);
#pragma unroll
                  for (int h = 0; h < 4; ++h) { const f32x4 q = *(LDSP const f32x4*)(qs + h * 128 + d); s1[h] += k[0] * q[0] + k[1] * q[1] + k[2] * q[2] + k[3] * q[3]; } } }
            float psum0 = 0.f, psum1 = 0.f;
#pragma unroll
            for (int h = 0; h < 4; ++h) {
                const float a0 = v0 ? s0[h] - slope[h] * ((float)t - (16.f * lane + 15.5f)) : -__builtin_inff();
                const float a1 = v1 ? s1[h] - slope[h] * ((float)t - (16.f * (lane + 64) + 15.5f)) : -__builtin_inff();
                const float mx = wmax(fmaxf(a0, a1));
                const float e0 = v0 ? __expf(a0 - mx) : 0.f, e1 = v1 ? __expf(a1 - mx) : 0.f;
                const float sum = wsum(e0 + e1), inv = 1.f / fmaxf(sum, 1e-30f);
                const float p0 = e0 * inv, p1 = e1 * inv;
                pl[h * 128 + lane] = p0; pl[h * 128 + 64 + lane] = p1; psum0 += p0; psum1 += p1;
            }
            ps[1 + lane] = psum0; ps[65 + lane] = psum1; if (lane == 0) { ps[0] = 0.f; ps[129] = 0.f; }
            lds_fence();
            f32x2 acc[4];
#pragma unroll
            for (int h = 0; h < 4; ++h) acc[h] = (f32x2){0.f, 0.f};
            const int nvis = t >= 31 ? ((t - 31) >> 4) + 1 : 0;
            const float* vp = CMP + ((((size_t)8 + b) * 128) * 4 + g) * 128 + 2 * lane;
            for (int n = 0; n < nvis; ++n) { const f32x2 v = *(const f32x2*)(vp + (size_t)n * 512);
#pragma unroll
                for (int h = 0; h < 4; ++h) acc[h] += pl[h * 128 + n] * v; }
#pragma unroll
            for (int h = 0; h < 4; ++h) ofin[h] = gate[h][0] * acc[h];
        }
        unsigned selmask;
        {
            const int j = lane & 31, cur = t >> 6;
            const float imp = ps[4 * j] + 2.f * (ps[1 + 4 * j] + ps[2 + 4 * j] + ps[3 + 4 * j]) + ps[4 + 4 * j];
            const bool forced = (j == 0) || (j == cur) || (j == cur - 1), causal = (64 * j <= t);
            const float score = forced ? 1.0e6f : (causal ? imp : -1.0f);
            int rank = 0;
            for (int i = 0; i < 32; ++i) { const float si = __shfl(score, i); rank += ((si > score) || (si == score && i < j)) ? 1 : 0; }
            selmask = (unsigned)__ballot(rank < 16 && lane < 32);
            if (lane == 0) ((unsigned*)(c.ws + WS_SEL))[((size_t)b * 4 + g) * 2048 + t] = selmask;
        }
        lds_fence();
        {
            float m[4], l[4]; f32x2 acc[4];
#pragma unroll
            for (int h = 0; h < 4; ++h) { m[h] = -__builtin_inff(); l[h] = 0.f; acc[h] = (f32x2){0.f, 0.f}; }
            for (int j = 0; j < 32; ++j) {
                if (!((selmask >> j) & 1u)) continue;
                if (64 * j > t) continue;
                const int kpos = 64 * j + lane, dist = t - kpos; const bool valid = dist >= 0;
                const bf16_t* kb = proj + (size_t)(b * S_ + kpos) * PW0 + 2048 + 1024 + g * 128;
                float s[4]; dots_bf16(kb, valid, qs, s);
#pragma unroll
                for (int h = 0; h < 4; ++h) s[h] -= slope[h] * (float)dist;
                online_tile(s, valid, m, l, acc, pl, proj + (size_t)(b * S_ + 64 * j) * PW0 + 2048 + 1536 + g * 128, PW0, min(64, t - 64 * j + 1), lane);
            }
#pragma unroll
            for (int h = 0; h < 4; ++h) ofin[h] += (gate[h][1] / l[h]) * acc[h];
        }
        {
            float m[4], l[4]; f32x2 acc[4];
#pragma unroll
            for (int h = 0; h < 4; ++h) { m[h] = -__builtin_inff(); l[h] = 0.f; acc[h] = (f32x2){0.f, 0.f}; }
            for (int i = 0; i < 8; ++i) {
                const int k0 = t - 511 + 64 * i; if (k0 + 63 < 0) continue;
                const int kpos = k0 + lane, dist = t - kpos; const bool valid = kpos >= 0;
                const bf16_t* kb = proj + (size_t)(b * S_ + (valid ? kpos : 0)) * PW0 + 2048 + 2048 + g * 128;
                float s[4]; dots_bf16(kb, valid, qs, s);
#pragma unroll
                for (int h = 0; h < 4; ++h) s[h] -= slope[h] * (float)dist;
                const int kfirst = k0 < 0 ? -k0 : 0;
#pragma unroll
                for (int h = 0; h < 4; ++h) {
                    const float sv = valid ? s[h] : -__builtin_inff();
                    const float tm = wmax(sv); const float mn = fmaxf(m[h], tm);
                    float alpha = 1.f, p = 0.f;
                    if (mn > -__builtin_inff()) { alpha = __expf(m[h] - mn); p = valid ? __expf(sv - mn) : 0.f; }
                    l[h] = l[h] * alpha + wsum(p); acc[h] *= alpha; m[h] = mn; pl[h * 64 + lane] = p;
                }
                lds_fence();
                const bf16_t* vb = proj + 2048 + 2560 + g * 128 + 2 * lane;
                for (int k = kfirst; k < 64; ++k) {
                    const unsigned w = *(const unsigned*)(vb + (size_t)(b * S_ + k0 + k) * PW0);
                    const f32x2 v = {__uint_as_float(w << 16), __uint_as_float(w & 0xffff0000u)};
#pragma unroll
                    for (int h = 0; h < 4; ++h) acc[h] += pl[h * 64 + k] * v;
                }
                lds_fence();
            }
#pragma unroll
            for (int h = 0; h < 4; ++h) ofin[h] += (gate[h][2] / l[h]) * acc[h];
        }
#pragma unroll
        for (int h = 0; h < 4; ++h) *(unsigned*)(O + (size_t)(b * S_ + t) * D_ + (4 * g + h) * 128 + 2 * lane) = pk2(ofin[h][0], ofin[h][1]);
        lds_fence();
    }
}

__device__ __forceinline__ void dil_attn_ref_phase(const Ctx& c) {
    LDSP float* wl = (LDSP float*)(c.lds + c.wave * 8192);
    LDSP float* qs = wl;
    LDSP float* pl = wl + 128;
    const bf16_t* proj = (const bf16_t*)(c.ws + WS_PROJ);
    bf16_t* O = (bf16_t*)(c.ws + WS_O);
    const int lane = c.lane, nw = c.G * NWAVE;
    const float scale = 0.08838834764831845f;
    for (int u = c.bid * NWAVE + c.wave; u < B_ * S_ * 16; u += nw) {
        const int h = u & 15, t = (u >> 4) & 2047, b = u >> 15;
        const bf16_t* prow = proj + (size_t)(b * S_ + t) * PW1;
        { const unsigned w = *(const unsigned*)(prow + h * 128 + 2 * lane); qs[2 * lane] = __uint_as_float(w << 16) * scale; qs[2 * lane + 1] = __uint_as_float(w & 0xffff0000u) * scale; }
        lds_fence();
        const float slope = exp2f(-0.5f * (float)(h + 1));
        float lse[3]; f32x2 og[3];
#pragma unroll
        for (int gi = 0; gi < 3; ++gi) {
            const int r = gi == 0 ? 1 : gi == 1 ? 4 : 16;
            const int uq = t / r; const int imax = uq < 128 ? uq : 128;
            const size_t koff = 2048 + (size_t)gi * 4096 + h * 128, voff = koff + 2048;
            float m = -__builtin_inff(), l = 0.f; f32x2 acc = {0.f, 0.f};
            for (int tile = 0; tile * 64 <= imax; ++tile) {
                const int i = tile * 64 + lane; const bool valid = i <= imax;
                float s = 0.f;
                if (valid) { const bf16_t* kr = proj + (size_t)(b * S_ + t - r * i) * PW1 + koff;
                    for (int d8 = 0; d8 < 16; ++d8) { const u32x4 w = *(const u32x4*)(kr + d8 * 8);
                        const f32x4 qa = *(LDSP const f32x4*)(qs + d8 * 8), qb = *(LDSP const f32x4*)(qs + d8 * 8 + 4);
                        s += __uint_as_float(w.x << 16) * qa[0] + __uint_as_float(w.x & 0xffff0000u) * qa[1] + __uint_as_float(w.y << 16) * qa[2] + __uint_as_float(w.y & 0xffff0000u) * qa[3]
                           + __uint_as_float(w.z << 16) * qb[0] + __uint_as_float(w.z & 0xffff0000u) * qb[1] + __uint_as_float(w.w << 16) * qb[2] + __uint_as_float(w.w & 0xffff0000u) * qb[3]; }
                    s -= slope * (float)(r * i); }
                const float sv = valid ? s : -__builtin_inff();
                const float mn = fmaxf(m, wmax(sv));
                const float alpha = __expf(m - mn), p = valid ? __expf(sv - mn) : 0.f;
                l = l * alpha + wsum(p); acc *= alpha; m = mn; pl[lane] = p;
                lds_fence();
                const int kc = min(64, imax - tile * 64 + 1);
                for (int k = 0; k < kc; ++k) { const unsigned w = *(const unsigned*)(proj + (size_t)(b * S_ + t - r * (tile * 64 + k)) * PW1 + voff + 2 * lane);
                    acc += pl[k] * (f32x2){__uint_as_float(w << 16), __uint_as_float(w & 0xffff0000u)}; }
                lds_fence();
            }
            lse[gi] = m + __logf(l); og[gi] = acc * (1.f / l);
        }
        const float mx = fmaxf(lse[0], fmaxf(lse[1], lse[2]));
        const float w0 = __expf(lse[0] - mx), w1 = __expf(lse[1] - mx), w2 = __expf(lse[2] - mx), inv = 1.f / (w0 + w1 + w2);
        const f32x2 o = (w0 * inv) * og[0] + (w1 * inv) * og[1] + (w2 * inv) * og[2];
        *(unsigned*)(O + (size_t)(b * S_ + t) * D_ + h * 128 + 2 * lane) = pk2(o[0], o[1]);
        lds_fence();
    }
}


namespace att {
typedef __attribute__((address_space(1))) char gchar;
typedef __attribute__((address_space(1))) float gfloat;
typedef __attribute__((address_space(1))) unsigned gunsigned;
typedef short bf16x8 __attribute__((ext_vector_type(8)));
typedef short s16x4 __attribute__((ext_vector_type(4)));
typedef float f32x16 __attribute__((ext_vector_type(16)));
constexpr int SHM = 16384;
constexpr int OFF_V = 0, OFF_K = 3 * SHM, OFF_WS = 6 * SHM, OFF_MISC = 6 * SHM + 8 * 256;
constexpr int OFF_PS = OFF_MISC + 256, OFF_SC = OFF_PS + 8 * (8 * 129 * 4), OFF_GT = OFF_SC + 8 * 1024;
constexpr int OFF_AT = OFF_GT + 8 * 512;
constexpr int OFF_PS_ = 0;
constexpr float C2 = 0.08838834764831845f * 1.4426950408889634f;
constexpr float LOG2E = 1.4426950408889634f;
constexpr float THR = 6.0f;

#define ATT_KSWZ(row, colB) ((row) * 256 + ((colB) ^ (((row) & 15) << 4)))
#define ATT_SBAR() __builtin_amdgcn_sched_barrier(0)
__device__ __forceinline__ int v_st(int k, int c) { const int kk = (k & ~0xC) | ((k & 4) << 1) | ((k & 8) >> 1); return ((kk >> 3) * 4 + (c >> 5)) * 512 + ((kk & 7) * 32 + (c & 31)) * 2; }
__device__ __forceinline__ int v_rd_base(int lane) { return ((lane & 3) << 3) | (((lane >> 2) & 3) << 6) | (((lane >> 4) & 1) << 5) | (((lane >> 5) & 1) << 8); }
__device__ __forceinline__ int crow(int r, int hi) { return (r & 3) + 8 * (r >> 2) + 4 * hi; }
extern "C" __device__ float fmul_legacy_(float, float) __asm("llvm.amdgcn.fmul.legacy");
__device__ __forceinline__ unsigned cvtpk(float lo, float hi) { unsigned r; asm volatile("v_cvt_pk_bf16_f32 %0, %1, %2" : "=v"(r) : "v"(lo), "v"(hi)); return r; }

struct Lane { int lane, r32, hi, wid, tid; LDSP const char* at; int atmul; };

template <bool INIT = false>
__device__ __forceinline__ void qkt(f32x16& p0, f32x16& p1, LDSP const char* Kt, int r32, int hi, const bf16x8* qr, LDSP const char* at = nullptr) {
    if (INIT) {
        bf16x8 t_[8];
#pragma unroll
        for (int i = 0; i < 8; ++i) t_[i] = *reinterpret_cast<LDSP const bf16x8*>(at + 16 * i);
#pragma unroll
        for (int i = 0; i < 4; ++i) { const f32x4 a_ = *reinterpret_cast<const f32x4*>(&t_[i]), b_ = *reinterpret_cast<const f32x4*>(&t_[4 + i]);
            p0[4 * i] = a_[0]; p0[4 * i + 1] = a_[1]; p0[4 * i + 2] = a_[2]; p0[4 * i + 3] = a_[3]; p1[4 * i] = b_[0]; p1[4 * i + 1] = b_[1]; p1[4 * i + 2] = b_[2]; p1[4 * i + 3] = b_[3]; } }
    else { p0 = f32x16{}; p1 = f32x16{}; }
    int kb[4];
    int k0_ = ATT_KSWZ(r32, hi * 16); asm volatile("" : "+v"(k0_));
#pragma unroll
    for (int dd = 0; dd < 4; ++dd) kb[dd] = k0_ ^ (dd << 5);
    bf16x8 f[8][2];
#define ATT_KRD(d0) do { LDSP const char* a_ = Kt + (kb[(d0) & 3] ^ (((d0) >> 2) << 7)); f[d0][0] = *reinterpret_cast<LDSP const bf16x8*>(a_); f[d0][1] = *reinterpret_cast<LDSP const bf16x8*>(a_ + 32 * 256); } while (0)
    ATT_KRD(0); ATT_KRD(1); ATT_KRD(2);
#pragma unroll
    for (int d0 = 0; d0 < 8; ++d0) {
        ATT_SBAR();
        if (d0 + 3 < 8) { if (d0 == 0) ATT_KRD(3); else if (d0 == 1) ATT_KRD(4); else if (d0 == 2) ATT_KRD(5); else if (d0 == 3) ATT_KRD(6); else ATT_KRD(7); }
        p0 = __builtin_amdgcn_mfma_f32_32x32x16_bf16(f[d0][0], qr[d0], p0, 0, 0, 0);
        p1 = __builtin_amdgcn_mfma_f32_32x32x16_bf16(f[d0][1], qr[d0], p1, 0, 0, 0);
    }
#undef ATT_KRD
}
__device__ __forceinline__ void pv_tile(f32x16* o, int vb, bf16x8 pa0, bf16x8 pa1, bf16x8 pa2, bf16x8 pa3) {
#define ATT_TRRD(dst, off) asm volatile("ds_read_b64_tr_b16 %0, %1 offset:%2" : "=&v"(dst) : "v"(vb), "i"(off) : "memory")
#define ATT_RD8(S, d0) do { constexpr int b_ = (d0) * 512; ATT_TRRD(S##l0, b_); ATT_TRRD(S##h0, b_ + 2048); ATT_TRRD(S##l1, b_ + 4096); ATT_TRRD(S##h1, b_ + 6144); \
        ATT_TRRD(S##l2, b_ + 8192); ATT_TRRD(S##h2, b_ + 10240); ATT_TRRD(S##l3, b_ + 12288); ATT_TRRD(S##h3, b_ + 14336); } while (0)
#define ATT_MM4(S, d0) do { \
        o[d0] = __builtin_amdgcn_mfma_f32_32x32x16_bf16(pa0, (bf16x8){S##l0[0], S##l0[1], S##l0[2], S##l0[3], S##h0[0], S##h0[1], S##h0[2], S##h0[3]}, o[d0], 0, 0, 0); \
        o[d0] = __builtin_amdgcn_mfma_f32_32x32x16_bf16(pa1, (bf16x8){S##l1[0], S##l1[1], S##l1[2], S##l1[3], S##h1[0], S##h1[1], S##h1[2], S##h1[3]}, o[d0], 0, 0, 0); \
        o[d0] = __builtin_amdgcn_mfma_f32_32x32x16_bf16(pa2, (bf16x8){S##l2[0], S##l2[1], S##l2[2], S##l2[3], S##h2[0], S##h2[1], S##h2[2], S##h2[3]}, o[d0], 0, 0, 0); \
        o[d0] = __builtin_amdgcn_mfma_f32_32x32x16_bf16(pa3, (bf16x8){S##l3[0], S##l3[1], S##l3[2], S##l3[3], S##h3[0], S##h3[1], S##h3[2], S##h3[3]}, o[d0], 0, 0, 0); } while (0)
    s16x4 Al0, Al1, Al2, Al3, Ah0, Ah1, Ah2, Ah3, Bl0, Bl1, Bl2, Bl3, Bh0, Bh1, Bh2, Bh3;
    asm volatile("s_waitcnt lgkmcnt(0)" ::: "memory"); ATT_SBAR();
    ATT_RD8(A, 0); ATT_RD8(B, 1);
    asm volatile("s_waitcnt lgkmcnt(8)" ::: "memory"); ATT_SBAR(); ATT_MM4(A, 0); ATT_SBAR();
    ATT_RD8(A, 2);
    asm volatile("s_waitcnt lgkmcnt(8)" ::: "memory"); ATT_SBAR(); ATT_MM4(B, 1); ATT_SBAR();
    ATT_RD8(B, 3);
    asm volatile("s_waitcnt lgkmcnt(8)" ::: "memory"); ATT_SBAR(); ATT_MM4(A, 2); ATT_SBAR();
    asm volatile("s_waitcnt lgkmcnt(0)" ::: "memory"); ATT_SBAR(); ATT_MM4(B, 3);
#undef ATT_MM4
#undef ATT_RD8
#undef ATT_TRRD
}
__device__ __forceinline__ void mask_tile(f32x16& p0, f32x16& p1, int dq, unsigned W) {
    const float NEG = -__builtin_inff();
#pragma unroll
    for (int r = 0; r < 16; ++r) { const int cc = (r & 3) + 8 * (r >> 2);
        if ((unsigned)(dq - cc) >= W) p0[r] = NEG;
        if ((unsigned)(dq - cc - 32) >= W) p1[r] = NEG; }
}
__device__ __forceinline__ void alibi_tile(f32x16& p0, f32x16& p1, float sl2) {
#pragma unroll
    for (int r = 0; r < 16; ++r) { const float cc = (float)((r & 3) + 8 * (r >> 2)); p0[r] = fmaf(sl2, cc, p0[r]); p1[r] = fmaf(sl2, cc + 32.f, p1[r]); }
}
__device__ __forceinline__ void alibi_table_write(LDSP char* lds, int slot, int i, float sl2) {
    const int r = i & 15; ((LDSP float*)(lds + OFF_AT))[slot * 32 + i] = sl2 * (float)((r & 3) + 8 * (r >> 2) + (i & 16) * 2);
}
__device__ __forceinline__ void softmax_a(f32x16& p0, f32x16& p1, float base, float& m_reg, float& alpha) {
    float pmax = p0[0];
#pragma unroll
    for (int r = 1; r < 16; ++r) pmax = fmaxf(pmax, p0[r]);
#pragma unroll
    for (int r = 0; r < 16; ++r) pmax = fmaxf(pmax, p1[r]);
    pmax += base;
    { auto rr = __builtin_amdgcn_permlane32_swap(__float_as_uint(pmax), __float_as_uint(pmax), false, false); pmax = fmaxf(__uint_as_float(rr[0]), __uint_as_float(rr[1])); }
    float mn;
    if (__all(pmax - m_reg <= THR)) { mn = m_reg; alpha = 1.f; }
    else { mn = fmaxf(m_reg, pmax); alpha = __builtin_amdgcn_exp2f(m_reg - mn); m_reg = mn; }
    const float sub = mn - base;
#pragma unroll
    for (int r = 0; r < 16; ++r) p0[r] = __builtin_amdgcn_exp2f(p0[r] - sub);
#pragma unroll
    for (int r = 0; r < 16; ++r) p1[r] = __builtin_amdgcn_exp2f(p1[r] - sub);
}
__device__ __forceinline__ float rowsum2(const f32x16& p0, const f32x16& p1) {
    float ps = 0;
#pragma unroll
    for (int r = 0; r < 16; ++r) ps += p0[r];
#pragma unroll
    for (int r = 0; r < 16; ++r) ps += p1[r];
    auto rr = __builtin_amdgcn_permlane32_swap(__float_as_uint(ps), __float_as_uint(ps), false, false);
    return __uint_as_float(rr[0]) + __uint_as_float(rr[1]);
}
__device__ __forceinline__ void pack_p(const f32x16& p0, const f32x16& p1, bf16x8& pa0, bf16x8& pa1, bf16x8& pa2, bf16x8& pa3) {
#define ATT_PK4(P, B_, OUT) do { unsigned a0 = cvtpk(P[B_ + 0], P[B_ + 1]), a1 = cvtpk(P[B_ + 2], P[B_ + 3]); \
        unsigned b0 = cvtpk(P[B_ + 4], P[B_ + 5]), b1 = cvtpk(P[B_ + 6], P[B_ + 7]); \
        auto r0 = __builtin_amdgcn_permlane32_swap(a0, b0, false, false); auto r1 = __builtin_amdgcn_permlane32_swap(a1, b1, false, false); \
        u32x4 w = {r0[0], r1[0], r0[1], r1[1]}; OUT = *reinterpret_cast<bf16x8*>(&w); } while (0)
    ATT_PK4(p0, 0, pa0); ATT_PK4(p0, 8, pa1); ATT_PK4(p1, 0, pa2); ATT_PK4(p1, 8, pa3);
#undef ATT_PK4
}
__device__ __forceinline__ void scale_rows(f32x16* o, float f, LDSP float* xl, int r32, int hi) {
    if (hi == 0) xl[r32] = f;
    asm volatile("s_waitcnt lgkmcnt(0)" ::: "memory");
    float fr[16];
#pragma unroll
    for (int r = 0; r < 16; ++r) fr[r] = xl[crow(r, hi)];
#pragma unroll
    for (int d = 0; d < 4; ++d)
#pragma unroll
        for (int r = 0; r < 16; ++r) o[d][r] = fmul_legacy_(o[d][r], fr[r]);
    asm volatile("s_waitcnt lgkmcnt(0)" ::: "memory");
}
__device__ __forceinline__ bf16x8 scale8(u32x4 w, float s) {
    u32x4 o;
    o.x = cvtpk(__uint_as_float(w.x << 16) * s, __uint_as_float(w.x & 0xffff0000u) * s); o.y = cvtpk(__uint_as_float(w.y << 16) * s, __uint_as_float(w.y & 0xffff0000u) * s);
    o.z = cvtpk(__uint_as_float(w.z << 16) * s, __uint_as_float(w.z & 0xffff0000u) * s); o.w = cvtpk(__uint_as_float(w.w << 16) * s, __uint_as_float(w.w & 0xffff0000u) * s);
    return *reinterpret_cast<bf16x8*>(&o);
}
__device__ __forceinline__ bf16x8 aug_frag(unsigned dword0, int hi) { u32x4 w = {hi ? 0u : dword0, 0u, 0u, 0u}; return *reinterpret_cast<bf16x8*>(&w); }
__device__ __forceinline__ unsigned split_bf16(float x) {
    const unsigned hb = (unsigned)f2bf(x); const float rem = x - __uint_as_float(hb << 16); return hb | ((unsigned)f2bf(rem) << 16);
}

struct DmaMap { int m0, m1; };
__device__ __forceinline__ int dma_map1(int q) {
    const int krow = q >> 4, kcol = ((q & 15) ^ (krow & 15)) * 8;
    const int sub = q >> 5, kk = (sub >> 2) * 8 + ((q & 31) >> 2), vrow = (kk & ~0xC) | ((kk & 4) << 1) | ((kk & 8) >> 1), vcol = (sub & 3) * 32 + (q & 3) * 8;
    return krow | (kcol << 6) | (vrow << 13) | (vcol << 19);
}
__device__ __forceinline__ DmaMap dma_map(int wid, int lane) { DmaMap d; d.m0 = dma_map1(wid * 64 + lane); d.m1 = dma_map1(512 + wid * 64 + lane); return d; }
__device__ __forceinline__ void stage_dma(const DmaMap& dm, const bf16_t* Kb, const bf16_t* Vb, size_t stride, int row0, int rmax, LDSP char* lds, int buf, int wid, int which = 3) {
#pragma unroll
    for (int i = 0; i < 2; ++i) {
        const int m = i ? dm.m1 : dm.m0;
        if (which & 1) { int kr = row0 + (m & 63); kr = kr < 0 ? 0 : (kr > rmax ? rmax : kr);
            const bf16_t* ks = Kb + (size_t)kr * stride + ((m >> 6) & 127);
            __builtin_amdgcn_global_load_lds((const unsigned*)ks, (LDSP unsigned*)(lds + OFF_K + buf * SHM + i * 8192 + wid * 1024), 16, 0, 0); }
        if (which & 2) { int vr = row0 + ((m >> 13) & 63); vr = vr < 0 ? 0 : (vr > rmax ? rmax : vr);
            const bf16_t* vs = Vb + (size_t)vr * stride + ((m >> 19) & 127);
            __builtin_amdgcn_global_load_lds((const unsigned*)vs, (LDSP unsigned*)(lds + OFF_V + buf * SHM + i * 8192 + wid * 1024), 16, 0, 0); }
    }
}
struct Stage { u32x4 k0, k1, v0, v1; };
__device__ __forceinline__ void stage_load(Stage& s, const bf16_t* Kb, const bf16_t* Vb, size_t stride, int row0, int rmax, int tid) {
    const int sr = tid >> 4, sc = (tid & 15) * 8;
    int ra = row0 + sr, rb = row0 + 32 + sr; ra = ra < 0 ? 0 : (ra > rmax ? rmax : ra); rb = rb < 0 ? 0 : (rb > rmax ? rmax : rb);
    s.v0 = *(const u32x4*)(Vb + (size_t)ra * stride + sc); s.v1 = *(const u32x4*)(Vb + (size_t)rb * stride + sc);
    s.k0 = *(const u32x4*)(Kb + (size_t)ra * stride + sc); s.k1 = *(const u32x4*)(Kb + (size_t)rb * stride + sc);
}
__device__ __forceinline__ void stage_write(const Stage& s, LDSP char* lds, int buf, int tid) {
    const int sr = tid >> 4, sc = (tid & 15) * 8;
    *(LDSP u32x4*)(lds + OFF_K + buf * SHM + ATT_KSWZ(sr, sc * 2)) = s.k0; *(LDSP u32x4*)(lds + OFF_K + buf * SHM + ATT_KSWZ(sr, sc * 2) + 32 * 256) = s.k1;
    *(LDSP u32x4*)(lds + OFF_V + buf * SHM + v_st(sr, sc)) = s.v0; *(LDSP u32x4*)(lds + OFF_V + buf * SHM + v_st(32 + sr, sc)) = s.v1;
}
__device__ __forceinline__ void stage_dma_at(const DmaMap& dm, const bf16_t* Kb, const bf16_t* Vb, size_t stride, int row0, int rmax, LDSP char* kdst, LDSP char* vdst, int wid) {
#pragma unroll
    for (int i = 0; i < 2; ++i) {
        const int m = i ? dm.m1 : dm.m0;
        int kr = row0 + (m & 63), vr = row0 + ((m >> 13) & 63); kr = kr < 0 ? 0 : (kr > rmax ? rmax : kr); vr = vr < 0 ? 0 : (vr > rmax ? rmax : vr);
        const bf16_t* ks = Kb + (size_t)kr * stride + ((m >> 6) & 127); const bf16_t* vs = Vb + (size_t)vr * stride + ((m >> 19) & 127);
        __builtin_amdgcn_global_load_lds((const unsigned*)ks, (LDSP unsigned*)(kdst + i * 8192 + wid * 1024), 16, 0, 0);
        __builtin_amdgcn_global_load_lds((const unsigned*)vs, (LDSP unsigned*)(vdst + i * 8192 + wid * 1024), 16, 0, 0);
    }
}
#define ATT_DMA_SYNC() do { asm volatile("s_waitcnt vmcnt(0)" ::: "memory"); __syncthreads(); } while (0)
#define ATT_RING_SYNC(more) do { if (more) asm volatile("s_waitcnt vmcnt(4)" ::: "memory"); else asm volatile("s_waitcnt vmcnt(0)" ::: "memory"); \
        asm volatile("s_waitcnt lgkmcnt(0)" ::: "memory"); __builtin_amdgcn_s_barrier(); asm volatile("" ::: "memory"); } while (0)

struct Pass { float m, l; f32x16 o[4]; };
__device__ __forceinline__ void pass_init(Pass& P) { P.m = -1e30f; P.l = 0.f;
#pragma unroll
    for (int d = 0; d < 4; ++d) P.o[d] = f32x16{}; }

struct PFrag { bf16x8 a0, a1, a2, a3; };
__device__ __forceinline__ void tile_sm(Pass& P, PFrag& F, f32x16& p0, f32x16& p1, LDSP float* xl, const Lane& L, float sl2, bool need_mask, int dq0, unsigned W, float base);
__device__ __forceinline__ void tile_qk_at(Pass& P, PFrag& F, LDSP const char* Kt, LDSP float* xl, const Lane& L, const bf16x8* qr, float sl2, bool need_mask, int dq0, unsigned W, float base) {
    f32x16 p0, p1;
    qkt<true>(p0, p1, Kt, L.r32, L.hi, qr, L.at + (L.r32 >> 3) * L.atmul);
    tile_sm(P, F, p0, p1, xl, L, sl2, need_mask, dq0, W, base);
}
__device__ __forceinline__ void tile_sm(Pass& P, PFrag& F, f32x16& p0, f32x16& p1, LDSP float* xl, const Lane& L, float sl2, bool need_mask, int dq0, unsigned W, float base) {
    if (need_mask) mask_tile(p0, p1, dq0 - 4 * L.hi, W);
    float alpha;
    const float m_prev = P.m;
    softmax_a(p0, p1, base + sl2 * (float)(4 * L.hi), P.m, alpha);
    if (__any(alpha < 1.f && m_prev > -1e29f)) scale_rows(P.o, alpha, xl, L.r32, L.hi);
    P.l = P.l * alpha + rowsum2(p0, p1);
    pack_p(p0, p1, F.a0, F.a1, F.a2, F.a3);
}
__device__ __forceinline__ void tile_qk(Pass& P, PFrag& F, LDSP char* lds, int buf, const Lane& L, const bf16x8* qr, float sl2, bool need_mask, int dq0, unsigned W, float base) {
    tile_qk_at(P, F, lds + OFF_K + buf * SHM, (LDSP float*)(lds + OFF_WS + L.wid * 256), L, qr, sl2, need_mask, dq0, W, base);
}
__device__ __forceinline__ void tile_pv_at(Pass& P, const PFrag& F, LDSP char* Vt, const Lane& L) {
    ATT_SBAR();
    const int vb = (int)(unsigned)(uintptr_t)Vt + v_rd_base(L.lane);
    pv_tile(P.o, vb, F.a0, F.a1, F.a2, F.a3);
}
__device__ __forceinline__ void tile_pv(Pass& P, const PFrag& F, LDSP char* lds, int buf, const Lane& L) {
    ATT_SBAR();
    const int vb = (int)(unsigned)(uintptr_t)(lds + OFF_V + buf * SHM) + v_rd_base(L.lane);
    pv_tile(P.o, vb, F.a0, F.a1, F.a2, F.a3);
}
#define ATT_EV_EVEN(k_) do { if ((k_) == 0 || (k_) >= n) asm volatile("s_waitcnt vmcnt(0)" ::: "memory"); else if ((k_) + 1 < n) asm volatile("s_waitcnt vmcnt(4)" ::: "memory"); else asm volatile("s_waitcnt vmcnt(2)" ::: "memory"); \
        asm volatile("s_waitcnt lgkmcnt(0)" ::: "memory"); __builtin_amdgcn_s_barrier(); asm volatile("" ::: "memory"); } while (0)
#define ATT_ISSUE(k_) do { if ((k_) + 2 < n) pol.dma(pol.tile((k_) + 2), ((k_) + 2) % 3, 1); if ((k_) + 1 < n) pol.dma(pol.tile((k_) + 1), ((k_) + 1) % 3, 2); } while (0)
#define ATT_EV_ODD() do { asm volatile("s_waitcnt lgkmcnt(0)" ::: "memory"); __builtin_amdgcn_s_barrier(); asm volatile("" ::: "memory"); } while (0)
template <class Pol, bool STAGGER = true>
__device__ __forceinline__ void ring_pass(Pass& P, const Pol& pol, LDSP char* lds, const Lane& L, const bf16x8* qr, float sl2, bool pre = false) {
    const int n = pol.n;
    const bool lag = STAGGER && L.wid >= 4;
    LDSP float* xl = (LDSP float*)(lds + OFF_WS + L.wid * 256);
    if (!pre) { pol.dma(pol.tile(0), 0, 3); if (n > 1) pol.dma(pol.tile(1), 1, 1); }
    ATT_EV_EVEN(0); ATT_ISSUE(0);
    if (lag) ATT_EV_ODD();
    PFrag F;
    bool actp = false; int buf = 0, bufp = 0;
    for (int i = 0; i < n; ++i) {
        if (actp) tile_pv(P, F, lds, bufp, L);
        ATT_SBAR();
        const int j = pol.tile(i);
        bool act; f32x16 p0, p1;
        { bool nm_; int dq_; unsigned W_; float base_; pol.prep(j, act, nm_, dq_, W_, base_); }
        if (act) { int rr_ = L.r32; if (L.atmul) asm volatile("" : "+v"(rr_)); qkt<true>(p0, p1, lds + OFF_K + buf * SHM, L.r32, L.hi, qr, L.at + (rr_ >> 3) * L.atmul); }
        if (!lag) { if (STAGGER) ATT_EV_ODD(); } else ATT_EV_EVEN(i + 1);
        if (act) { int j2 = j; asm volatile("" : "+s"(j2));
            bool a2_, need_mask; int dq0; unsigned W; float base; pol.prep(j2, a2_, need_mask, dq0, W, base);
            tile_sm(P, F, p0, p1, xl, L, sl2, need_mask, dq0, W, base); }
        else { const bf16x8 z_ = {}; F.a0 = z_; F.a1 = z_; F.a2 = z_; F.a3 = z_; }
        if (!lag) ATT_EV_EVEN(i + 1); else ATT_EV_ODD();
        ATT_ISSUE(i + 1);
        actp = act; bufp = buf; buf = buf == 2 ? 0 : buf + 1;
    }
    if (actp) tile_pv(P, F, lds, bufp, L);
    if (STAGGER && !lag) ATT_EV_ODD();
}
}

__device__ __forceinline__ void nsa_attn_mfma_phase(const Ctx& c) {
    using namespace att;
    LDSP char* lds = (LDSP char*)c.lds;
    const bf16_t* proj = (const bf16_t*)(c.ws + WS_PROJ);
    const bf16_t* CMPB = (const bf16_t*)(c.ws + WS_CMPB);
    float* ACC = (float*)(c.ws + WS_ACC);
    bf16_t* O = (bf16_t*)(c.ws + WS_O);
    Lane L; L.tid = c.tid; L.lane = c.lane; L.r32 = c.lane & 31; L.hi = c.lane >> 5; L.wid = c.wave; L.at = lds + OFF_AT; L.atmul = 128;
    const DmaMap dm = dma_map(L.wid, L.lane);
    LDSP float* xl = (LDSP float*)(lds + OFF_WS + L.wid * 256);
    LDSP unsigned* misc = (LDSP unsigned*)(lds + OFF_MISC);
    { LDSP float* psw0 = (LDSP float*)(lds + OFF_PS + L.wid * (8 * 129 * 4));
#pragma unroll
      for (int i = 0; i < 17; ++i) { const int w = L.lane + 64 * i; if (w < 8 * 129) psw0[w] = 0.f; } }
    for (int uu = c.bid; uu < (DUP_PH == 104 ? 2048 : 1024); uu += c.G) {
        const int u = uu & 1023, cc_ = u & 255, ri_ = u >> 8, bg = (cc_ >> 4) + 16 * (ri_ >> 1), q0_ = (ri_ >> 1) ? 15 - (cc_ & 15) : (cc_ & 15), qb = (ri_ & 1) ? 31 - q0_ : q0_, b = bg >> 2, g = bg & 3;
        const int qi = L.r32 & 7, hl = L.r32 >> 3, t = 64 * qb + 8 * L.wid + qi, h = 4 * g + hl;
        const bf16_t* prow = proj + (size_t)(b * S_ + t) * PW0;
        __syncthreads();
        { int tw = c.tid; asm volatile("" : "+v"(tw));
          if (tw < 128) alibi_table_write(lds, tw >> 5, tw & 31, exp2f(-0.5f * (float)(4 * g + (tw >> 5) + 1)) * LOG2E); }
        { const bf16_t* Kc0 = CMPB + ((size_t)(0 * 8 + b) * 128 * 4 + g) * 128; const bf16_t* Vc0 = CMPB + ((size_t)(1 * 8 + b) * 128 * 4 + g) * 128;
          stage_dma(dm, Kc0, Vc0, 512, 0, 127, lds, 0, L.wid); stage_dma(dm, Kc0, Vc0, 512, 64, 127, lds, 1, L.wid); }
        bf16x8 qr[8];
        { u32x4 qraw_[8];
#pragma unroll
          for (int d0 = 0; d0 < 8; ++d0) qraw_[d0] = *(const u32x4*)(prow + h * 128 + d0 * 16 + L.hi * 8);
#pragma unroll
          for (int d0 = 0; d0 < 8; ++d0) qr[d0] = scale8(qraw_[d0], C2); }
        const float slope = exp2f(-0.5f * (float)(h + 1));
        LDSP float* gtw = (LDSP float*)(lds + OFF_GT + L.wid * 512);
        if (L.hi == 0) {
#pragma unroll
            for (int j = 0; j < 3; ++j) gtw[L.r32 * 3 + j] = 1.f / (1.f + __expf(-bf2f(prow[5120 + h * 3 + j])));
        }
#define NSA_GATE(j) (gtw[L.r32 * 3 + (j)])
        char* accb = (char*)ACC + ((size_t)c.bid * NWAVE + L.wid) * 16384;
        const unsigned avo = (unsigned)(L.lane * 4);
        unsigned selmask;
#if !defined(NSA_NO_CMP)
        for (int repc_ = 0; repc_ < (DUP_PH == 301 ? 2 : 1); ++repc_) { if (repc_) __syncthreads();
            const bf16_t* Kc = CMPB + ((size_t)(0 * 8 + b) * 128 * 4 + g) * 128; const bf16_t* Vc = CMPB + ((size_t)(1 * 8 + b) * 128 * 4 + g) * 128;
            ATT_DMA_SYNC();
            const float sl2 = slope * 16.f * LOG2E, qf = ((float)t - 15.5f) * 0.0625f;
            const int nq = (t - 31) >> 4;
            f32x16 pA0, pA1, pB0, pB1;
            qkt(pA0, pA1, lds + OFF_K, L.r32, L.hi, qr); alibi_tile(pA0, pA1, sl2);
            qkt(pB0, pB1, lds + OFF_K + SHM, L.r32, L.hi, qr); alibi_tile(pB0, pB1, sl2);
            mask_tile(pA0, pA1, nq - 4 * L.hi, 0x40000000u); mask_tile(pB0, pB1, nq - 64 - 4 * L.hi, 0x40000000u);
            const float baseA = -sl2 * (qf - (float)(4 * L.hi)), baseB = -sl2 * (qf - 64.f - (float)(4 * L.hi));
            float mA = pA0[0], mB = pB0[0];
#pragma unroll
            for (int r = 1; r < 16; ++r) { mA = fmaxf(mA, pA0[r]); mB = fmaxf(mB, pB0[r]); }
#pragma unroll
            for (int r = 0; r < 16; ++r) { mA = fmaxf(mA, pA1[r]); mB = fmaxf(mB, pB1[r]); }
            float mx = fmaxf(mA + baseA, mB + baseB);
            { auto rr = __builtin_amdgcn_permlane32_swap(__float_as_uint(mx), __float_as_uint(mx), false, false); mx = fmaxf(__uint_as_float(rr[0]), __uint_as_float(rr[1])); }
            if (mx == -__builtin_inff()) mx = 0.f;
            const float subA = mx - baseA, subB = mx - baseB;
#pragma unroll
            for (int r = 0; r < 16; ++r) { pA0[r] = __builtin_amdgcn_exp2f(pA0[r] - subA); pA1[r] = __builtin_amdgcn_exp2f(pA1[r] - subA); pB0[r] = __builtin_amdgcn_exp2f(pB0[r] - subB); pB1[r] = __builtin_amdgcn_exp2f(pB1[r] - subB); }
            const float lsum = rowsum2(pA0, pA1) + rowsum2(pB0, pB1);
            const float inv = 1.f / fmaxf(lsum, 1e-30f);
#pragma unroll
            for (int r = 0; r < 16; ++r) { pA0[r] *= inv; pA1[r] *= inv; pB0[r] *= inv; pB1[r] *= inv; }
            bf16x8 paA0, paA1, paA2, paA3, paB0, paB1, paB2, paB3;
            pack_p(pA0, pA1, paA0, paA1, paA2, paA3); pack_p(pB0, pB1, paB0, paB1, paB2, paB3);
            LDSP float* psw = (LDSP float*)(lds + OFF_PS + L.wid * (8 * 129 * 4));
#pragma unroll
            for (int r = 0; r < 16; ++r) {
                float a = pA0[r], b2 = pA1[r], c2 = pB0[r], d2 = pB1[r];
                a += __shfl_xor(a, 8); b2 += __shfl_xor(b2, 8); c2 += __shfl_xor(c2, 8); d2 += __shfl_xor(d2, 8);
                a += __shfl_xor(a, 16); b2 += __shfl_xor(b2, 16); c2 += __shfl_xor(c2, 16); d2 += __shfl_xor(d2, 16);
                if (hl == 0) { const int n0 = crow(r, L.hi); LDSP float* pp = psw + qi * 129 + n0; pp[0] = a; pp[32] = b2; pp[64] = c2; pp[96] = d2; }
                if ((r & 3) == 3) asm volatile("" ::: "memory");
            }
            asm volatile("s_waitcnt lgkmcnt(0)" ::: "memory");
            {
                LDSP float* scw = (LDSP float*)(lds + OFF_SC + L.wid * 1024);
                int sq = L.lane & 7, jb = L.lane >> 3; asm volatile("" : "+v"(sq), "+v"(jb));
                const int tq = 64 * qb + 8 * L.wid + sq;
                const LDSP float* pq = psw + sq * 129;
                float sj[4];
#pragma unroll
                for (int i = 0; i < 4; ++i) { const int j = jb + 8 * i;
                    const float imp = (j ? pq[4 * j - 1] : 0.f) + 2.f * (pq[4 * j] + pq[4 * j + 1] + pq[4 * j + 2]) + pq[4 * j + 3];
                    const bool forced = (j == 0) || (j == qb) || (j == qb - 1), causal = (64 * j <= tq);
                    sj[i] = forced ? 1.0e6f : (causal ? imp : -1.0f); scw[sq * 32 + j] = sj[i]; }
                asm volatile("s_waitcnt lgkmcnt(0)" ::: "memory");
                int rk[4] = {0, 0, 0, 0};
                for (int i2 = 0; i2 < 32; ++i2) { const float si = scw[sq * 32 + i2];
#pragma unroll
                    for (int i = 0; i < 4; ++i) rk[i] += ((si > sj[i]) || (si == sj[i] && i2 < jb + 8 * i)) ? 1 : 0; }
                unsigned bits = 0u;
#pragma unroll
                for (int i = 0; i < 4; ++i) if (rk[i] < 16) bits |= 1u << (jb + 8 * i);
                bits |= (unsigned)__shfl_xor((int)bits, 8); bits |= (unsigned)__shfl_xor((int)bits, 16); bits |= (unsigned)__shfl_xor((int)bits, 32);
                selmask = bits;
                if (L.lane < 8) ((unsigned*)(c.ws + WS_SEL))[((size_t)b * 4 + g) * 2048 + tq] = selmask;
            }
            f32x16 o[4];
#pragma unroll
            for (int d = 0; d < 4; ++d) o[d] = f32x16{};
            ATT_SBAR();
            pv_tile(o, (int)(unsigned)(uintptr_t)(lds + OFF_V) + v_rd_base(L.lane), paA0, paA1, paA2, paA3);
            pv_tile(o, (int)(unsigned)(uintptr_t)(lds + OFF_V + SHM) + v_rd_base(L.lane), paB0, paB1, paB2, paB3);
            scale_rows(o, NSA_GATE(0), xl, L.r32, L.hi);
#pragma unroll
            for (int h2 = 0; h2 < 2; ++h2) { gchar* pq = (gchar*)(accb + avo + h2 * 4096); asm volatile("" : "+v"(pq));
#pragma unroll
                for (int k = 0; k < 16; ++k) { const int q = 2 * h2 + (k >> 3), rl = (k & 7) >> 1, dh = k & 1;
                    *(gunsigned*)(pq + k * 256) = cvtpk(o[2 * dh][q * 4 + rl], o[2 * dh + 1][q * 4 + rl]); } }
        }
#else
        selmask = 0xffffffffu;
#endif
#if !defined(NSA_NO_SEL)
        {
            const unsigned causal_bits = (qb == 31) ? 0xffffffffu : ((1u << (qb + 1)) - 1u);
            unsigned wmask = selmask & causal_bits;
#pragma unroll
            for (int o_ = 1; o_ < 64; o_ <<= 1) wmask |= (unsigned)__shfl_xor((int)wmask, o_);
            if (c.tid == 0) misc[0] = 0u;
            __syncthreads();
            if (L.lane == 0) atomicOr((unsigned*)(misc + 0), wmask);
            __syncthreads();
            unsigned rem = (unsigned)__builtin_amdgcn_readfirstlane((int)misc[0]);
            wmask = (unsigned)__builtin_amdgcn_readfirstlane((int)wmask);
            const float sl2 = slope * LOG2E;
            const bf16_t* Kb = proj + (size_t)b * S_ * PW0 + 2048 + 1024 + g * 128; const bf16_t* Vb = Kb + 512;
            Pass P; pass_init(P);
            const int ntl = __builtin_popcount(rem);
            if (c.tid == 0) { unsigned rr_ = rem; int k_ = 0; while (rr_) { const int jj_ = 31 - __builtin_clz(rr_); rr_ &= ~(1u << jj_); misc[8 + k_] = (unsigned)jj_; ++k_; } }
            __syncthreads();
            struct SelPol { int n; LDSP const unsigned* list; const DmaMap& dm; const bf16_t* Kb; const bf16_t* Vb; LDSP char* lds; int wid; unsigned wmask, selmask; int t; float sl2;
                __device__ __forceinline__ int tile(int i) const { return (int)__builtin_amdgcn_readfirstlane((int)list[(DUP_PH == 311) ? (i >= (n >> 1) ? i - (n >> 1) : i) : i]); }
                __device__ __forceinline__ void dma(int j, int buf, int which) const { DmaMap d2 = dm; asm volatile("" : "+v"(d2.m0), "+v"(d2.m1));   stage_dma(d2, Kb, Vb, PW0, 64 * j, S_ - 1, lds, buf, wid, which); }
                __device__ __forceinline__ void prep(int j, bool& act, bool& need_mask, int& dq0, unsigned& W, float& base) const {
                    act = (wmask >> j) & 1u; const bool mine = (selmask >> j) & 1u;
                    dq0 = mine ? t - 64 * j : -1; need_mask = !__all(mine && (t - 64 * j >= 63)); W = 0x40000000u; base = -sl2 * (float)(t - 64 * j); }
            } pol{(DUP_PH == 311) ? 2 * ntl : ntl, (LDSP const unsigned*)(misc + 8), dm, Kb, Vb, lds, L.wid, wmask, selmask, t, sl2};
            ring_pass(P, pol, lds, L, qr, sl2);
            scale_rows(P.o, NSA_GATE(1) / P.l, xl, L.r32, L.hi);
            {
                gchar* pa_ = (gchar*)(accb + avo); asm volatile("" : "+v"(pa_)); gchar* pb_ = (gchar*)(accb + avo + 4096); asm volatile("" : "+v"(pb_));
                unsigned wa[16], wb[16];
#pragma unroll
                for (int k = 0; k < 16; ++k) { wa[k] = *(const gunsigned*)(pa_ + k * 256); wb[k] = *(const gunsigned*)(pb_ + k * 256); }
#pragma unroll
                for (int k = 0; k < 16; ++k) { const int qq = k >> 3, rl = (k & 7) >> 1, dh = k & 1;
                    *(gunsigned*)(pa_ + k * 256) = cvtpk(__uint_as_float(wa[k] << 16) + P.o[2 * dh][qq * 4 + rl], __uint_as_float(wa[k] & 0xffff0000u) + P.o[2 * dh + 1][qq * 4 + rl]);
                    *(gunsigned*)(pb_ + k * 256) = cvtpk(__uint_as_float(wb[k] << 16) + P.o[2 * dh][(2 + qq) * 4 + rl], __uint_as_float(wb[k] & 0xffff0000u) + P.o[2 * dh + 1][(2 + qq) * 4 + rl]); }
                asm volatile("" ::: "memory"); }
        }
#endif
#if !defined(NSA_NO_WIN)
        for (int repw_ = 0; repw_ < (DUP_PH == 302 ? 2 : 1); ++repw_) {
            __syncthreads();
            const float sl2 = slope * LOG2E;
            const bf16_t* Kb = proj + (size_t)b * S_ * PW0 + 2048 + 2048 + g * 128; const bf16_t* Vb = Kb + 512;
            Pass P; pass_init(P);
            const int jlo = qb - 8 > 0 ? qb - 8 : 0;
            struct WinPol { int n, jhi; const DmaMap& dm; const bf16_t* Kb; const bf16_t* Vb; LDSP char* lds; int wid, t; float sl2;
                __device__ __forceinline__ int tile(int i) const { return (DUP_PH == 312) ? jhi - (i >= (n >> 1) ? i - (n >> 1) : i) : jhi - i; }
                __device__ __forceinline__ void dma(int j, int buf, int which) const { DmaMap d2 = dm; asm volatile("" : "+v"(d2.m0), "+v"(d2.m1));   stage_dma(d2, Kb, Vb, PW0, 64 * j, S_ - 1, lds, buf, wid, which); }
                __device__ __forceinline__ void prep(int j, bool& act, bool& need_mask, int& dq0, unsigned& W, float& base) const {
                    dq0 = t - 64 * j; act = __any((dq0 >= 0) && (dq0 - 63 < 512)); need_mask = !__all(dq0 - 63 >= 0 && dq0 < 512); W = 512u; base = -sl2 * (float)dq0; }
            } pol{(DUP_PH == 312) ? 2 * (qb - jlo + 1) : (qb - jlo + 1), qb, dm, Kb, Vb, lds, L.wid, t, sl2};
            ring_pass(P, pol, lds, L, qr, sl2);
            scale_rows(P.o, NSA_GATE(2) / P.l, xl, L.r32, L.hi);
            char* ob = (char*)O + ((size_t)(b * S_ + 64 * qb + 8 * L.wid) * D_ + (size_t)(4 * g) * 128) * 2;
            const unsigned ovo = (unsigned)(L.hi * 4 * D_ * 2 + L.r32 * 2);
            {
                gchar* pa_ = (gchar*)(accb + avo); asm volatile("" : "+v"(pa_)); gchar* pb_ = (gchar*)(accb + avo + 4096); asm volatile("" : "+v"(pb_));
                unsigned wa[16], wb[16];
#pragma unroll
                for (int k = 0; k < 16; ++k) { wa[k] = *(const gunsigned*)(pa_ + k * 256); wb[k] = *(const gunsigned*)(pb_ + k * 256); }
#pragma unroll
                for (int q = 0; q < 4; ++q) {
#pragma unroll
                    for (int rl = 0; rl < 4; ++rl) { gchar* po = (gchar*)(ob + ovo + (rl * D_ + q * 128) * 2); asm volatile("" : "+v"(po));
#pragma unroll
                        for (int d = 0; d < 4; ++d) { const unsigned w_ = (q >> 1) ? wb[(q & 1) * 8 + rl * 2 + (d >> 1)] : wa[(q & 1) * 8 + rl * 2 + (d >> 1)];
                            const float v = ((d & 1) ? __uint_as_float(w_ & 0xffff0000u) : __uint_as_float(w_ << 16)) + P.o[d][q * 4 + rl];
                            const float vn = __int_as_float(__builtin_amdgcn_update_dpp(0, __float_as_int(v), 0xB1, 0xF, 0xF, false));
                            if ((L.r32 & 1) == 0) *(gunsigned*)(po + d * 64) = cvtpk(v, vn); } } }
                asm volatile("" ::: "memory"); }
        }
#endif
    }
}

struct DilUnit { int gi, r, b, rho, h, blk, rows, jhi, jlo, Lst; };
__device__ __forceinline__ DilUnit dil_decode(int u) {
    DilUnit d;
    if (u < 2048) { d.gi = u >> 10; const int v = u & 1023; d.h = v & 15; d.r = d.gi ? 4 : 1;
        if (d.gi == 0) { d.rho = 0; d.b = v >> 7; d.blk = ((v >> 4) + (d.b >> 1)) & 7; } else { d.rho = (v >> 5) & 3; d.b = v >> 7; d.blk = ((v >> 4) + (d.b >> 1)) & 1; } d.rows = 256; }
    else { d.gi = 2; const int v = u - 2048; d.h = v & 15; d.rho = (v >> 4) & 15; d.b = v >> 8; d.blk = 0; d.r = 16; d.rows = 128; }
    d.Lst = S_ / d.r; d.jhi = (d.blk * 256 + d.rows - 1) >> 6; d.jlo = (d.blk * 256 - 128) > 0 ? (d.blk * 256 - 128) >> 6 : 0;
    return d;
}
__device__ __forceinline__ void dil_attn_mfma_phase(const Ctx& c) {
    using namespace att;
    LDSP char* lds = (LDSP char*)c.lds;
    const bf16_t* proj = (const bf16_t*)(c.ws + WS_PROJ);
    bf16_t* OG = (bf16_t*)(c.ws + WS_OG); float* LSE = (float*)(c.ws + WS_LSE);
    Lane L; L.tid = c.tid; L.lane = c.lane; L.r32 = c.lane & 31; L.hi = c.lane >> 5; L.wid = c.wave; L.at = lds + OFF_AT; L.atmul = 0;
    const DmaMap dm = dma_map(L.wid, L.lane);
    LDSP float* xl = (LDSP float*)(lds + OFF_WS + L.wid * 256);
    const int NU = 2048;
    int uu = c.bid;
    if (uu >= NU) return;
    DilUnit U = dil_decode(uu);
    u32x4 qraw[8];
#define DIL_ADDR(sec_, b_, h_, pos_) ((((size_t)(sec_) * 8 + (b_)) * 16 + (h_)) * 2048 + (pos_)) * 128
#define DIL_KB(U_) (proj + DIL_ADDR(1 + 2 * (U_).gi, (U_).b, (U_).h, (U_).rho * (U_).Lst))
#define DIL_SEC ((size_t)8 * 16 * 2048 * 128)
#define DIL_ISSUE(U_) do { const bf16_t* kb_ = DIL_KB(U_); \
        stage_dma(dm, kb_, kb_ + DIL_SEC, 128, 64 * (U_).jhi, (U_).Lst - 1, lds, 0, L.wid); \
        if ((U_).jhi > (U_).jlo) stage_dma(dm, kb_, kb_ + DIL_SEC, 128, 64 * ((U_).jhi - 1), (U_).Lst - 1, lds, 1, L.wid, 1); \
        const int uq_ = (U_).blk * 256 + L.wid * 32 + L.r32; const int tq_ = ((L.wid * 32 < (U_).rows) ? uq_ : 0) * (U_).r + (U_).rho; \
        const bf16_t* prow_ = proj + DIL_ADDR(0, (U_).b, (U_).h, tq_); int hiq_ = L.hi; asm volatile("" : "+v"(hiq_));   \
        _Pragma("unroll") for (int d0 = 0; d0 < 8; ++d0) qraw[d0] = *(const u32x4*)(prow_ + d0 * 16 + hiq_ * 8); } while (0)
    __syncthreads();
    DIL_ISSUE(U);
    while (true) {
        const int gi = U.gi, r = U.r, b = U.b, rho = U.rho, h = U.h, blk = U.blk, rows = U.rows;
        const int uq = blk * 256 + L.wid * 32 + L.r32;
        const bool wave_on = L.wid * 32 < rows;
        const int tq = (wave_on ? uq : 0) * r + rho;
        const float slope = exp2f(-0.5f * (float)(h + 1));
        const float sl2 = slope * (float)r * LOG2E;
        { int tw = c.tid; asm volatile("" : "+v"(tw)); if (tw < 32) alibi_table_write(lds, 0, tw, sl2); }
        const bf16_t* Kb = DIL_KB(U); const bf16_t* Vb = Kb + DIL_SEC;
        const size_t kstride = 128;
        bf16x8 qr[8];
#pragma unroll
        for (int d0 = 0; d0 < 8; ++d0) qr[d0] = scale8(qraw[d0], C2);
        Pass P; pass_init(P);
        const int jhi = U.jhi, jlo = U.jlo;
        struct DilPol { int n, jhi; const DmaMap& dm; const bf16_t* Kb; const bf16_t* Vb; size_t kstride; int rmax; LDSP char* lds; int wid, uq; bool wave_on; float sl2;
            __device__ __forceinline__ int tile(int i) const { return jhi - i; }
            __device__ __forceinline__ void dma(int j, int buf, int which) const { stage_dma(dm, Kb, Vb, kstride, 64 * j, rmax, lds, buf, wid, which); }
            __device__ __forceinline__ void prep(int j, bool& act, bool& need_mask, int& dq0, unsigned& W, float& base) const {
                dq0 = uq - 64 * j; act = wave_on && __any((dq0 >= 0) && (dq0 - 63 < 129)); need_mask = !__all(dq0 - 63 >= 0 && dq0 < 129); W = 129u; base = -sl2 * (float)dq0; }
        } pol{jhi - jlo + 1, jhi, dm, Kb, Vb, kstride, U.Lst - 1, lds, L.wid, uq, wave_on, sl2};
        ring_pass<DilPol, (DIL_STAGGER != 0)>(P, pol, lds, L, qr, sl2, true);
        const int un = uu + c.G; const bool more = un < NU;
        __syncthreads();
        if (more) { U = dil_decode(un); DIL_ISSUE(U); }
        if (wave_on) {
            scale_rows(P.o, 1.f / P.l, xl, L.r32, L.hi);
            if (L.hi == 0) LSE[((size_t)gi * T_ + (size_t)b * S_ + tq) * 16 + h] = P.m + __log2f(P.l);
            int r32e = L.r32; asm volatile("" : "+v"(r32e));
#pragma unroll
            for (int rr = 0; rr < 16; ++rr) { const int rw = crow(rr, L.hi); const int tt = (blk * 256 + L.wid * 32 + rw) * r + rho;
                bf16_t* op = OG + ((size_t)gi * T_ + (size_t)b * S_ + tt) * D_ + h * 128 + r32e;
#pragma unroll
                for (int d = 0; d < 4; ++d) { const float v = P.o[d][rr]; const float vn = __int_as_float(__builtin_amdgcn_update_dpp(0, __float_as_int(v), 0xB1, 0xF, 0xF, false));
                    if ((L.r32 & 1) == 0) *(unsigned*)(op + d * 32) = cvtpk(v, vn); } }
        }
        if (!more) break;
        uu = un;
    }
    {
        int widp = L.wid; asm volatile("" : "+v"(widp));
        asm volatile("" : "+v"(L.r32), "+v"(L.hi), "+v"(L.lane));
        LDSP float* xl2 = (LDSP float*)(lds + 8 * SHM + widp * 256);
        const int half = L.wid >> 2, wl = L.wid & 3;
        L.at = lds + OFF_AT + half * 128;
        for (int v = c.bid; v < 1024; v += c.G) {
            const int hp = v & 7, rho = (v >> 3) & 15, b = v >> 7, h = hp + 8 * half;
            __syncthreads();
            { int tw = c.tid; asm volatile("" : "+v"(tw)); if (tw < 64) alibi_table_write(lds, tw >> 5, tw & 31, exp2f(-0.5f * (float)(hp + 8 * (tw >> 5) + 1)) * 16.f * LOG2E); }
#pragma unroll
            for (int hh = 0; hh < 2; ++hh) {
                const bf16_t* kb_ = proj + DIL_ADDR(5, b, hp + 8 * hh, rho * 128);
                stage_dma_at(dm, kb_, kb_ + DIL_SEC, 128, 64, 127, lds + 4 * SHM + (2 * hh + 1) * SHM, lds + (2 * hh + 1) * SHM, L.wid);
                stage_dma_at(dm, kb_, kb_ + DIL_SEC, 128, 0, 127, lds + 4 * SHM + (2 * hh) * SHM, lds + (2 * hh) * SHM, L.wid);
            }
            const int uq = wl * 32 + L.r32, tq = uq * 16 + rho;
            bf16x8 qr[8];
            { u32x4 qraw_[8]; const bf16_t* prow_ = proj + DIL_ADDR(0, b, h, tq);
#pragma unroll
              for (int d0 = 0; d0 < 8; ++d0) qraw_[d0] = *(const u32x4*)(prow_ + d0 * 16 + L.hi * 8);
#pragma unroll
              for (int d0 = 0; d0 < 8; ++d0) qr[d0] = scale8(qraw_[d0], C2); }
            const float sl2 = exp2f(-0.5f * (float)(h + 1)) * 16.f * LOG2E;
            Pass P; pass_init(P);
            ATT_DMA_SYNC();
#pragma unroll
            for (int jj = 1; jj >= 0; --jj) {
                const int dq0 = uq - 64 * jj;
                if (__any(dq0 >= 0)) {
                    PFrag F;
                    tile_qk_at(P, F, lds + 4 * SHM + (2 * half + jj) * SHM, xl2, L, qr, sl2, !__all(dq0 - 63 >= 0), dq0, 129u, -sl2 * (float)dq0);
                    tile_pv_at(P, F, lds + (2 * half + jj) * SHM, L);
                }
            }
            scale_rows(P.o, 1.f / P.l, xl2, L.r32, L.hi);
            if (L.hi == 0) LSE[((size_t)2 * T_ + (size_t)b * S_ + tq) * 16 + h] = P.m + __log2f(P.l);
#pragma unroll
            for (int rr = 0; rr < 16; ++rr) { const int rw = crow(rr, L.hi); const int tt = (wl * 32 + rw) * 16 + rho;
                bf16_t* op = OG + ((size_t)2 * T_ + (size_t)b * S_ + tt) * D_ + h * 128 + L.r32;
#pragma unroll
                for (int d = 0; d < 4; ++d) { const float v_ = P.o[d][rr]; const float vn = __int_as_float(__builtin_amdgcn_update_dpp(0, __float_as_int(v_), 0xB1, 0xF, 0xF, false));
                    if ((L.r32 & 1) == 0) *(unsigned*)(op + d * 32) = cvtpk(v_, vn); } }
        }
    }
#undef DIL_ISSUE
#undef DIL_KB
#undef DIL_ADDR
#undef DIL_SEC
}
__device__ __forceinline__ void dil_merge_phase(const Ctx& c) {
    const bf16_t* OG = (const bf16_t*)(c.ws + WS_OG); const float* LSE = (const float*)(c.ws + WS_LSE); bf16_t* O = (bf16_t*)(c.ws + WS_O);
    const int nw = c.G * NWAVE, lane = c.lane, h = lane >> 2;
    for (int row0 = c.bid * NWAVE + c.wave; row0 < T_; row0 += 2 * nw) {
        const int row1 = row0 + nw < T_ ? row0 + nw : row0;
        u32x4 a[2][4], bq[2][4], cq[2][4]; float l0[2], l1[2], l2[2];
#pragma unroll
        for (int rr = 0; rr < 2; ++rr) { const int row = rr ? row1 : row0;
            l0[rr] = LSE[((size_t)0 * T_ + row) * 16 + h]; l1[rr] = LSE[((size_t)1 * T_ + row) * 16 + h]; l2[rr] = LSE[((size_t)2 * T_ + row) * 16 + h];
#pragma unroll
            for (int q = 0; q < 4; ++q) { const size_t off = (size_t)row * D_ + lane * 32 + q * 8;
                a[rr][q] = *(const u32x4*)(OG + off); bq[rr][q] = *(const u32x4*)(OG + (size_t)T_ * D_ + off); cq[rr][q] = *(const u32x4*)(OG + (size_t)2 * T_ * D_ + off); } }
#pragma unroll
        for (int rr = 0; rr < 2; ++rr) { const int row = rr ? row1 : row0;
            const float mx = fmaxf(l0[rr], fmaxf(l1[rr], l2[rr]));
            float w0 = exp2f(l0[rr] - mx), w1 = exp2f(l1[rr] - mx), w2 = exp2f(l2[rr] - mx); const float inv = 1.f / (w0 + w1 + w2); w0 *= inv; w1 *= inv; w2 *= inv;
#pragma unroll
            for (int q = 0; q < 4; ++q) { const size_t off = (size_t)row * D_ + lane * 32 + q * 8;
                u32x4 o;
#define MRG(f) o.f = att::cvtpk(w0 * __uint_as_float(a[rr][q].f << 16) + w1 * __uint_as_float(bq[rr][q].f << 16) + w2 * __uint_as_float(cq[rr][q].f << 16), \
                                w0 * __uint_as_float(a[rr][q].f & 0xffff0000u) + w1 * __uint_as_float(bq[rr][q].f & 0xffff0000u) + w2 * __uint_as_float(cq[rr][q].f & 0xffff0000u))
                MRG(x); MRG(y); MRG(z); MRG(w);
#undef MRG
                *(u32x4*)(O + off) = o; } }
    }
}

constexpr int N_PHASES = 20;

__global__ void __launch_bounds__(NTHR, 2) fwd(Args args) {
    extern __shared__ __attribute__((aligned(16))) unsigned char lds_raw[];
    const Ctx c0{args, args.ws, (LDSP unsigned char*)lds_raw, 0, 0, __builtin_amdgcn_readfirstlane((int)threadIdx.x >> 6), (int)gridDim.x, (int)blockIdx.x};
    const int tid0 = (int)threadIdx.x;
    const int lo = args.ph_lo, hi = args.ph_hi;
    LDSP unsigned* xbw = (LDSP unsigned*)(c0.lds + LDS_BYTES - 16);
    XcdBarrier bar; bar.bar = (unsigned*)(c0.ws + WS_BAR); bar.x = 0; bar.st = nullptr;
    if (hi - lo > 1) {
        if (tid0 == 0) { xbw[0] = 0u; xbw[1] = 0u; xbw[2] = 0u; xbw[3] = 0u; }
        __syncthreads();
        bar = xcd_barrier_post((unsigned*)(c0.ws + WS_BAR), (volatile LAS unsigned*)xbw);
    }
#define IN(k) (lo <= (k) && (k) < hi)
#define SEAM(k) do { if (IN(k) && IN((k) + 1)) xcd_barrier(bar); else __syncthreads(); } while (0)
    const int vcu = (c0.G % 8 == 0) ? (c0.bid % 8) * (c0.G / 8) + c0.bid / 8 : c0.bid;
    float* MOD = (float*)(c0.ws + WS_MOD);
    bf16_t* X = (bf16_t*)(c0.ws + WS_X); bf16_t* Hb = (bf16_t*)(c0.ws + WS_H); bf16_t* Ob = (bf16_t*)(c0.ws + WS_O); bf16_t* PROJ = (bf16_t*)(c0.ws + WS_PROJ);
    bf16_t* HID = (bf16_t*)(c0.ws + WS_HID); bf16_t* YO = (bf16_t*)(c0.ws + WS_YO);
    bf16_t* WE1 = (bf16_t*)(c0.ws + WS_WE1); bf16_t* WE2 = (bf16_t*)(c0.ws + WS_WE2);

    enum { PH_PRO = 0, PH_NORM0, PH_PROJ0, PH_CMP, PH_ATT0, PH_OUT0, PH_RT0, PH_DSP0, PH_E1_0, PH_E2_0, PH_CN1, PH_PROJ1, PH_ATT1, PH_MRG1, PH_OUT1, PH_RT1, PH_DSP1, PH_E1_1, PH_E2_1, PH_FIN, PH_COUNT };
    static_assert(PH_COUNT == N_PHASES, "phase count");
    if (IN(PH_PRO)) for (int rep_ = 0; rep_ < ((DUP_PH == 200 + PH_PRO) ? 2 : 1); ++rep_) { const Ctx c = fresh(c0); if (rep_) __syncthreads();
#if DUP_PH == 100
        for (int rep_ = 0; rep_ < 2; ++rep_) {
#endif
        mod_units(c); __syncthreads();
        tr_matrix(c, c.A.in[7], D_, 5168, PW0, (bf16_t*)(c.ws + WS_WNSAIN));
        tr_matrix(c, c.A.in[11], D_, D_, D_, (bf16_t*)(c.ws + WS_WNSAOUT));
        tr_matrix(c, c.A.in[12], D_, PW1, PW1, (bf16_t*)(c.ws + WS_WDILIN));
        tr_matrix(c, c.A.in[13], D_, D_, D_, (bf16_t*)(c.ws + WS_WDILOUT));
        tr_matrix(c, c.A.in[8], 4096, 128, 128, (bf16_t*)(c.ws + WS_W1T));
        tr_matrix(c, c.A.in[8] + (size_t)4096 * 128, 4096, 128, 128, (bf16_t*)(c.ws + WS_W1T) + (size_t)128 * 4096);
        tr_experts(c, 0, TRX_T0, TRX_ALL, c.bid * NWAVE + c.wave, c.G * NWAVE);
#if DUP_PH == 100
        __syncthreads(); }
#endif
        SEAM(PH_PRO);
    }
    if (IN(PH_NORM0)) for (int rep_ = 0; rep_ < ((DUP_PH == 200 + PH_NORM0) ? 2 : 1); ++rep_) { const Ctx c = fresh(c0); if (rep_) __syncthreads(); norm_phase<0>(c, c.A.in[0], nullptr, c.A.in[4], MOD + 0 * 2048, MOD + 1 * 2048, nullptr, Hb); SEAM(PH_NORM0); }
    if (IN(PH_PROJ0)) for (int rep_ = 0; rep_ < ((DUP_PH == 200 + PH_PROJ0) ? 2 : 1); ++rep_) { const Ctx c = fresh(c0); if (rep_) __syncthreads();
        pg8::Gemm g{Hb, (const bf16_t*)(c.ws + WS_WNSAIN), T_, PW0, D_}; pg8::StaticOrder S; S.init(T_, PW0, c.G, c.bid);
        pg8::EpiBf16<0> E{PROJ, PW0, nullptr, 0, 0};
        pg8::gemm_phase<pg8::EpiBf16<0>, pg8::StaticOrder, false>((PG8_LAS unsigned char*)c.lds, g, S, E, nullptr);
        { const int nwg = (T_ / 256) * (PW0 / 256), rounds = (nwg + c.G - 1) / c.G; int first_idle = nwg - (rounds - 1) * c.G; if (first_idle >= c.G) first_idle = 0;
          if (c.bid >= first_idle) tr_experts(c, 0, 0, TRX_T0, (c.bid - first_idle) * NWAVE + c.wave, (c.G - first_idle) * NWAVE); }
        SEAM(PH_PROJ0);
    }
    if (IN(PH_CMP)) for (int rep_ = 0; rep_ < ((DUP_PH == 200 + PH_CMP) ? 2 : 1); ++rep_) { const Ctx c = fresh(c0); if (rep_) __syncthreads();
#if CMP_REF
        compress_phase(c);
#else
        compress_mfma_phase(c);
#endif
        SEAM(PH_CMP); }
    if (IN(PH_ATT0)) for (int rep_ = 0; rep_ < ((DUP_PH == 200 + PH_ATT0) ? 2 : 1); ++rep_) { const Ctx c = fresh(c0); if (rep_) __syncthreads();
#if NSA_REF
        nsa_attn_ref_phase(c);
#else
        nsa_attn_mfma_phase(c);
#endif
        SEAM(PH_ATT0);
    }
    if (IN(PH_OUT0)) for (int rep_ = 0; rep_ < ((DUP_PH == 200 + PH_OUT0) ? 2 : 1); ++rep_) { const Ctx c = fresh(c0); if (rep_) __syncthreads();
        pg8::Gemm g{Ob, (const bf16_t*)(c.ws + WS_WNSAOUT), T_, D_, D_}; pg8::StaticOrder S; S.init(T_, D_, c.G, c.bid);
        EpiResid<true> E{c.A.in[0], X, MOD + 2 * 2048};
        pg8::gemm_phase<EpiResid<true>, pg8::StaticOrder, false>((PG8_LAS unsigned char*)c.lds, g, S, E, nullptr);
        SEAM(PH_OUT0);
    }
    if (IN(PH_RT0)) for (int rep_ = 0; rep_ < ((DUP_PH == 200 + PH_RT0) ? 2 : 1); ++rep_) { const Ctx c = fresh(c0); if (rep_) __syncthreads(); norm_phase<1>(c, X, nullptr, c.A.in[5], MOD + 3 * 2048, MOD + 4 * 2048, nullptr, Hb); SEAM(PH_RT0); }
    if (IN(PH_DSP0)) for (int rep_ = 0; rep_ < ((DUP_PH == 200 + PH_DSP0) ? 2 : 1); ++rep_) { const Ctx c = fresh(c0); if (rep_) __syncthreads(); dispatch_phase(c); SEAM(PH_DSP0); }
    if (IN(PH_E1_0)) for (int rep_ = 0; rep_ < ((DUP_PH == 200 + PH_E1_0) ? 2 : 1); ++rep_) { const Ctx c = fresh(c0); if (rep_) __syncthreads();
        moe_tab_to_lds(c);
        pg8::Gemm g{Hb, WE1, CAP, 16 * 2816, D_}; MoeOrder S{(LDSP const int*)(c.lds + LDS_MISC), c.G, vcu, 11};
        EpiSwiglu E{HID};
        pg8::gemm_phase_g<EpiSwiglu, MoeOrder, false>((const int*)(c.ws + WS_SLOTTOK), (PG8_LAS unsigned char*)c.lds, g, S, E, nullptr);
        SEAM(PH_E1_0);
    }
    if (IN(PH_E2_0)) for (int rep_ = 0; rep_ < ((DUP_PH == 200 + PH_E2_0) ? 2 : 1); ++rep_) { const Ctx c = fresh(c0); if (rep_) __syncthreads();
        moe_tab_to_lds(c);
        pg8::Gemm g{HID, WE2, CAP, 16 * 2048, DE}; MoeOrder S{(LDSP const int*)(c.lds + LDS_MISC), c.G, vcu, 8};
        EpiDown E{YO, (const float*)(c.ws + WS_SLOTW)};
        pg8::gemm_phase<EpiDown, MoeOrder, false>((PG8_LAS unsigned char*)c.lds, g, S, E, nullptr);
        { const int total = ld_i((const int*)(c.ws + WS_TAB) + 16) * 8, rounds = (total + c.G - 1) / c.G; int first_idle = total - (rounds - 1) * c.G; if (first_idle >= c.G || first_idle < 0) first_idle = 0;
          if (vcu >= first_idle) tr_experts(c, 1, 0, TRX_T1, (vcu - first_idle) * NWAVE + c.wave, (c.G - first_idle) * NWAVE); }
        SEAM(PH_E2_0);
    }
    if (IN(PH_CN1)) for (int rep_ = 0; rep_ < ((DUP_PH == 200 + PH_CN1) ? 2 : 1); ++rep_) { const Ctx c = fresh(c0); if (rep_) __syncthreads();
        norm_phase<2>(c, X, X, c.A.in[4] + 2048, MOD + (size_t)8 * MODW + 0 * 2048, MOD + (size_t)8 * MODW + 1 * 2048, MOD + 5 * 2048, Hb);
        __syncthreads();
        tr_experts(c, 1, TRX_T1, TRX_ALL, c.bid * NWAVE + c.wave, c.G * NWAVE);
        SEAM(PH_CN1);
    }
    if (IN(PH_PROJ1)) for (int rep_ = 0; rep_ < ((DUP_PH == 200 + PH_PROJ1) ? 2 : 1); ++rep_) { const Ctx c = fresh(c0); if (rep_) __syncthreads();
        pg8::Gemm g{Hb, (const bf16_t*)(c.ws + WS_WDILIN), T_, PW1, D_}; pg8::StaticOrder S; S.init(T_, PW1, c.G, c.bid);
        EpiDilProj E{PROJ};
        pg8::gemm_phase<EpiDilProj, pg8::StaticOrder, false>((PG8_LAS unsigned char*)c.lds, g, S, E, nullptr);
        SEAM(PH_PROJ1);
    }
    if (IN(PH_ATT1)) for (int rep_ = 0; rep_ < ((DUP_PH == 200 + PH_ATT1) ? 2 : 1); ++rep_) { const Ctx c = fresh(c0); if (rep_) __syncthreads();
#if DIL_REF
        dil_attn_ref_phase(c);
#else
        dil_attn_mfma_phase(c);
#endif
        SEAM(PH_ATT1);
    }
    if (IN(PH_MRG1)) for (int rep_ = 0; rep_ < ((DUP_PH == 200 + PH_MRG1) ? 2 : 1); ++rep_) { const Ctx c = fresh(c0); if (rep_) __syncthreads();
#if !DIL_REF
        dil_merge_phase(c);
#endif
        SEAM(PH_MRG1);
    }
    if (IN(PH_OUT1)) for (int rep_ = 0; rep_ < ((DUP_PH == 200 + PH_OUT1) ? 2 : 1); ++rep_) { const Ctx c = fresh(c0); if (rep_) __syncthreads();
        pg8::Gemm g{Ob, (const bf16_t*)(c.ws + WS_WDILOUT), T_, D_, D_}; pg8::StaticOrder S; S.init(T_, D_, c.G, c.bid);
        EpiResid<false> E{X, X, MOD + (size_t)8 * MODW + 2 * 2048};
        pg8::gemm_phase<EpiResid<false>, pg8::StaticOrder, false>((PG8_LAS unsigned char*)c.lds, g, S, E, nullptr);
        SEAM(PH_OUT1);
    }
    if (IN(PH_RT1)) for (int rep_ = 0; rep_ < ((DUP_PH == 200 + PH_RT1) ? 2 : 1); ++rep_) { const Ctx c = fresh(c0); if (rep_) __syncthreads(); norm_phase<1>(c, X, nullptr, c.A.in[5] + 2048, MOD + (size_t)8 * MODW + 3 * 2048, MOD + (size_t)8 * MODW + 4 * 2048, nullptr, Hb); SEAM(PH_RT1); }
    if (IN(PH_DSP1)) for (int rep_ = 0; rep_ < ((DUP_PH == 200 + PH_DSP1) ? 2 : 1); ++rep_) { const Ctx c = fresh(c0); if (rep_) __syncthreads(); dispatch_phase(c); SEAM(PH_DSP1); }
    if (IN(PH_E1_1)) for (int rep_ = 0; rep_ < ((DUP_PH == 200 + PH_E1_1) ? 2 : 1); ++rep_) { const Ctx c = fresh(c0); if (rep_) __syncthreads();
        moe_tab_to_lds(c);
        pg8::Gemm g{Hb, WE1, CAP, 16 * 2816, D_}; MoeOrder S{(LDSP const int*)(c.lds + LDS_MISC), c.G, vcu, 11};
        EpiSwiglu E{HID};
        pg8::gemm_phase_g<EpiSwiglu, MoeOrder, false>((const int*)(c.ws + WS_SLOTTOK), (PG8_LAS unsigned char*)c.lds, g, S, E, nullptr);
        SEAM(PH_E1_1);
    }
    if (IN(PH_E2_1)) for (int rep_ = 0; rep_ < ((DUP_PH == 200 + PH_E2_1) ? 2 : 1); ++rep_) { const Ctx c = fresh(c0); if (rep_) __syncthreads();
        moe_tab_to_lds(c);
        pg8::Gemm g{HID, WE2, CAP, 16 * 2048, DE}; MoeOrder S{(LDSP const int*)(c.lds + LDS_MISC), c.G, vcu, 8};
        EpiDown E{YO, (const float*)(c.ws + WS_SLOTW)};
        pg8::gemm_phase<EpiDown, MoeOrder, false>((PG8_LAS unsigned char*)c.lds, g, S, E, nullptr);
        SEAM(PH_E2_1);
    }
#if DUP_PH == 250
    if (hi - lo > 1) { for (int k_ = 0; k_ < 10; ++k_) xcd_barrier(bar); }
#endif
    if (IN(PH_FIN)) for (int rep_ = 0; rep_ < ((DUP_PH == 200 + PH_FIN) ? 2 : 1); ++rep_) { const Ctx c = fresh(c0); if (rep_) __syncthreads(); norm_phase<3>(c, X, nullptr, c.A.in[6], nullptr, nullptr, MOD + (size_t)8 * MODW + 5 * 2048, nullptr); }
#undef IN
#undef SEAM
}

extern "C" void kernel_launch(void* const* d_in, const int* in_sizes, int n_in, void* d_out, int out_size, void* d_ws, size_t ws_size, hipStream_t stream) {
    static int grid = 0;
    if (grid == 0) {
        if (n_in != 19 || out_size != T_ * D_ || ws_size < WS_END) { fprintf(stderr, "kernel_launch: unexpected shapes (n_in %d out %d ws %zu need %zu)\n", n_in, out_size, ws_size, (size_t)WS_END); grid = -1; return; }
        int dev = 0, cus = 0;
        if (hipGetDevice(&dev) != hipSuccess || hipDeviceGetAttribute(&cus, hipDeviceAttributeMultiprocessorCount, dev) != hipSuccess) { grid = -1; return; }
        if (hipFuncSetAttribute((const void*)fwd, hipFuncAttributeMaxDynamicSharedMemorySize, LDS_BYTES) != hipSuccess) { fprintf(stderr, "kernel_launch: hipFuncSetAttribute failed\n"); grid = -1; return; }
        int per_cu = 0;
        if (hipOccupancyMaxActiveBlocksPerMultiprocessor(&per_cu, (const void*)fwd, NTHR, LDS_BYTES) != hipSuccess || per_cu < 1) fprintf(stderr, "kernel_launch: occupancy query says %d\n", per_cu);
        (void)hipGetLastError();
        grid = cus > 256 ? 256 : cus;
    }
    if (grid < 0) return;
    (void)hipMemsetAsync((char*)d_ws + WS_BAR, 0, WS_CTL_END, stream);
    Args a{};
    for (int i = 0; i < 19; ++i) a.in[i] = (const float*)d_in[i];
    a.out = (float*)d_out; a.ws = (unsigned char*)d_ws;
#if MK_ONE_LAUNCH
    a.ph_lo = 0; a.ph_hi = N_PHASES;
    hipLaunchKernelGGL(fwd, dim3(grid), dim3(NTHR), LDS_BYTES, stream, a);
#else
    for (int p = 0; p < N_PHASES; ++p) { a.ph_lo = p; a.ph_hi = p + 1; hipLaunchKernelGGL(fwd, dim3(grid), dim3(NTHR), LDS_BYTES, stream, a); }
#endif
}
```

```cpp
#define MK_ONE_LAUNCH 1
#define NSA_REF 0
#define DIL_REF 0
#define DUP_PH 0
#define CMP_REF 0
#define DIL_STAGGER 1
#define DIL_STREAM 1
#include <hip/hip_runtime.h>
#include <cstdio>
#include <cstdint>
#define XB_TMO      128
#define XB_XCNT(j)  (256  + 64 * (j))
#define XB_XSUB(j)  (1280 + 64 * (j))
#define XB_XGEN(j)  (2304 + 64 * (j))
#define XB_TOP      3328
#define XB_TOPGEN   3392
#define XCD_BAR_WORDS 3456
#define XB_SPIN_CAP (1u << 18)
#define LAS __attribute__((address_space(3)))

__device__ __forceinline__ unsigned xb_ld(unsigned* p)              { return __hip_atomic_load(p, __ATOMIC_RELAXED, __HIP_MEMORY_SCOPE_AGENT); }
__device__ __forceinline__ unsigned xb_add(unsigned* p, unsigned v) { return __hip_atomic_fetch_add(p, v, __ATOMIC_RELAXED, __HIP_MEMORY_SCOPE_AGENT); }
__device__ __forceinline__ unsigned xb_xcc_id() { return (unsigned)__builtin_amdgcn_s_getreg((3 << 11) | 20) & 0xFu; }
#define XB_SPIN(cond, bar) do { unsigned _sp = 0; while (cond) { __builtin_amdgcn_s_sleep(1); \
    if ((++_sp & 255u) == 0u) { if (xb_ld(&(bar)[XB_TMO])) break; if (_sp > XB_SPIN_CAP) { atomicAdd(&(bar)[XB_TMO], 1u); break; } } } } while (0)

struct XcdBarrier {
    unsigned* bar; unsigned x;
    volatile LAS unsigned* st;
};

__device__ __forceinline__ XcdBarrier xcd_barrier_post(unsigned* bar, volatile LAS unsigned* st) {
    XcdBarrier b; b.bar = bar; b.x = xb_xcc_id(); b.st = st;
    if (threadIdx.x == 0) (void)xb_add(&bar[XB_XCNT(b.x)], 1u);
    return b;
}
__device__ __forceinline__ void xcd_barrier_complete(unsigned* bar, unsigned x, unsigned& nloc, unsigned& nx) {
    const unsigned G = gridDim.x * gridDim.y * gridDim.z;
    unsigned sum, cnt, mine, sp = 0u;
    for (;;) {
        sum = 0u; cnt = 0u; mine = 0u;
#pragma unroll
        for (unsigned j = 0; j < 16; ++j) { const unsigned c = xb_ld(&bar[XB_XCNT(j)]); sum += c; cnt += (c > 0u) ? 1u : 0u; mine = (j == x) ? c : mine; }
        if (sum == G) break;
        __builtin_amdgcn_s_sleep(1);
        if ((++sp & 255u) == 0u) { if (xb_ld(&bar[XB_TMO])) break; if (sp > XB_SPIN_CAP) { atomicAdd(&bar[XB_TMO], 1u); break; } }
    }
    nloc = mine > 0u ? mine : 1u; nx = cnt > 0u ? cnt : 1u;
}

__device__ __forceinline__ void xcd_barrier(const XcdBarrier& b) {
    asm volatile("s_waitcnt vmcnt(0)" ::: "memory");
    __syncthreads();
    if (threadIdx.x == 0) {
        unsigned* bar = b.bar;
        __builtin_amdgcn_s_waitcnt(0);
        unsigned nloc = b.st[0], nx = b.st[1];
        if (nloc == 0u) { xcd_barrier_complete(bar, b.x, nloc, nx); b.st[0] = nloc; b.st[1] = nx; }
        const unsigned old = xb_add(&bar[XB_XSUB(b.x)], 1u);
        const unsigned gen = old / nloc;
        if (old + 1u == (gen + 1u) * nloc) {
            __builtin_amdgcn_fence(__ATOMIC_RELEASE, "agent");
            asm volatile("s_waitcnt vmcnt(0)" ::: "memory");
            const unsigned og = xb_add(&bar[XB_TOP], 1u);
            const unsigned tg = og / nx;
            if (og + 1u == (tg + 1u) * nx) xb_add(&bar[XB_TOPGEN], 1u);
            else XB_SPIN(xb_ld(&bar[XB_TOPGEN]) == tg, bar);
            __builtin_amdgcn_fence(__ATOMIC_ACQUIRE, "agent");
            xb_add(&bar[XB_XGEN(b.x)], 1u);
            asm volatile("s_waitcnt vmcnt(0)" ::: "memory");
        } else {
            XB_SPIN(xb_ld(&bar[XB_XGEN(b.x)]) == gen, bar);
            __builtin_amdgcn_fence(__ATOMIC_ACQUIRE, "agent");
            asm volatile("s_waitcnt vmcnt(0)" ::: "memory");
        }
    }
    __syncthreads();
}
namespace pg8 {
#define PG8_LAS __attribute__((address_space(3)))
typedef unsigned short bf16_t;
typedef short bf16x8 __attribute__((ext_vector_type(8)));
typedef float f32x4 __attribute__((ext_vector_type(4)));
typedef unsigned u32x4 __attribute__((ext_vector_type(4)));
constexpr int BM = 256, BK = 64, HALF = 128, HTB = HALF * BK * 2  , STAGE_BYTES = 8 * HTB, NXCD = 8, WGM = 8;

__host__ __device__ __forceinline__ int lds_byte(int r, int c) { const int st = (r >> 4) * 2 + (c >> 5), rr = r & 15, cc = c & 31, ob = rr * 64 + cc * 2; return st * 1024 + (ob ^ (((ob >> 9) & 1) << 5)); }
__host__ __device__ __forceinline__ void stage_rc(int b, int& R, int& C) { const int st = b / 1024, sb = b % 1024, swz = sb ^ (((sb >> 9) & 1) << 5); R = (st >> 1) * 16 + swz / 64; C = (st & 1) * 32 + (swz % 64) / 2; }
__host__ __device__ __forceinline__ int perm32(int rho) { const int n = rho >> 4, i = rho & 15; return 8 * (i >> 2) + 4 * n + (i & 3); }

struct Unit { int pm, pn; };
struct Gemm { const bf16_t* A; const bf16_t* Bt; int M, N, K; };

struct StaticOrder {
    int nM, nN, nwg, G, c;
    __host__ __device__ void init(int M, int N, int G_, int c_) { nM = M / BM; nN = N / BM; nwg = nM * nN; G = G_; c = c_; }
    __host__ __device__ bool next(int i, Unit& u) const {
        const long L = (long)i * G + c; if (L >= nwg) return false;
        int wgid = (int)L; { const int q = nwg / NXCD, r = nwg % NXCD, xcd = wgid % NXCD, off = wgid / NXCD; wgid = (xcd < r ? xcd * (q + 1) : r * (q + 1) + (xcd - r) * q) + off; }
        const int nig = WGM * nN, gid = wgid / nig, fm = gid * WGM, gsz = (nM - fm) < WGM ? (nM - fm) : WGM;
        u.pm = fm + ((wgid % nig) % gsz); u.pn = (wgid % nig) / gsz; return true;
    }
    __device__ __forceinline__ void a_ready(const Unit&) const {}
    __device__ __forceinline__ void done(const Unit&) const {}
};
struct CountedOrder : StaticOrder {
    const unsigned* ready; unsigned need; unsigned* tmo;
    __device__ __forceinline__ void a_ready(const Unit& u) const {
        if (threadIdx.x < 64) {
            const unsigned long long t0 = __builtin_amdgcn_s_memrealtime(); unsigned polls = 0;
            while ((unsigned)__builtin_amdgcn_readfirstlane(__hip_atomic_load(ready + 64 * u.pm, __ATOMIC_RELAXED, __HIP_MEMORY_SCOPE_AGENT)) < need) {
                if ((++polls & 255u) == 0u && __builtin_amdgcn_readfirstlane(__hip_atomic_load(tmo, __ATOMIC_RELAXED, __HIP_MEMORY_SCOPE_AGENT)) != 0u) break;
                if (__builtin_amdgcn_s_memrealtime() - t0 > 2000000ull) {
                    if (threadIdx.x == 0) { unsigned expect = 0u; __hip_atomic_compare_exchange_strong(tmo + 1, &expect, 0x600u | (unsigned)(u.pm & 0xff), __ATOMIC_RELAXED, __ATOMIC_RELAXED, __HIP_MEMORY_SCOPE_AGENT); __hip_atomic_store(tmo, 1u, __ATOMIC_RELAXED, __HIP_MEMORY_SCOPE_AGENT); }
                    break; }
                __builtin_amdgcn_s_sleep(2); }
            __builtin_amdgcn_fence(__ATOMIC_ACQUIRE, "agent");
            asm volatile("s_waitcnt vmcnt(0)" ::: "memory");
        }
#if !defined(BROKEN_HOOK_NO_BARRIER)
        asm volatile("" ::: "memory"); __builtin_amdgcn_s_barrier(); asm volatile("" ::: "memory");
#endif
    }
};

__device__ __forceinline__ unsigned cvt_pk_bf16(float lo, float hi) { unsigned r; asm volatile("v_cvt_pk_bf16_f32 %0, %1, %2" : "=v"(r) : "v"(lo), "v"(hi)); return r; }
typedef float f32x2 __attribute__((ext_vector_type(2)));
__device__ __forceinline__ f32x2 gelu_pk(f32x2 v) {
    const f32x2 av = __builtin_elementwise_abs(v), d = av * 0.2316418882f + 1.0f;
    f32x2 t; t.x = __builtin_amdgcn_rcpf(d.x); t.y = __builtin_amdgcn_rcpf(d.y);
    f32x2 q = t * 0.5307027145f + (-0.7265760135f); q = q * t + 0.7107068705f; q = q * t + (-0.142248368f); q = q * t + 0.127414796f; q = q * t;
    const f32x2 s = (v * v) * (-0.72134752044f);
    f32x2 e; e.x = __builtin_amdgcn_exp2f(s.x); e.y = __builtin_amdgcn_exp2f(s.y);
    const f32x2 m = v * (q * e), r = v - m;
    f32x2 o; o.x = v.x < 0.f ? m.x : r.x; o.y = v.y < 0.f ? m.y : r.y; return o;
}

struct EpiF32 {
    static constexpr bool PERM = false, AFTER_DRAIN = false;
    float* C; int ldc; const float* bias;
    __device__ __forceinline__ void operator()(const f32x4 (&acc)[2][2][4][2], const Unit& u, int wr, int wc, int fr, int fq) const {
        const int row0 = u.pm * BM + wr * 64 + fr, col0 = u.pn * BM + wc * 32 + 4 * fq;
        f32x4 bv[2][2];
#pragma unroll
        for (int bj = 0; bj < 2; ++bj)
#pragma unroll
            for (int n = 0; n < 2; ++n) bv[bj][n] = bias ? *(const f32x4*)(bias + col0 + bj * HALF + n * 16) : (f32x4){0.f, 0.f, 0.f, 0.f};
#pragma unroll
        for (int ai = 0; ai < 2; ++ai)
#pragma unroll
            for (int m = 0; m < 4; ++m) { float* rowp = C + (size_t)(row0 + ai * HALF + m * 16) * ldc + col0;
#pragma unroll
                for (int bj = 0; bj < 2; ++bj)
#pragma unroll
                    for (int n = 0; n < 2; ++n) *(f32x4*)(rowp + bj * HALF + n * 16) = acc[ai][bj][m][n] + bv[bj][n]; }
    }
};
template <int ACT  > struct EpiBf16 {
    static constexpr bool PERM = true, AFTER_DRAIN = false;
    bf16_t* O; int ldc; const float* bias; int split_cols; size_t split_stride;
    __device__ __forceinline__ void operator()(const f32x4 (&acc)[2][2][4][2], const Unit& u, int wr, int wc, int fr, int fq) const {
        const int row0 = u.pm * BM + wr * 64 + fr; int colt = u.pn * BM; bf16_t* base = O;
        if (split_cols) { const int t = colt / split_cols; base += (size_t)t * split_stride; colt -= t * split_cols; }
        const int col0 = colt + wc * 32 + 8 * fq, bcol0 = u.pn * BM + wc * 32 + 8 * fq;
        f32x4 bv[2][2];
#pragma unroll
        for (int bj = 0; bj < 2; ++bj)
#pragma unroll
            for (int n = 0; n < 2; ++n) bv[bj][n] = bias ? *(const f32x4*)(bias + bcol0 + bj * HALF + 4 * n) : (f32x4){0.f, 0.f, 0.f, 0.f};
#pragma unroll
        for (int ai = 0; ai < 2; ++ai)
#pragma unroll
            for (int m = 0; m < 4; ++m) { bf16_t* rowp = base + (size_t)(row0 + ai * HALF + m * 16) * ldc + col0;
#pragma unroll
                for (int bj = 0; bj < 2; ++bj) { f32x4 v0 = acc[ai][bj][m][0] + bv[bj][0], v1 = acc[ai][bj][m][1] + bv[bj][1];
                    if (ACT == 1) { f32x2 a = gelu_pk((f32x2){v0[0], v0[1]}), b = gelu_pk((f32x2){v0[2], v0[3]}), c = gelu_pk((f32x2){v1[0], v1[1]}), d = gelu_pk((f32x2){v1[2], v1[3]});
                        v0 = (f32x4){a.x, a.y, b.x, b.y}; v1 = (f32x4){c.x, c.y, d.x, d.y}; }
                    if (ACT == 2) {
#pragma unroll
                        for (int j = 0; j < 4; ++j) { v0[j] = 0.5f * v0[j] * (1.0f + erff(v0[j] * 0.70710678f)); v1[j] = 0.5f * v1[j] * (1.0f + erff(v1[j] * 0.70710678f)); } }
                    u32x4 w; w.x = cvt_pk_bf16(v0[0], v0[1]); w.y = cvt_pk_bf16(v0[2], v0[3]); w.z = cvt_pk_bf16(v1[0], v1[1]); w.w = cvt_pk_bf16(v1[2], v1[3]);
                    *(u32x4*)(rowp + bj * HALF) = w; } }
    }
};

template <class Epi, class Sched, bool STAMP = false>
__device__ __forceinline__ void gemm_phase(PG8_LAS unsigned char* lds, const Gemm g, const Sched& S, const Epi& E, unsigned long long* stamps) {
    const int tid = threadIdx.x, wid = __builtin_amdgcn_readfirstlane(tid >> 6), lane = tid & 63, wr = wid >> 2, wc = wid & 3, fr = lane & 15, fq = lane >> 4;
    const int K = g.K, nt = K / BK;
    int ts_lo = 0, ts_hi = 0, nts = 0; const unsigned long long rt_entry = STAMP ? (unsigned long long)wall_clock64() : 0ull;
#define PG8_STAMP() do { if (STAMP && wid == 0 && nts < 64) { const unsigned long long _c = (unsigned long long)clock64(); \
        ts_lo = (lane == nts) ? (int)(unsigned)_c : ts_lo; ts_hi = (lane == nts) ? (int)(unsigned)(_c >> 32) : ts_hi; ++nts; } } while (0)
    PG8_STAMP();
    unsigned voffA[2], voffB[2];
#pragma unroll
    for (int i = 0; i < 2; ++i) { int R, C; stage_rc(tid * 16 + i * 8192, R, C); const int Rb = Epi::PERM ? ((R & ~31) + perm32(R & 31)) : R;
        voffA[i] = (unsigned)(R * K + C) * 2u; voffB[i] = (unsigned)(Rb * K + C) * 2u; }
    const size_t kstep = (size_t)(BK * 2);
    const size_t hstep = (size_t)HALF * K * 2;
    const size_t tstep = 2 * hstep;
    const unsigned ldsw = (unsigned)wid * 1024u;
    const int aoff = lds_byte(wr * 64 + fr, fq * 8), boff = lds_byte(wc * 32 + fr, fq * 8);
#define PG8_SA(b, h) (((b) * 2 + (h)) * HTB)
#define PG8_SB(b, h) ((4 + (b) * 2 + (h)) * HTB)
#define PG8_STAGE(bufoff, gbase, voff) do { _Pragma("unroll") for (int _i = 0; _i < 2; ++_i) \
        __builtin_amdgcn_global_load_lds((const unsigned*)((const char*)(gbase) + (voff)[_i]), (PG8_LAS unsigned*)(lds + (bufoff) + ldsw + _i * 8192), 16, 0, 0); } while (0)
#define PG8_LDA(dst, b, h) do { _Pragma("unroll") for (int m = 0; m < 4; ++m) _Pragma("unroll") for (int k = 0; k < 2; ++k) dst[m][k] = *(const PG8_LAS bf16x8*)(lds + PG8_SA(b, h) + aoff + m * 2048 + k * 1024); } while (0)
#define PG8_LDB(dst, b, h) do { _Pragma("unroll") for (int n = 0; n < 2; ++n) _Pragma("unroll") for (int k = 0; k < 2; ++k) dst[n][k] = *(const PG8_LAS bf16x8*)(lds + PG8_SB(b, h) + boff + n * 2048 + k * 1024); } while (0)
#define PG8_MMA(ai, bj, At, Bt) do { __builtin_amdgcn_s_setprio(1); _Pragma("unroll") for (int m = 0; m < 4; ++m) _Pragma("unroll") for (int n = 0; n < 2; ++n) _Pragma("unroll") for (int k = 0; k < 2; ++k) \
        acc[ai][bj][m][n] = __builtin_amdgcn_mfma_f32_16x16x32_bf16(Bt[n][k], At[m][k], acc[ai][bj][m][n], 0, 0, 0); __builtin_amdgcn_s_setprio(0); } while (0)
#define PG8_WAIT_V(n) asm volatile("s_waitcnt vmcnt(" #n ")" ::: "memory")
#define PG8_WAIT_L(n) asm volatile("s_waitcnt lgkmcnt(" #n ")" ::: "memory")
#define PG8_BAR __builtin_amdgcn_s_barrier()
#define PG8_SCHED __builtin_amdgcn_sched_barrier(0)
    Unit cur, nxt; int ui = 0;
    if (!S.next(0, cur)) return;
    f32x4 acc[2][2][4][2];
#pragma unroll
    for (int a = 0; a < 2; ++a)
#pragma unroll
        for (int b = 0; b < 2; ++b)
#pragma unroll
            for (int m = 0; m < 4; ++m)
#pragma unroll
                for (int n = 0; n < 2; ++n) acc[a][b][m][n] = (f32x4){0.f, 0.f, 0.f, 0.f};
    bf16x8 At[4][2], B0[2][2], B1[2][2];
    const char* cA = (const char*)g.A + (size_t)cur.pm * tstep; const char* cB = (const char*)g.Bt + (size_t)cur.pn * tstep;
    S.a_ready(cur);
    PG8_STAGE(PG8_SB(0, 0), cB, voffB); PG8_STAGE(PG8_SA(0, 0), cA, voffA); PG8_STAGE(PG8_SB(0, 1), cB + hstep, voffB); PG8_STAGE(PG8_SA(0, 1), cA + hstep, voffA);
    if (wr == 1) PG8_BAR;
    PG8_WAIT_V(4); PG8_BAR;
    PG8_STAGE(PG8_SB(1, 0), cB + kstep, voffB); PG8_STAGE(PG8_SA(1, 0), cA + kstep, voffA); PG8_STAGE(PG8_SB(1, 1), cB + hstep + kstep, voffB);
    PG8_WAIT_V(6); PG8_BAR;
    PG8_STAMP();
    for (;;) {
        const bool has_next = S.next(ui + 1, nxt);
        const char* nA = has_next ? (const char*)g.A + (size_t)nxt.pm * tstep : cA; const char* nB = has_next ? (const char*)g.Bt + (size_t)nxt.pn * tstep : cB;
        for (int t = 0; t < nt; t += 2) {
            const bool last = (t == nt - 2);
            const char* a1 = cA + (size_t)(t + 1) * kstep;
            const char* a2 = last ? nA : cA + (size_t)(t + 2) * kstep; const char* b2 = last ? nB : cB + (size_t)(t + 2) * kstep;
            const char* a3 = a2 + kstep; const char* b3 = b2 + kstep;
            if (last && has_next) S.a_ready(nxt);
            PG8_LDB(B0, 0, 0); PG8_SCHED; PG8_LDA(At, 0, 0); PG8_STAGE(PG8_SA(1, 1), a1 + hstep, voffA);
            PG8_WAIT_L(8); PG8_BAR; PG8_WAIT_L(0); PG8_MMA(0, 0, At, B0); PG8_BAR; PG8_SCHED;
            PG8_LDB(B1, 0, 1); PG8_STAGE(PG8_SB(0, 0), b2, voffB);
            PG8_BAR; PG8_WAIT_L(0); PG8_MMA(0, 1, At, B1); PG8_BAR;
            PG8_LDA(At, 0, 1); PG8_STAGE(PG8_SA(0, 0), a2, voffA);
            PG8_BAR; PG8_WAIT_L(0); PG8_MMA(1, 0, At, B0); PG8_BAR; PG8_SCHED;
            PG8_STAGE(PG8_SB(0, 1), b2 + hstep, voffB);
            PG8_WAIT_V(6); PG8_BAR; PG8_MMA(1, 1, At, B1); PG8_BAR;
            PG8_LDB(B0, 1, 0); PG8_SCHED; PG8_LDA(At, 1, 0); PG8_STAGE(PG8_SA(0, 1), a2 + hstep, voffA);
            PG8_WAIT_L(8); PG8_BAR; PG8_WAIT_L(0); PG8_MMA(0, 0, At, B0); PG8_BAR; PG8_SCHED;
            PG8_LDB(B1, 1, 1); PG8_STAGE(PG8_SB(1, 0), b3, voffB);
            PG8_BAR; PG8_WAIT_L(0); PG8_MMA(0, 1, At, B1); PG8_BAR;
            PG8_LDA(At, 1, 1); PG8_STAGE(PG8_SA(1, 0), a3, voffA);
            PG8_BAR; PG8_WAIT_L(0); PG8_MMA(1, 0, At, B0); PG8_BAR; PG8_SCHED;
            PG8_STAGE(PG8_SB(1, 1), b3 + hstep, voffB);
            PG8_WAIT_V(6); PG8_BAR; PG8_MMA(1, 1, At, B1); PG8_BAR;
        }
        PG8_STAMP();
        if constexpr (!Epi::AFTER_DRAIN) { E(acc, cur, wr, wc, fr, fq); S.done(cur); }
        PG8_STAMP();
        if (!has_next) break;
#pragma unroll
        for (int a = 0; a < 2; ++a)
#pragma unroll
            for (int b = 0; b < 2; ++b)
#pragma unroll
                for (int m = 0; m < 4; ++m)
#pragma unroll
                    for (int n = 0; n < 2; ++n) acc[a][b][m][n] = (f32x4){0.f, 0.f, 0.f, 0.f};
        cur = nxt; cA = nA; cB = nB; ++ui;
    }
    PG8_WAIT_V(0);
    if (wr == 0) PG8_BAR;
    PG8_BAR;
    if constexpr (Epi::AFTER_DRAIN) { E.fused(acc, cur, wr, wc, fr, fq, lds, wid, lane); S.done(cur); }
    PG8_STAMP();
    if (STAMP && wid == 0) { stamps[lane] = lane < nts ? (((unsigned long long)(unsigned)ts_hi << 32) | (unsigned)ts_lo) : 0ull;
        if (lane == 62) stamps[62] = rt_entry; if (lane == 63) stamps[63] = (unsigned long long)wall_clock64(); }
#undef PG8_STAMP
#undef PG8_SA
#undef PG8_SB
#undef PG8_STAGE
#undef PG8_LDA
#undef PG8_LDB
#undef PG8_MMA
#undef PG8_WAIT_V
#undef PG8_WAIT_L
#undef PG8_BAR
#undef PG8_SCHED
}
template <class Epi, class Sched, bool STAMP = false>
__device__ __forceinline__ void gemm_phase_g(const int* rowmap, PG8_LAS unsigned char* lds, const Gemm g, const Sched& S, const Epi& E, unsigned long long* stamps) {
    const int tid = threadIdx.x, wid = __builtin_amdgcn_readfirstlane(tid >> 6), lane = tid & 63, wr = wid >> 2, wc = wid & 3, fr = lane & 15, fq = lane >> 4;
    const int K = g.K, nt = K / BK;
    int ts_lo = 0, ts_hi = 0, nts = 0; const unsigned long long rt_entry = STAMP ? (unsigned long long)wall_clock64() : 0ull;
#define PG8_STAMP() do { if (STAMP && wid == 0 && nts < 64) { const unsigned long long _c = (unsigned long long)clock64(); \
        ts_lo = (lane == nts) ? (int)(unsigned)_c : ts_lo; ts_hi = (lane == nts) ? (int)(unsigned)(_c >> 32) : ts_hi; ++nts; } } while (0)
    PG8_STAMP();
    unsigned voffB[2], cpartA[2]; int rowA[2];
#pragma unroll
    for (int i = 0; i < 2; ++i) { int R, C; stage_rc(tid * 16 + i * 8192, R, C); const int Rb = Epi::PERM ? ((R & ~31) + perm32(R & 31)) : R;
        rowA[i] = R; cpartA[i] = (unsigned)C * 2u; voffB[i] = (unsigned)(Rb * K + C) * 2u; }
    unsigned cvoff[2][2], nvoff[2][2];
#define PG8_ROWS(dst, u_) do { _Pragma("unroll") for (int h_ = 0; h_ < 2; ++h_) _Pragma("unroll") for (int i_ = 0; i_ < 2; ++i_) { \
        const int tok_ = __hip_atomic_load(rowmap + (u_).pm * 256 + h_ * 128 + rowA[i_], __ATOMIC_RELAXED, __HIP_MEMORY_SCOPE_AGENT); dst[h_][i_] = (unsigned)tok_ * (unsigned)(K * 2) + cpartA[i_]; } } while (0)
    const size_t kstep = (size_t)(BK * 2);
    const size_t hstep = (size_t)HALF * K * 2;
    const size_t tstep = 2 * hstep;
    const unsigned ldsw = (unsigned)wid * 1024u;
    const int aoff = lds_byte(wr * 64 + fr, fq * 8), boff = lds_byte(wc * 32 + fr, fq * 8);
#define PG8_SA(b, h) (((b) * 2 + (h)) * HTB)
#define PG8_SB(b, h) ((4 + (b) * 2 + (h)) * HTB)
#define PG8_STAGE(bufoff, gbase, voff) do { _Pragma("unroll") for (int _i = 0; _i < 2; ++_i) \
        __builtin_amdgcn_global_load_lds((const unsigned*)((const char*)(gbase) + (voff)[_i]), (PG8_LAS unsigned*)(lds + (bufoff) + ldsw + _i * 8192), 16, 0, 0); } while (0)
#define PG8_LDA(dst, b, h) do { _Pragma("unroll") for (int m = 0; m < 4; ++m) _Pragma("unroll") for (int k = 0; k < 2; ++k) dst[m][k] = *(const PG8_LAS bf16x8*)(lds + PG8_SA(b, h) + aoff + m * 2048 + k * 1024); } while (0)
#define PG8_LDB(dst, b, h) do { _Pragma("unroll") for (int n = 0; n < 2; ++n) _Pragma("unroll") for (int k = 0; k < 2; ++k) dst[n][k] = *(const PG8_LAS bf16x8*)(lds + PG8_SB(b, h) + boff + n * 2048 + k * 1024); } while (0)
#define PG8_MMA(ai, bj, At, Bt) do { __builtin_amdgcn_s_setprio(1); _Pragma("unroll") for (int m = 0; m < 4; ++m) _Pragma("unroll") for (int n = 0; n < 2; ++n) _Pragma("unroll") for (int k = 0; k < 2; ++k) \
        acc[ai][bj][m][n] = __builtin_amdgcn_mfma_f32_16x16x32_bf16(Bt[n][k], At[m][k], acc[ai][bj][m][n], 0, 0, 0); __builtin_amdgcn_s_setprio(0); } while (0)
#define PG8_WAIT_V(n) asm volatile("s_waitcnt vmcnt(" #n ")" ::: "memory")
#define PG8_WAIT_L(n) asm volatile("s_waitcnt lgkmcnt(" #n ")" ::: "memory")
#define PG8_BAR __builtin_amdgcn_s_barrier()
#define PG8_SCHED __builtin_amdgcn_sched_barrier(0)
    Unit cur, nxt; int ui = 0;
    if (!S.next(0, cur)) return;
    f32x4 acc[2][2][4][2];
#pragma unroll
    for (int a = 0; a < 2; ++a)
#pragma unroll
        for (int b = 0; b < 2; ++b)
#pragma unroll
            for (int m = 0; m < 4; ++m)
#pragma unroll
                for (int n = 0; n < 2; ++n) acc[a][b][m][n] = (f32x4){0.f, 0.f, 0.f, 0.f};
    bf16x8 At[4][2], B0[2][2], B1[2][2];
    const char* gA0 = (const char*)g.A; const char* cB = (const char*)g.Bt + (size_t)cur.pn * tstep;
    S.a_ready(cur);
    PG8_ROWS(cvoff, cur);
    PG8_STAGE(PG8_SB(0, 0), cB, voffB); PG8_STAGE(PG8_SA(0, 0), gA0, cvoff[0]); PG8_STAGE(PG8_SB(0, 1), cB + hstep, voffB); PG8_STAGE(PG8_SA(0, 1), gA0, cvoff[1]);
    if (wr == 1) PG8_BAR;
    PG8_WAIT_V(4); PG8_BAR;
    PG8_STAGE(PG8_SB(1, 0), cB + kstep, voffB); PG8_STAGE(PG8_SA(1, 0), gA0 + kstep, cvoff[0]); PG8_STAGE(PG8_SB(1, 1), cB + hstep + kstep, voffB);
    PG8_WAIT_V(6); PG8_BAR;
    PG8_STAMP();
    for (;;) {
        const bool has_next = S.next(ui + 1, nxt);
        const char* nB = has_next ? (const char*)g.Bt + (size_t)nxt.pn * tstep : cB;
        if (has_next) PG8_ROWS(nvoff, nxt); else { nvoff[0][0] = cvoff[0][0]; nvoff[0][1] = cvoff[0][1]; nvoff[1][0] = cvoff[1][0]; nvoff[1][1] = cvoff[1][1]; }
        for (int t = 0; t < nt; t += 2) {
            const bool last = (t == nt - 2);
            const char* a1 = gA0 + (size_t)(t + 1) * kstep;
            const char* a2 = last ? gA0 : gA0 + (size_t)(t + 2) * kstep; const char* b2 = last ? nB : cB + (size_t)(t + 2) * kstep;
            const char* a3 = a2 + kstep; const char* b3 = b2 + kstep;
            unsigned v2[2][2];
#pragma unroll
            for (int h_ = 0; h_ < 2; ++h_) { v2[h_][0] = last ? nvoff[h_][0] : cvoff[h_][0]; v2[h_][1] = last ? nvoff[h_][1] : cvoff[h_][1]; }
            if (last && has_next) S.a_ready(nxt);
            PG8_LDB(B0, 0, 0); PG8_SCHED; PG8_LDA(At, 0, 0); PG8_STAGE(PG8_SA(1, 1), a1, cvoff[1]);
            PG8_WAIT_L(8); PG8_BAR; PG8_WAIT_L(0); PG8_MMA(0, 0, At, B0); PG8_BAR; PG8_SCHED;
            PG8_LDB(B1, 0, 1); PG8_STAGE(PG8_SB(0, 0), b2, voffB);
            PG8_BAR; PG8_WAIT_L(0); PG8_MMA(0, 1, At, B1); PG8_BAR;
            PG8_LDA(At, 0, 1); PG8_STAGE(PG8_SA(0, 0), a2, v2[0]);
            PG8_BAR; PG8_WAIT_L(0); PG8_MMA(1, 0, At, B0); PG8_BAR; PG8_SCHED;
            PG8_STAGE(PG8_SB(0, 1), b2 + hstep, voffB);
            PG8_WAIT_V(6); PG8_BAR; PG8_MMA(1, 1, At, B1); PG8_BAR;
            PG8_LDB(B0, 1, 0); PG8_SCHED; PG8_LDA(At, 1, 0); PG8_STAGE(PG8_SA(0, 1), a2, v2[1]);
            PG8_WAIT_L(8); PG8_BAR; PG8_WAIT_L(0); PG8_MMA(0, 0, At, B0); PG8_BAR; PG8_SCHED;
            PG8_LDB(B1, 1, 1); PG8_STAGE(PG8_SB(1, 0), b3, voffB);
            PG8_BAR; PG8_WAIT_L(0); PG8_MMA(0, 1, At, B1); PG8_BAR;
            PG8_LDA(At, 1, 1); PG8_STAGE(PG8_SA(1, 0), a3, v2[0]);
            PG8_BAR; PG8_WAIT_L(0); PG8_MMA(1, 0, At, B0); PG8_BAR; PG8_SCHED;
            PG8_STAGE(PG8_SB(1, 1), b3 + hstep, voffB);
            PG8_WAIT_V(6); PG8_BAR; PG8_MMA(1, 1, At, B1); PG8_BAR;
        }
        PG8_STAMP();
        if constexpr (!Epi::AFTER_DRAIN) { E(acc, cur, wr, wc, fr, fq); S.done(cur); }
        PG8_STAMP();
        if (!has_next) break;
#pragma unroll
        for (int a = 0; a < 2; ++a)
#pragma unroll
            for (int b = 0; b < 2; ++b)
#pragma unroll
                for (int m = 0; m < 4; ++m)
#pragma unroll
                    for (int n = 0; n < 2; ++n) acc[a][b][m][n] = (f32x4){0.f, 0.f, 0.f, 0.f};
        cur = nxt; cB = nB; ++ui; cvoff[0][0] = nvoff[0][0]; cvoff[0][1] = nvoff[0][1]; cvoff[1][0] = nvoff[1][0]; cvoff[1][1] = nvoff[1][1];
    }
    PG8_WAIT_V(0);
    if (wr == 0) PG8_BAR;
    PG8_BAR;
    if constexpr (Epi::AFTER_DRAIN) { E.fused(acc, cur, wr, wc, fr, fq, lds, wid, lane); S.done(cur); }
    PG8_STAMP();
    if (STAMP && wid == 0) { stamps[lane] = lane < nts ? (((unsigned long long)(unsigned)ts_hi << 32) | (unsigned)ts_lo) : 0ull;
        if (lane == 62) stamps[62] = rt_entry; if (lane == 63) stamps[63] = (unsigned long long)wall_clock64(); }
#undef PG8_STAMP
#undef PG8_ROWS
#undef PG8_SA
#undef PG8_SB
#undef PG8_STAGE
#undef PG8_LDA
#undef PG8_LDB
#undef PG8_MMA
#undef PG8_WAIT_V
#undef PG8_WAIT_L
#undef PG8_BAR
#undef PG8_SCHED
}
}

#define LDSP __attribute__((address_space(3)))
typedef unsigned short bf16_t;
typedef float f32x4 __attribute__((ext_vector_type(4)));
typedef float f32x2 __attribute__((ext_vector_type(2)));
typedef unsigned u32x4 __attribute__((ext_vector_type(4)));
typedef unsigned u32x2 __attribute__((ext_vector_type(2)));

constexpr int T_ = 16384, D_ = 2048, S_ = 2048, B_ = 8;
constexpr int PW0 = 5376, PW1 = 14336, DE = 1408, CAP = 36864, MODW = 12288;
constexpr int NTHR = 512, NWAVE = 8;
constexpr int LDS_BYTES = 147456;
constexpr int LDS_MISC = 131072;

constexpr size_t al256(size_t x) { return (x + 255) & ~(size_t)255; }
constexpr size_t WS_BAR     = 0;
constexpr size_t WS_CTL_END = 16384;
constexpr size_t WS_TAB     = WS_CTL_END;
constexpr size_t WS_BLKCNT  = WS_TAB + 1024;
constexpr size_t WS_MOD     = al256(WS_BLKCNT + 256 * 16 * 4);
constexpr size_t WS_RIDX    = al256(WS_MOD + (size_t)2 * 8 * MODW * 4);
constexpr size_t WS_RW      = al256(WS_RIDX + (size_t)T_ * 2 * 4);
constexpr size_t WS_TOKSLOT = al256(WS_RW + (size_t)T_ * 2 * 4);
constexpr size_t WS_SLOTW   = al256(WS_TOKSLOT + (size_t)T_ * 2 * 4);
constexpr size_t WS_SLOTTOK = al256(WS_SLOTW + (size_t)CAP * 4);
constexpr size_t WS_SEL     = al256(WS_SLOTTOK + (size_t)CAP * 4);
constexpr size_t WS_CMP     = al256(WS_SEL + (size_t)8 * 4 * 2048 * 4);
constexpr size_t WS_LSE     = al256(WS_CMP + (size_t)2 * 8 * 128 * 4 * 128 * 4);
constexpr size_t WS_WNSAIN  = al256(WS_LSE + (size_t)3 * T_ * 16 * 4);
constexpr size_t WS_WNSAOUT = al256(WS_WNSAIN + (size_t)PW0 * D_ * 2);
constexpr size_t WS_WDILIN  = al256(WS_WNSAOUT + (size_t)D_ * D_ * 2);
constexpr size_t WS_WDILOUT = al256(WS_WDILIN + (size_t)PW1 * D_ * 2);
constexpr size_t WS_WE1     = al256(WS_WDILOUT + (size_t)D_ * D_ * 2);
constexpr size_t WS_WE2     = al256(WS_WE1 + (size_t)16 * 2816 * D_ * 2);
constexpr size_t WS_X       = al256(WS_WE2 + (size_t)16 * D_ * DE * 2);
constexpr size_t WS_H       = al256(WS_X + (size_t)T_ * D_ * 2);
constexpr size_t WS_O       = al256(WS_H + (size_t)T_ * D_ * 2);
constexpr size_t WS_PROJ    = al256(WS_O + (size_t)T_ * D_ * 2);
constexpr size_t WS_XIN     = WS_PROJ;
constexpr size_t WS_HID     = al256(WS_XIN + (size_t)CAP * D_ * 2);
constexpr size_t WS_YO      = al256(WS_HID + (size_t)CAP * DE * 2);
constexpr size_t WS_OG      = al256(WS_PROJ + (size_t)T_ * PW1 * 2);
constexpr size_t WS_ACC     = WS_OG;
constexpr size_t WS_CMPB    = al256(WS_OG + (size_t)3 * T_ * D_ * 2);
constexpr size_t WS_W1T     = al256(WS_CMPB + (size_t)2 * 8 * 128 * 4 * 128 * 2);
constexpr size_t WS_POSB    = al256(WS_W1T + (size_t)2 * 128 * 4096 * 2);
constexpr size_t WS_END     = al256(WS_POSB + 2 * 32 * 128 * 4);
static_assert(WS_END < (size_t)1560000000, "workspace budget");
static_assert(WS_YO + (size_t)CAP * D_ * 2 <= WS_END, "moe buffers must fit inside the proj region");

__device__ __forceinline__ float bf2f(bf16_t v) { return __uint_as_float(((unsigned)v) << 16); }
__device__ __forceinline__ bf16_t f2bf(float f) { unsigned u = __float_as_uint(f); u += 0x7FFFu + ((u >> 16) & 1u); return (bf16_t)(u >> 16); }
__device__ __forceinline__ unsigned pk2(float lo, float hi) { return (unsigned)f2bf(lo) | ((unsigned)f2bf(hi) << 16); }
__device__ __forceinline__ int ld_i(const int* p) { return __hip_atomic_load(p, __ATOMIC_RELAXED, __HIP_MEMORY_SCOPE_AGENT); }
__device__ __forceinline__ float ld_f(const float* p) { return __hip_atomic_load(p, __ATOMIC_RELAXED, __HIP_MEMORY_SCOPE_AGENT); }
__device__ __forceinline__ float wsum(float v) { for (int o = 32; o >= 1; o >>= 1) v += __shfl_xor(v, o); return v; }
__device__ __forceinline__ float wmax(float v) { for (int o = 32; o >= 1; o >>= 1) v = fmaxf(v, __shfl_xor(v, o)); return v; }
__device__ __forceinline__ void lds_fence() { asm volatile("s_waitcnt lgkmcnt(0)" ::: "memory"); }

struct Args { const float* in[19]; float* out; unsigned char* ws; int ph_lo, ph_hi; };
struct Ctx {
    const Args& A; unsigned char* ws;
    LDSP unsigned char* lds;
    int tid, lane, wave, G, bid;
};
__device__ __forceinline__ Ctx fresh(const Ctx& c0) {
    int l = (int)__builtin_amdgcn_mbcnt_hi(~0u, __builtin_amdgcn_mbcnt_lo(~0u, 0u)); asm volatile("" : "+v"(l));
    const int t = c0.wave * 64 + l;
    Ctx c{c0.A, c0.ws, c0.lds, t, l, c0.wave, c0.G, c0.bid};
    return c;
}

__device__ __forceinline__ void mod_units(const Ctx& c) {
    if (c.bid >= 192) {
        {
            const int i = c.bid - 192, j = i & 1, p = i >> 1, e = c.tid & 127, q = c.tid >> 7;
            LDSP float* red = (LDSP float*)c.lds;
            const float* w1 = c.A.in[8] + ((size_t)j * 4096 + p * 128 + q * 32) * 128 + e; const float* pos = c.A.in[10] + j * 4096 + p * 128 + q * 32;
            float s = 0.f;
#pragma unroll
            for (int k = 0; k < 32; ++k) s += pos[k] * w1[(size_t)k * 128];
            red[q * 128 + e] = s;
            __syncthreads();
            if (c.tid < 128) ((float*)(c.ws + WS_POSB))[(j * 32 + p) * 128 + c.tid] = red[c.tid] + red[128 + c.tid] + red[256 + c.tid] + red[384 + c.tid];
        }
        return;
    }
    LDSP float* cs = (LDSP float*)c.lds;
    LDSP float* red = (LDSP float*)(c.lds + 65536);
    const float* cin = c.A.in[1];
    for (int i = c.tid; i < 8 * 2048; i += NTHR) { const float v = cin[i]; cs[i] = v / (1.f + __expf(-v)); }
    __syncthreads();
    float* MOD = (float*)(c.ws + WS_MOD);
    for (int u = c.bid; u < 192; u += c.G) {
        const int layer = u / 96, cb = (u % 96) * 128;
        const int c4 = c.tid & 31, kc = c.tid >> 5;
        f32x4 acc[8];
#pragma unroll
        for (int b = 0; b < 8; ++b) acc[b] = (f32x4){0.f, 0.f, 0.f, 0.f};
        const float* wp = c.A.in[2] + ((size_t)layer * 2048 + kc * 128) * MODW + cb + 4 * c4;
        for (int k0 = 0; k0 < 128; k0 += 8) {
            f32x4 w[8];
#pragma unroll
            for (int q = 0; q < 8; ++q) w[q] = __builtin_nontemporal_load((const f32x4*)(wp + (size_t)(k0 + q) * MODW));
#pragma unroll
            for (int q = 0; q < 8; ++q) { const int k = kc * 128 + k0 + q;
#pragma unroll
                for (int b = 0; b < 8; ++b) acc[b] += cs[b * 2048 + k] * w[q]; }
        }
#pragma unroll
        for (int b = 0; b < 8; ++b) *(LDSP f32x4*)(red + (kc * 8 + b) * 128 + 4 * c4) = acc[b];
        __syncthreads();
        for (int idx = c.tid; idx < 1024; idx += NTHR) {
            const int b = idx >> 7, col = idx & 127; float s = c.A.in[3][layer * MODW + cb + col];
#pragma unroll
            for (int q = 0; q < 16; ++q) s += red[(q * 8 + b) * 128 + col];
            MOD[((size_t)layer * 8 + b) * MODW + cb + col] = s;
        }
        __syncthreads();
    }
}

__device__ __forceinline__ void tr_tile(const float* src, int ld, int nvalid, bf16_t* dst, int dld, LDSP float* tile, int lane) {
    const int cq = (lane & 15) * 4, r4 = lane >> 4;
    f32x4 v[16];
#pragma unroll
    for (int i = 0; i < 16; ++i) {
        const int k = i * 4 + r4;
        if (cq < nvalid) v[i] = __builtin_nontemporal_load((const f32x4*)(src + (size_t)k * ld + cq)); else v[i] = (f32x4){0.f, 0.f, 0.f, 0.f};
    }
#pragma unroll
    for (int i = 0; i < 16; ++i) {
        const int k = i * 4 + r4;
        tile[k * 65 + cq + 0] = v[i][0]; tile[k * 65 + cq + 1] = v[i][1]; tile[k * 65 + cq + 2] = v[i][2]; tile[k * 65 + cq + 3] = v[i][3];
    }
    lds_fence();
    const int k8 = (lane & 7) * 8, rr = lane >> 3;
#pragma unroll
    for (int i = 0; i < 8; ++i) {
        const int r = i * 8 + rr;
        u32x4 w;
        w.x = pk2(tile[(k8 + 0) * 65 + r], tile[(k8 + 1) * 65 + r]); w.y = pk2(tile[(k8 + 2) * 65 + r], tile[(k8 + 3) * 65 + r]);
        w.z = pk2(tile[(k8 + 4) * 65 + r], tile[(k8 + 5) * 65 + r]); w.w = pk2(tile[(k8 + 6) * 65 + r], tile[(k8 + 7) * 65 + r]);
        *(u32x4*)(dst + (size_t)r * dld + k8) = w;
    }
    lds_fence();
}
__device__ __forceinline__ void tr_matrix(const Ctx& c, const float* W, int K, int N, int nrows, bf16_t* Wt) {
    LDSP float* tile = (LDSP float*)(c.lds + c.wave * 16640);
    const int nrt = nrows / 64, nkt = K / 64, nw = c.G * NWAVE;
    for (int t = c.bid * NWAVE + c.wave; t < nrt * nkt; t += nw) {
        const int rt = t % nrt, kt = t / nrt;
        int nv = N - rt * 64; nv = nv > 64 ? 64 : (nv < 0 ? 0 : nv);
        tr_tile(W + (size_t)kt * 64 * N + rt * 64, N, nv, Wt + (size_t)rt * 64 * K + kt * 64, K, tile, c.lane);
    }
}
constexpr int TRX_WE1 = 16 * 2 * 32 * 22, TRX_ALL = TRX_WE1 + 16 * 22 * 32;
__device__ __forceinline__ void tr_experts(const Ctx& c, int layer, int lo, int hi, int gw, int nw) {
    LDSP float* tile = (LDSP float*)(c.lds + c.wave * 16640);
    bf16_t* WE1 = (bf16_t*)(c.ws + WS_WE1); bf16_t* WE2 = (bf16_t*)(c.ws + WS_WE2);
    for (int tt = lo + gw; tt < hi; tt += nw) {
        if (tt < TRX_WE1) {
            const int t = tt, ct = t % 22, kt = (t / 22) % 32, half = (t / 704) & 1, e = t / 1408;
            const float* W = (half ? c.A.in[17] : c.A.in[16]) + (size_t)(layer * 16 + e) * D_ * DE;
            const int j = ct >> 1, rt = ct & 1;
            tr_tile(W + (size_t)kt * 64 * DE + ct * 64, DE, 64, WE1 + ((size_t)e * 2816 + j * 256 + half * 128 + rt * 64) * D_ + kt * 64, D_, tile, c.lane);
        } else {
            const int t = tt - TRX_WE1, rt = t % 32, kt = (t / 32) % 22, e = t / 704;
            const float* W = c.A.in[18] + (size_t)(layer * 16 + e) * DE * D_;
            tr_tile(W + (size_t)kt * 64 * D_ + rt * 64, D_, 64, WE2 + ((size_t)e * 2048 + rt * 64) * DE + kt * 64, DE, tile, c.lane);
        }
    }
}
constexpr int TRX_T0 = 11264;
constexpr int TRX_T1 = 8192;

struct RouteOut { int i0, i1; float w0, w1; };
__device__ __forceinline__ RouteOut route16(const float (&lg)[16], const float* rb) {
    float sc[16], bi[16];
#pragma unroll
    for (int e = 0; e < 16; ++e) { sc[e] = 1.f / (1.f + __expf(-lg[e])); bi[e] = sc[e] + rb[e]; }
    float gs[4];
#pragma unroll
    for (int g = 0; g < 4; ++g) {
        float m1 = bi[4 * g], m2 = -3.0e38f;
#pragma unroll
        for (int i = 1; i < 4; ++i) { const float v = bi[4 * g + i]; if (v > m1) { m2 = m1; m1 = v; } else if (v > m2) m2 = v; }
        gs[g] = m1 + m2;
    }
    int bg = 0; float bv = gs[0];
#pragma unroll
    for (int g = 1; g < 4; ++g) if (gs[g] > bv) { bv = gs[g]; bg = g; }
    float cb[4], cs[4];
#pragma unroll
    for (int i = 0; i < 4; ++i) { cb[i] = bg == 0 ? bi[i] : bg == 1 ? bi[4 + i] : bg == 2 ? bi[8 + i] : bi[12 + i]; cs[i] = bg == 0 ? sc[i] : bg == 1 ? sc[4 + i] : bg == 2 ? sc[8 + i] : sc[12 + i]; }
    int a0 = 0; float v0 = cb[0], s0 = cs[0];
#pragma unroll
    for (int i = 1; i < 4; ++i) if (cb[i] > v0) { v0 = cb[i]; a0 = i; s0 = cs[i]; }
    int a1 = -1; float v1 = -3.0e38f, s1 = 0.f;
#pragma unroll
    for (int i = 0; i < 4; ++i) if (i != a0 && cb[i] > v1) { v1 = cb[i]; a1 = i; s1 = cs[i]; }
    RouteOut r; r.i0 = bg * 4 + a0; r.i1 = bg * 4 + a1; const float s = s0 + s1; r.w0 = s0 / s; r.w1 = s1 / s; return r;
}

__device__ __forceinline__ f32x4 up4(u32x2 a) { f32x4 y; y[0] = __uint_as_float(a.x << 16); y[1] = __uint_as_float(a.x & 0xffff0000u); y[2] = __uint_as_float(a.y << 16); y[3] = __uint_as_float(a.y & 0xffff0000u); return y; }
template <int MODE> struct RowRaw { f32x4 xf[MODE == 0 ? 8 : 1]; u32x2 xb[MODE == 0 ? 1 : 8]; u32x2 ya[MODE >= 2 ? 8 : 1], yb[MODE >= 2 ? 8 : 1]; };
template <int MODE>
__device__ __forceinline__ void norm_load(RowRaw<MODE>& R, const void* xsrc_, const bf16_t* YO, int row, int s0, int s1, int lane) {
#pragma unroll
    for (int i = 0; i < 8; ++i) {
        if (MODE == 0) R.xf[i] = *(const f32x4*)((const float*)xsrc_ + (size_t)row * D_ + i * 256 + lane * 4);
        else R.xb[i] = *(const u32x2*)((const bf16_t*)xsrc_ + (size_t)row * D_ + i * 256 + lane * 4);
        if (MODE >= 2) { R.ya[i] = *(const u32x2*)(YO + (size_t)s0 * D_ + i * 256 + lane * 4); R.yb[i] = *(const u32x2*)(YO + (size_t)s1 * D_ + i * 256 + lane * 4); }
    }
}
template <int MODE>
__device__ __forceinline__ void norm_phase(const Ctx& c, const void* xsrc_, bf16_t* xdst, const float* gain, const float* msh, const float* msc, const float* mgf, bf16_t* hdst) {
    LDSP float* rwT = (LDSP float*)c.lds;
    LDSP int* cnt = (LDSP int*)(c.lds + LDS_MISC);
    if (MODE == 1) {
        const float* rw = c.A.in[14];
        for (int i0 = c.tid; i0 < 32768; i0 += NTHR * 16) {
            float t_[16];
#pragma unroll
            for (int k = 0; k < 16; ++k) t_[k] = rw[i0 + k * NTHR];
#pragma unroll
            for (int k = 0; k < 16; ++k) { const int i = i0 + k * NTHR; rwT[(i & 15) * 2048 + (i >> 4)] = t_[k]; }
        }
        if (c.tid < 16) cnt[c.tid] = 0;
        __syncthreads();
    }
    const int nw = c.G * NWAVE, gw = c.bid * NWAVE + c.wave, lane = c.lane;
    const bf16_t* YO = (const bf16_t*)(c.ws + WS_YO);
    const int* TOKSLOT = (const int*)(c.ws + WS_TOKSLOT);
    int sl0[8], sl1[8];
#pragma unroll
    for (int k = 0; k < 8; ++k) { sl0[k] = 0; sl1[k] = 0; if (MODE >= 2) { const int r_ = gw + k * nw; if (r_ < T_) { sl0[k] = ld_i(TOKSLOT + r_ * 2); sl1[k] = ld_i(TOKSLOT + r_ * 2 + 1); } } }
    RowRaw<MODE> cur, nxt;
    if (gw < T_) norm_load<MODE>(cur, xsrc_, YO, gw, sl0[0], sl1[0], lane);
    int kk = 0;
    for (int row = gw; row < T_; row += nw, ++kk) {
        const int b = row >> 11;
        {
            const int rn = row + nw; int n0 = 0, n1 = 0;
            if (MODE >= 2) {
                if (kk + 1 < 8) {
#pragma unroll
                    for (int k = 1; k < 8; ++k) if (k == kk + 1) { n0 = sl0[k]; n1 = sl1[k]; }
                } else if (rn < T_) { n0 = ld_i(TOKSLOT + rn * 2); n1 = ld_i(TOKSLOT + rn * 2 + 1); }
            }
            if (rn < T_) norm_load<MODE>(nxt, xsrc_, YO, rn, n0, n1, lane);
        }
        f32x4 v[8];
#pragma unroll
        for (int i = 0; i < 8; ++i) { if (MODE == 0) v[i] = cur.xf[i]; else v[i] = up4(cur.xb[i]); }
        if (MODE >= 2) {
            f32x4 mg[8];
#pragma unroll
            for (int i = 0; i < 8; ++i) mg[i] = *(const f32x4*)(mgf + (size_t)b * MODW + i * 256 + lane * 4);
            asm volatile("" ::: "memory");
#pragma unroll
            for (int i = 0; i < 8; ++i) {
                const f32x4 y = up4(cur.ya[i]) + up4(cur.yb[i]);
                v[i] += mg[i] * y;
                if (MODE == 2) { u32x2 w; w.x = pk2(v[i][0], v[i][1]); w.y = pk2(v[i][2], v[i][3]); *(u32x2*)(xdst + (size_t)row * D_ + i * 256 + lane * 4) = w; }
            }
        }
        float ss = 0.f;
#pragma unroll
        for (int i = 0; i < 8; ++i) ss += v[i][0] * v[i][0] + v[i][1] * v[i][1] + v[i][2] * v[i][2] + v[i][3] * v[i][3];
        ss = wsum(ss);
        const float rinv = 1.0f / sqrtf(ss * (1.0f / 2048.0f) + 1e-6f);
        f32x4 ga[8];
#pragma unroll
        for (int i = 0; i < 8; ++i) ga[i] = *(const f32x4*)(gain + i * 256 + lane * 4);
        if (MODE == 3) {
            asm volatile("" ::: "memory");
#pragma unroll
            for (int i = 0; i < 8; ++i) *(f32x4*)(c.A.out + (size_t)row * D_ + i * 256 + lane * 4) = v[i] * rinv * ga[i];
        } else {
            f32x4 sha[8], sca[8];
#pragma unroll
            for (int i = 0; i < 8; ++i) { sha[i] = *(const f32x4*)(msh + (size_t)b * MODW + i * 256 + lane * 4); sca[i] = *(const f32x4*)(msc + (size_t)b * MODW + i * 256 + lane * 4); }
            asm volatile("" ::: "memory");
#pragma unroll
            for (int i = 0; i < 8; ++i) {
                const f32x4 g = ga[i], sh = sha[i], sc = sca[i];
                v[i] = (v[i] * rinv * g) * (1.0f + sc) + sh;
                u32x2 w; w.x = pk2(v[i][0], v[i][1]); w.y = pk2(v[i][2], v[i][3]);
                *(u32x2*)(hdst + (size_t)row * D_ + i * 256 + lane * 4) = w;
            }
            if (MODE == 1) {
                float pa_[16];
                f32x4 rA[8], rB[8];
#define RT_RD(dst, e_) do { _Pragma("unroll") for (int i = 0; i < 8; ++i) dst[i] = *(LDSP f32x4*)(rwT + (e_) * 2048 + i * 256 + lane * 4); asm volatile("" ::: "memory"); } while (0)
#define RT_DOT(src, e_) do { float a = 0.f; _Pragma("unroll") for (int i = 0; i < 8; ++i) a += v[i][0] * src[i][0] + v[i][1] * src[i][1] + v[i][2] * src[i][2] + v[i][3] * src[i][3]; pa_[e_] = a; } while (0)
                RT_RD(rA, 0);
#pragma unroll
                for (int e = 0; e < 16; e += 2) { RT_RD(rB, e + 1); RT_DOT(rA, e); if (e + 2 < 16) RT_RD(rA, e + 2); RT_DOT(rB, e + 1); }
#undef RT_RD
#undef RT_DOT
                float lg[16];
                { const bool b5 = lane & 32, b4 = lane & 16, b3 = lane & 8, b2 = lane & 4;
                  float b_[8], c_[4], d_[2];
#pragma unroll
                  for (int i = 0; i < 8; ++i) { const float snd = b5 ? pa_[i] : pa_[i + 8]; b_[i] = (b5 ? pa_[i + 8] : pa_[i]) + __shfl_xor(snd, 32); }
#pragma unroll
                  for (int i = 0; i < 4; ++i) { const float snd = b4 ? b_[i] : b_[i + 4]; c_[i] = (b4 ? b_[i + 4] : b_[i]) + __shfl_xor(snd, 16); }
#pragma unroll
                  for (int i = 0; i < 2; ++i) { const float snd = b3 ? c_[i] : c_[i + 2]; d_[i] = (b3 ? c_[i + 2] : c_[i]) + __shfl_xor(snd, 8); }
                  float e_ = (b2 ? d_[1] : d_[0]) + __shfl_xor(b2 ? d_[0] : d_[1], 4);
                  e_ += __shfl_xor(e_, 2); e_ += __shfl_xor(e_, 1);
#pragma unroll
                  for (int e = 0; e < 16; ++e) lg[e] = __int_as_float(__builtin_amdgcn_readlane(__float_as_int(e_), 4 * e)); }
                const RouteOut r = route16(lg, c.A.in[15]);
                if (lane == 0) {
                    int* RIDX = (int*)(c.ws + WS_RIDX); float* RW = (float*)(c.ws + WS_RW);
                    RIDX[row * 2] = r.i0; RIDX[row * 2 + 1] = r.i1; RW[row * 2] = r.w0; RW[row * 2 + 1] = r.w1;
                    atomicAdd((int*)(cnt + r.i0), 1); atomicAdd((int*)(cnt + r.i1), 1);
                }
            }
        }
        cur = nxt;
    }
    if (MODE == 1) {
        __syncthreads();
        if (c.tid < 16) ((int*)(c.ws + WS_BLKCNT))[c.bid * 16 + c.tid] = cnt[c.tid];
    }
}

__device__ __forceinline__ void dispatch_phase(const Ctx& c) {
    LDSP int* tot = (LDSP int*)c.lds;
    LDSP int* pre = tot + 16;
    LDSP int* start = tot + 32;
    LDSP int* pstart = tot + 48;
    LDSP int* ea = tot + 80;
    LDSP int* sl = tot + 208;
    if (c.tid < 32) tot[c.tid] = 0;
    __syncthreads();
    const int* BLKCNT = (const int*)(c.ws + WS_BLKCNT);
    for (int idx = c.tid; idx < c.G * 16; idx += NTHR) {
        const int v = ld_i(BLKCNT + idx), e = idx & 15, bl = idx >> 4;
        atomicAdd((int*)(tot + e), v); if (bl < c.bid) atomicAdd((int*)(pre + e), v);
    }
    __syncthreads();
    if (c.tid == 0) {
        int run = 0;
        for (int e = 0; e < 16; ++e) { pstart[e] = run; start[e] = run + pre[e]; run += (tot[e] + 255) / 256 * 256; }
        pstart[16] = run;
    }
    __syncthreads();
    if (c.bid == 0 && c.tid < 17) ((int*)(c.ws + WS_TAB))[c.tid] = pstart[c.tid] >> 8;
    const int* RIDX = (const int*)(c.ws + WS_RIDX); const float* RW = (const float*)(c.ws + WS_RW);
    const int nw = c.G * NWAVE;
    if (c.tid < 128) { const int a = c.tid, wv = a >> 4, i = (a >> 1) & 7, k = a & 1; const int row = (c.bid * NWAVE + wv) + i * nw; ea[a] = ld_i(RIDX + row * 2 + k); }
    __syncthreads();
    if (c.tid < 128) {
        const int a = c.tid, wv = a >> 4, i = (a >> 1) & 7, k = a & 1; const int row = (c.bid * NWAVE + wv) + i * nw;
        const int e = ea[a]; int rank = 0;
        for (int j = 0; j < a; ++j) rank += (ea[j] == e) ? 1 : 0;
        const int slot = start[e] + rank; sl[a] = slot;
        ((int*)(c.ws + WS_TOKSLOT))[row * 2 + k] = slot;
        ((float*)(c.ws + WS_SLOTW))[slot] = ld_f(RW + row * 2 + k);
        ((int*)(c.ws + WS_SLOTTOK))[slot] = row;
    }
    if (c.bid == 0) {
        for (int e = 0; e < 16; ++e) for (int s = pstart[e] + tot[e] + c.tid; s < pstart[e + 1]; s += NTHR) { ((float*)(c.ws + WS_SLOTW))[s] = 0.f; ((int*)(c.ws + WS_SLOTTOK))[s] = 0; }
    }
}

template <bool BASE_F32> struct EpiResid {
    static constexpr bool PERM = true, AFTER_DRAIN = false;
    const void* base; bf16_t* out; const float* gate;
    __device__ __forceinline__ void operator()(const pg8::f32x4 (&acc)[2][2][4][2], const pg8::Unit& u, int wr, int wc, int fr, int fq) const {
        const int row0 = u.pm * 256 + wr * 64 + fr, col0 = u.pn * 256 + wc * 32 + 8 * fq, b = u.pm >> 3;
        pg8::f32x4 gv[2][2];
#pragma unroll
        for (int bj = 0; bj < 2; ++bj)
#pragma unroll
            for (int n = 0; n < 2; ++n) gv[bj][n] = *(const pg8::f32x4*)(gate + (size_t)b * MODW + col0 + bj * 128 + n * 4);
#pragma unroll
        for (int ai = 0; ai < 2; ++ai) {
            pg8::f32x4 b0[4][2], b1[4][2];
#pragma unroll
            for (int m = 0; m < 4; ++m) { const size_t off = (size_t)(row0 + ai * 128 + m * 16) * D_ + col0;
#pragma unroll
                for (int bj = 0; bj < 2; ++bj) {
                    if (BASE_F32) { b0[m][bj] = *(const pg8::f32x4*)((const float*)base + off + bj * 128); b1[m][bj] = *(const pg8::f32x4*)((const float*)base + off + bj * 128 + 4); }
                    else { const pg8::u32x4 w = *(const pg8::u32x4*)((const bf16_t*)base + off + bj * 128);
                        b0[m][bj] = (pg8::f32x4){__uint_as_float(w.x << 16), __uint_as_float(w.x & 0xffff0000u), __uint_as_float(w.y << 16), __uint_as_float(w.y & 0xffff0000u)};
                        b1[m][bj] = (pg8::f32x4){__uint_as_float(w.z << 16), __uint_as_float(w.z & 0xffff0000u), __uint_as_float(w.w << 16), __uint_as_float(w.w & 0xffff0000u)}; } } }
            asm volatile("" ::: "memory");
#pragma unroll
            for (int m = 0; m < 4; ++m) { const size_t off = (size_t)(row0 + ai * 128 + m * 16) * D_ + col0;
#pragma unroll
                for (int bj = 0; bj < 2; ++bj) {
                    const pg8::f32x4 v0 = b0[m][bj] + gv[bj][0] * acc[ai][bj][m][0], v1 = b1[m][bj] + gv[bj][1] * acc[ai][bj][m][1];
                    pg8::u32x4 q; q.x = pg8::cvt_pk_bf16(v0[0], v0[1]); q.y = pg8::cvt_pk_bf16(v0[2], v0[3]); q.z = pg8::cvt_pk_bf16(v1[0], v1[1]); q.w = pg8::cvt_pk_bf16(v1[2], v1[3]);
                    *(pg8::u32x4*)(out + off + bj * 128) = q; } }
            asm volatile("" ::: "memory");
        }
    }
};
struct EpiDilProj {
    static constexpr bool PERM = true, AFTER_DRAIN = false;
    bf16_t* O;
    __device__ __forceinline__ void operator()(const pg8::f32x4 (&acc)[2][2][4][2], const pg8::Unit& u, int wr, int wc, int fr, int fq) const {
        const int sec = u.pn >> 3, b = u.pm >> 3, lg = sec < 3 ? 0 : (sec < 5 ? 2 : 4), d = wc * 32 + 8 * fq;
        const int t0 = (u.pm & 7) * 256 + wr * 64 + fr;
#pragma unroll
        for (int ai = 0; ai < 2; ++ai)
#pragma unroll
            for (int m = 0; m < 4; ++m) { const int t = t0 + ai * 128 + m * 16; const int pos = ((t & ((1 << lg) - 1)) << (11 - lg)) + (t >> lg);
#pragma unroll
                for (int bj = 0; bj < 2; ++bj) { const int h = (u.pn & 7) * 2 + bj;
                    const pg8::f32x4 v0 = acc[ai][bj][m][0], v1 = acc[ai][bj][m][1];
                    pg8::u32x4 w; w.x = pg8::cvt_pk_bf16(v0[0], v0[1]); w.y = pg8::cvt_pk_bf16(v0[2], v0[3]); w.z = pg8::cvt_pk_bf16(v1[0], v1[1]); w.w = pg8::cvt_pk_bf16(v1[2], v1[3]);
                    *(pg8::u32x4*)(O + ((((size_t)sec * 8 + b) * 16 + h) * 2048 + pos) * 128 + d) = w; } }
    }
};
struct EpiSwiglu {
    static constexpr bool PERM = true, AFTER_DRAIN = false;
    bf16_t* Hd;
    __device__ __forceinline__ void operator()(const pg8::f32x4 (&acc)[2][2][4][2], const pg8::Unit& u, int wr, int wc, int fr, int fq) const {
        const int row0 = u.pm * 256 + wr * 64 + fr, j = u.pn % 11, col = j * 128 + wc * 32 + 8 * fq;
#pragma unroll
        for (int ai = 0; ai < 2; ++ai)
#pragma unroll
            for (int m = 0; m < 4; ++m) {
                float o[8];
#pragma unroll
                for (int n = 0; n < 2; ++n)
#pragma unroll
                    for (int i = 0; i < 4; ++i) { const float g = acc[ai][0][m][n][i], up = acc[ai][1][m][n][i]; o[n * 4 + i] = g / (1.f + __expf(-g)) * up; }
                pg8::u32x4 w; w.x = pg8::cvt_pk_bf16(o[0], o[1]); w.y = pg8::cvt_pk_bf16(o[2], o[3]); w.z = pg8::cvt_pk_bf16(o[4], o[5]); w.w = pg8::cvt_pk_bf16(o[6], o[7]);
                *(pg8::u32x4*)(Hd + (size_t)(row0 + ai * 128 + m * 16) * DE + col) = w;
            }
    }
};
struct EpiDown {
    static constexpr bool PERM = true, AFTER_DRAIN = false;
    bf16_t* Y; const float* sw;
    __device__ __forceinline__ void operator()(const pg8::f32x4 (&acc)[2][2][4][2], const pg8::Unit& u, int wr, int wc, int fr, int fq) const {
        const int row0 = u.pm * 256 + wr * 64 + fr, col0 = (u.pn & 7) * 256 + wc * 32 + 8 * fq;
        float wv[2][4];
#pragma unroll
        for (int ai = 0; ai < 2; ++ai)
#pragma unroll
            for (int m = 0; m < 4; ++m) wv[ai][m] = sw[row0 + ai * 128 + m * 16];
        asm volatile("" ::: "memory");
#pragma unroll
        for (int ai = 0; ai < 2; ++ai)
#pragma unroll
            for (int m = 0; m < 4; ++m) { const int row = row0 + ai * 128 + m * 16; const float w = wv[ai][m];
#pragma unroll
                for (int bj = 0; bj < 2; ++bj) { const pg8::f32x4 v0 = acc[ai][bj][m][0] * w, v1 = acc[ai][bj][m][1] * w;
                    pg8::u32x4 q; q.x = pg8::cvt_pk_bf16(v0[0], v0[1]); q.y = pg8::cvt_pk_bf16(v0[2], v0[3]); q.z = pg8::cvt_pk_bf16(v1[0], v1[1]); q.w = pg8::cvt_pk_bf16(v1[2], v1[3]);
                    *(pg8::u32x4*)(Y + (size_t)row * D_ + col0 + bj * 128) = q; } }
    }
};
struct MoeOrder {
    LDSP const int* bs;
    int G, vc, ncol;
    __device__ __forceinline__ bool next(int i, pg8::Unit& u) const {
        const int L = i * G + vc; if (L >= bs[16] * ncol) return false;
        int e = 0;
#pragma unroll
        for (int k = 1; k < 16; ++k) e += (L >= bs[k] * ncol) ? 1 : 0;
        const int b0 = bs[e], nb = bs[e + 1] - b0, r = L - b0 * ncol;
        const int j = r / nb, bi = r - j * nb;
        u.pm = b0 + bi; u.pn = e * ncol + j; return true;
    }
    __device__ __forceinline__ void a_ready(const pg8::Unit&) const {}
    __device__ __forceinline__ void done(const pg8::Unit&) const {}
};
__device__ __forceinline__ void moe_tab_to_lds(const Ctx& c) {
    LDSP int* bs = (LDSP int*)(c.lds + LDS_MISC);
    if (c.tid < 17) bs[c.tid] = ld_i((const int*)(c.ws + WS_TAB) + c.tid);
    __syncthreads();
}

__device__ __forceinline__ float gelu_tanh(float x) { const float u = 0.7978845608028654f * (x + 0.044715f * x * x * x); return 0.5f * x * (1.f + tanhf(u)); }
__device__ __forceinline__ void compress_phase(const Ctx& c) {
    LDSP float* tok = (LDSP float*)c.lds;
    LDSP float* pos = (LDSP float*)(c.lds + 73728);
    LDSP float* part = (LDSP float*)(c.lds + 73728 + 16384);
    LDSP float* hid = (LDSP float*)(c.lds + 73728 + 32768);
    const bf16_t* proj = (const bf16_t*)(c.ws + WS_PROJ);
    float* CMP = (float*)(c.ws + WS_CMP);
    for (int uu = c.bid; uu < (DUP_PH == 103 ? 2048 : 1024); uu += c.G) {
        const int u = uu & 1023, ch = u & 15, j = (u >> 4) & 1, g = (u >> 5) & 3, b = u >> 7, n0 = ch * 8;
        for (int idx = c.tid; idx < 144 * 16; idx += NTHR) {
            const int tl = idx >> 4, d8 = (idx & 15) * 8, t = n0 * 16 + tl;
            u32x4 w = (u32x4){0u, 0u, 0u, 0u};
            if (t < S_) w = *(const u32x4*)(proj + (size_t)(b * S_ + t) * PW0 + 2048 + j * 512 + g * 128 + d8);
            LDSP float* dp = tok + tl * 128 + d8;
            dp[0] = __uint_as_float(w.x << 16); dp[1] = __uint_as_float(w.x & 0xffff0000u); dp[2] = __uint_as_float(w.y << 16); dp[3] = __uint_as_float(w.y & 0xffff0000u);
            dp[4] = __uint_as_float(w.z << 16); dp[5] = __uint_as_float(w.z & 0xffff0000u); dp[6] = __uint_as_float(w.w << 16); dp[7] = __uint_as_float(w.w & 0xffff0000u);
        }
        for (int idx = c.tid; idx < 4096; idx += NTHR) pos[idx] = c.A.in[10][j * 4096 + idx];
        __syncthreads();
        const int e = c.tid & 127, q = c.tid >> 7;
        float acc[8];
#pragma unroll
        for (int i = 0; i < 8; ++i) acc[i] = 0.f;
        const float* w1 = c.A.in[8] + (size_t)j * 32 * 128 * 128;
        for (int l = q * 8; l < q * 8 + 8; ++l) {
#pragma unroll 4
            for (int d = 0; d < 128; ++d) {
                const float w = w1[((size_t)l * 128 + d) * 128 + e]; const float p = pos[l * 128 + d];
#pragma unroll
                for (int i = 0; i < 8; ++i) acc[i] += (tok[(16 * i + l) * 128 + d] + p) * w;
            }
        }
#pragma unroll
        for (int i = 0; i < 8; ++i) part[(q * 8 + i) * 128 + e] = acc[i];
        __syncthreads();
        for (int idx = c.tid; idx < 1024; idx += NTHR) { const int i = idx >> 7, ee = idx & 127; hid[idx] = gelu_tanh(part[(0 * 8 + i) * 128 + ee] + part[(1 * 8 + i) * 128 + ee] + part[(2 * 8 + i) * 128 + ee] + part[(3 * 8 + i) * 128 + ee]); }
        __syncthreads();
        const float* w2 = c.A.in[9] + (size_t)j * 128 * 128;
        for (int idx = c.tid; idx < 1024; idx += NTHR) {
            const int i = idx >> 7, f = idx & 127, n = n0 + i; float s = 0.f;
            for (int ee = 0; ee < 128; ++ee) s += hid[i * 128 + ee] * w2[ee * 128 + f];
            if (n < 127) CMP[((((size_t)j * 8 + b) * 128 + n) * 4 + g) * 128 + f] = s;
            ((bf16_t*)(c.ws + WS_CMPB))[((((size_t)j * 8 + b) * 128 + n) * 4 + g) * 128 + f] = (n < 127) ? f2bf(s) : (bf16_t)0;
        }
        __syncthreads();
    }
}

__device__ __forceinline__ void compress_mfma_phase(const Ctx& c) {
    typedef short bf16x8 __attribute__((ext_vector_type(8)));
    LDSP char* lds = (LDSP char*)c.lds;
    LDSP float* red = (LDSP float*)c.lds;
    LDSP float* hid = (LDSP float*)(c.lds + 69632);
    const bf16_t* proj = (const bf16_t*)(c.ws + WS_PROJ);
    const bf16_t* W1T = (const bf16_t*)(c.ws + WS_W1T);
    const float* POSB = (const float*)(c.ws + WS_POSB);
    float* CMP = (float*)(c.ws + WS_CMP); bf16_t* CMPB = (bf16_t*)(c.ws + WS_CMPB);
    const int lane = c.lane, wid = c.wave;
    for (int uu = c.bid; uu < (DUP_PH == 103 ? 1024 : 512); uu += c.G) {
        const int u = uu & 511, nb = u & 7, j = (u >> 3) & 1, g = (u >> 4) & 3, b = u >> 6, n0 = nb * 16;
        __syncthreads();
        for (int idx = c.tid; idx < 272 * 16; idx += NTHR) {
            const int tl = idx >> 4, ch = idx & 15, t = n0 * 16 + tl;
            u32x4 w = (u32x4){0u, 0u, 0u, 0u};
            if (t < S_) w = *(const u32x4*)(proj + (size_t)(b * S_ + t) * PW0 + 2048 + j * 512 + g * 128 + ch * 8);
            *(LDSP u32x4*)(lds + tl * 256 + ((ch ^ ((tl >> 4) & 15)) << 4)) = w;
        }
        __syncthreads();
        f32x4 acc[8];
#pragma unroll
        for (int cb = 0; cb < 8; ++cb) acc[cb] = (f32x4){0.f, 0.f, 0.f, 0.f};
        const int r = lane & 15, kg = lane >> 4;
        const bf16_t* wb = W1T + ((size_t)(j * 128 + r) * 4096 + kg * 8);
#pragma unroll 2
        for (int s = 0; s < 16; ++s) {
            const int ks = wid * 16 + s, l = ks >> 2, ch = (ks & 3) * 4 + kg, tl = 16 * r + l;
            const bf16x8 a = *(LDSP const bf16x8*)(lds + tl * 256 + ((ch ^ ((tl >> 4) & 15)) << 4));
            bf16x8 bf[8];
#pragma unroll
            for (int cb = 0; cb < 8; ++cb) bf[cb] = *(const bf16x8*)(wb + (size_t)cb * 16 * 4096 + ks * 32);
#pragma unroll
            for (int cb = 0; cb < 8; ++cb) acc[cb] = __builtin_amdgcn_mfma_f32_16x16x32_bf16(a, bf[cb], acc[cb], 0, 0, 0);
        }
        __syncthreads();
#pragma unroll
        for (int cb = 0; cb < 8; ++cb)
#pragma unroll
            for (int i = 0; i < 4; ++i) red[(wid * 16 + kg * 4 + i) * 128 + cb * 16 + r] = acc[cb][i];
        __syncthreads();
        { const int row = c.tid >> 5, e4 = (c.tid & 31) * 4;
          f32x4 s = (f32x4){0.f, 0.f, 0.f, 0.f};
#pragma unroll 8
          for (int p = 0; p < 32; ++p) s += *(const f32x4*)(POSB + (j * 32 + p) * 128 + e4);
#pragma unroll
          for (int w = 0; w < 8; ++w) s += *(LDSP const f32x4*)(red + (w * 16 + row) * 128 + e4);
          f32x4 h; h[0] = gelu_tanh(s[0]); h[1] = gelu_tanh(s[1]); h[2] = gelu_tanh(s[2]); h[3] = gelu_tanh(s[3]);
          *(LDSP f32x4*)(hid + row * 128 + e4) = h; }
        __syncthreads();
        { const int row = c.tid >> 5, f4 = (c.tid & 31) * 4, n = n0 + row;
          const float* w2 = c.A.in[9] + (size_t)j * 128 * 128 + f4;
          f32x4 s = (f32x4){0.f, 0.f, 0.f, 0.f};
#pragma unroll 8
          for (int e = 0; e < 128; ++e) s += hid[row * 128 + e] * *(const f32x4*)(w2 + e * 128);
          const size_t o = ((((size_t)j * 8 + b) * 128 + n) * 4 + g) * 128 + f4;
          if (n < 127) *(f32x4*)(CMP + o) = s; else s = (f32x4){0.f, 0.f, 0.f, 0.f};
          u32x2 w; w.x = pk2(s[0], s[1]); w.y = pk2(s[2], s[3]); *(u32x2*)(CMPB + o) = w; }
    }
}

__device__ __forceinline__ void dots_bf16(const bf16_t* krow, bool ok, LDSP const float* qs, float (&s)[4]) {
    s[0] = s[1] = s[2] = s[3] = 0.f;
    if (!ok) return;
#pragma unroll 4
    for (int d8 = 0; d8 < 16; ++d8) {
        const u32x4 w = *(const u32x4*)(krow + d8 * 8);
        float k[8] = {__uint_as_float(w.x << 16), __uint_as_float(w.x & 0xffff0000u), __uint_as_float(w.y << 16), __uint_as_float(w.y & 0xffff0000u),
                      __uint_as_float(w.z << 16), __uint_as_float(w.z & 0xffff0000u), __uint_as_float(w.w << 16), __uint_as_float(w.w & 0xffff0000u)};
#pragma unroll
        for (int h = 0; h < 4; ++h) {
            const f32x4 qa = *(LDSP const f32x4*)(qs + h * 128 + d8 * 8), qb = *(LDSP const f32x4*)(qs + h * 128 + d8 * 8 + 4);
            s[h] += k[0] * qa[0] + k[1] * qa[1] + k[2] * qa[2] + k[3] * qa[3] + k[4] * qb[0] + k[5] * qb[1] + k[6] * qb[2] + k[7] * qb[3];
        }
    }
}
__device__ __forceinline__ void online_tile(const float (&s)[4], const bool valid, float (&m)[4], float (&l)[4], f32x2 (&acc)[4], LDSP float* pl,
                                            const bf16_t* vbase, size_t vstride, int kcount, int lane) {
#pragma unroll
    for (int h = 0; h < 4; ++h) {
        const float sv = valid ? s[h] : -__builtin_inff();
        const float tm = wmax(sv); const float mn = fmaxf(m[h], tm);
        float alpha = 1.f, p = 0.f;
        if (mn > -__builtin_inff()) { alpha = __expf(m[h] - mn); p = valid ? __expf(sv - mn) : 0.f; }
        l[h] = l[h] * alpha + wsum(p); acc[h] *= alpha; m[h] = mn;
        pl[h * 64 + lane] = p;
    }
    lds_fence();
    for (int k = 0; k < kcount; ++k) {
        const unsigned w = *(const unsigned*)(vbase + (size_t)k * vstride + 2 * lane);
        const f32x2 v = {__uint_as_float(w << 16), __uint_as_float(w & 0xffff0000u)};
#pragma unroll
        for (int h = 0; h < 4; ++h) acc[h] += pl[h * 64 + k] * v;
    }
    lds_fence();
}
__device__ __forceinline__ void nsa_attn_ref_phase(const Ctx& c) {
    LDSP float* wl = (LDSP float*)(c.lds + c.wave * 8192);
    LDSP float* qs = wl;
    LDSP float* pl = wl + 512;
    LDSP float* ps = wl + 1024;
    const bf16_t* proj = (const bf16_t*)(c.ws + WS_PROJ);
    const float* CMP = (const float*)(c.ws + WS_CMP);
    bf16_t* O = (bf16_t*)(c.ws + WS_O);
    const int lane = c.lane, nw = c.G * NWAVE;
    const float scale = 0.08838834764831845f;
    for (int u = c.bid * NWAVE + c.wave; u < B_ * S_ * 4; u += nw) {
        const int g = u & 3, t = (u >> 2) & 2047, b = u >> 13;
        const bf16_t* prow = proj + (size_t)(b * S_ + t) * PW0;
        { const u32x4 w = *(const u32x4*)(prow + g * 512 + lane * 8); LDSP float* qd = qs + lane * 8;
          qd[0] = __uint_as_float(w.x << 16) * scale; qd[1] = __uint_as_float(w.x & 0xffff0000u) * scale; qd[2] = __uint_as_float(w.y << 16) * scale; qd[3] = __uint_as_float(w.y & 0xffff0000u) * scale;
          qd[4] = __uint_as_float(w.z << 16) * scale; qd[5] = __uint_as_float(w.z & 0xffff0000u) * scale; qd[6] = __uint_as_float(w.w << 16) * scale; qd[7] = __uint_as_float(w.w & 0xffff0000u) * scale; }
        lds_fence();
        float slope[4], gate[4][3];
#pragma unroll
        for (int h = 0; h < 4; ++h) { slope[h] = exp2f(-0.5f * (float)(4 * g + h + 1));
#pragma unroll
            for (int j = 0; j < 3; ++j) { const float x = bf2f(prow[5120 + (4 * g + h) * 3 + j]); gate[h][j] = 1.f / (1.f + __expf(-x)); } }
        f32x2 ofin[4];
        {
            float s0[4], s1[4]; bool v0, v1;
            { const int n = lane; v0 = (16 * n + 31 <= t); const float* kp = CMP + (((size_t)b * 128 + n) * 4 + g) * 128;
              s0[0] = s0[1] = s0[2] = s0[3] = 0.f;
              if (v0) for (int d = 0; d < 128; d += 4) { const f32x4 k = *(const f32x4*)(kp + d);
#pragma unroll
                  for (int h = 0; h < 4; ++h) { const f32x4 q = *(LDSP const f32x4*)(qs + h * 128 + d); s0[h] += k[0] * q[0] + k[1] * q[1] + k[2] * q[2] + k[3] * q[3]; } } }
            { const int n = lane + 64; v1 = (n < 127) && (16 * n + 31 <= t); const float* kp = CMP + (((size_t)b * 128 + n) * 4 + g) * 128;
              s1[0] = s1[1] = s1[2] = s1[3] = 0.f;
              if (v1) for (int d = 0; d < 128; d += 4) { const f32x4 k = *(const f32x4*)(kp + d);
#pragma unroll
                  for (int h = 0; h < 4; ++h) { const f32x4 q = *(LDSP const f32x4*)(qs + h * 128 + d); s1[h] += k[0] * q[0] + k[1] * q[1] + k[2] * q[2] + k[3] * q[3]; } } }
            float psum0 = 0.f, psum1 = 0.f;
#pragma unroll
            for (int h = 0; h < 4; ++h) {
                const float a0 = v0 ? s0[h] - slope[h] * ((float)t - (16.f * lane + 15.5f)) : -__builtin_inff();
                const float a1 = v1 ? s1[h] - slope[h] * ((float)t - (16.f * (lane + 64) + 15.5f)) : -__builtin_inff();
                const float mx = wmax(fmaxf(a0, a1));
                const float e0 = v0 ? __expf(a0 - mx) : 0.f, e1 = v1 ? __expf(a1 - mx) : 0.f;
                const float sum = wsum(e0 + e1), inv = 1.f / fmaxf(sum, 1e-30f);
                const float p0 = e0 * inv, p1 = e1 * inv;
                pl[h * 128 + lane] = p0; pl[h * 128 + 64 + lane] = p1; psum0 += p0; psum1 += p1;
            }
            ps[1 + lane] = psum0; ps[65 + lane] = psum1; if (lane == 0) { ps[0] = 0.f; ps[129] = 0.f; }
            lds_fence();
            f32x2 acc[4];
#pragma unroll
            for (int h = 0; h < 4; ++h) acc[h] = (f32x2){0.f, 0.f};
            const int nvis = t >= 31 ? ((t - 31) >> 4) + 1 : 0;
            const float* vp = CMP + ((((size_t)8 + b) * 128) * 4 + g) * 128 + 2 * lane;
            for (int n = 0; n < nvis; ++n) { const f32x2 v = *(const f32x2*)(vp + (size_t)n * 512);
#pragma unroll
                for (int h = 0; h < 4; ++h) acc[h] += pl[h * 128 + n] * v; }
#pragma unroll
            for (int h = 0; h < 4; ++h) ofin[h] = gate[h][0] * acc[h];
        }
        unsigned selmask;
        {
            const int j = lane & 31, cur = t >> 6;
            const float imp = ps[4 * j] + 2.f * (ps[1 + 4 * j] + ps[2 + 4 * j] + ps[3 + 4 * j]) + ps[4 + 4 * j];
            const bool forced = (j == 0) || (j == cur) || (j == cur - 1), causal = (64 * j <= t);
            const float score = forced ? 1.0e6f : (causal ? imp : -1.0f);
            int rank = 0;
            for (int i = 0; i < 32; ++i) { const float si = __shfl(score, i); rank += ((si > score) || (si == score && i < j)) ? 1 : 0; }
            selmask = (unsigned)__ballot(rank < 16 && lane < 32);
            if (lane == 0) ((unsigned*)(c.ws + WS_SEL))[((size_t)b * 4 + g) * 2048 + t] = selmask;
        }
        lds_fence();
        {
            float m[4], l[4]; f32x2 acc[4];
#pragma unroll
            for (int h = 0; h < 4; ++h) { m[h] = -__builtin_inff(); l[h] = 0.f; acc[h] = (f32x2){0.f, 0.f}; }
            for (int j = 0; j < 32; ++j) {
                if (!((selmask >> j) & 1u)) continue;
                if (64 * j > t) continue;
                const int kpos = 64 * j + lane, dist = t - kpos; const bool valid = dist >= 0;
                const bf16_t* kb = proj + (size_t)(b * S_ + kpos) * PW0 + 2048 + 1024 + g * 128;
                float s[4]; dots_bf16(kb, valid, qs, s);
#pragma unroll
                for (int h = 0; h < 4; ++h) s[h] -= slope[h] * (float)dist;
                online_tile(s, valid, m, l, acc, pl, proj + (size_t)(b * S_ + 64 * j) * PW0 + 2048 + 1536 + g * 128, PW0, min(64, t - 64 * j + 1), lane);
            }
#pragma unroll
            for (int h = 0; h < 4; ++h) ofin[h] += (gate[h][1] / l[h]) * acc[h];
        }
        {
            float m[4], l[4]; f32x2 acc[4];
#pragma unroll
            for (int h = 0; h < 4; ++h) { m[h] = -__builtin_inff(); l[h] = 0.f; acc[h] = (f32x2){0.f, 0.f}; }
            for (int i = 0; i < 8; ++i) {
                const int k0 = t - 511 + 64 * i; if (k0 + 63 < 0) continue;
                const int kpos = k0 + lane, dist = t - kpos; const bool valid = kpos >= 0;
                const bf16_t* kb = proj + (size_t)(b * S_ + (valid ? kpos : 0)) * PW0 + 2048 + 2048 + g * 128;
                float s[4]; dots_bf16(kb, valid, qs, s);
#pragma unroll
                for (int h = 0; h < 4; ++h) s[h] -= slope[h] * (float)dist;
                const int kfirst = k0 < 0 ? -k0 : 0;
#pragma unroll
                for (int h = 0; h < 4; ++h) {
                    const float sv = valid ? s[h] : -__builtin_inff();
                    const float tm = wmax(sv); const float mn = fmaxf(m[h], tm);
                    float alpha = 1.f, p = 0.f;
                    if (mn > -__builtin_inff()) { alpha = __expf(m[h] - mn); p = valid ? __expf(sv - mn) : 0.f; }
                    l[h] = l[h] * alpha + wsum(p); acc[h] *= alpha; m[h] = mn; pl[h * 64 + lane] = p;
                }
                lds_fence();
                const bf16_t* vb = proj + 2048 + 2560 + g * 128 + 2 * lane;
                for (int k = kfirst; k < 64; ++k) {
                    const unsigned w = *(const unsigned*)(vb + (size_t)(b * S_ + k0 + k) * PW0);
                    const f32x2 v = {__uint_as_float(w << 16), __uint_as_float(w & 0xffff0000u)};
#pragma unroll
                    for (int h = 0; h < 4; ++h) acc[h] += pl[h * 64 + k] * v;
                }
                lds_fence();
            }
#pragma unroll
            for (int h = 0; h < 4; ++h) ofin[h] += (gate[h][2] / l[h]) * acc[h];
        }
#pragma unroll
        for (int h = 0; h < 4; ++h) *(unsigned*)(O + (size_t)(b * S_ + t) * D_ + (4 * g + h) * 128 + 2 * lane) = pk2(ofin[h][0], ofin[h][1]);
        lds_fence();
    }
}

__device__ __forceinline__ void dil_attn_ref_phase(const Ctx& c) {
    LDSP float* wl = (LDSP float*)(c.lds + c.wave * 8192);
    LDSP float* qs = wl;
    LDSP float* pl = wl + 128;
    const bf16_t* proj = (const bf16_t*)(c.ws + WS_PROJ);
    bf16_t* O = (bf16_t*)(c.ws + WS_O);
    const int lane = c.lane, nw = c.G * NWAVE;
    const float scale = 0.08838834764831845f;
    for (int u = c.bid * NWAVE + c.wave; u < B_ * S_ * 16; u += nw) {
        const int h = u & 15, t = (u >> 4) & 2047, b = u >> 15;
        const bf16_t* prow = proj + (size_t)(b * S_ + t) * PW1;
        { const unsigned w = *(const unsigned*)(prow + h * 128 + 2 * lane); qs[2 * lane] = __uint_as_float(w << 16) * scale; qs[2 * lane + 1] = __uint_as_float(w & 0xffff0000u) * scale; }
        lds_fence();
        const float slope = exp2f(-0.5f * (float)(h + 1));
        float lse[3]; f32x2 og[3];
#pragma unroll
        for (int gi = 0; gi < 3; ++gi) {
            const int r = gi == 0 ? 1 : gi == 1 ? 4 : 16;
            const int uq = t / r; const int imax = uq < 128 ? uq : 128;
            const size_t koff = 2048 + (size_t)gi * 4096 + h * 128, voff = koff + 2048;
            float m = -__builtin_inff(), l = 0.f; f32x2 acc = {0.f, 0.f};
            for (int tile = 0; tile * 64 <= imax; ++tile) {
                const int i = tile * 64 + lane; const bool valid = i <= imax;
                float s = 0.f;
                if (valid) { const bf16_t* kr = proj + (size_t)(b * S_ + t - r * i) * PW1 + koff;
                    for (int d8 = 0; d8 < 16; ++d8) { const u32x4 w = *(const u32x4*)(kr + d8 * 8);
                        const f32x4 qa = *(LDSP const f32x4*)(qs + d8 * 8), qb = *(LDSP const f32x4*)(qs + d8 * 8 + 4);
                        s += __uint_as_float(w.x << 16) * qa[0] + __uint_as_float(w.x & 0xffff0000u) * qa[1] + __uint_as_float(w.y << 16) * qa[2] + __uint_as_float(w.y & 0xffff0000u) * qa[3]
                           + __uint_as_float(w.z << 16) * qb[0] + __uint_as_float(w.z & 0xffff0000u) * qb[1] + __uint_as_float(w.w << 16) * qb[2] + __uint_as_float(w.w & 0xffff0000u) * qb[3]; }
                    s -= slope * (float)(r * i); }
                const float sv = valid ? s : -__builtin_inff();
                const float mn = fmaxf(m, wmax(sv));
                const float alpha = __expf(m - mn), p = valid ? __expf(sv - mn) : 0.f;
                l = l * alpha + wsum(p); acc *= alpha; m = mn; pl[lane] = p;
                lds_fence();
                const int kc = min(64, imax - tile * 64 + 1);
                for (int k = 0; k < kc; ++k) { const unsigned w = *(const unsigned*)(proj + (size_t)(b * S_ + t - r * (tile * 64 + k)) * PW1 + voff + 2 * lane);
                    acc += pl[k] * (f32x2){__uint_as_float(w << 16), __uint_as_float(w & 0xffff0000u)}; }
                lds_fence();
            }
            lse[gi] = m + __logf(l); og[gi] = acc * (1.f / l);
        }
        const float mx = fmaxf(lse[0], fmaxf(lse[1], lse[2]));
        const float w0 = __expf(lse[0] - mx), w1 = __expf(lse[1] - mx), w2 = __expf(lse[2] - mx), inv = 1.f / (w0 + w1 + w2);
        const f32x2 o = (w0 * inv) * og[0] + (w1 * inv) * og[1] + (w2 * inv) * og[2];
        *(unsigned*)(O + (size_t)(b * S_ + t) * D_ + h * 128 + 2 * lane) = pk2(o[0], o[1]);
        lds_fence();
    }
}


namespace att {
typedef __attribute__((address_space(1))) char gchar;
typedef __attribute__((address_space(1))) float gfloat;
typedef __attribute__((address_space(1))) unsigned gunsigned;
typedef short bf16x8 __attribute__((ext_vector_type(8)));
typedef short s16x4 __attribute__((ext_vector_type(4)));
typedef float f32x16 __attribute__((ext_vector_type(16)));
constexpr int SHM = 16384;
constexpr int OFF_V = 0, OFF_K = 3 * SHM, OFF_WS = 6 * SHM, OFF_MISC = 6 * SHM + 8 * 256;
constexpr int OFF_PS = OFF_MISC + 256, OFF_SC = OFF_PS + 8 * (8 * 129 * 4), OFF_GT = OFF_SC + 8 * 1024;
constexpr int OFF_AT = OFF_GT + 8 * 512;
constexpr int OFF_PS_ = 0;
constexpr float C2 = 0.08838834764831845f * 1.4426950408889634f;
constexpr float LOG2E = 1.4426950408889634f;
constexpr float THR = 6.0f;

#define ATT_KSWZ(row, colB) ((row) * 256 + ((colB) ^ (((row) & 15) << 4)))
#define ATT_SBAR() __builtin_amdgcn_sched_barrier(0)
__device__ __forceinline__ int v_st(int k, int c) { const int kk = (k & ~0xC) | ((k & 4) << 1) | ((k & 8) >> 1); return ((kk >> 3) * 4 + (c >> 5)) * 512 + ((kk & 7) * 32 + (c & 31)) * 2; }
__device__ __forceinline__ int v_rd_base(int lane) { return ((lane & 3) << 3) | (((lane >> 2) & 3) << 6) | (((lane >> 4) & 1) << 5) | (((lane >> 5) & 1) << 8); }
__device__ __forceinline__ int crow(int r, int hi) { return (r & 3) + 8 * (r >> 2) + 4 * hi; }
extern "C" __device__ float fmul_legacy_(float, float) __asm("llvm.amdgcn.fmul.legacy");
__device__ __forceinline__ unsigned cvtpk(float lo, float hi) { unsigned r; asm volatile("v_cvt_pk_bf16_f32 %0, %1, %2" : "=v"(r) : "v"(lo), "v"(hi)); return r; }

struct Lane { int lane, r32, hi, wid, tid; LDSP const char* at; int atmul; };

template <bool INIT = false>
__device__ __forceinline__ void qkt(f32x16& p0, f32x16& p1, LDSP const char* Kt, int r32, int hi, const bf16x8* qr, LDSP const char* at = nullptr) {
    if (INIT) {
        bf16x8 t_[8];
#pragma unroll
        for (int i = 0; i < 8; ++i) t_[i] = *reinterpret_cast<LDSP const bf16x8*>(at + 16 * i);
#pragma unroll
        for (int i = 0; i < 4; ++i) { const f32x4 a_ = *reinterpret_cast<const f32x4*>(&t_[i]), b_ = *reinterpret_cast<const f32x4*>(&t_[4 + i]);
            p0[4 * i] = a_[0]; p0[4 * i + 1] = a_[1]; p0[4 * i + 2] = a_[2]; p0[4 * i + 3] = a_[3]; p1[4 * i] = b_[0]; p1[4 * i + 1] = b_[1]; p1[4 * i + 2] = b_[2]; p1[4 * i + 3] = b_[3]; } }
    else { p0 = f32x16{}; p1 = f32x16{}; }
    int kb[4];
    int k0_ = ATT_KSWZ(r32, hi * 16); asm volatile("" : "+v"(k0_));
#pragma unroll
    for (int dd = 0; dd < 4; ++dd) kb[dd] = k0_ ^ (dd << 5);
    bf16x8 f[8][2];
#define ATT_KRD(d0) do { LDSP const char* a_ = Kt + (kb[(d0) & 3] ^ (((d0) >> 2) << 7)); f[d0][0] = *reinterpret_cast<LDSP const bf16x8*>(a_); f[d0][1] = *reinterpret_cast<LDSP const bf16x8*>(a_ + 32 * 256); } while (0)
    ATT_KRD(0); ATT_KRD(1); ATT_KRD(2);
#pragma unroll
    for (int d0 = 0; d0 < 8; ++d0) {
        ATT_SBAR();
        if (d0 + 3 < 8) { if (d0 == 0) ATT_KRD(3); else if (d0 == 1) ATT_KRD(4); else if (d0 == 2) ATT_KRD(5); else if (d0 == 3) ATT_KRD(6); else ATT_KRD(7); }
        p0 = __builtin_amdgcn_mfma_f32_32x32x16_bf16(f[d0][0], qr[d0], p0, 0, 0, 0);
        p1 = __builtin_amdgcn_mfma_f32_32x32x16_bf16(f[d0][1], qr[d0], p1, 0, 0, 0);
    }
#undef ATT_KRD
}
__device__ __forceinline__ void pv_tile(f32x16* o, int vb, bf16x8 pa0, bf16x8 pa1, bf16x8 pa2, bf16x8 pa3) {
#define ATT_TRRD(dst, off) asm volatile("ds_read_b64_tr_b16 %0, %1 offset:%2" : "=&v"(dst) : "v"(vb), "i"(off) : "memory")
#define ATT_RD8(S, d0) do { constexpr int b_ = (d0) * 512; ATT_TRRD(S##l0, b_); ATT_TRRD(S##h0, b_ + 2048); ATT_TRRD(S##l1, b_ + 4096); ATT_TRRD(S##h1, b_ + 6144); \
        ATT_TRRD(S##l2, b_ + 8192); ATT_TRRD(S##h2, b_ + 10240); ATT_TRRD(S##l3, b_ + 12288); ATT_TRRD(S##h3, b_ + 14336); } while (0)
#define ATT_MM4(S, d0) do { \
        o[d0] = __builtin_amdgcn_mfma_f32_32x32x16_bf16(pa0, (bf16x8){S##l0[0], S##l0[1], S##l0[2], S##l0[3], S##h0[0], S##h0[1], S##h0[2], S##h0[3]}, o[d0], 0, 0, 0); \
        o[d0] = __builtin_amdgcn_mfma_f32_32x32x16_bf16(pa1, (bf16x8){S##l1[0], S##l1[1], S##l1[2], S##l1[3], S##h1[0], S##h1[1], S##h1[2], S##h1[3]}, o[d0], 0, 0, 0); \
        o[d0] = __builtin_amdgcn_mfma_f32_32x32x16_bf16(pa2, (bf16x8){S##l2[0], S##l2[1], S##l2[2], S##l2[3], S##h2[0], S##h2[1], S##h2[2], S##h2[3]}, o[d0], 0, 0, 0); \
        o[d0] = __builtin_amdgcn_mfma_f32_32x32x16_bf16(pa3, (bf16x8){S##l3[0], S##l3[1], S##l3[2], S##l3[3], S##h3[0], S##h3[1], S##h3[2], S##h3[3]}, o[d0], 0, 0, 0); } while (0)
    s16x4 Al0, Al1, Al2, Al3, Ah0, Ah1, Ah2, Ah3, Bl0, Bl1, Bl2, Bl3, Bh0, Bh1, Bh2, Bh3;
    asm volatile("s_waitcnt lgkmcnt(0)" ::: "memory"); ATT_SBAR();
    ATT_RD8(A, 0); ATT_RD8(B, 1);
    asm volatile("s_waitcnt lgkmcnt(8)" ::: "memory"); ATT_SBAR(); ATT_MM4(A, 0); ATT_SBAR();
    ATT_RD8(A, 2);
    asm volatile("s_waitcnt lgkmcnt(8)" ::: "memory"); ATT_SBAR(); ATT_MM4(B, 1); ATT_SBAR();
    ATT_RD8(B, 3);
    asm volatile("s_waitcnt lgkmcnt(8)" ::: "memory"); ATT_SBAR(); ATT_MM4(A, 2); ATT_SBAR();
    asm volatile("s_waitcnt lgkmcnt(0)" ::: "memory"); ATT_SBAR(); ATT_MM4(B, 3);
#undef ATT_MM4
#undef ATT_RD8
#undef ATT_TRRD
}
__device__ __forceinline__ void mask_tile(f32x16& p0, f32x16& p1, int dq, unsigned W) {
    const float NEG = -__builtin_inff();
#pragma unroll
    for (int r = 0; r < 16; ++r) { const int cc = (r & 3) + 8 * (r >> 2);
        if ((unsigned)(dq - cc) >= W) p0[r] = NEG;
        if ((unsigned)(dq - cc - 32) >= W) p1[r] = NEG; }
}
__device__ __forceinline__ void alibi_tile(f32x16& p0, f32x16& p1, float sl2) {
#pragma unroll
    for (int r = 0; r < 16; ++r) { const float cc = (float)((r & 3) + 8 * (r >> 2)); p0[r] = fmaf(sl2, cc, p0[r]); p1[r] = fmaf(sl2, cc + 32.f, p1[r]); }
}
__device__ __forceinline__ void alibi_table_write(LDSP char* lds, int slot, int i, float sl2) {
    const int r = i & 15; ((LDSP float*)(lds + OFF_AT))[slot * 32 + i] = sl2 * (float)((r & 3) + 8 * (r >> 2) + (i & 16) * 2);
}
__device__ __forceinline__ void softmax_a(f32x16& p0, f32x16& p1, float base, float& m_reg, float& alpha) {
    float pmax = p0[0];
#pragma unroll
    for (int r = 1; r < 16; ++r) pmax = fmaxf(pmax, p0[r]);
#pragma unroll
    for (int r = 0; r < 16; ++r) pmax = fmaxf(pmax, p1[r]);
    pmax += base;
    { auto rr = __builtin_amdgcn_permlane32_swap(__float_as_uint(pmax), __float_as_uint(pmax), false, false); pmax = fmaxf(__uint_as_float(rr[0]), __uint_as_float(rr[1])); }
    float mn;
    if (__all(pmax - m_reg <= THR)) { mn = m_reg; alpha = 1.f; }
    else { mn = fmaxf(m_reg, pmax); alpha = __builtin_amdgcn_exp2f(m_reg - mn); m_reg = mn; }
    const float sub = mn - base;
#pragma unroll
    for (int r = 0; r < 16; ++r) p0[r] = __builtin_amdgcn_exp2f(p0[r] - sub);
#pragma unroll
    for (int r = 0; r < 16; ++r) p1[r] = __builtin_amdgcn_exp2f(p1[r] - sub);
}
__device__ __forceinline__ float rowsum2(const f32x16& p0, const f32x16& p1) {
    float ps = 0;
#pragma unroll
    for (int r = 0; r < 16; ++r) ps += p0[r];
#pragma unroll
    for (int r = 0; r < 16; ++r) ps += p1[r];
    auto rr = __builtin_amdgcn_permlane32_swap(__float_as_uint(ps), __float_as_uint(ps), false, false);
    return __uint_as_float(rr[0]) + __uint_as_float(rr[1]);
}
__device__ __forceinline__ void pack_p(const f32x16& p0, const f32x16& p1, bf16x8& pa0, bf16x8& pa1, bf16x8& pa2, bf16x8& pa3) {
#define ATT_PK4(P, B_, OUT) do { unsigned a0 = cvtpk(P[B_ + 0], P[B_ + 1]), a1 = cvtpk(P[B_ + 2], P[B_ + 3]); \
        unsigned b0 = cvtpk(P[B_ + 4], P[B_ + 5]), b1 = cvtpk(P[B_ + 6], P[B_ + 7]); \
        auto r0 = __builtin_amdgcn_permlane32_swap(a0, b0, false, false); auto r1 = __builtin_amdgcn_permlane32_swap(a1, b1, false, false); \
        u32x4 w = {r0[0], r1[0], r0[1], r1[1]}; OUT = *reinterpret_cast<bf16x8*>(&w); } while (0)
    ATT_PK4(p0, 0, pa0); ATT_PK4(p0, 8, pa1); ATT_PK4(p1, 0, pa2); ATT_PK4(p1, 8, pa3);
#undef ATT_PK4
}
__device__ __forceinline__ void scale_rows(f32x16* o, float f, LDSP float* xl, int r32, int hi) {
    if (hi == 0) xl[r32] = f;
    asm volatile("s_waitcnt lgkmcnt(0)" ::: "memory");
    float fr[16];
#pragma unroll
    for (int r = 0; r < 16; ++r) fr[r] = xl[crow(r, hi)];
#pragma unroll
    for (int d = 0; d < 4; ++d)
#pragma unroll
        for (int r = 0; r < 16; ++r) o[d][r] = fmul_legacy_(o[d][r], fr[r]);
    asm volatile("s_waitcnt lgkmcnt(0)" ::: "memory");
}
__device__ __forceinline__ bf16x8 scale8(u32x4 w, float s) {
    u32x4 o;
    o.x = cvtpk(__uint_as_float(w.x << 16) * s, __uint_as_float(w.x & 0xffff0000u) * s); o.y = cvtpk(__uint_as_float(w.y << 16) * s, __uint_as_float(w.y & 0xffff0000u) * s);
    o.z = cvtpk(__uint_as_float(w.z << 16) * s, __uint_as_float(w.z & 0xffff0000u) * s); o.w = cvtpk(__uint_as_float(w.w << 16) * s, __uint_as_float(w.w & 0xffff0000u) * s);
    return *reinterpret_cast<bf16x8*>(&o);
}
__device__ __forceinline__ bf16x8 aug_frag(unsigned dword0, int hi) { u32x4 w = {hi ? 0u : dword0, 0u, 0u, 0u}; return *reinterpret_cast<bf16x8*>(&w); }
__device__ __forceinline__ unsigned split_bf16(float x) {
    const unsigned hb = (unsigned)f2bf(x); const float rem = x - __uint_as_float(hb << 16); return hb | ((unsigned)f2bf(rem) << 16);
}

struct DmaMap { int m0, m1; };
__device__ __forceinline__ int dma_map1(int q) {
    const int krow = q >> 4, kcol = ((q & 15) ^ (krow & 15)) * 8;
    const int sub = q >> 5, kk = (sub >> 2) * 8 + ((q & 31) >> 2), vrow = (kk & ~0xC) | ((kk & 4) << 1) | ((kk & 8) >> 1), vcol = (sub & 3) * 32 + (q & 3) * 8;
    return krow | (kcol << 6) | (vrow << 13) | (vcol << 19);
}
__device__ __forceinline__ DmaMap dma_map(int wid, int lane) { DmaMap d; d.m0 = dma_map1(wid * 64 + lane); d.m1 = dma_map1(512 + wid * 64 + lane); return d; }
__device__ __forceinline__ void stage_dma(const DmaMap& dm, const bf16_t* Kb, const bf16_t* Vb, size_t stride, int row0, int rmax, LDSP char* lds, int buf, int wid, int which = 3) {
#pragma unroll
    for (int i = 0; i < 2; ++i) {
        const int m = i ? dm.m1 : dm.m0;
        if (which & 1) { int kr = row0 + (m & 63); kr = kr < 0 ? 0 : (kr > rmax ? rmax : kr);
            const bf16_t* ks = Kb + (size_t)kr * stride + ((m >> 6) & 127);
            __builtin_amdgcn_global_load_lds((const unsigned*)ks, (LDSP unsigned*)(lds + OFF_K + buf * SHM + i * 8192 + wid * 1024), 16, 0, 0); }
        if (which & 2) { int vr = row0 + ((m >> 13) & 63); vr = vr < 0 ? 0 : (vr > rmax ? rmax : vr);
            const bf16_t* vs = Vb + (size_t)vr * stride + ((m >> 19) & 127);
            __builtin_amdgcn_global_load_lds((const unsigned*)vs, (LDSP unsigned*)(lds + OFF_V + buf * SHM + i * 8192 + wid * 1024), 16, 0, 0); }
    }
}
struct DmaOff { unsigned k, v; };
__device__ __forceinline__ DmaOff dma_off(const DmaMap& dm, unsigned strideB) {
    const int m = dm.m0; DmaOff o; o.k = (unsigned)(m & 63) * strideB + (unsigned)((m >> 6) & 127) * 2u; o.v = (unsigned)((m >> 13) & 63) * strideB + (unsigned)((m >> 19) & 127) * 2u; return o;
}
__device__ __forceinline__ void stage_dma_fast(const DmaOff& o, const bf16_t* Kb, const bf16_t* Vb, unsigned strideB, int row0, LDSP char* lds, int buf, int wid, int which) {
    const size_t tb = (size_t)(unsigned)row0 * strideB;
#pragma unroll
    for (int i = 0; i < 2; ++i) {
        if (which & 1) __builtin_amdgcn_global_load_lds((const unsigned*)((const char*)Kb + tb + (size_t)i * 32 * strideB + o.k), (LDSP unsigned*)(lds + OFF_K + buf * SHM + i * 8192 + wid * 1024), 16, 0, 0);
        if (which & 2) __builtin_amdgcn_global_load_lds((const unsigned*)((const char*)Vb + tb + (size_t)i * 32 * strideB + o.v), (LDSP unsigned*)(lds + OFF_V + buf * SHM + i * 8192 + wid * 1024), 16, 0, 0);
    }
}
struct Stage { u32x4 k0, k1, v0, v1; };
__device__ __forceinline__ void stage_load(Stage& s, const bf16_t* Kb, const bf16_t* Vb, size_t stride, int row0, int rmax, int tid) {
    const int sr = tid >> 4, sc = (tid & 15) * 8;
    int ra = row0 + sr, rb = row0 + 32 + sr; ra = ra < 0 ? 0 : (ra > rmax ? rmax : ra); rb = rb < 0 ? 0 : (rb > rmax ? rmax : rb);
    s.v0 = *(const u32x4*)(Vb + (size_t)ra * stride + sc); s.v1 = *(const u32x4*)(Vb + (size_t)rb * stride + sc);
    s.k0 = *(const u32x4*)(Kb + (size_t)ra * stride + sc); s.k1 = *(const u32x4*)(Kb + (size_t)rb * stride + sc);
}
__device__ __forceinline__ void stage_write(const Stage& s, LDSP char* lds, int buf, int tid) {
    const int sr = tid >> 4, sc = (tid & 15) * 8;
    *(LDSP u32x4*)(lds + OFF_K + buf * SHM + ATT_KSWZ(sr, sc * 2)) = s.k0; *(LDSP u32x4*)(lds + OFF_K + buf * SHM + ATT_KSWZ(sr, sc * 2) + 32 * 256) = s.k1;
    *(LDSP u32x4*)(lds + OFF_V + buf * SHM + v_st(sr, sc)) = s.v0; *(LDSP u32x4*)(lds + OFF_V + buf * SHM + v_st(32 + sr, sc)) = s.v1;
}
__device__ __forceinline__ void stage_dma_at(const DmaMap& dm, const bf16_t* Kb, const bf16_t* Vb, size_t stride, int row0, int rmax, LDSP char* kdst, LDSP char* vdst, int wid) {
#pragma unroll
    for (int i = 0; i < 2; ++i) {
        const int m = i ? dm.m1 : dm.m0;
        int kr = row0 + (m & 63), vr = row0 + ((m >> 13) & 63); kr = kr < 0 ? 0 : (kr > rmax ? rmax : kr); vr = vr < 0 ? 0 : (vr > rmax ? rmax : vr);
        const bf16_t* ks = Kb + (size_t)kr * stride + ((m >> 6) & 127); const bf16_t* vs = Vb + (size_t)vr * stride + ((m >> 19) & 127);
        __builtin_amdgcn_global_load_lds((const unsigned*)ks, (LDSP unsigned*)(kdst + i * 8192 + wid * 1024), 16, 0, 0);
        __builtin_amdgcn_global_load_lds((const unsigned*)vs, (LDSP unsigned*)(vdst + i * 8192 + wid * 1024), 16, 0, 0);
    }
}
#define ATT_DMA_SYNC() do { asm volatile("s_waitcnt vmcnt(0)" ::: "memory"); __syncthreads(); } while (0)
#define ATT_RING_SYNC(more) do { if (more) asm volatile("s_waitcnt vmcnt(4)" ::: "memory"); else asm volatile("s_waitcnt vmcnt(0)" ::: "memory"); \
        asm volatile("s_waitcnt lgkmcnt(0)" ::: "memory"); __builtin_amdgcn_s_barrier(); asm volatile("" ::: "memory"); } while (0)

struct Pass { float m, l; f32x16 o[4]; };
__device__ __forceinline__ void pass_init(Pass& P) { P.m = -1e30f; P.l = 0.f;
#pragma unroll
    for (int d = 0; d < 4; ++d) P.o[d] = f32x16{}; }

struct PFrag { bf16x8 a0, a1, a2, a3; };
__device__ __forceinline__ void tile_sm(Pass& P, PFrag& F, f32x16& p0, f32x16& p1, LDSP float* xl, const Lane& L, float sl2, bool need_mask, int dq0, unsigned W, float base);
__device__ __forceinline__ void tile_qk_at(Pass& P, PFrag& F, LDSP const char* Kt, LDSP float* xl, const Lane& L, const bf16x8* qr, float sl2, bool need_mask, int dq0, unsigned W, float base) {
    f32x16 p0, p1;
    qkt<true>(p0, p1, Kt, L.r32, L.hi, qr, L.at + (L.r32 >> 3) * L.atmul);
    tile_sm(P, F, p0, p1, xl, L, sl2, need_mask, dq0, W, base);
}
__device__ __forceinline__ void tile_sm(Pass& P, PFrag& F, f32x16& p0, f32x16& p1, LDSP float* xl, const Lane& L, float sl2, bool need_mask, int dq0, unsigned W, float base) {
    if (need_mask) mask_tile(p0, p1, dq0 - 4 * L.hi, W);
    float alpha;
    const float m_prev = P.m;
    softmax_a(p0, p1, base + sl2 * (float)(4 * L.hi), P.m, alpha);
    if (__any(alpha < 1.f && m_prev > -1e29f)) scale_rows(P.o, alpha, xl, L.r32, L.hi);
    P.l = P.l * alpha + rowsum2(p0, p1);
    pack_p(p0, p1, F.a0, F.a1, F.a2, F.a3);
}
__device__ __forceinline__ void tile_qk(Pass& P, PFrag& F, LDSP char* lds, int buf, const Lane& L, const bf16x8* qr, float sl2, bool need_mask, int dq0, unsigned W, float base) {
    tile_qk_at(P, F, lds + OFF_K + buf * SHM, (LDSP float*)(lds + OFF_WS + L.wid * 256), L, qr, sl2, need_mask, dq0, W, base);
}
__device__ __forceinline__ void tile_pv_at(Pass& P, const PFrag& F, LDSP char* Vt, const Lane& L) {
    ATT_SBAR();
    const int vb = (int)(unsigned)(uintptr_t)Vt + v_rd_base(L.lane);
    pv_tile(P.o, vb, F.a0, F.a1, F.a2, F.a3);
}
__device__ __forceinline__ void tile_pv(Pass& P, const PFrag& F, LDSP char* lds, int buf, const Lane& L) {
    ATT_SBAR();
    const int vb = (int)(unsigned)(uintptr_t)(lds + OFF_V + buf * SHM) + v_rd_base(L.lane);
    pv_tile(P.o, vb, F.a0, F.a1, F.a2, F.a3);
}
#define ATT_EV_EVEN(k_) do { if ((k_) == 0 || (k_) >= n) asm volatile("s_waitcnt vmcnt(0)" ::: "memory"); else if ((k_) + 1 < n) asm volatile("s_waitcnt vmcnt(4)" ::: "memory"); else asm volatile("s_waitcnt vmcnt(2)" ::: "memory"); \
        asm volatile("s_waitcnt lgkmcnt(0)" ::: "memory"); __builtin_amdgcn_s_barrier(); asm volatile("" ::: "memory"); } while (0)
#define ATT_ISSUE(k_) do { if ((k_) + 2 < n) pol.dma(pol.tile((k_) + 2), ((k_) + 2) % 3, 1); if ((k_) + 1 < n) pol.dma(pol.tile((k_) + 1), ((k_) + 1) % 3, 2); } while (0)
#define ATT_EV_ODD() do { asm volatile("s_waitcnt lgkmcnt(0)" ::: "memory"); __builtin_amdgcn_s_barrier(); asm volatile("" ::: "memory"); } while (0)
template <class Pol, bool STAGGER = true>
__device__ __forceinline__ void ring_pass(Pass& P, const Pol& pol, LDSP char* lds, const Lane& L, const bf16x8* qr, float sl2, bool pre = false) {
    const int n = pol.n;
    const bool lag = STAGGER && L.wid >= 4;
    LDSP float* xl = (LDSP float*)(lds + OFF_WS + L.wid * 256);
    if (!pre) { pol.dma(pol.tile(0), 0, 3); if (n > 1) pol.dma(pol.tile(1), 1, 1); }
    ATT_EV_EVEN(0); ATT_ISSUE(0);
    if (lag) ATT_EV_ODD();
    PFrag F;
    bool actp = false; int buf = 0, bufp = 0;
    for (int i = 0; i < n; ++i) {
        if (actp) tile_pv(P, F, lds, bufp, L);
        ATT_SBAR();
        const int j = pol.tile(i);
        bool act; f32x16 p0, p1;
        { bool nm_; int dq_; unsigned W_; float base_; pol.prep(j, act, nm_, dq_, W_, base_); }
        if (act) { int rr_ = L.r32; if (L.atmul) asm volatile("" : "+v"(rr_)); qkt<true>(p0, p1, lds + OFF_K + buf * SHM, L.r32, L.hi, qr, L.at + (rr_ >> 3) * L.atmul); }
        if (!lag) { if (STAGGER) ATT_EV_ODD(); } else ATT_EV_EVEN(i + 1);
        if (act) { int j2 = j; asm volatile("" : "+s"(j2));
            bool a2_, need_mask; int dq0; unsigned W; float base; pol.prep(j2, a2_, need_mask, dq0, W, base);
            tile_sm(P, F, p0, p1, xl, L, sl2, need_mask, dq0, W, base); }
        else { const bf16x8 z_ = {}; F.a0 = z_; F.a1 = z_; F.a2 = z_; F.a3 = z_; }
        if (!lag) ATT_EV_EVEN(i + 1); else ATT_EV_ODD();
        ATT_ISSUE(i + 1);
        actp = act; bufp = buf; buf = buf == 2 ? 0 : buf + 1;
    }
    if (actp) tile_pv(P, F, lds, bufp, L);
    if (STAGGER && !lag) ATT_EV_ODD();
}
}

__device__ __forceinline__ void nsa_attn_mfma_phase(const Ctx& c) {
    using namespace att;
    LDSP char* lds = (LDSP char*)c.lds;
    const bf16_t* proj = (const bf16_t*)(c.ws + WS_PROJ);
    const bf16_t* CMPB = (const bf16_t*)(c.ws + WS_CMPB);
    float* ACC = (float*)(c.ws + WS_ACC);
    bf16_t* O = (bf16_t*)(c.ws + WS_O);
    Lane L; L.tid = c.tid; L.lane = c.lane; L.r32 = c.lane & 31; L.hi = c.lane >> 5; L.wid = c.wave; L.at = lds + OFF_AT; L.atmul = 128;
    const DmaMap dm = dma_map(L.wid, L.lane);
    LDSP float* xl = (LDSP float*)(lds + OFF_WS + L.wid * 256);
    LDSP unsigned* misc = (LDSP unsigned*)(lds + OFF_MISC);
    { LDSP float* psw0 = (LDSP float*)(lds + OFF_PS + L.wid * (8 * 129 * 4));
#pragma unroll
      for (int i = 0; i < 17; ++i) { const int w = L.lane + 64 * i; if (w < 8 * 129) psw0[w] = 0.f; } }
    for (int uu = c.bid; uu < (DUP_PH == 104 ? 2048 : 1024); uu += c.G) {
        const int u = uu & 1023, cc_ = u & 255, ri_ = u >> 8, bg = (cc_ >> 4) + 16 * (ri_ >> 1), q0_ = (ri_ >> 1) ? 15 - (cc_ & 15) : (cc_ & 15), qb = (ri_ & 1) ? 31 - q0_ : q0_, b = bg >> 2, g = bg & 3;
        const int qi = L.r32 & 7, hl = L.r32 >> 3, t = 64 * qb + 8 * L.wid + qi, h = 4 * g + hl;
        const bf16_t* prow = proj + (size_t)(b * S_ + t) * PW0;
        __syncthreads();
        { int tw = c.tid; asm volatile("" : "+v"(tw));
          if (tw < 128) alibi_table_write(lds, tw >> 5, tw & 31, exp2f(-0.5f * (float)(4 * g + (tw >> 5) + 1)) * LOG2E); }
        { const bf16_t* Kc0 = CMPB + ((size_t)(0 * 8 + b) * 128 * 4 + g) * 128; const bf16_t* Vc0 = CMPB + ((size_t)(1 * 8 + b) * 128 * 4 + g) * 128;
          stage_dma(dm, Kc0, Vc0, 512, 0, 127, lds, 0, L.wid); stage_dma(dm, Kc0, Vc0, 512, 64, 127, lds, 1, L.wid); }
        bf16x8 qr[8];
        { u32x4 qraw_[8];
#pragma unroll
          for (int d0 = 0; d0 < 8; ++d0) qraw_[d0] = *(const u32x4*)(prow + h * 128 + d0 * 16 + L.hi * 8);
#pragma unroll
          for (int d0 = 0; d0 < 8; ++d0) qr[d0] = scale8(qraw_[d0], C2); }
        const float slope = exp2f(-0.5f * (float)(h + 1));
        LDSP float* gtw = (LDSP float*)(lds + OFF_GT + L.wid * 512);
        if (L.hi == 0) {
#pragma unroll
            for (int j = 0; j < 3; ++j) gtw[L.r32 * 3 + j] = 1.f / (1.f + __expf(-bf2f(prow[5120 + h * 3 + j])));
        }
#define NSA_GATE(j) (gtw[L.r32 * 3 + (j)])
        char* accb = (char*)ACC + ((size_t)c.bid * NWAVE + L.wid) * 16384;
        const unsigned avo = (unsigned)(L.lane * 4);
        unsigned selmask;
#if !defined(NSA_NO_CMP)
        for (int repc_ = 0; repc_ < (DUP_PH == 301 ? 2 : 1); ++repc_) { if (repc_) __syncthreads();
            const bf16_t* Kc = CMPB + ((size_t)(0 * 8 + b) * 128 * 4 + g) * 128; const bf16_t* Vc = CMPB + ((size_t)(1 * 8 + b) * 128 * 4 + g) * 128;
            ATT_DMA_SYNC();
            const float sl2 = slope * 16.f * LOG2E, qf = ((float)t - 15.5f) * 0.0625f;
            const int nq = (t - 31) >> 4;
            f32x16 pA0, pA1, pB0, pB1;
            qkt(pA0, pA1, lds + OFF_K, L.r32, L.hi, qr); alibi_tile(pA0, pA1, sl2);
            qkt(pB0, pB1, lds + OFF_K + SHM, L.r32, L.hi, qr); alibi_tile(pB0, pB1, sl2);
            mask_tile(pA0, pA1, nq - 4 * L.hi, 0x40000000u); mask_tile(pB0, pB1, nq - 64 - 4 * L.hi, 0x40000000u);
            const float baseA = -sl2 * (qf - (float)(4 * L.hi)), baseB = -sl2 * (qf - 64.f - (float)(4 * L.hi));
            float mA = pA0[0], mB = pB0[0];
#pragma unroll
            for (int r = 1; r < 16; ++r) { mA = fmaxf(mA, pA0[r]); mB = fmaxf(mB, pB0[r]); }
#pragma unroll
            for (int r = 0; r < 16; ++r) { mA = fmaxf(mA, pA1[r]); mB = fmaxf(mB, pB1[r]); }
            float mx = fmaxf(mA + baseA, mB + baseB);
            { auto rr = __builtin_amdgcn_permlane32_swap(__float_as_uint(mx), __float_as_uint(mx), false, false); mx = fmaxf(__uint_as_float(rr[0]), __uint_as_float(rr[1])); }
            if (mx == -__builtin_inff()) mx = 0.f;
            const float subA = mx - baseA, subB = mx - baseB;
#pragma unroll
            for (int r = 0; r < 16; ++r) { pA0[r] = __builtin_amdgcn_exp2f(pA0[r] - subA); pA1[r] = __builtin_amdgcn_exp2f(pA1[r] - subA); pB0[r] = __builtin_amdgcn_exp2f(pB0[r] - subB); pB1[r] = __builtin_amdgcn_exp2f(pB1[r] - subB); }
            const float lsum = rowsum2(pA0, pA1) + rowsum2(pB0, pB1);
            const float inv = 1.f / fmaxf(lsum, 1e-30f);
#pragma unroll
            for (int r = 0; r < 16; ++r) { pA0[r] *= inv; pA1[r] *= inv; pB0[r] *= inv; pB1[r] *= inv; }
            bf16x8 paA0, paA1, paA2, paA3, paB0, paB1, paB2, paB3;
            pack_p(pA0, pA1, paA0, paA1, paA2, paA3); pack_p(pB0, pB1, paB0, paB1, paB2, paB3);
            LDSP float* psw = (LDSP float*)(lds + OFF_PS + L.wid * (8 * 129 * 4));
#pragma unroll
            for (int r = 0; r < 16; ++r) {
                float a = pA0[r], b2 = pA1[r], c2 = pB0[r], d2 = pB1[r];
                a += __shfl_xor(a, 8); b2 += __shfl_xor(b2, 8); c2 += __shfl_xor(c2, 8); d2 += __shfl_xor(d2, 8);
                a += __shfl_xor(a, 16); b2 += __shfl_xor(b2, 16); c2 += __shfl_xor(c2, 16); d2 += __shfl_xor(d2, 16);
                if (hl == 0) { const int n0 = crow(r, L.hi); LDSP float* pp = psw + qi * 129 + n0; pp[0] = a; pp[32] = b2; pp[64] = c2; pp[96] = d2; }
                if ((r & 3) == 3) asm volatile("" ::: "memory");
            }
            asm volatile("s_waitcnt lgkmcnt(0)" ::: "memory");
            {
                LDSP float* scw = (LDSP float*)(lds + OFF_SC + L.wid * 1024);
                int sq = L.lane & 7, jb = L.lane >> 3; asm volatile("" : "+v"(sq), "+v"(jb));
                const int tq = 64 * qb + 8 * L.wid + sq;
                const LDSP float* pq = psw + sq * 129;
                float sj[4];
#pragma unroll
                for (int i = 0; i < 4; ++i) { const int j = jb + 8 * i;
                    const float imp = (j ? pq[4 * j - 1] : 0.f) + 2.f * (pq[4 * j] + pq[4 * j + 1] + pq[4 * j + 2]) + pq[4 * j + 3];
                    const bool forced = (j == 0) || (j == qb) || (j == qb - 1), causal = (64 * j <= tq);
                    sj[i] = forced ? 1.0e6f : (causal ? imp : -1.0f); scw[sq * 32 + j] = sj[i]; }
                asm volatile("s_waitcnt lgkmcnt(0)" ::: "memory");
                int rk[4] = {0, 0, 0, 0};
                for (int i2 = 0; i2 < 32; ++i2) { const float si = scw[sq * 32 + i2];
#pragma unroll
                    for (int i = 0; i < 4; ++i) rk[i] += ((si > sj[i]) || (si == sj[i] && i2 < jb + 8 * i)) ? 1 : 0; }
                unsigned bits = 0u;
#pragma unroll
                for (int i = 0; i < 4; ++i) if (rk[i] < 16) bits |= 1u << (jb + 8 * i);
                bits |= (unsigned)__shfl_xor((int)bits, 8); bits |= (unsigned)__shfl_xor((int)bits, 16); bits |= (unsigned)__shfl_xor((int)bits, 32);
                selmask = bits;
                if (L.lane < 8) ((unsigned*)(c.ws + WS_SEL))[((size_t)b * 4 + g) * 2048 + tq] = selmask;
            }
            f32x16 o[4];
#pragma unroll
            for (int d = 0; d < 4; ++d) o[d] = f32x16{};
            ATT_SBAR();
            pv_tile(o, (int)(unsigned)(uintptr_t)(lds + OFF_V) + v_rd_base(L.lane), paA0, paA1, paA2, paA3);
            pv_tile(o, (int)(unsigned)(uintptr_t)(lds + OFF_V + SHM) + v_rd_base(L.lane), paB0, paB1, paB2, paB3);
            scale_rows(o, NSA_GATE(0), xl, L.r32, L.hi);
#pragma unroll
            for (int h2 = 0; h2 < 2; ++h2) { gchar* pq = (gchar*)(accb + avo + h2 * 4096); asm volatile("" : "+v"(pq));
#pragma unroll
                for (int k = 0; k < 16; ++k) { const int q = 2 * h2 + (k >> 3), rl = (k & 7) >> 1, dh = k & 1;
                    *(gunsigned*)(pq + k * 256) = cvtpk(o[2 * dh][q * 4 + rl], o[2 * dh + 1][q * 4 + rl]); } }
        }
#else
        selmask = 0xffffffffu;
#endif
#if !defined(NSA_NO_SEL)
        {
            const unsigned causal_bits = (qb == 31) ? 0xffffffffu : ((1u << (qb + 1)) - 1u);
            unsigned wmask = selmask & causal_bits;
#pragma unroll
            for (int o_ = 1; o_ < 64; o_ <<= 1) wmask |= (unsigned)__shfl_xor((int)wmask, o_);
            if (c.tid == 0) misc[0] = 0u;
            __syncthreads();
            if (L.lane == 0) atomicOr((unsigned*)(misc + 0), wmask);
            __syncthreads();
            unsigned rem = (unsigned)__builtin_amdgcn_readfirstlane((int)misc[0]);
            wmask = (unsigned)__builtin_amdgcn_readfirstlane((int)wmask);
            const float sl2 = slope * LOG2E;
            const bf16_t* Kb = proj + (size_t)b * S_ * PW0 + 2048 + 1024 + g * 128; const bf16_t* Vb = Kb + 512;
            Pass P; pass_init(P);
            const int ntl = __builtin_popcount(rem);
            if (c.tid == 0) { unsigned rr_ = rem; int k_ = 0; while (rr_) { const int jj_ = 31 - __builtin_clz(rr_); rr_ &= ~(1u << jj_); misc[8 + k_] = (unsigned)jj_; ++k_; } }
            __syncthreads();
            const int lv_ = (int)((LDSP const unsigned*)(misc + 8))[L.lane & 31];
            struct SelPol { int n; int lv; DmaOff off; const bf16_t* Kb; const bf16_t* Vb; LDSP char* lds; int wid; unsigned wmask, selmask; int t; float sl2;
                __device__ __forceinline__ int tile(int i) const { return __builtin_amdgcn_readlane(lv, (DUP_PH == 311) ? (i >= (n >> 1) ? i - (n >> 1) : i) : i); }
                __device__ __forceinline__ void dma(int j, int buf, int which) const { stage_dma_fast(off, Kb, Vb, PW0 * 2, 64 * j, lds, buf, wid, which); }
                __device__ __forceinline__ void prep(int j, bool& act, bool& need_mask, int& dq0, unsigned& W, float& base) const {
                    act = (wmask >> j) & 1u; const bool mine = (selmask >> j) & 1u;
                    dq0 = mine ? t - 64 * j : -1; need_mask = !__all(mine && (t - 64 * j >= 63)); W = 0x40000000u; base = -sl2 * (float)(t - 64 * j); }
            } pol{(DUP_PH == 311) ? 2 * ntl : ntl, lv_, dma_off(dm, PW0 * 2), Kb, Vb, lds, L.wid, wmask, selmask, t, sl2};
            ring_pass(P, pol, lds, L, qr, sl2);
            scale_rows(P.o, NSA_GATE(1) / P.l, xl, L.r32, L.hi);
            {
                gchar* pa_ = (gchar*)(accb + avo); asm volatile("" : "+v"(pa_)); gchar* pb_ = (gchar*)(accb + avo + 4096); asm volatile("" : "+v"(pb_));
                unsigned wa[16], wb[16];
#pragma unroll
                for (int k = 0; k < 16; ++k) { wa[k] = *(const gunsigned*)(pa_ + k * 256); wb[k] = *(const gunsigned*)(pb_ + k * 256); }
#pragma unroll
                for (int k = 0; k < 16; ++k) { const int qq = k >> 3, rl = (k & 7) >> 1, dh = k & 1;
                    *(gunsigned*)(pa_ + k * 256) = cvtpk(__uint_as_float(wa[k] << 16) + P.o[2 * dh][qq * 4 + rl], __uint_as_float(wa[k] & 0xffff0000u) + P.o[2 * dh + 1][qq * 4 + rl]);
                    *(gunsigned*)(pb_ + k * 256) = cvtpk(__uint_as_float(wb[k] << 16) + P.o[2 * dh][(2 + qq) * 4 + rl], __uint_as_float(wb[k] & 0xffff0000u) + P.o[2 * dh + 1][(2 + qq) * 4 + rl]); }
                asm volatile("" ::: "memory"); }
        }
#endif
#if !defined(NSA_NO_WIN)
        for (int repw_ = 0; repw_ < (DUP_PH == 302 ? 2 : 1); ++repw_) {
            __syncthreads();
            const float sl2 = slope * LOG2E;
            const bf16_t* Kb = proj + (size_t)b * S_ * PW0 + 2048 + 2048 + g * 128; const bf16_t* Vb = Kb + 512;
            Pass P; pass_init(P);
            const int jlo = qb - 8 > 0 ? qb - 8 : 0;
            struct WinPol { int n, jhi; DmaOff off; const bf16_t* Kb; const bf16_t* Vb; LDSP char* lds; int wid, t; float sl2;
                __device__ __forceinline__ int tile(int i) const { return (DUP_PH == 312) ? jhi - (i >= (n >> 1) ? i - (n >> 1) : i) : jhi - i; }
                __device__ __forceinline__ void dma(int j, int buf, int which) const { stage_dma_fast(off, Kb, Vb, PW0 * 2, 64 * j, lds, buf, wid, which); }
                __device__ __forceinline__ void prep(int j, bool& act, bool& need_mask, int& dq0, unsigned& W, float& base) const {
                    dq0 = t - 64 * j; act = __any((dq0 >= 0) && (dq0 - 63 < 512)); need_mask = !__all(dq0 - 63 >= 0 && dq0 < 512); W = 512u; base = -sl2 * (float)dq0; }
            } pol{(DUP_PH == 312) ? 2 * (qb - jlo + 1) : (qb - jlo + 1), qb, dma_off(dm, PW0 * 2), Kb, Vb, lds, L.wid, t, sl2};
            ring_pass(P, pol, lds, L, qr, sl2);
            scale_rows(P.o, NSA_GATE(2) / P.l, xl, L.r32, L.hi);
            char* ob = (char*)O + ((size_t)(b * S_ + 64 * qb + 8 * L.wid) * D_ + (size_t)(4 * g) * 128) * 2;
            const unsigned ovo = (unsigned)(L.hi * 4 * D_ * 2 + L.r32 * 2);
            {
                gchar* pa_ = (gchar*)(accb + avo); asm volatile("" : "+v"(pa_)); gchar* pb_ = (gchar*)(accb + avo + 4096); asm volatile("" : "+v"(pb_));
                unsigned wa[16], wb[16];
#pragma unroll
                for (int k = 0; k < 16; ++k) { wa[k] = *(const gunsigned*)(pa_ + k * 256); wb[k] = *(const gunsigned*)(pb_ + k * 256); }
#pragma unroll
                for (int q = 0; q < 4; ++q) {
#pragma unroll
                    for (int rl = 0; rl < 4; ++rl) { gchar* po = (gchar*)(ob + ovo + (rl * D_ + q * 128) * 2); asm volatile("" : "+v"(po));
#pragma unroll
                        for (int d = 0; d < 4; ++d) { const unsigned w_ = (q >> 1) ? wb[(q & 1) * 8 + rl * 2 + (d >> 1)] : wa[(q & 1) * 8 + rl * 2 + (d >> 1)];
                            const float v = ((d & 1) ? __uint_as_float(w_ & 0xffff0000u) : __uint_as_float(w_ << 16)) + P.o[d][q * 4 + rl];
                            const float vn = __int_as_float(__builtin_amdgcn_update_dpp(0, __float_as_int(v), 0xB1, 0xF, 0xF, false));
                            if ((L.r32 & 1) == 0) *(gunsigned*)(po + d * 64) = cvtpk(v, vn); } } }
                asm volatile("" ::: "memory"); }
        }
#endif
    }
}

struct DilUnit { int gi, r, b, rho, h, blk, rows, jhi, jlo, Lst; };
__device__ __forceinline__ DilUnit dil_decode(int u) {
    DilUnit d;
    if (u < 2048) { d.gi = u >> 10; const int v = u & 1023; d.h = v & 15; d.r = d.gi ? 4 : 1;
        if (d.gi == 0) { d.rho = 0; d.b = v >> 7; d.blk = ((v >> 4) + (d.b >> 1)) & 7; } else { d.rho = (v >> 5) & 3; d.b = v >> 7; d.blk = ((v >> 4) + (d.b >> 1)) & 1; } d.rows = 256; }
    else { d.gi = 2; const int v = u - 2048; d.h = v & 15; d.rho = (v >> 4) & 15; d.b = v >> 8; d.blk = 0; d.r = 16; d.rows = 128; }
    d.Lst = S_ / d.r; d.jhi = (d.blk * 256 + d.rows - 1) >> 6; d.jlo = (d.blk * 256 - 128) > 0 ? (d.blk * 256 - 128) >> 6 : 0;
    return d;
}
__device__ __forceinline__ void dil_attn_mfma_phase(const Ctx& c) {
    using namespace att;
    LDSP char* lds = (LDSP char*)c.lds;
    const bf16_t* proj = (const bf16_t*)(c.ws + WS_PROJ);
    bf16_t* OG = (bf16_t*)(c.ws + WS_OG); float* LSE = (float*)(c.ws + WS_LSE);
    Lane L; L.tid = c.tid; L.lane = c.lane; L.r32 = c.lane & 31; L.hi = c.lane >> 5; L.wid = c.wave; L.at = lds + OFF_AT; L.atmul = 0;
    const DmaMap dm = dma_map(L.wid, L.lane);
    LDSP float* xl = (LDSP float*)(lds + OFF_WS + L.wid * 256);
    const int NU = 2048;
    int uu = c.bid;
    if (uu >= NU) return;
    DilUnit U = dil_decode(uu);
    u32x4 qraw[8];
#define DIL_ADDR(sec_, b_, h_, pos_) ((((size_t)(sec_) * 8 + (b_)) * 16 + (h_)) * 2048 + (pos_)) * 128
#define DIL_KB(U_) (proj + DIL_ADDR(1 + 2 * (U_).gi, (U_).b, (U_).h, (U_).rho * (U_).Lst))
#define DIL_SEC ((size_t)8 * 16 * 2048 * 128)
#define DIL_ISSUE(U_) do { const bf16_t* kb_ = DIL_KB(U_); \
        stage_dma(dm, kb_, kb_ + DIL_SEC, 128, 64 * (U_).jhi, (U_).Lst - 1, lds, 0, L.wid); \
        if ((U_).jhi > (U_).jlo) stage_dma(dm, kb_, kb_ + DIL_SEC, 128, 64 * ((U_).jhi - 1), (U_).Lst - 1, lds, 1, L.wid, 1); \
        const int uq_ = (U_).blk * 256 + L.wid * 32 + L.r32; const int tq_ = ((L.wid * 32 < (U_).rows) ? uq_ : 0) * (U_).r + (U_).rho; \
        const bf16_t* prow_ = proj + DIL_ADDR(0, (U_).b, (U_).h, tq_); int hiq_ = L.hi; asm volatile("" : "+v"(hiq_));   \
        _Pragma("unroll") for (int d0 = 0; d0 < 8; ++d0) qraw[d0] = *(const u32x4*)(prow_ + d0 * 16 + hiq_ * 8); } while (0)
    __syncthreads();
    DIL_ISSUE(U);
    while (true) {
        const int gi = U.gi, r = U.r, b = U.b, rho = U.rho, h = U.h, blk = U.blk, rows = U.rows;
        const int uq = blk * 256 + L.wid * 32 + L.r32;
        const bool wave_on = L.wid * 32 < rows;
        const int tq = (wave_on ? uq : 0) * r + rho;
        const float slope = exp2f(-0.5f * (float)(h + 1));
        const float sl2 = slope * (float)r * LOG2E;
        { int tw = c.tid; asm volatile("" : "+v"(tw)); if (tw < 32) alibi_table_write(lds, 0, tw, sl2); }
        const bf16_t* Kb = DIL_KB(U); const bf16_t* Vb = Kb + DIL_SEC;
        const size_t kstride = 128;
        bf16x8 qr[8];
#pragma unroll
        for (int d0 = 0; d0 < 8; ++d0) qr[d0] = scale8(qraw[d0], C2);
        Pass P; pass_init(P);
        const int jhi = U.jhi, jlo = U.jlo;
        struct DilPol { int n, jhi; DmaOff off; const bf16_t* Kb; const bf16_t* Vb; size_t kstride; int rmax; LDSP char* lds; int wid, uq; bool wave_on; float sl2;
            __device__ __forceinline__ int tile(int i) const { return jhi - i; }
            __device__ __forceinline__ void dma(int j, int buf, int which) const { stage_dma_fast(off, Kb, Vb, 256u, 64 * j, lds, buf, wid, which); }
            __device__ __forceinline__ void prep(int j, bool& act, bool& need_mask, int& dq0, unsigned& W, float& base) const {
                dq0 = uq - 64 * j; act = wave_on && __any((dq0 >= 0) && (dq0 - 63 < 129)); need_mask = !__all(dq0 - 63 >= 0 && dq0 < 129); W = 129u; base = -sl2 * (float)dq0; }
        } pol{jhi - jlo + 1, jhi, dma_off(dm, 256u), Kb, Vb, kstride, U.Lst - 1, lds, L.wid, uq, wave_on, sl2};
        ring_pass<DilPol, (DIL_STAGGER != 0)>(P, pol, lds, L, qr, sl2, true);
        const int un = uu + c.G; const bool more = un < NU;
        __syncthreads();
        if (more) { U = dil_decode(un); DIL_ISSUE(U); }
        if (wave_on) {
            scale_rows(P.o, 1.f / P.l, xl, L.r32, L.hi);
            if (L.hi == 0) LSE[((size_t)gi * T_ + (size_t)b * S_ + tq) * 16 + h] = P.m + __log2f(P.l);
            int r32e = L.r32; asm volatile("" : "+v"(r32e));
#pragma unroll
            for (int rr = 0; rr < 16; ++rr) { const int rw = crow(rr, L.hi); const int tt = (blk * 256 + L.wid * 32 + rw) * r + rho;
                bf16_t* op = OG + ((size_t)gi * T_ + (size_t)b * S_ + tt) * D_ + h * 128 + r32e;
#pragma unroll
                for (int d = 0; d < 4; ++d) { const float v = P.o[d][rr]; const float vn = __int_as_float(__builtin_amdgcn_update_dpp(0, __float_as_int(v), 0xB1, 0xF, 0xF, false));
                    if ((L.r32 & 1) == 0) *(unsigned*)(op + d * 32) = cvtpk(v, vn); } }
        }
        if (!more) break;
        uu = un;
    }
    {
        int widp = L.wid; asm volatile("" : "+v"(widp));
        asm volatile("" : "+v"(L.r32), "+v"(L.hi), "+v"(L.lane));
        LDSP float* xl2 = (LDSP float*)(lds + 8 * SHM + widp * 256);
        const int half = L.wid >> 2, wl = L.wid & 3;
        L.at = lds + OFF_AT + half * 128;
        for (int v = c.bid; v < 1024; v += c.G) {
            const int hp = v & 7, rho = (v >> 3) & 15, b = v >> 7, h = hp + 8 * half;
            __syncthreads();
            { int tw = c.tid; asm volatile("" : "+v"(tw)); if (tw < 64) alibi_table_write(lds, tw >> 5, tw & 31, exp2f(-0.5f * (float)(hp + 8 * (tw >> 5) + 1)) * 16.f * LOG2E); }
#pragma unroll
            for (int hh = 0; hh < 2; ++hh) {
                const bf16_t* kb_ = proj + DIL_ADDR(5, b, hp + 8 * hh, rho * 128);
                stage_dma_at(dm, kb_, kb_ + DIL_SEC, 128, 64, 127, lds + 4 * SHM + (2 * hh + 1) * SHM, lds + (2 * hh + 1) * SHM, L.wid);
                stage_dma_at(dm, kb_, kb_ + DIL_SEC, 128, 0, 127, lds + 4 * SHM + (2 * hh) * SHM, lds + (2 * hh) * SHM, L.wid);
            }
            const int uq = wl * 32 + L.r32, tq = uq * 16 + rho;
            bf16x8 qr[8];
            { u32x4 qraw_[8]; const bf16_t* prow_ = proj + DIL_ADDR(0, b, h, tq);
#pragma unroll
              for (int d0 = 0; d0 < 8; ++d0) qraw_[d0] = *(const u32x4*)(prow_ + d0 * 16 + L.hi * 8);
#pragma unroll
              for (int d0 = 0; d0 < 8; ++d0) qr[d0] = scale8(qraw_[d0], C2); }
            const float sl2 = exp2f(-0.5f * (float)(h + 1)) * 16.f * LOG2E;
            Pass P; pass_init(P);
            ATT_DMA_SYNC();
#pragma unroll
            for (int jj = 1; jj >= 0; --jj) {
                const int dq0 = uq - 64 * jj;
                if (__any(dq0 >= 0)) {
                    PFrag F;
                    tile_qk_at(P, F, lds + 4 * SHM + (2 * half + jj) * SHM, xl2, L, qr, sl2, !__all(dq0 - 63 >= 0), dq0, 129u, -sl2 * (float)dq0);
                    tile_pv_at(P, F, lds + (2 * half + jj) * SHM, L);
                }
            }
            scale_rows(P.o, 1.f / P.l, xl2, L.r32, L.hi);
            if (L.hi == 0) LSE[((size_t)2 * T_ + (size_t)b * S_ + tq) * 16 + h] = P.m + __log2f(P.l);
#pragma unroll
            for (int rr = 0; rr < 16; ++rr) { const int rw = crow(rr, L.hi); const int tt = (wl * 32 + rw) * 16 + rho;
                bf16_t* op = OG + ((size_t)2 * T_ + (size_t)b * S_ + tt) * D_ + h * 128 + L.r32;
#pragma unroll
                for (int d = 0; d < 4; ++d) { const float v_ = P.o[d][rr]; const float vn = __int_as_float(__builtin_amdgcn_update_dpp(0, __float_as_int(v_), 0xB1, 0xF, 0xF, false));
                    if ((L.r32 & 1) == 0) *(unsigned*)(op + d * 32) = cvtpk(v_, vn); } }
        }
    }
#undef DIL_ISSUE
#undef DIL_KB
#undef DIL_ADDR
#undef DIL_SEC
}
__device__ __forceinline__ void dil_merge_phase(const Ctx& c) {
    const bf16_t* OG = (const bf16_t*)(c.ws + WS_OG); const float* LSE = (const float*)(c.ws + WS_LSE); bf16_t* O = (bf16_t*)(c.ws + WS_O);
    const int nw = c.G * NWAVE, lane = c.lane, h = lane >> 2;
    for (int row0 = c.bid * NWAVE + c.wave; row0 < T_; row0 += 2 * nw) {
        const int row1 = row0 + nw < T_ ? row0 + nw : row0;
        u32x4 a[2][4], bq[2][4], cq[2][4]; float l0[2], l1[2], l2[2];
#pragma unroll
        for (int rr = 0; rr < 2; ++rr) { const int row = rr ? row1 : row0;
            l0[rr] = LSE[((size_t)0 * T_ + row) * 16 + h]; l1[rr] = LSE[((size_t)1 * T_ + row) * 16 + h]; l2[rr] = LSE[((size_t)2 * T_ + row) * 16 + h];
#pragma unroll
            for (int q = 0; q < 4; ++q) { const size_t off = (size_t)row * D_ + lane * 32 + q * 8;
                a[rr][q] = *(const u32x4*)(OG + off); bq[rr][q] = *(const u32x4*)(OG + (size_t)T_ * D_ + off); cq[rr][q] = *(const u32x4*)(OG + (size_t)2 * T_ * D_ + off); } }
#pragma unroll
        for (int rr = 0; rr < 2; ++rr) { const int row = rr ? row1 : row0;
            const float mx = fmaxf(l0[rr], fmaxf(l1[rr], l2[rr]));
            float w0 = exp2f(l0[rr] - mx), w1 = exp2f(l1[rr] - mx), w2 = exp2f(l2[rr] - mx); const float inv = 1.f / (w0 + w1 + w2); w0 *= inv; w1 *= inv; w2 *= inv;
#pragma unroll
            for (int q = 0; q < 4; ++q) { const size_t off = (size_t)row * D_ + lane * 32 + q * 8;
                u32x4 o;
#define MRG(f) o.f = att::cvtpk(w0 * __uint_as_float(a[rr][q].f << 16) + w1 * __uint_as_float(bq[rr][q].f << 16) + w2 * __uint_as_float(cq[rr][q].f << 16), \
                                w0 * __uint_as_float(a[rr][q].f & 0xffff0000u) + w1 * __uint_as_float(bq[rr][q].f & 0xffff0000u) + w2 * __uint_as_float(cq[rr][q].f & 0xffff0000u))
                MRG(x); MRG(y); MRG(z); MRG(w);
#undef MRG
                *(u32x4*)(O + off) = o; } }
    }
}

constexpr int N_PHASES = 20;

__global__ void __launch_bounds__(NTHR, 2) fwd(Args args) {
    extern __shared__ __attribute__((aligned(16))) unsigned char lds_raw[];
    const Ctx c0{args, args.ws, (LDSP unsigned char*)lds_raw, 0, 0, __builtin_amdgcn_readfirstlane((int)threadIdx.x >> 6), (int)gridDim.x, (int)blockIdx.x};
    const int tid0 = (int)threadIdx.x;
    const int lo = args.ph_lo, hi = args.ph_hi;
    LDSP unsigned* xbw = (LDSP unsigned*)(c0.lds + LDS_BYTES - 16);
    XcdBarrier bar; bar.bar = (unsigned*)(c0.ws + WS_BAR); bar.x = 0; bar.st = nullptr;
    if (hi - lo > 1) {
        if (tid0 == 0) { xbw[0] = 0u; xbw[1] = 0u; xbw[2] = 0u; xbw[3] = 0u; }
        __syncthreads();
        bar = xcd_barrier_post((unsigned*)(c0.ws + WS_BAR), (volatile LAS unsigned*)xbw);
    }
#define IN(k) (lo <= (k) && (k) < hi)
#define SEAM(k) do { if (IN(k) && IN((k) + 1)) xcd_barrier(bar); else __syncthreads(); } while (0)
    const int vcu = (c0.G % 8 == 0) ? (c0.bid % 8) * (c0.G / 8) + c0.bid / 8 : c0.bid;
    float* MOD = (float*)(c0.ws + WS_MOD);
    bf16_t* X = (bf16_t*)(c0.ws + WS_X); bf16_t* Hb = (bf16_t*)(c0.ws + WS_H); bf16_t* Ob = (bf16_t*)(c0.ws + WS_O); bf16_t* PROJ = (bf16_t*)(c0.ws + WS_PROJ);
    bf16_t* HID = (bf16_t*)(c0.ws + WS_HID); bf16_t* YO = (bf16_t*)(c0.ws + WS_YO);
    bf16_t* WE1 = (bf16_t*)(c0.ws + WS_WE1); bf16_t* WE2 = (bf16_t*)(c0.ws + WS_WE2);

    enum { PH_PRO = 0, PH_NORM0, PH_PROJ0, PH_CMP, PH_ATT0, PH_OUT0, PH_RT0, PH_DSP0, PH_E1_0, PH_E2_0, PH_CN1, PH_PROJ1, PH_ATT1, PH_MRG1, PH_OUT1, PH_RT1, PH_DSP1, PH_E1_1, PH_E2_1, PH_FIN, PH_COUNT };
    static_assert(PH_COUNT == N_PHASES, "phase count");
    if (IN(PH_PRO)) for (int rep_ = 0; rep_ < ((DUP_PH == 200 + PH_PRO) ? 2 : 1); ++rep_) { const Ctx c = fresh(c0); if (rep_) __syncthreads();
#if DUP_PH == 100
        for (int rep_ = 0; rep_ < 2; ++rep_) {
#endif
        mod_units(c); __syncthreads();
        tr_matrix(c, c.A.in[7], D_, 5168, PW0, (bf16_t*)(c.ws + WS_WNSAIN));
        tr_matrix(c, c.A.in[11], D_, D_, D_, (bf16_t*)(c.ws + WS_WNSAOUT));
        tr_matrix(c, c.A.in[12], D_, PW1, PW1, (bf16_t*)(c.ws + WS_WDILIN));
        tr_matrix(c, c.A.in[13], D_, D_, D_, (bf16_t*)(c.ws + WS_WDILOUT));
        tr_matrix(c, c.A.in[8], 4096, 128, 128, (bf16_t*)(c.ws + WS_W1T));
        tr_matrix(c, c.A.in[8] + (size_t)4096 * 128, 4096, 128, 128, (bf16_t*)(c.ws + WS_W1T) + (size_t)128 * 4096);
        tr_experts(c, 0, TRX_T0, TRX_ALL, c.bid * NWAVE + c.wave, c.G * NWAVE);
#if DUP_PH == 100
        __syncthreads(); }
#endif
        SEAM(PH_PRO);
    }
    if (IN(PH_NORM0)) for (int rep_ = 0; rep_ < ((DUP_PH == 200 + PH_NORM0) ? 2 : 1); ++rep_) { const Ctx c = fresh(c0); if (rep_) __syncthreads(); norm_phase<0>(c, c.A.in[0], nullptr, c.A.in[4], MOD + 0 * 2048, MOD + 1 * 2048, nullptr, Hb); SEAM(PH_NORM0); }
    if (IN(PH_PROJ0)) for (int rep_ = 0; rep_ < ((DUP_PH == 200 + PH_PROJ0) ? 2 : 1); ++rep_) { const Ctx c = fresh(c0); if (rep_) __syncthreads();
        pg8::Gemm g{Hb, (const bf16_t*)(c.ws + WS_WNSAIN), T_, PW0, D_}; pg8::StaticOrder S; S.init(T_, PW0, c.G, c.bid);
        pg8::EpiBf16<0> E{PROJ, PW0, nullptr, 0, 0};
        pg8::gemm_phase<pg8::EpiBf16<0>, pg8::StaticOrder, false>((PG8_LAS unsigned char*)c.lds, g, S, E, nullptr);
        { const int nwg = (T_ / 256) * (PW0 / 256), rounds = (nwg + c.G - 1) / c.G; int first_idle = nwg - (rounds - 1) * c.G; if (first_idle >= c.G) first_idle = 0;
          if (c.bid >= first_idle) tr_experts(c, 0, 0, TRX_T0, (c.bid - first_idle) * NWAVE + c.wave, (c.G - first_idle) * NWAVE); }
        SEAM(PH_PROJ0);
    }
    if (IN(PH_CMP)) for (int rep_ = 0; rep_ < ((DUP_PH == 200 + PH_CMP) ? 2 : 1); ++rep_) { const Ctx c = fresh(c0); if (rep_) __syncthreads();
#if CMP_REF
        compress_phase(c);
#else
        compress_mfma_phase(c);
#endif
        SEAM(PH_CMP); }
    if (IN(PH_ATT0)) for (int rep_ = 0; rep_ < ((DUP_PH == 200 + PH_ATT0) ? 2 : 1); ++rep_) { const Ctx c = fresh(c0); if (rep_) __syncthreads();
#if NSA_REF
        nsa_attn_ref_phase(c);
#else
        nsa_attn_mfma_phase(c);
#endif
        SEAM(PH_ATT0);
    }
    if (IN(PH_OUT0)) for (int rep_ = 0; rep_ < ((DUP_PH == 200 + PH_OUT0) ? 2 : 1); ++rep_) { const Ctx c = fresh(c0); if (rep_) __syncthreads();
        pg8::Gemm g{Ob, (const bf16_t*)(c.ws + WS_WNSAOUT), T_, D_, D_}; pg8::StaticOrder S; S.init(T_, D_, c.G, c.bid);
        EpiResid<true> E{c.A.in[0], X, MOD + 2 * 2048};
        pg8::gemm_phase<EpiResid<true>, pg8::StaticOrder, false>((PG8_LAS unsigned char*)c.lds, g, S, E, nullptr);
        SEAM(PH_OUT0);
    }
    if (IN(PH_RT0)) for (int rep_ = 0; rep_ < ((DUP_PH == 200 + PH_RT0) ? 2 : 1); ++rep_) { const Ctx c = fresh(c0); if (rep_) __syncthreads(); norm_phase<1>(c, X, nullptr, c.A.in[5], MOD + 3 * 2048, MOD + 4 * 2048, nullptr, Hb); SEAM(PH_RT0); }
    if (IN(PH_DSP0)) for (int rep_ = 0; rep_ < ((DUP_PH == 200 + PH_DSP0) ? 2 : 1); ++rep_) { const Ctx c = fresh(c0); if (rep_) __syncthreads(); dispatch_phase(c); SEAM(PH_DSP0); }
    if (IN(PH_E1_0)) for (int rep_ = 0; rep_ < ((DUP_PH == 200 + PH_E1_0) ? 2 : 1); ++rep_) { const Ctx c = fresh(c0); if (rep_) __syncthreads();
        moe_tab_to_lds(c);
        pg8::Gemm g{Hb, WE1, CAP, 16 * 2816, D_}; MoeOrder S{(LDSP const int*)(c.lds + LDS_MISC), c.G, vcu, 11};
        EpiSwiglu E{HID};
        pg8::gemm_phase_g<EpiSwiglu, MoeOrder, false>((const int*)(c.ws + WS_SLOTTOK), (PG8_LAS unsigned char*)c.lds, g, S, E, nullptr);
        SEAM(PH_E1_0);
    }
    if (IN(PH_E2_0)) for (int rep_ = 0; rep_ < ((DUP_PH == 200 + PH_E2_0) ? 2 : 1); ++rep_) { const Ctx c = fresh(c0); if (rep_) __syncthreads();
        moe_tab_to_lds(c);
        pg8::Gemm g{HID, WE2, CAP, 16 * 2048, DE}; MoeOrder S{(LDSP const int*)(c.lds + LDS_MISC), c.G, vcu, 8};
        EpiDown E{YO, (const float*)(c.ws + WS_SLOTW)};
        pg8::gemm_phase<EpiDown, MoeOrder, false>((PG8_LAS unsigned char*)c.lds, g, S, E, nullptr);
        { const int total = ld_i((const int*)(c.ws + WS_TAB) + 16) * 8, rounds = (total + c.G - 1) / c.G; int first_idle = total - (rounds - 1) * c.G; if (first_idle >= c.G || first_idle < 0) first_idle = 0;
          if (vcu >= first_idle) tr_experts(c, 1, 0, TRX_T1, (vcu - first_idle) * NWAVE + c.wave, (c.G - first_idle) * NWAVE); }
        SEAM(PH_E2_0);
    }
    if (IN(PH_CN1)) for (int rep_ = 0; rep_ < ((DUP_PH == 200 + PH_CN1) ? 2 : 1); ++rep_) { const Ctx c = fresh(c0); if (rep_) __syncthreads();
        norm_phase<2>(c, X, X, c.A.in[4] + 2048, MOD + (size_t)8 * MODW + 0 * 2048, MOD + (size_t)8 * MODW + 1 * 2048, MOD + 5 * 2048, Hb);
        __syncthreads();
        tr_experts(c, 1, TRX_T1, TRX_ALL, c.bid * NWAVE + c.wave, c.G * NWAVE);
        SEAM(PH_CN1);
    }
    if (IN(PH_PROJ1)) for (int rep_ = 0; rep_ < ((DUP_PH == 200 + PH_PROJ1) ? 2 : 1); ++rep_) { const Ctx c = fresh(c0); if (rep_) __syncthreads();
        pg8::Gemm g{Hb, (const bf16_t*)(c.ws + WS_WDILIN), T_, PW1, D_}; pg8::StaticOrder S; S.init(T_, PW1, c.G, c.bid);
        EpiDilProj E{PROJ};
        pg8::gemm_phase<EpiDilProj, pg8::StaticOrder, false>((PG8_LAS unsigned char*)c.lds, g, S, E, nullptr);
        SEAM(PH_PROJ1);
    }
    if (IN(PH_ATT1)) for (int rep_ = 0; rep_ < ((DUP_PH == 200 + PH_ATT1) ? 2 : 1); ++rep_) { const Ctx c = fresh(c0); if (rep_) __syncthreads();
#if DIL_REF
        dil_attn_ref_phase(c);
#else
        dil_attn_mfma_phase(c);
#endif
        SEAM(PH_ATT1);
    }
    if (IN(PH_MRG1)) for (int rep_ = 0; rep_ < ((DUP_PH == 200 + PH_MRG1) ? 2 : 1); ++rep_) { const Ctx c = fresh(c0); if (rep_) __syncthreads();
#if !DIL_REF
        dil_merge_phase(c);
#endif
        SEAM(PH_MRG1);
    }
    if (IN(PH_OUT1)) for (int rep_ = 0; rep_ < ((DUP_PH == 200 + PH_OUT1) ? 2 : 1); ++rep_) { const Ctx c = fresh(c0); if (rep_) __syncthreads();
        pg8::Gemm g{Ob, (const bf16_t*)(c.ws + WS_WDILOUT), T_, D_, D_}; pg8::StaticOrder S; S.init(T_, D_, c.G, c.bid);
        EpiResid<false> E{X, X, MOD + (size_t)8 * MODW + 2 * 2048};
        pg8::gemm_phase<EpiResid<false>, pg8::StaticOrder, false>((PG8_LAS unsigned char*)c.lds, g, S, E, nullptr);
        SEAM(PH_OUT1);
    }
    if (IN(PH_RT1)) for (int rep_ = 0; rep_ < ((DUP_PH == 200 + PH_RT1) ? 2 : 1); ++rep_) { const Ctx c = fresh(c0); if (rep_) __syncthreads(); norm_phase<1>(c, X, nullptr, c.A.in[5] + 2048, MOD + (size_t)8 * MODW + 3 * 2048, MOD + (size_t)8 * MODW + 4 * 2048, nullptr, Hb); SEAM(PH_RT1); }
    if (IN(PH_DSP1)) for (int rep_ = 0; rep_ < ((DUP_PH == 200 + PH_DSP1) ? 2 : 1); ++rep_) { const Ctx c = fresh(c0); if (rep_) __syncthreads(); dispatch_phase(c); SEAM(PH_DSP1); }
    if (IN(PH_E1_1)) for (int rep_ = 0; rep_ < ((DUP_PH == 200 + PH_E1_1) ? 2 : 1); ++rep_) { const Ctx c = fresh(c0); if (rep_) __syncthreads();
        moe_tab_to_lds(c);
        pg8::Gemm g{Hb, WE1, CAP, 16 * 2816, D_}; MoeOrder S{(LDSP const int*)(c.lds + LDS_MISC), c.G, vcu, 11};
        EpiSwiglu E{HID};
        pg8::gemm_phase_g<EpiSwiglu, MoeOrder, false>((const int*)(c.ws + WS_SLOTTOK), (PG8_LAS unsigned char*)c.lds, g, S, E, nullptr);
        SEAM(PH_E1_1);
    }
    if (IN(PH_E2_1)) for (int rep_ = 0; rep_ < ((DUP_PH == 200 + PH_E2_1) ? 2 : 1); ++rep_) { const Ctx c = fresh(c0); if (rep_) __syncthreads();
        moe_tab_to_lds(c);
        pg8::Gemm g{HID, WE2, CAP, 16 * 2048, DE}; MoeOrder S{(LDSP const int*)(c.lds + LDS_MISC), c.G, vcu, 8};
        EpiDown E{YO, (const float*)(c.ws + WS_SLOTW)};
        pg8::gemm_phase<EpiDown, MoeOrder, false>((PG8_LAS unsigned char*)c.lds, g, S, E, nullptr);
        SEAM(PH_E2_1);
    }
#if DUP_PH == 250
    if (hi - lo > 1) { for (int k_ = 0; k_ < 10; ++k_) xcd_barrier(bar); }
#endif
    if (IN(PH_FIN)) for (int rep_ = 0; rep_ < ((DUP_PH == 200 + PH_FIN) ? 2 : 1); ++rep_) { const Ctx c = fresh(c0); if (rep_) __syncthreads(); norm_phase<3>(c, X, nullptr, c.A.in[6], nullptr, nullptr, MOD + (size_t)8 * MODW + 5 * 2048, nullptr); }
#undef IN
#undef SEAM
}

extern "C" void kernel_launch(void* const* d_in, const int* in_sizes, int n_in, void* d_out, int out_size, void* d_ws, size_t ws_size, hipStream_t stream) {
    static int grid = 0;
    if (grid == 0) {
        if (n_in != 19 || out_size != T_ * D_ || ws_size < WS_END) { fprintf(stderr, "kernel_launch: unexpected shapes (n_in %d out %d ws %zu need %zu)\n", n_in, out_size, ws_size, (size_t)WS_END); grid = -1; return; }
        int dev = 0, cus = 0;
        if (hipGetDevice(&dev) != hipSuccess || hipDeviceGetAttribute(&cus, hipDeviceAttributeMultiprocessorCount, dev) != hipSuccess) { grid = -1; return; }
        if (hipFuncSetAttribute((const void*)fwd, hipFuncAttributeMaxDynamicSharedMemorySize, LDS_BYTES) != hipSuccess) { fprintf(stderr, "kernel_launch: hipFuncSetAttribute failed\n"); grid = -1; return; }
        int per_cu = 0;
        if (hipOccupancyMaxActiveBlocksPerMultiprocessor(&per_cu, (const void*)fwd, NTHR, LDS_BYTES) != hipSuccess || per_cu < 1) fprintf(stderr, "kernel_launch: occupancy query says %d\n", per_cu);
        (void)hipGetLastError();
        grid = cus > 256 ? 256 : cus;
    }
    if (grid < 0) return;
    (void)hipMemsetAsync((char*)d_ws + WS_BAR, 0, WS_CTL_END, stream);
    Args a{};
    for (int i = 0; i < 19; ++i) a.in[i] = (const float*)d_in[i];
    a.out = (float*)d_out; a.ws = (unsigned char*)d_ws;
#if MK_ONE_LAUNCH
    a.ph_lo = 0; a.ph_hi = N_PHASES;
    hipLaunchKernelGGL(fwd, dim3(grid), dim3(NTHR), LDS_BYTES, stream, a);
#else
    for (int p = 0; p < N_PHASES; ++p) { a.ph_lo = p; a.ph_hi = p + 1; hipLaunchKernelGGL(fwd, dim3(grid), dim3(NTHR), LDS_BYTES, stream, a); }
#endif
}
```

```cpp
#define MK_ONE_LAUNCH 1
#define NSA_REF 0
#define DIL_REF 0
#define DUP_PH 0
#define CMP_REF 0
#define DIL_STAGGER 1
#define DIL_STREAM 1
#include <hip/hip_runtime.h>
#include <cstdio>
#include <cstdint>
#define XB_TMO      128
#define XB_XCNT(j)  (256  + 64 * (j))
#define XB_XSUB(j)  (1280 + 64 * (j))
#define XB_XGEN(j)  (2304 + 64 * (j))
#define XB_TOP      3328
#define XB_TOPGEN   3392
#define XCD_BAR_WORDS 3456
#define XB_SPIN_CAP (1u << 18)
#define LAS __attribute__((address_space(3)))

__device__ __forceinline__ unsigned xb_ld(unsigned* p)              { return __hip_atomic_load(p, __ATOMIC_RELAXED, __HIP_MEMORY_SCOPE_AGENT); }
__device__ __forceinline__ unsigned xb_add(unsigned* p, unsigned v) { return __hip_atomic_fetch_add(p, v, __ATOMIC_RELAXED, __HIP_MEMORY_SCOPE_AGENT); }
__device__ __forceinline__ unsigned xb_xcc_id() { return (unsigned)__builtin_amdgcn_s_getreg((3 << 11) | 20) & 0xFu; }
#define XB_SPIN(cond, bar) do { unsigned _sp = 0; while (cond) { __builtin_amdgcn_s_sleep(1); \
    if ((++_sp & 255u) == 0u) { if (xb_ld(&(bar)[XB_TMO])) break; if (_sp > XB_SPIN_CAP) { atomicAdd(&(bar)[XB_TMO], 1u); break; } } } } while (0)

struct XcdBarrier {
    unsigned* bar; unsigned x;
    volatile LAS unsigned* st;
};

__device__ __forceinline__ XcdBarrier xcd_barrier_post(unsigned* bar, volatile LAS unsigned* st) {
    XcdBarrier b; b.bar = bar; b.x = xb_xcc_id(); b.st = st;
    if (threadIdx.x == 0) (void)xb_add(&bar[XB_XCNT(b.x)], 1u);
    return b;
}
__device__ __forceinline__ void xcd_barrier_complete(unsigned* bar, unsigned x, unsigned& nloc, unsigned& nx) {
    const unsigned G = gridDim.x * gridDim.y * gridDim.z;
    unsigned sum, cnt, mine, sp = 0u;
    for (;;) {
        sum = 0u; cnt = 0u; mine = 0u;
#pragma unroll
        for (unsigned j = 0; j < 16; ++j) { const unsigned c = xb_ld(&bar[XB_XCNT(j)]); sum += c; cnt += (c > 0u) ? 1u : 0u; mine = (j == x) ? c : mine; }
        if (sum == G) break;
        __builtin_amdgcn_s_sleep(1);
        if ((++sp & 255u) == 0u) { if (xb_ld(&bar[XB_TMO])) break; if (sp > XB_SPIN_CAP) { atomicAdd(&bar[XB_TMO], 1u); break; } }
    }
    nloc = mine > 0u ? mine : 1u; nx = cnt > 0u ? cnt : 1u;
}

__device__ __forceinline__ void xcd_barrier(const XcdBarrier& b) {
    asm volatile("s_waitcnt vmcnt(0)" ::: "memory");
    __syncthreads();
    if (threadIdx.x == 0) {
        unsigned* bar = b.bar;
        __builtin_amdgcn_s_waitcnt(0);
        unsigned nloc = b.st[0], nx = b.st[1];
        if (nloc == 0u) { xcd_barrier_complete(bar, b.x, nloc, nx); b.st[0] = nloc; b.st[1] = nx; }
        const unsigned old = xb_add(&bar[XB_XSUB(b.x)], 1u);
        const unsigned gen = old / nloc;
        if (old + 1u == (gen + 1u) * nloc) {
            __builtin_amdgcn_fence(__ATOMIC_RELEASE, "agent");
            asm volatile("s_waitcnt vmcnt(0)" ::: "memory");
            const unsigned og = xb_add(&bar[XB_TOP], 1u);
            const unsigned tg = og / nx;
            if (og + 1u == (tg + 1u) * nx) xb_add(&bar[XB_TOPGEN], 1u);
            else XB_SPIN(xb_ld(&bar[XB_TOPGEN]) == tg, bar);
            __builtin_amdgcn_fence(__ATOMIC_ACQUIRE, "agent");
            xb_add(&bar[XB_XGEN(b.x)], 1u);
            asm volatile("s_waitcnt vmcnt(0)" ::: "memory");
        } else {
            XB_SPIN(xb_ld(&bar[XB_XGEN(b.x)]) == gen, bar);
            __builtin_amdgcn_fence(__ATOMIC_ACQUIRE, "agent");
            asm volatile("s_waitcnt vmcnt(0)" ::: "memory");
        }
    }
    __syncthreads();
}
namespace pg8 {
#define PG8_LAS __attribute__((address_space(3)))
typedef unsigned short bf16_t;
typedef short bf16x8 __attribute__((ext_vector_type(8)));
typedef float f32x4 __attribute__((ext_vector_type(4)));
typedef unsigned u32x4 __attribute__((ext_vector_type(4)));
constexpr int BM = 256, BK = 64, HALF = 128, HTB = HALF * BK * 2  , STAGE_BYTES = 8 * HTB, NXCD = 8, WGM = 8;

__host__ __device__ __forceinline__ int lds_byte(int r, int c) { const int st = (r >> 4) * 2 + (c >> 5), rr = r & 15, cc = c & 31, ob = rr * 64 + cc * 2; return st * 1024 + (ob ^ (((ob >> 9) & 1) << 5)); }
__host__ __device__ __forceinline__ void stage_rc(int b, int& R, int& C) { const int st = b / 1024, sb = b % 1024, swz = sb ^ (((sb >> 9) & 1) << 5); R = (st >> 1) * 16 + swz / 64; C = (st & 1) * 32 + (swz % 64) / 2; }
__host__ __device__ __forceinline__ int perm32(int rho) { const int n = rho >> 4, i = rho & 15; return 8 * (i >> 2) + 4 * n + (i & 3); }

struct Unit { int pm, pn; };
struct Gemm { const bf16_t* A; const bf16_t* Bt; int M, N, K; };

struct StaticOrder {
    int nM, nN, nwg, G, c;
    __host__ __device__ void init(int M, int N, int G_, int c_) { nM = M / BM; nN = N / BM; nwg = nM * nN; G = G_; c = c_; }
    __host__ __device__ bool next(int i, Unit& u) const {
        const long L = (long)i * G + c; if (L >= nwg) return false;
        int wgid = (int)L; { const int q = nwg / NXCD, r = nwg % NXCD, xcd = wgid % NXCD, off = wgid / NXCD; wgid = (xcd < r ? xcd * (q + 1) : r * (q + 1) + (xcd - r) * q) + off; }
        const int nig = WGM * nN, gid = wgid / nig, fm = gid * WGM, gsz = (nM - fm) < WGM ? (nM - fm) : WGM;
        u.pm = fm + ((wgid % nig) % gsz); u.pn = (wgid % nig) / gsz; return true;
    }
    __device__ __forceinline__ void a_ready(const Unit&) const {}
    __device__ __forceinline__ void done(const Unit&) const {}
};
struct CountedOrder : StaticOrder {
    const unsigned* ready; unsigned need; unsigned* tmo;
    __device__ __forceinline__ void a_ready(const Unit& u) const {
        if (threadIdx.x < 64) {
            const unsigned long long t0 = __builtin_amdgcn_s_memrealtime(); unsigned polls = 0;
            while ((unsigned)__builtin_amdgcn_readfirstlane(__hip_atomic_load(ready + 64 * u.pm, __ATOMIC_RELAXED, __HIP_MEMORY_SCOPE_AGENT)) < need) {
                if ((++polls & 255u) == 0u && __builtin_amdgcn_readfirstlane(__hip_atomic_load(tmo, __ATOMIC_RELAXED, __HIP_MEMORY_SCOPE_AGENT)) != 0u) break;
                if (__builtin_amdgcn_s_memrealtime() - t0 > 2000000ull) {
                    if (threadIdx.x == 0) { unsigned expect = 0u; __hip_atomic_compare_exchange_strong(tmo + 1, &expect, 0x600u | (unsigned)(u.pm & 0xff), __ATOMIC_RELAXED, __ATOMIC_RELAXED, __HIP_MEMORY_SCOPE_AGENT); __hip_atomic_store(tmo, 1u, __ATOMIC_RELAXED, __HIP_MEMORY_SCOPE_AGENT); }
                    break; }
                __builtin_amdgcn_s_sleep(2); }
            __builtin_amdgcn_fence(__ATOMIC_ACQUIRE, "agent");
            asm volatile("s_waitcnt vmcnt(0)" ::: "memory");
        }
#if !defined(BROKEN_HOOK_NO_BARRIER)
        asm volatile("" ::: "memory"); __builtin_amdgcn_s_barrier(); asm volatile("" ::: "memory");
#endif
    }
};

__device__ __forceinline__ unsigned cvt_pk_bf16(float lo, float hi) { unsigned r; asm volatile("v_cvt_pk_bf16_f32 %0, %1, %2" : "=v"(r) : "v"(lo), "v"(hi)); return r; }
typedef float f32x2 __attribute__((ext_vector_type(2)));
__device__ __forceinline__ f32x2 gelu_pk(f32x2 v) {
    const f32x2 av = __builtin_elementwise_abs(v), d = av * 0.2316418882f + 1.0f;
    f32x2 t; t.x = __builtin_amdgcn_rcpf(d.x); t.y = __builtin_amdgcn_rcpf(d.y);
    f32x2 q = t * 0.5307027145f + (-0.7265760135f); q = q * t + 0.7107068705f; q = q * t + (-0.142248368f); q = q * t + 0.127414796f; q = q * t;
    const f32x2 s = (v * v) * (-0.72134752044f);
    f32x2 e; e.x = __builtin_amdgcn_exp2f(s.x); e.y = __builtin_amdgcn_exp2f(s.y);
    const f32x2 m = v * (q * e), r = v - m;
    f32x2 o; o.x = v.x < 0.f ? m.x : r.x; o.y = v.y < 0.f ? m.y : r.y; return o;
}

struct EpiF32 {
    static constexpr bool PERM = false, AFTER_DRAIN = false;
    float* C; int ldc; const float* bias;
    __device__ __forceinline__ void operator()(const f32x4 (&acc)[2][2][4][2], const Unit& u, int wr, int wc, int fr, int fq) const {
        const int row0 = u.pm * BM + wr * 64 + fr, col0 = u.pn * BM + wc * 32 + 4 * fq;
        f32x4 bv[2][2];
#pragma unroll
        for (int bj = 0; bj < 2; ++bj)
#pragma unroll
            for (int n = 0; n < 2; ++n) bv[bj][n] = bias ? *(const f32x4*)(bias + col0 + bj * HALF + n * 16) : (f32x4){0.f, 0.f, 0.f, 0.f};
#pragma unroll
        for (int ai = 0; ai < 2; ++ai)
#pragma unroll
            for (int m = 0; m < 4; ++m) { float* rowp = C + (size_t)(row0 + ai * HALF + m * 16) * ldc + col0;
#pragma unroll
                for (int bj = 0; bj < 2; ++bj)
#pragma unroll
                    for (int n = 0; n < 2; ++n) *(f32x4*)(rowp + bj * HALF + n * 16) = acc[ai][bj][m][n] + bv[bj][n]; }
    }
};
template <int ACT  > struct EpiBf16 {
    static constexpr bool PERM = true, AFTER_DRAIN = false;
    bf16_t* O; int ldc; const float* bias; int split_cols; size_t split_stride;
    __device__ __forceinline__ void operator()(const f32x4 (&acc)[2][2][4][2], const Unit& u, int wr, int wc, int fr, int fq) const {
        const int row0 = u.pm * BM + wr * 64 + fr; int colt = u.pn * BM; bf16_t* base = O;
        if (split_cols) { const int t = colt / split_cols; base += (size_t)t * split_stride; colt -= t * split_cols; }
        const int col0 = colt + wc * 32 + 8 * fq, bcol0 = u.pn * BM + wc * 32 + 8 * fq;
        f32x4 bv[2][2];
#pragma unroll
        for (int bj = 0; bj < 2; ++bj)
#pragma unroll
            for (int n = 0; n < 2; ++n) bv[bj][n] = bias ? *(const f32x4*)(bias + bcol0 + bj * HALF + 4 * n) : (f32x4){0.f, 0.f, 0.f, 0.f};
#pragma unroll
        for (int ai = 0; ai < 2; ++ai)
#pragma unroll
            for (int m = 0; m < 4; ++m) { bf16_t* rowp = base + (size_t)(row0 + ai * HALF + m * 16) * ldc + col0;
#pragma unroll
                for (int bj = 0; bj < 2; ++bj) { f32x4 v0 = acc[ai][bj][m][0] + bv[bj][0], v1 = acc[ai][bj][m][1] + bv[bj][1];
                    if (ACT == 1) { f32x2 a = gelu_pk((f32x2){v0[0], v0[1]}), b = gelu_pk((f32x2){v0[2], v0[3]}), c = gelu_pk((f32x2){v1[0], v1[1]}), d = gelu_pk((f32x2){v1[2], v1[3]});
                        v0 = (f32x4){a.x, a.y, b.x, b.y}; v1 = (f32x4){c.x, c.y, d.x, d.y}; }
                    if (ACT == 2) {
#pragma unroll
                        for (int j = 0; j < 4; ++j) { v0[j] = 0.5f * v0[j] * (1.0f + erff(v0[j] * 0.70710678f)); v1[j] = 0.5f * v1[j] * (1.0f + erff(v1[j] * 0.70710678f)); } }
                    u32x4 w; w.x = cvt_pk_bf16(v0[0], v0[1]); w.y = cvt_pk_bf16(v0[2], v0[3]); w.z = cvt_pk_bf16(v1[0], v1[1]); w.w = cvt_pk_bf16(v1[2], v1[3]);
                    *(u32x4*)(rowp + bj * HALF) = w; } }
    }
};

template <class Epi, class Sched, bool STAMP = false>
__device__ __forceinline__ void gemm_phase(PG8_LAS unsigned char* lds, const Gemm g, const Sched& S, const Epi& E, unsigned long long* stamps) {
    const int tid = threadIdx.x, wid = __builtin_amdgcn_readfirstlane(tid >> 6), lane = tid & 63, wr = wid >> 2, wc = wid & 3, fr = lane & 15, fq = lane >> 4;
    const int K = g.K, nt = K / BK;
    int ts_lo = 0, ts_hi = 0, nts = 0; const unsigned long long rt_entry = STAMP ? (unsigned long long)wall_clock64() : 0ull;
#define PG8_STAMP() do { if (STAMP && wid == 0 && nts < 64) { const unsigned long long _c = (unsigned long long)clock64(); \
        ts_lo = (lane == nts) ? (int)(unsigned)_c : ts_lo; ts_hi = (lane == nts) ? (int)(unsigned)(_c >> 32) : ts_hi; ++nts; } } while (0)
    PG8_STAMP();
    unsigned voffA[2], voffB[2];
#pragma unroll
    for (int i = 0; i < 2; ++i) { int R, C; stage_rc(tid * 16 + i * 8192, R, C); const int Rb = Epi::PERM ? ((R & ~31) + perm32(R & 31)) : R;
        voffA[i] = (unsigned)(R * K + C) * 2u; voffB[i] = (unsigned)(Rb * K + C) * 2u; }
    const size_t kstep = (size_t)(BK * 2);
    const size_t hstep = (size_t)HALF * K * 2;
    const size_t tstep = 2 * hstep;
    const unsigned ldsw = (unsigned)wid * 1024u;
    const int aoff = lds_byte(wr * 64 + fr, fq * 8), boff = lds_byte(wc * 32 + fr, fq * 8);
#define PG8_SA(b, h) (((b) * 2 + (h)) * HTB)
#define PG8_SB(b, h) ((4 + (b) * 2 + (h)) * HTB)
#define PG8_STAGE(bufoff, gbase, voff) do { _Pragma("unroll") for (int _i = 0; _i < 2; ++_i) \
        __builtin_amdgcn_global_load_lds((const unsigned*)((const char*)(gbase) + (voff)[_i]), (PG8_LAS unsigned*)(lds + (bufoff) + ldsw + _i * 8192), 16, 0, 0); } while (0)
#define PG8_LDA(dst, b, h) do { _Pragma("unroll") for (int m = 0; m < 4; ++m) _Pragma("unroll") for (int k = 0; k < 2; ++k) dst[m][k] = *(const PG8_LAS bf16x8*)(lds + PG8_SA(b, h) + aoff + m * 2048 + k * 1024); } while (0)
#define PG8_LDB(dst, b, h) do { _Pragma("unroll") for (int n = 0; n < 2; ++n) _Pragma("unroll") for (int k = 0; k < 2; ++k) dst[n][k] = *(const PG8_LAS bf16x8*)(lds + PG8_SB(b, h) + boff + n * 2048 + k * 1024); } while (0)
#define PG8_MMA(ai, bj, At, Bt) do { __builtin_amdgcn_s_setprio(1); _Pragma("unroll") for (int m = 0; m < 4; ++m) _Pragma("unroll") for (int n = 0; n < 2; ++n) _Pragma("unroll") for (int k = 0; k < 2; ++k) \
        acc[ai][bj][m][n] = __builtin_amdgcn_mfma_f32_16x16x32_bf16(Bt[n][k], At[m][k], acc[ai][bj][m][n], 0, 0, 0); __builtin_amdgcn_s_setprio(0); } while (0)
#define PG8_WAIT_V(n) asm volatile("s_waitcnt vmcnt(" #n ")" ::: "memory")
#define PG8_WAIT_L(n) asm volatile("s_waitcnt lgkmcnt(" #n ")" ::: "memory")
#define PG8_BAR __builtin_amdgcn_s_barrier()
#define PG8_SCHED __builtin_amdgcn_sched_barrier(0)
    Unit cur, nxt; int ui = 0;
    if (!S.next(0, cur)) return;
    f32x4 acc[2][2][4][2];
#pragma unroll
    for (int a = 0; a < 2; ++a)
#pragma unroll
        for (int b = 0; b < 2; ++b)
#pragma unroll
            for (int m = 0; m < 4; ++m)
#pragma unroll
                for (int n = 0; n < 2; ++n) acc[a][b][m][n] = (f32x4){0.f, 0.f, 0.f, 0.f};
    bf16x8 At[4][2], B0[2][2], B1[2][2];
    const char* cA = (const char*)g.A + (size_t)cur.pm * tstep; const char* cB = (const char*)g.Bt + (size_t)cur.pn * tstep;
    S.a_ready(cur);
    PG8_STAGE(PG8_SB(0, 0), cB, voffB); PG8_STAGE(PG8_SA(0, 0), cA, voffA); PG8_STAGE(PG8_SB(0, 1), cB + hstep, voffB); PG8_STAGE(PG8_SA(0, 1), cA + hstep, voffA);
    if (wr == 1) PG8_BAR;
    PG8_WAIT_V(4); PG8_BAR;
    PG8_STAGE(PG8_SB(1, 0), cB + kstep, voffB); PG8_STAGE(PG8_SA(1, 0), cA + kstep, voffA); PG8_STAGE(PG8_SB(1, 1), cB + hstep + kstep, voffB);
    PG8_WAIT_V(6); PG8_BAR;
    PG8_STAMP();
    for (;;) {
        const bool has_next = S.next(ui + 1, nxt);
        const char* nA = has_next ? (const char*)g.A + (size_t)nxt.pm * tstep : cA; const char* nB = has_next ? (const char*)g.Bt + (size_t)nxt.pn * tstep : cB;
        for (int t = 0; t < nt; t += 2) {
            const bool last = (t == nt - 2);
            const char* a1 = cA + (size_t)(t + 1) * kstep;
            const char* a2 = last ? nA : cA + (size_t)(t + 2) * kstep; const char* b2 = last ? nB : cB + (size_t)(t + 2) * kstep;
            const char* a3 = a2 + kstep; const char* b3 = b2 + kstep;
            if (last && has_next) S.a_ready(nxt);
            PG8_LDB(B0, 0, 0); PG8_SCHED; PG8_LDA(At, 0, 0); PG8_STAGE(PG8_SA(1, 1), a1 + hstep, voffA);
            PG8_WAIT_L(8); PG8_BAR; PG8_WAIT_L(0); PG8_MMA(0, 0, At, B0); PG8_BAR; PG8_SCHED;
            PG8_LDB(B1, 0, 1); PG8_STAGE(PG8_SB(0, 0), b2, voffB);
            PG8_BAR; PG8_WAIT_L(0); PG8_MMA(0, 1, At, B1); PG8_BAR;
            PG8_LDA(At, 0, 1); PG8_STAGE(PG8_SA(0, 0), a2, voffA);
            PG8_BAR; PG8_WAIT_L(0); PG8_MMA(1, 0, At, B0); PG8_BAR; PG8_SCHED;
            PG8_STAGE(PG8_SB(0, 1), b2 + hstep, voffB);
            PG8_WAIT_V(6); PG8_BAR; PG8_MMA(1, 1, At, B1); PG8_BAR;
            PG8_LDB(B0, 1, 0); PG8_SCHED; PG8_LDA(At, 1, 0); PG8_STAGE(PG8_SA(0, 1), a2 + hstep, voffA);
            PG8_WAIT_L(8); PG8_BAR; PG8_WAIT_L(0); PG8_MMA(0, 0, At, B0); PG8_BAR; PG8_SCHED;
            PG8_LDB(B1, 1, 1); PG8_STAGE(PG8_SB(1, 0), b3, voffB);
            PG8_BAR; PG8_WAIT_L(0); PG8_MMA(0, 1, At, B1); PG8_BAR;
            PG8_LDA(At, 1, 1); PG8_STAGE(PG8_SA(1, 0), a3, voffA);
            PG8_BAR; PG8_WAIT_L(0); PG8_MMA(1, 0, At, B0); PG8_BAR; PG8_SCHED;
            PG8_STAGE(PG8_SB(1, 1), b3 + hstep, voffB);
            PG8_WAIT_V(6); PG8_BAR; PG8_MMA(1, 1, At, B1); PG8_BAR;
        }
        PG8_STAMP();
        if constexpr (!Epi::AFTER_DRAIN) { E(acc, cur, wr, wc, fr, fq); S.done(cur); }
        PG8_STAMP();
        if (!has_next) break;
#pragma unroll
        for (int a = 0; a < 2; ++a)
#pragma unroll
            for (int b = 0; b < 2; ++b)
#pragma unroll
                for (int m = 0; m < 4; ++m)
#pragma unroll
                    for (int n = 0; n < 2; ++n) acc[a][b][m][n] = (f32x4){0.f, 0.f, 0.f, 0.f};
        cur = nxt; cA = nA; cB = nB; ++ui;
    }
    PG8_WAIT_V(0);
    if (wr == 0) PG8_BAR;
    PG8_BAR;
    if constexpr (Epi::AFTER_DRAIN) { E.fused(acc, cur, wr, wc, fr, fq, lds, wid, lane); S.done(cur); }
    PG8_STAMP();
    if (STAMP && wid == 0) { stamps[lane] = lane < nts ? (((unsigned long long)(unsigned)ts_hi << 32) | (unsigned)ts_lo) : 0ull;
        if (lane == 62) stamps[62] = rt_entry; if (lane == 63) stamps[63] = (unsigned long long)wall_clock64(); }
#undef PG8_STAMP
#undef PG8_SA
#undef PG8_SB
#undef PG8_STAGE
#undef PG8_LDA
#undef PG8_LDB
#undef PG8_MMA
#undef PG8_WAIT_V
#undef PG8_WAIT_L
#undef PG8_BAR
#undef PG8_SCHED
}
template <class Epi, class Sched, bool STAMP = false>
__device__ __forceinline__ void gemm_phase_g(const int* rowmap, PG8_LAS unsigned char* lds, const Gemm g, const Sched& S, const Epi& E, unsigned long long* stamps) {
    const int tid = threadIdx.x, wid = __builtin_amdgcn_readfirstlane(tid >> 6), lane = tid & 63, wr = wid >> 2, wc = wid & 3, fr = lane & 15, fq = lane >> 4;
    const int K = g.K, nt = K / BK;
    int ts_lo = 0, ts_hi = 0, nts = 0; const unsigned long long rt_entry = STAMP ? (unsigned long long)wall_clock64() : 0ull;
#define PG8_STAMP() do { if (STAMP && wid == 0 && nts < 64) { const unsigned long long _c = (unsigned long long)clock64(); \
        ts_lo = (lane == nts) ? (int)(unsigned)_c : ts_lo; ts_hi = (lane == nts) ? (int)(unsigned)(_c >> 32) : ts_hi; ++nts; } } while (0)
    PG8_STAMP();
    unsigned voffB[2], cpartA[2]; int rowA[2];
#pragma unroll
    for (int i = 0; i < 2; ++i) { int R, C; stage_rc(tid * 16 + i * 8192, R, C); const int Rb = Epi::PERM ? ((R & ~31) + perm32(R & 31)) : R;
        rowA[i] = R; cpartA[i] = (unsigned)C * 2u; voffB[i] = (unsigned)(Rb * K + C) * 2u; }
    unsigned cvoff[2][2], nvoff[2][2];
#define PG8_ROWS(dst, u_) do { _Pragma("unroll") for (int h_ = 0; h_ < 2; ++h_) _Pragma("unroll") for (int i_ = 0; i_ < 2; ++i_) { \
        const int tok_ = __hip_atomic_load(rowmap + (u_).pm * 256 + h_ * 128 + rowA[i_], __ATOMIC_RELAXED, __HIP_MEMORY_SCOPE_AGENT); dst[h_][i_] = (unsigned)tok_ * (unsigned)(K * 2) + cpartA[i_]; } } while (0)
    const size_t kstep = (size_t)(BK * 2);
    const size_t hstep = (size_t)HALF * K * 2;
    const size_t tstep = 2 * hstep;
    const unsigned ldsw = (unsigned)wid * 1024u;
    const int aoff = lds_byte(wr * 64 + fr, fq * 8), boff = lds_byte(wc * 32 + fr, fq * 8);
#define PG8_SA(b, h) (((b) * 2 + (h)) * HTB)
#define PG8_SB(b, h) ((4 + (b) * 2 + (h)) * HTB)
#define PG8_STAGE(bufoff, gbase, voff) do { _Pragma("unroll") for (int _i = 0; _i < 2; ++_i) \
        __builtin_amdgcn_global_load_lds((const unsigned*)((const char*)(gbase) + (voff)[_i]), (PG8_LAS unsigned*)(lds + (bufoff) + ldsw + _i * 8192), 16, 0, 0); } while (0)
#define PG8_LDA(dst, b, h) do { _Pragma("unroll") for (int m = 0; m < 4; ++m) _Pragma("unroll") for (int k = 0; k < 2; ++k) dst[m][k] = *(const PG8_LAS bf16x8*)(lds + PG8_SA(b, h) + aoff + m * 2048 + k * 1024); } while (0)
#define PG8_LDB(dst, b, h) do { _Pragma("unroll") for (int n = 0; n < 2; ++n) _Pragma("unroll") for (int k = 0; k < 2; ++k) dst[n][k] = *(const PG8_LAS bf16x8*)(lds + PG8_SB(b, h) + boff + n * 2048 + k * 1024); } while (0)
#define PG8_MMA(ai, bj, At, Bt) do { __builtin_amdgcn_s_setprio(1); _Pragma("unroll") for (int m = 0; m < 4; ++m) _Pragma("unroll") for (int n = 0; n < 2; ++n) _Pragma("unroll") for (int k = 0; k < 2; ++k) \
        acc[ai][bj][m][n] = __builtin_amdgcn_mfma_f32_16x16x32_bf16(Bt[n][k], At[m][k], acc[ai][bj][m][n], 0, 0, 0); __builtin_amdgcn_s_setprio(0); } while (0)
#define PG8_WAIT_V(n) asm volatile("s_waitcnt vmcnt(" #n ")" ::: "memory")
#define PG8_WAIT_L(n) asm volatile("s_waitcnt lgkmcnt(" #n ")" ::: "memory")
#define PG8_BAR __builtin_amdgcn_s_barrier()
#define PG8_SCHED __builtin_amdgcn_sched_barrier(0)
    Unit cur, nxt; int ui = 0;
    if (!S.next(0, cur)) return;
    f32x4 acc[2][2][4][2];
#pragma unroll
    for (int a = 0; a < 2; ++a)
#pragma unroll
        for (int b = 0; b < 2; ++b)
#pragma unroll
            for (int m = 0; m < 4; ++m)
#pragma unroll
                for (int n = 0; n < 2; ++n) acc[a][b][m][n] = (f32x4){0.f, 0.f, 0.f, 0.f};
    bf16x8 At[4][2], B0[2][2], B1[2][2];
    const char* gA0 = (const char*)g.A; const char* cB = (const char*)g.Bt + (size_t)cur.pn * tstep;
    S.a_ready(cur);
    PG8_ROWS(cvoff, cur);
    PG8_STAGE(PG8_SB(0, 0), cB, voffB); PG8_STAGE(PG8_SA(0, 0), gA0, cvoff[0]); PG8_STAGE(PG8_SB(0, 1), cB + hstep, voffB); PG8_STAGE(PG8_SA(0, 1), gA0, cvoff[1]);
    if (wr == 1) PG8_BAR;
    PG8_WAIT_V(4); PG8_BAR;
    PG8_STAGE(PG8_SB(1, 0), cB + kstep, voffB); PG8_STAGE(PG8_SA(1, 0), gA0 + kstep, cvoff[0]); PG8_STAGE(PG8_SB(1, 1), cB + hstep + kstep, voffB);
    PG8_WAIT_V(6); PG8_BAR;
    PG8_STAMP();
    for (;;) {
        const bool has_next = S.next(ui + 1, nxt);
        const char* nB = has_next ? (const char*)g.Bt + (size_t)nxt.pn * tstep : cB;
        if (has_next) PG8_ROWS(nvoff, nxt); else { nvoff[0][0] = cvoff[0][0]; nvoff[0][1] = cvoff[0][1]; nvoff[1][0] = cvoff[1][0]; nvoff[1][1] = cvoff[1][1]; }
        for (int t = 0; t < nt; t += 2) {
            const bool last = (t == nt - 2);
            const char* a1 = gA0 + (size_t)(t + 1) * kstep;
            const char* a2 = last ? gA0 : gA0 + (size_t)(t + 2) * kstep; const char* b2 = last ? nB : cB + (size_t)(t + 2) * kstep;
            const char* a3 = a2 + kstep; const char* b3 = b2 + kstep;
            unsigned v2[2][2];
#pragma unroll
            for (int h_ = 0; h_ < 2; ++h_) { v2[h_][0] = last ? nvoff[h_][0] : cvoff[h_][0]; v2[h_][1] = last ? nvoff[h_][1] : cvoff[h_][1]; }
            if (last && has_next) S.a_ready(nxt);
            PG8_LDB(B0, 0, 0); PG8_SCHED; PG8_LDA(At, 0, 0); PG8_STAGE(PG8_SA(1, 1), a1, cvoff[1]);
            PG8_WAIT_L(8); PG8_BAR; PG8_WAIT_L(0); PG8_MMA(0, 0, At, B0); PG8_BAR; PG8_SCHED;
            PG8_LDB(B1, 0, 1); PG8_STAGE(PG8_SB(0, 0), b2, voffB);
            PG8_BAR; PG8_WAIT_L(0); PG8_MMA(0, 1, At, B1); PG8_BAR;
            PG8_LDA(At, 0, 1); PG8_STAGE(PG8_SA(0, 0), a2, v2[0]);
            PG8_BAR; PG8_WAIT_L(0); PG8_MMA(1, 0, At, B0); PG8_BAR; PG8_SCHED;
            PG8_STAGE(PG8_SB(0, 1), b2 + hstep, voffB);
            PG8_WAIT_V(6); PG8_BAR; PG8_MMA(1, 1, At, B1); PG8_BAR;
            PG8_LDB(B0, 1, 0); PG8_SCHED; PG8_LDA(At, 1, 0); PG8_STAGE(PG8_SA(0, 1), a2, v2[1]);
            PG8_WAIT_L(8); PG8_BAR; PG8_WAIT_L(0); PG8_MMA(0, 0, At, B0); PG8_BAR; PG8_SCHED;
            PG8_LDB(B1, 1, 1); PG8_STAGE(PG8_SB(1, 0), b3, voffB);
            PG8_BAR; PG8_WAIT_L(0); PG8_MMA(0, 1, At, B1); PG8_BAR;
            PG8_LDA(At, 1, 1); PG8_STAGE(PG8_SA(1, 0), a3, v2[0]);
            PG8_BAR; PG8_WAIT_L(0); PG8_MMA(1, 0, At, B0); PG8_BAR; PG8_SCHED;
            PG8_STAGE(PG8_SB(1, 1), b3 + hstep, voffB);
            PG8_WAIT_V(6); PG8_BAR; PG8_MMA(1, 1, At, B1); PG8_BAR;
        }
        PG8_STAMP();
        if constexpr (!Epi::AFTER_DRAIN) { E(acc, cur, wr, wc, fr, fq); S.done(cur); }
        PG8_STAMP();
        if (!has_next) break;
#pragma unroll
        for (int a = 0; a < 2; ++a)
#pragma unroll
            for (int b = 0; b < 2; ++b)
#pragma unroll
                for (int m = 0; m < 4; ++m)
#pragma unroll
                    for (int n = 0; n < 2; ++n) acc[a][b][m][n] = (f32x4){0.f, 0.f, 0.f, 0.f};
        cur = nxt; cB = nB; ++ui; cvoff[0][0] = nvoff[0][0]; cvoff[0][1] = nvoff[0][1]; cvoff[1][0] = nvoff[1][0]; cvoff[1][1] = nvoff[1][1];
    }
    PG8_WAIT_V(0);
    if (wr == 0) PG8_BAR;
    PG8_BAR;
    if constexpr (Epi::AFTER_DRAIN) { E.fused(acc, cur, wr, wc, fr, fq, lds, wid, lane); S.done(cur); }
    PG8_STAMP();
    if (STAMP && wid == 0) { stamps[lane] = lane < nts ? (((unsigned long long)(unsigned)ts_hi << 32) | (unsigned)ts_lo) : 0ull;
        if (lane == 62) stamps[62] = rt_entry; if (lane == 63) stamps[63] = (unsigned long long)wall_clock64(); }
#undef PG8_STAMP
#undef PG8_ROWS
#undef PG8_SA
#undef PG8_SB
#undef PG8_STAGE
#undef PG8_LDA
#undef PG8_LDB
#undef PG8_MMA
#undef PG8_WAIT_V
#undef PG8_WAIT_L
#undef PG8_BAR
#undef PG8_SCHED
}
}

#define LDSP __attribute__((address_space(3)))
typedef unsigned short bf16_t;
typedef float f32x4 __attribute__((ext_vector_type(4)));
typedef float f32x2 __attribute__((ext_vector_type(2)));
typedef unsigned u32x4 __attribute__((ext_vector_type(4)));
typedef unsigned u32x2 __attribute__((ext_vector_type(2)));

constexpr int T_ = 16384, D_ = 2048, S_ = 2048, B_ = 8;
constexpr int PW0 = 5376, PW1 = 14336, DE = 1408, CAP = 36864, MODW = 12288;
constexpr int NTHR = 512, NWAVE = 8;
constexpr int LDS_BYTES = 147456;
constexpr int LDS_MISC = 131072;

constexpr size_t al256(size_t x) { return (x + 255) & ~(size_t)255; }
constexpr size_t WS_BAR     = 0;
constexpr size_t WS_CTL_END = 16384;
constexpr size_t WS_TAB     = WS_CTL_END;
constexpr size_t WS_BLKCNT  = WS_TAB + 1024;
constexpr size_t WS_MOD     = al256(WS_BLKCNT + 256 * 16 * 4);
constexpr size_t WS_RIDX    = al256(WS_MOD + (size_t)2 * 8 * MODW * 4);
constexpr size_t WS_RW      = al256(WS_RIDX + (size_t)T_ * 2 * 4);
constexpr size_t WS_TOKSLOT = al256(WS_RW + (size_t)T_ * 2 * 4);
constexpr size_t WS_SLOTW   = al256(WS_TOKSLOT + (size_t)T_ * 2 * 4);
constexpr size_t WS_SLOTTOK = al256(WS_SLOTW + (size_t)CAP * 4);
constexpr size_t WS_SEL     = al256(WS_SLOTTOK + (size_t)CAP * 4);
constexpr size_t WS_CMP     = al256(WS_SEL + (size_t)8 * 4 * 2048 * 4);
constexpr size_t WS_LSE     = al256(WS_CMP + (size_t)2 * 8 * 128 * 4 * 128 * 4);
constexpr size_t WS_WNSAIN  = al256(WS_LSE + (size_t)3 * T_ * 16 * 4);
constexpr size_t WS_WNSAOUT = al256(WS_WNSAIN + (size_t)PW0 * D_ * 2);
constexpr size_t WS_WDILIN  = al256(WS_WNSAOUT + (size_t)D_ * D_ * 2);
constexpr size_t WS_WDILOUT = al256(WS_WDILIN + (size_t)PW1 * D_ * 2);
constexpr size_t WS_WE1     = al256(WS_WDILOUT + (size_t)D_ * D_ * 2);
constexpr size_t WS_WE2     = al256(WS_WE1 + (size_t)16 * 2816 * D_ * 2);
constexpr size_t WS_X       = al256(WS_WE2 + (size_t)16 * D_ * DE * 2);
constexpr size_t WS_H       = al256(WS_X + (size_t)T_ * D_ * 2);
constexpr size_t WS_O       = al256(WS_H + (size_t)T_ * D_ * 2);
constexpr size_t WS_PROJ    = al256(WS_O + (size_t)T_ * D_ * 2);
constexpr size_t WS_XIN     = WS_PROJ;
constexpr size_t WS_HID     = al256(WS_XIN + (size_t)CAP * D_ * 2);
constexpr size_t WS_YO      = al256(WS_HID + (size_t)CAP * DE * 2);
constexpr size_t WS_OG      = al256(WS_PROJ + (size_t)T_ * PW1 * 2);
constexpr size_t WS_ACC     = WS_OG;
constexpr size_t WS_CMPB    = al256(WS_OG + (size_t)3 * T_ * D_ * 2);
constexpr size_t WS_W1T     = al256(WS_CMPB + (size_t)2 * 8 * 128 * 4 * 128 * 2);
constexpr size_t WS_POSB    = al256(WS_W1T + (size_t)2 * 128 * 4096 * 2);
constexpr size_t WS_END     = al256(WS_POSB + 2 * 32 * 128 * 4);
static_assert(WS_END < (size_t)1560000000, "workspace budget");
static_assert(WS_YO + (size_t)CAP * D_ * 2 <= WS_END, "moe buffers must fit inside the proj region");

__device__ __forceinline__ float bf2f(bf16_t v) { return __uint_as_float(((unsigned)v) << 16); }
__device__ __forceinline__ bf16_t f2bf(float f) { unsigned u = __float_as_uint(f); u += 0x7FFFu + ((u >> 16) & 1u); return (bf16_t)(u >> 16); }
__device__ __forceinline__ unsigned pk2(float lo, float hi) { return (unsigned)f2bf(lo) | ((unsigned)f2bf(hi) << 16); }
__device__ __forceinline__ int ld_i(const int* p) { return __hip_atomic_load(p, __ATOMIC_RELAXED, __HIP_MEMORY_SCOPE_AGENT); }
__device__ __forceinline__ float ld_f(const float* p) { return __hip_atomic_load(p, __ATOMIC_RELAXED, __HIP_MEMORY_SCOPE_AGENT); }
__device__ __forceinline__ float wsum(float v) { for (int o = 32; o >= 1; o >>= 1) v += __shfl_xor(v, o); return v; }
__device__ __forceinline__ float wmax(float v) { for (int o = 32; o >= 1; o >>= 1) v = fmaxf(v, __shfl_xor(v, o)); return v; }
__device__ __forceinline__ void lds_fence() { asm volatile("s_waitcnt lgkmcnt(0)" ::: "memory"); }

struct Args { const float* in[19]; float* out; unsigned char* ws; int ph_lo, ph_hi; };
struct Ctx {
    const Args& A; unsigned char* ws;
    LDSP unsigned char* lds;
    int tid, lane, wave, G, bid;
};
__device__ __forceinline__ Ctx fresh(const Ctx& c0) {
    int l = (int)__builtin_amdgcn_mbcnt_hi(~0u, __builtin_amdgcn_mbcnt_lo(~0u, 0u)); asm volatile("" : "+v"(l));
    const int t = c0.wave * 64 + l;
    Ctx c{c0.A, c0.ws, c0.lds, t, l, c0.wave, c0.G, c0.bid};
    return c;
}

__device__ __forceinline__ void mod_units(const Ctx& c) {
    if (c.bid >= 192) {
        {
            const int i = c.bid - 192, j = i & 1, p = i >> 1, e = c.tid & 127, q = c.tid >> 7;
            LDSP float* red = (LDSP float*)c.lds;
            const float* w1 = c.A.in[8] + ((size_t)j * 4096 + p * 128 + q * 32) * 128 + e; const float* pos = c.A.in[10] + j * 4096 + p * 128 + q * 32;
            float s = 0.f;
#pragma unroll
            for (int k = 0; k < 32; ++k) s += pos[k] * w1[(size_t)k * 128];
            red[q * 128 + e] = s;
            __syncthreads();
            if (c.tid < 128) ((float*)(c.ws + WS_POSB))[(j * 32 + p) * 128 + c.tid] = red[c.tid] + red[128 + c.tid] + red[256 + c.tid] + red[384 + c.tid];
        }
        return;
    }
    LDSP float* cs = (LDSP float*)c.lds;
    LDSP float* red = (LDSP float*)(c.lds + 65536);
    const float* cin = c.A.in[1];
    for (int i = c.tid; i < 8 * 2048; i += NTHR) { const float v = cin[i]; cs[i] = v / (1.f + __expf(-v)); }
    __syncthreads();
    float* MOD = (float*)(c.ws + WS_MOD);
    for (int u = c.bid; u < 192; u += c.G) {
        const int layer = u / 96, cb = (u % 96) * 128;
        const int c4 = c.tid & 31, kc = c.tid >> 5;
        f32x4 acc[8];
#pragma unroll
        for (int b = 0; b < 8; ++b) acc[b] = (f32x4){0.f, 0.f, 0.f, 0.f};
        const float* wp = c.A.in[2] + ((size_t)layer * 2048 + kc * 128) * MODW + cb + 4 * c4;
        for (int k0 = 0; k0 < 128; k0 += 8) {
            f32x4 w[8];
#pragma unroll
            for (int q = 0; q < 8; ++q) w[q] = __builtin_nontemporal_load((const f32x4*)(wp + (size_t)(k0 + q) * MODW));
#pragma unroll
            for (int q = 0; q < 8; ++q) { const int k = kc * 128 + k0 + q;
#pragma unroll
                for (int b = 0; b < 8; ++b) acc[b] += cs[b * 2048 + k] * w[q]; }
        }
#pragma unroll
        for (int b = 0; b < 8; ++b) *(LDSP f32x4*)(red + (kc * 8 + b) * 128 + 4 * c4) = acc[b];
        __syncthreads();
        for (int idx = c.tid; idx < 1024; idx += NTHR) {
            const int b = idx >> 7, col = idx & 127; float s = c.A.in[3][layer * MODW + cb + col];
#pragma unroll
            for (int q = 0; q < 16; ++q) s += red[(q * 8 + b) * 128 + col];
            MOD[((size_t)layer * 8 + b) * MODW + cb + col] = s;
        }
        __syncthreads();
    }
}

__device__ __forceinline__ void tr_tile(const float* src, int ld, int nvalid, bf16_t* dst, int dld, LDSP float* tile, int lane) {
    const int cq = (lane & 15) * 4, r4 = lane >> 4;
    f32x4 v[16];
#pragma unroll
    for (int i = 0; i < 16; ++i) {
        const int k = i * 4 + r4;
        if (cq < nvalid) v[i] = __builtin_nontemporal_load((const f32x4*)(src + (size_t)k * ld + cq)); else v[i] = (f32x4){0.f, 0.f, 0.f, 0.f};
    }
#pragma unroll
    for (int i = 0; i < 16; ++i) {
        const int k = i * 4 + r4;
        tile[k * 65 + cq + 0] = v[i][0]; tile[k * 65 + cq + 1] = v[i][1]; tile[k * 65 + cq + 2] = v[i][2]; tile[k * 65 + cq + 3] = v[i][3];
    }
    lds_fence();
    const int k8 = (lane & 7) * 8, rr = lane >> 3;
#pragma unroll
    for (int i = 0; i < 8; ++i) {
        const int r = i * 8 + rr;
        u32x4 w;
        w.x = pk2(tile[(k8 + 0) * 65 + r], tile[(k8 + 1) * 65 + r]); w.y = pk2(tile[(k8 + 2) * 65 + r], tile[(k8 + 3) * 65 + r]);
        w.z = pk2(tile[(k8 + 4) * 65 + r], tile[(k8 + 5) * 65 + r]); w.w = pk2(tile[(k8 + 6) * 65 + r], tile[(k8 + 7) * 65 + r]);
        *(u32x4*)(dst + (size_t)r * dld + k8) = w;
    }
    lds_fence();
}
__device__ __forceinline__ void tr_matrix(const Ctx& c, const float* W, int K, int N, int nrows, bf16_t* Wt) {
    LDSP float* tile = (LDSP float*)(c.lds + c.wave * 16640);
    const int nrt = nrows / 64, nkt = K / 64, nw = c.G * NWAVE;
    for (int t = c.bid * NWAVE + c.wave; t < nrt * nkt; t += nw) {
        const int rt = t % nrt, kt = t / nrt;
        int nv = N - rt * 64; nv = nv > 64 ? 64 : (nv < 0 ? 0 : nv);
        tr_tile(W + (size_t)kt * 64 * N + rt * 64, N, nv, Wt + (size_t)rt * 64 * K + kt * 64, K, tile, c.lane);
    }
}
constexpr int TRX_WE1 = 16 * 2 * 32 * 22, TRX_ALL = TRX_WE1 + 16 * 22 * 32;
__device__ __forceinline__ void tr_experts(const Ctx& c, int layer, int lo, int hi, int gw, int nw) {
    LDSP float* tile = (LDSP float*)(c.lds + c.wave * 16640);
    bf16_t* WE1 = (bf16_t*)(c.ws + WS_WE1); bf16_t* WE2 = (bf16_t*)(c.ws + WS_WE2);
    for (int tt = lo + gw; tt < hi; tt += nw) {
        if (tt < TRX_WE1) {
            const int t = tt, ct = t % 22, kt = (t / 22) % 32, half = (t / 704) & 1, e = t / 1408;
            const float* W = (half ? c.A.in[17] : c.A.in[16]) + (size_t)(layer * 16 + e) * D_ * DE;
            const int j = ct >> 1, rt = ct & 1;
            tr_tile(W + (size_t)kt * 64 * DE + ct * 64, DE, 64, WE1 + ((size_t)e * 2816 + j * 256 + half * 128 + rt * 64) * D_ + kt * 64, D_, tile, c.lane);
        } else {
            const int t = tt - TRX_WE1, rt = t % 32, kt = (t / 32) % 22, e = t / 704;
            const float* W = c.A.in[18] + (size_t)(layer * 16 + e) * DE * D_;
            tr_tile(W + (size_t)kt * 64 * D_ + rt * 64, D_, 64, WE2 + ((size_t)e * 2048 + rt * 64) * DE + kt * 64, DE, tile, c.lane);
        }
    }
}
constexpr int TRX_T0 = 11264;
constexpr int TRX_T1 = 8192;

struct RouteOut { int i0, i1; float w0, w1; };
__device__ __forceinline__ RouteOut route16(const float (&lg)[16], const float* rb) {
    float sc[16], bi[16];
#pragma unroll
    for (int e = 0; e < 16; ++e) { sc[e] = 1.f / (1.f + __expf(-lg[e])); bi[e] = sc[e] + rb[e]; }
    float gs[4];
#pragma unroll
    for (int g = 0; g < 4; ++g) {
        float m1 = bi[4 * g], m2 = -3.0e38f;
#pragma unroll
        for (int i = 1; i < 4; ++i) { const float v = bi[4 * g + i]; if (v > m1) { m2 = m1; m1 = v; } else if (v > m2) m2 = v; }
        gs[g] = m1 + m2;
    }
    int bg = 0; float bv = gs[0];
#pragma unroll
    for (int g = 1; g < 4; ++g) if (gs[g] > bv) { bv = gs[g]; bg = g; }
    float cb[4], cs[4];
#pragma unroll
    for (int i = 0; i < 4; ++i) { cb[i] = bg == 0 ? bi[i] : bg == 1 ? bi[4 + i] : bg == 2 ? bi[8 + i] : bi[12 + i]; cs[i] = bg == 0 ? sc[i] : bg == 1 ? sc[4 + i] : bg == 2 ? sc[8 + i] : sc[12 + i]; }
    int a0 = 0; float v0 = cb[0], s0 = cs[0];
#pragma unroll
    for (int i = 1; i < 4; ++i) if (cb[i] > v0) { v0 = cb[i]; a0 = i; s0 = cs[i]; }
    int a1 = -1; float v1 = -3.0e38f, s1 = 0.f;
#pragma unroll
    for (int i = 0; i < 4; ++i) if (i != a0 && cb[i] > v1) { v1 = cb[i]; a1 = i; s1 = cs[i]; }
    RouteOut r; r.i0 = bg * 4 + a0; r.i1 = bg * 4 + a1; const float s = s0 + s1; r.w0 = s0 / s; r.w1 = s1 / s; return r;
}

__device__ __forceinline__ f32x4 up4(u32x2 a) { f32x4 y; y[0] = __uint_as_float(a.x << 16); y[1] = __uint_as_float(a.x & 0xffff0000u); y[2] = __uint_as_float(a.y << 16); y[3] = __uint_as_float(a.y & 0xffff0000u); return y; }
template <int MODE> struct RowRaw { f32x4 xf[MODE == 0 ? 8 : 1]; u32x2 xb[MODE == 0 ? 1 : 8]; u32x2 ya[MODE >= 2 ? 8 : 1], yb[MODE >= 2 ? 8 : 1]; };
template <int MODE>
__device__ __forceinline__ void norm_load(RowRaw<MODE>& R, const void* xsrc_, const bf16_t* YO, int row, int s0, int s1, int lane) {
#pragma unroll
    for (int i = 0; i < 8; ++i) {
        if (MODE == 0) R.xf[i] = *(const f32x4*)((const float*)xsrc_ + (size_t)row * D_ + i * 256 + lane * 4);
        else R.xb[i] = *(const u32x2*)((const bf16_t*)xsrc_ + (size_t)row * D_ + i * 256 + lane * 4);
        if (MODE >= 2) { R.ya[i] = *(const u32x2*)(YO + (size_t)s0 * D_ + i * 256 + lane * 4); R.yb[i] = *(const u32x2*)(YO + (size_t)s1 * D_ + i * 256 + lane * 4); }
    }
}
template <int MODE>
__device__ __forceinline__ void norm_phase(const Ctx& c, const void* xsrc_, bf16_t* xdst, const float* gain, const float* msh, const float* msc, const float* mgf, bf16_t* hdst) {
    LDSP float* rwT = (LDSP float*)c.lds;
    LDSP int* cnt = (LDSP int*)(c.lds + LDS_MISC);
    if (MODE == 1) {
        const float* rw = c.A.in[14];
        for (int i0 = c.tid; i0 < 32768; i0 += NTHR * 16) {
            float t_[16];
#pragma unroll
            for (int k = 0; k < 16; ++k) t_[k] = rw[i0 + k * NTHR];
#pragma unroll
            for (int k = 0; k < 16; ++k) { const int i = i0 + k * NTHR; rwT[(i & 15) * 2048 + (i >> 4)] = t_[k]; }
        }
        if (c.tid < 16) cnt[c.tid] = 0;
        __syncthreads();
    }
    const int nw = c.G * NWAVE, gw = c.bid * NWAVE + c.wave, lane = c.lane;
    const bf16_t* YO = (const bf16_t*)(c.ws + WS_YO);
    const int* TOKSLOT = (const int*)(c.ws + WS_TOKSLOT);
    int sl0[8], sl1[8];
#pragma unroll
    for (int k = 0; k < 8; ++k) { sl0[k] = 0; sl1[k] = 0; if (MODE >= 2) { const int r_ = gw + k * nw; if (r_ < T_) { sl0[k] = ld_i(TOKSLOT + r_ * 2); sl1[k] = ld_i(TOKSLOT + r_ * 2 + 1); } } }
    RowRaw<MODE> cur, nxt;
    if (gw < T_) norm_load<MODE>(cur, xsrc_, YO, gw, sl0[0], sl1[0], lane);
    int kk = 0;
    for (int row = gw; row < T_; row += nw, ++kk) {
        const int b = row >> 11;
        {
            const int rn = row + nw; int n0 = 0, n1 = 0;
            if (MODE >= 2) {
                if (kk + 1 < 8) {
#pragma unroll
                    for (int k = 1; k < 8; ++k) if (k == kk + 1) { n0 = sl0[k]; n1 = sl1[k]; }
                } else if (rn < T_) { n0 = ld_i(TOKSLOT + rn * 2); n1 = ld_i(TOKSLOT + rn * 2 + 1); }
            }
            if (rn < T_) norm_load<MODE>(nxt, xsrc_, YO, rn, n0, n1, lane);
        }
        f32x4 v[8];
#pragma unroll
        for (int i = 0; i < 8; ++i) { if (MODE == 0) v[i] = cur.xf[i]; else v[i] = up4(cur.xb[i]); }
        if (MODE >= 2) {
            f32x4 mg[8];
#pragma unroll
            for (int i = 0; i < 8; ++i) mg[i] = *(const f32x4*)(mgf + (size_t)b * MODW + i * 256 + lane * 4);
            asm volatile("" ::: "memory");
#pragma unroll
            for (int i = 0; i < 8; ++i) {
                const f32x4 y = up4(cur.ya[i]) + up4(cur.yb[i]);
                v[i] += mg[i] * y;
                if (MODE == 2) { u32x2 w; w.x = pk2(v[i][0], v[i][1]); w.y = pk2(v[i][2], v[i][3]); *(u32x2*)(xdst + (size_t)row * D_ + i * 256 + lane * 4) = w; }
            }
        }
        float ss = 0.f;
#pragma unroll
        for (int i = 0; i < 8; ++i) ss += v[i][0] * v[i][0] + v[i][1] * v[i][1] + v[i][2] * v[i][2] + v[i][3] * v[i][3];
        ss = wsum(ss);
        const float rinv = 1.0f / sqrtf(ss * (1.0f / 2048.0f) + 1e-6f);
        f32x4 ga[8];
#pragma unroll
        for (int i = 0; i < 8; ++i) ga[i] = *(const f32x4*)(gain + i * 256 + lane * 4);
        if (MODE == 3) {
            asm volatile("" ::: "memory");
#pragma unroll
            for (int i = 0; i < 8; ++i) *(f32x4*)(c.A.out + (size_t)row * D_ + i * 256 + lane * 4) = v[i] * rinv * ga[i];
        } else {
            f32x4 sha[8], sca[8];
#pragma unroll
            for (int i = 0; i < 8; ++i) { sha[i] = *(const f32x4*)(msh + (size_t)b * MODW + i * 256 + lane * 4); sca[i] = *(const f32x4*)(msc + (size_t)b * MODW + i * 256 + lane * 4); }
            asm volatile("" ::: "memory");
#pragma unroll
            for (int i = 0; i < 8; ++i) {
                const f32x4 g = ga[i], sh = sha[i], sc = sca[i];
                v[i] = (v[i] * rinv * g) * (1.0f + sc) + sh;
                u32x2 w; w.x = pk2(v[i][0], v[i][1]); w.y = pk2(v[i][2], v[i][3]);
                *(u32x2*)(hdst + (size_t)row * D_ + i * 256 + lane * 4) = w;
            }
            if (MODE == 1) {
                float pa_[16];
                f32x4 rA[8], rB[8];
#define RT_RD(dst, e_) do { _Pragma("unroll") for (int i = 0; i < 8; ++i) dst[i] = *(LDSP f32x4*)(rwT + (e_) * 2048 + i * 256 + lane * 4); asm volatile("" ::: "memory"); } while (0)
#define RT_DOT(src, e_) do { float a = 0.f; _Pragma("unroll") for (int i = 0; i < 8; ++i) a += v[i][0] * src[i][0] + v[i][1] * src[i][1] + v[i][2] * src[i][2] + v[i][3] * src[i][3]; pa_[e_] = a; } while (0)
                RT_RD(rA, 0);
#pragma unroll
                for (int e = 0; e < 16; e += 2) { RT_RD(rB, e + 1); RT_DOT(rA, e); if (e + 2 < 16) RT_RD(rA, e + 2); RT_DOT(rB, e + 1); }
#undef RT_RD
#undef RT_DOT
                float lg[16];
                { const bool b5 = lane & 32, b4 = lane & 16, b3 = lane & 8, b2 = lane & 4;
                  float b_[8], c_[4], d_[2];
#pragma unroll
                  for (int i = 0; i < 8; ++i) { const float snd = b5 ? pa_[i] : pa_[i + 8]; b_[i] = (b5 ? pa_[i + 8] : pa_[i]) + __shfl_xor(snd, 32); }
#pragma unroll
                  for (int i = 0; i < 4; ++i) { const float snd = b4 ? b_[i] : b_[i + 4]; c_[i] = (b4 ? b_[i + 4] : b_[i]) + __shfl_xor(snd, 16); }
#pragma unroll
                  for (int i = 0; i < 2; ++i) { const float snd = b3 ? c_[i] : c_[i + 2]; d_[i] = (b3 ? c_[i + 2] : c_[i]) + __shfl_xor(snd, 8); }
                  float e_ = (b2 ? d_[1] : d_[0]) + __shfl_xor(b2 ? d_[0] : d_[1], 4);
                  e_ += __shfl_xor(e_, 2); e_ += __shfl_xor(e_, 1);
#pragma unroll
                  for (int e = 0; e < 16; ++e) lg[e] = __int_as_float(__builtin_amdgcn_readlane(__float_as_int(e_), 4 * e)); }
                const RouteOut r = route16(lg, c.A.in[15]);
                if (lane == 0) {
                    int* RIDX = (int*)(c.ws + WS_RIDX); float* RW = (float*)(c.ws + WS_RW);
                    RIDX[row * 2] = r.i0; RIDX[row * 2 + 1] = r.i1; RW[row * 2] = r.w0; RW[row * 2 + 1] = r.w1;
                    atomicAdd((int*)(cnt + r.i0), 1); atomicAdd((int*)(cnt + r.i1), 1);
                }
            }
        }
        cur = nxt;
    }
    if (MODE == 1) {
        __syncthreads();
        if (c.tid < 16) ((int*)(c.ws + WS_BLKCNT))[c.bid * 16 + c.tid] = cnt[c.tid];
    }
}

__device__ __forceinline__ void dispatch_phase(const Ctx& c) {
    LDSP int* tot = (LDSP int*)c.lds;
    LDSP int* pre = tot + 16;
    LDSP int* start = tot + 32;
    LDSP int* pstart = tot + 48;
    LDSP int* ea = tot + 80;
    LDSP int* sl = tot + 208;
    if (c.tid < 32) tot[c.tid] = 0;
    __syncthreads();
    const int* BLKCNT = (const int*)(c.ws + WS_BLKCNT);
    for (int idx = c.tid; idx < c.G * 16; idx += NTHR) {
        const int v = ld_i(BLKCNT + idx), e = idx & 15, bl = idx >> 4;
        atomicAdd((int*)(tot + e), v); if (bl < c.bid) atomicAdd((int*)(pre + e), v);
    }
    __syncthreads();
    if (c.tid == 0) {
        int run = 0;
        for (int e = 0; e < 16; ++e) { pstart[e] = run; start[e] = run + pre[e]; run += (tot[e] + 255) / 256 * 256; }
        pstart[16] = run;
    }
    __syncthreads();
    if (c.bid == 0 && c.tid < 17) ((int*)(c.ws + WS_TAB))[c.tid] = pstart[c.tid] >> 8;
    const int* RIDX = (const int*)(c.ws + WS_RIDX); const float* RW = (const float*)(c.ws + WS_RW);
    const int nw = c.G * NWAVE;
    if (c.tid < 128) { const int a = c.tid, wv = a >> 4, i = (a >> 1) & 7, k = a & 1; const int row = (c.bid * NWAVE + wv) + i * nw; ea[a] = ld_i(RIDX + row * 2 + k); }
    __syncthreads();
    if (c.tid < 128) {
        const int a = c.tid, wv = a >> 4, i = (a >> 1) & 7, k = a & 1; const int row = (c.bid * NWAVE + wv) + i * nw;
        const int e = ea[a]; int rank = 0;
        for (int j = 0; j < a; ++j) rank += (ea[j] == e) ? 1 : 0;
        const int slot = start[e] + rank; sl[a] = slot;
        ((int*)(c.ws + WS_TOKSLOT))[row * 2 + k] = slot;
        ((float*)(c.ws + WS_SLOTW))[slot] = ld_f(RW + row * 2 + k);
        ((int*)(c.ws + WS_SLOTTOK))[slot] = row;
    }
    if (c.bid == 0) {
        for (int e = 0; e < 16; ++e) for (int s = pstart[e] + tot[e] + c.tid; s < pstart[e + 1]; s += NTHR) { ((float*)(c.ws + WS_SLOTW))[s] = 0.f; ((int*)(c.ws + WS_SLOTTOK))[s] = 0; }
    }
}

template <bool BASE_F32> struct EpiResid {
    static constexpr bool PERM = true, AFTER_DRAIN = false;
    const void* base; bf16_t* out; const float* gate;
    __device__ __forceinline__ void operator()(const pg8::f32x4 (&acc)[2][2][4][2], const pg8::Unit& u, int wr, int wc, int fr, int fq) const {
        const int row0 = u.pm * 256 + wr * 64 + fr, col0 = u.pn * 256 + wc * 32 + 8 * fq, b = u.pm >> 3;
        pg8::f32x4 gv[2][2];
#pragma unroll
        for (int bj = 0; bj < 2; ++bj)
#pragma unroll
            for (int n = 0; n < 2; ++n) gv[bj][n] = *(const pg8::f32x4*)(gate + (size_t)b * MODW + col0 + bj * 128 + n * 4);
#pragma unroll
        for (int ai = 0; ai < 2; ++ai) {
            pg8::f32x4 b0[4][2], b1[4][2];
#pragma unroll
            for (int m = 0; m < 4; ++m) { const size_t off = (size_t)(row0 + ai * 128 + m * 16) * D_ + col0;
#pragma unroll
                for (int bj = 0; bj < 2; ++bj) {
                    if (BASE_F32) { b0[m][bj] = *(const pg8::f32x4*)((const float*)base + off + bj * 128); b1[m][bj] = *(const pg8::f32x4*)((const float*)base + off + bj * 128 + 4); }
                    else { const pg8::u32x4 w = *(const pg8::u32x4*)((const bf16_t*)base + off + bj * 128);
                        b0[m][bj] = (pg8::f32x4){__uint_as_float(w.x << 16), __uint_as_float(w.x & 0xffff0000u), __uint_as_float(w.y << 16), __uint_as_float(w.y & 0xffff0000u)};
                        b1[m][bj] = (pg8::f32x4){__uint_as_float(w.z << 16), __uint_as_float(w.z & 0xffff0000u), __uint_as_float(w.w << 16), __uint_as_float(w.w & 0xffff0000u)}; } } }
            asm volatile("" ::: "memory");
#pragma unroll
            for (int m = 0; m < 4; ++m) { const size_t off = (size_t)(row0 + ai * 128 + m * 16) * D_ + col0;
#pragma unroll
                for (int bj = 0; bj < 2; ++bj) {
                    const pg8::f32x4 v0 = b0[m][bj] + gv[bj][0] * acc[ai][bj][m][0], v1 = b1[m][bj] + gv[bj][1] * acc[ai][bj][m][1];
                    pg8::u32x4 q; q.x = pg8::cvt_pk_bf16(v0[0], v0[1]); q.y = pg8::cvt_pk_bf16(v0[2], v0[3]); q.z = pg8::cvt_pk_bf16(v1[0], v1[1]); q.w = pg8::cvt_pk_bf16(v1[2], v1[3]);
                    *(pg8::u32x4*)(out + off + bj * 128) = q; } }
            asm volatile("" ::: "memory");
        }
    }
};
struct EpiDilProj {
    static constexpr bool PERM = true, AFTER_DRAIN = false;
    bf16_t* O;
    __device__ __forceinline__ void operator()(const pg8::f32x4 (&acc)[2][2][4][2], const pg8::Unit& u, int wr, int wc, int fr, int fq) const {
        const int sec = u.pn >> 3, b = u.pm >> 3, lg = sec < 3 ? 0 : (sec < 5 ? 2 : 4), d = wc * 32 + 8 * fq;
        const int t0 = (u.pm & 7) * 256 + wr * 64 + fr;
#pragma unroll
        for (int ai = 0; ai < 2; ++ai)
#pragma unroll
            for (int m = 0; m < 4; ++m) { const int t = t0 + ai * 128 + m * 16; const int pos = ((t & ((1 << lg) - 1)) << (11 - lg)) + (t >> lg);
#pragma unroll
                for (int bj = 0; bj < 2; ++bj) { const int h = (u.pn & 7) * 2 + bj;
                    const pg8::f32x4 v0 = acc[ai][bj][m][0], v1 = acc[ai][bj][m][1];
                    pg8::u32x4 w; w.x = pg8::cvt_pk_bf16(v0[0], v0[1]); w.y = pg8::cvt_pk_bf16(v0[2], v0[3]); w.z = pg8::cvt_pk_bf16(v1[0], v1[1]); w.w = pg8::cvt_pk_bf16(v1[2], v1[3]);
                    *(pg8::u32x4*)(O + ((((size_t)sec * 8 + b) * 16 + h) * 2048 + pos) * 128 + d) = w; } }
    }
};
struct EpiSwiglu {
    static constexpr bool PERM = true, AFTER_DRAIN = false;
    bf16_t* Hd;
    __device__ __forceinline__ void operator()(const pg8::f32x4 (&acc)[2][2][4][2], const pg8::Unit& u, int wr, int wc, int fr, int fq) const {
        const int row0 = u.pm * 256 + wr * 64 + fr, j = u.pn % 11, col = j * 128 + wc * 32 + 8 * fq;
#pragma unroll
        for (int ai = 0; ai < 2; ++ai)
#pragma unroll
            for (int m = 0; m < 4; ++m) {
                float o[8];
#pragma unroll
                for (int n = 0; n < 2; ++n)
#pragma unroll
                    for (int i = 0; i < 4; ++i) { const float g = acc[ai][0][m][n][i], up = acc[ai][1][m][n][i]; o[n * 4 + i] = g / (1.f + __expf(-g)) * up; }
                pg8::u32x4 w; w.x = pg8::cvt_pk_bf16(o[0], o[1]); w.y = pg8::cvt_pk_bf16(o[2], o[3]); w.z = pg8::cvt_pk_bf16(o[4], o[5]); w.w = pg8::cvt_pk_bf16(o[6], o[7]);
                *(pg8::u32x4*)(Hd + (size_t)(row0 + ai * 128 + m * 16) * DE + col) = w;
            }
    }
};
struct EpiDown {
    static constexpr bool PERM = true, AFTER_DRAIN = false;
    bf16_t* Y; const float* sw;
    __device__ __forceinline__ void operator()(const pg8::f32x4 (&acc)[2][2][4][2], const pg8::Unit& u, int wr, int wc, int fr, int fq) const {
        const int row0 = u.pm * 256 + wr * 64 + fr, col0 = (u.pn & 7) * 256 + wc * 32 + 8 * fq;
        float wv[2][4];
#pragma unroll
        for (int ai = 0; ai < 2; ++ai)
#pragma unroll
            for (int m = 0; m < 4; ++m) wv[ai][m] = sw[row0 + ai * 128 + m * 16];
        asm volatile("" ::: "memory");
#pragma unroll
        for (int ai = 0; ai < 2; ++ai)
#pragma unroll
            for (int m = 0; m < 4; ++m) { const int row = row0 + ai * 128 + m * 16; const float w = wv[ai][m];
#pragma unroll
                for (int bj = 0; bj < 2; ++bj) { const pg8::f32x4 v0 = acc[ai][bj][m][0] * w, v1 = acc[ai][bj][m][1] * w;
                    pg8::u32x4 q; q.x = pg8::cvt_pk_bf16(v0[0], v0[1]); q.y = pg8::cvt_pk_bf16(v0[2], v0[3]); q.z = pg8::cvt_pk_bf16(v1[0], v1[1]); q.w = pg8::cvt_pk_bf16(v1[2], v1[3]);
                    *(pg8::u32x4*)(Y + (size_t)row * D_ + col0 + bj * 128) = q; } }
    }
};
struct MoeOrder {
    LDSP const int* bs;
    int G, vc, ncol;
    __device__ __forceinline__ bool next(int i, pg8::Unit& u) const {
        const int L = i * G + vc; if (L >= bs[16] * ncol) return false;
        int e = 0;
#pragma unroll
        for (int k = 1; k < 16; ++k) e += (L >= bs[k] * ncol) ? 1 : 0;
        const int b0 = bs[e], nb = bs[e + 1] - b0, r = L - b0 * ncol;
        const int j = r / nb, bi = r - j * nb;
        u.pm = b0 + bi; u.pn = e * ncol + j; return true;
    }
    __device__ __forceinline__ void a_ready(const pg8::Unit&) const {}
    __device__ __forceinline__ void done(const pg8::Unit&) const {}
};
__device__ __forceinline__ void moe_tab_to_lds(const Ctx& c) {
    LDSP int* bs = (LDSP int*)(c.lds + LDS_MISC);
    if (c.tid < 17) bs[c.tid] = ld_i((const int*)(c.ws + WS_TAB) + c.tid);
    __syncthreads();
}

__device__ __forceinline__ float gelu_tanh(float x) { const float u = 0.7978845608028654f * (x + 0.044715f * x * x * x); return 0.5f * x * (1.f + tanhf(u)); }
__device__ __forceinline__ void compress_phase(const Ctx& c) {
    LDSP float* tok = (LDSP float*)c.lds;
    LDSP float* pos = (LDSP float*)(c.lds + 73728);
    LDSP float* part = (LDSP float*)(c.lds + 73728 + 16384);
    LDSP float* hid = (LDSP float*)(c.lds + 73728 + 32768);
    const bf16_t* proj = (const bf16_t*)(c.ws + WS_PROJ);
    float* CMP = (float*)(c.ws + WS_CMP);
    for (int uu = c.bid; uu < (DUP_PH == 103 ? 2048 : 1024); uu += c.G) {
        const int u = uu & 1023, ch = u & 15, j = (u >> 4) & 1, g = (u >> 5) & 3, b = u >> 7, n0 = ch * 8;
        for (int idx = c.tid; idx < 144 * 16; idx += NTHR) {
            const int tl = idx >> 4, d8 = (idx & 15) * 8, t = n0 * 16 + tl;
            u32x4 w = (u32x4){0u, 0u, 0u, 0u};
            if (t < S_) w = *(const u32x4*)(proj + (size_t)(b * S_ + t) * PW0 + 2048 + j * 512 + g * 128 + d8);
            LDSP float* dp = tok + tl * 128 + d8;
            dp[0] = __uint_as_float(w.x << 16); dp[1] = __uint_as_float(w.x & 0xffff0000u); dp[2] = __uint_as_float(w.y << 16); dp[3] = __uint_as_float(w.y & 0xffff0000u);
            dp[4] = __uint_as_float(w.z << 16); dp[5] = __uint_as_float(w.z & 0xffff0000u); dp[6] = __uint_as_float(w.w << 16); dp[7] = __uint_as_float(w.w & 0xffff0000u);
        }
        for (int idx = c.tid; idx < 4096; idx += NTHR) pos[idx] = c.A.in[10][j * 4096 + idx];
        __syncthreads();
        const int e = c.tid & 127, q = c.tid >> 7;
        float acc[8];
#pragma unroll
        for (int i = 0; i < 8; ++i) acc[i] = 0.f;
        const float* w1 = c.A.in[8] + (size_t)j * 32 * 128 * 128;
        for (int l = q * 8; l < q * 8 + 8; ++l) {
#pragma unroll 4
            for (int d = 0; d < 128; ++d) {
                const float w = w1[((size_t)l * 128 + d) * 128 + e]; const float p = pos[l * 128 + d];
#pragma unroll
                for (int i = 0; i < 8; ++i) acc[i] += (tok[(16 * i + l) * 128 + d] + p) * w;
            }
        }
#pragma unroll
        for (int i = 0; i < 8; ++i) part[(q * 8 + i) * 128 + e] = acc[i];
        __syncthreads();
        for (int idx = c.tid; idx < 1024; idx += NTHR) { const int i = idx >> 7, ee = idx & 127; hid[idx] = gelu_tanh(part[(0 * 8 + i) * 128 + ee] + part[(1 * 8 + i) * 128 + ee] + part[(2 * 8 + i) * 128 + ee] + part[(3 * 8 + i) * 128 + ee]); }
        __syncthreads();
        const float* w2 = c.A.in[9] + (size_t)j * 128 * 128;
        for (int idx = c.tid; idx < 1024; idx += NTHR) {
            const int i = idx >> 7, f = idx & 127, n = n0 + i; float s = 0.f;
            for (int ee = 0; ee < 128; ++ee) s += hid[i * 128 + ee] * w2[ee * 128 + f];
            if (n < 127) CMP[((((size_t)j * 8 + b) * 128 + n) * 4 + g) * 128 + f] = s;
            ((bf16_t*)(c.ws + WS_CMPB))[((((size_t)j * 8 + b) * 128 + n) * 4 + g) * 128 + f] = (n < 127) ? f2bf(s) : (bf16_t)0;
        }
        __syncthreads();
    }
}

__device__ __forceinline__ void compress_mfma_phase(const Ctx& c) {
    typedef short bf16x8 __attribute__((ext_vector_type(8)));
    LDSP char* lds = (LDSP char*)c.lds;
    LDSP float* red = (LDSP float*)c.lds;
    LDSP float* hid = (LDSP float*)(c.lds + 69632);
    const bf16_t* proj = (const bf16_t*)(c.ws + WS_PROJ);
    const bf16_t* W1T = (const bf16_t*)(c.ws + WS_W1T);
    const float* POSB = (const float*)(c.ws + WS_POSB);
    float* CMP = (float*)(c.ws + WS_CMP); bf16_t* CMPB = (bf16_t*)(c.ws + WS_CMPB);
    const int lane = c.lane, wid = c.wave;
    for (int uu = c.bid; uu < (DUP_PH == 103 ? 1024 : 512); uu += c.G) {
        const int u = uu & 511, nb = u & 7, j = (u >> 3) & 1, g = (u >> 4) & 3, b = u >> 6, n0 = nb * 16;
        __syncthreads();
        for (int idx = c.tid; idx < 272 * 16; idx += NTHR) {
            const int tl = idx >> 4, ch = idx & 15, t = n0 * 16 + tl;
            u32x4 w = (u32x4){0u, 0u, 0u, 0u};
            if (t < S_) w = *(const u32x4*)(proj + (size_t)(b * S_ + t) * PW0 + 2048 + j * 512 + g * 128 + ch * 8);
            *(LDSP u32x4*)(lds + tl * 256 + ((ch ^ ((tl >> 4) & 15)) << 4)) = w;
        }
        __syncthreads();
        f32x4 acc[8];
#pragma unroll
        for (int cb = 0; cb < 8; ++cb) acc[cb] = (f32x4){0.f, 0.f, 0.f, 0.f};
        const int r = lane & 15, kg = lane >> 4;
        const bf16_t* wb = W1T + ((size_t)(j * 128 + r) * 4096 + kg * 8);
#pragma unroll 2
        for (int s = 0; s < 16; ++s) {
            const int ks = wid * 16 + s, l = ks >> 2, ch = (ks & 3) * 4 + kg, tl = 16 * r + l;
            const bf16x8 a = *(LDSP const bf16x8*)(lds + tl * 256 + ((ch ^ ((tl >> 4) & 15)) << 4));
            bf16x8 bf[8];
#pragma unroll
            for (int cb = 0; cb < 8; ++cb) bf[cb] = *(const bf16x8*)(wb + (size_t)cb * 16 * 4096 + ks * 32);
#pragma unroll
            for (int cb = 0; cb < 8; ++cb) acc[cb] = __builtin_amdgcn_mfma_f32_16x16x32_bf16(a, bf[cb], acc[cb], 0, 0, 0);
        }
        __syncthreads();
#pragma unroll
        for (int cb = 0; cb < 8; ++cb)
#pragma unroll
            for (int i = 0; i < 4; ++i) red[(wid * 16 + kg * 4 + i) * 128 + cb * 16 + r] = acc[cb][i];
        __syncthreads();
        { const int row = c.tid >> 5, e4 = (c.tid & 31) * 4;
          f32x4 s = (f32x4){0.f, 0.f, 0.f, 0.f};
#pragma unroll 8
          for (int p = 0; p < 32; ++p) s += *(const f32x4*)(POSB + (j * 32 + p) * 128 + e4);
#pragma unroll
          for (int w = 0; w < 8; ++w) s += *(LDSP const f32x4*)(red + (w * 16 + row) * 128 + e4);
          f32x4 h; h[0] = gelu_tanh(s[0]); h[1] = gelu_tanh(s[1]); h[2] = gelu_tanh(s[2]); h[3] = gelu_tanh(s[3]);
          *(LDSP f32x4*)(hid + row * 128 + e4) = h; }
        __syncthreads();
        { const int row = c.tid >> 5, f4 = (c.tid & 31) * 4, n = n0 + row;
          const float* w2 = c.A.in[9] + (size_t)j * 128 * 128 + f4;
          f32x4 s = (f32x4){0.f, 0.f, 0.f, 0.f};
#pragma unroll 8
          for (int e = 0; e < 128; ++e) s += hid[row * 128 + e] * *(const f32x4*)(w2 + e * 128);
          const size_t o = ((((size_t)j * 8 + b) * 128 + n) * 4 + g) * 128 + f4;
          if (n < 127) *(f32x4*)(CMP + o) = s; else s = (f32x4){0.f, 0.f, 0.f, 0.f};
          u32x2 w; w.x = pk2(s[0], s[1]); w.y = pk2(s[2], s[3]); *(u32x2*)(CMPB + o) = w; }
    }
}

__device__ __forceinline__ void dots_bf16(const bf16_t* krow, bool ok, LDSP const float* qs, float (&s)[4]) {
    s[0] = s[1] = s[2] = s[3] = 0.f;
    if (!ok) return;
#pragma unroll 4
    for (int d8 = 0; d8 < 16; ++d8) {
        const u32x4 w = *(const u32x4*)(krow + d8 * 8);
        float k[8] = {__uint_as_float(w.x << 16), __uint_as_float(w.x & 0xffff0000u), __uint_as_float(w.y << 16), __uint_as_float(w.y & 0xffff0000u),
                      __uint_as_float(w.z << 16), __uint_as_float(w.z & 0xffff0000u), __uint_as_float(w.w << 16), __uint_as_float(w.w & 0xffff0000u)};
#pragma unroll
        for (int h = 0; h < 4; ++h) {
            const f32x4 qa = *(LDSP const f32x4*)(qs + h * 128 + d8 * 8), qb = *(LDSP const f32x4*)(qs + h * 128 + d8 * 8 + 4);
            s[h] += k[0] * qa[0] + k[1] * qa[1] + k[2] * qa[2] + k[3] * qa[3] + k[4] * qb[0] + k[5] * qb[1] + k[6] * qb[2] + k[7] * qb[3];
        }
    }
}
__device__ __forceinline__ void online_tile(const float (&s)[4], const bool valid, float (&m)[4], float (&l)[4], f32x2 (&acc)[4], LDSP float* pl,
                                            const bf16_t* vbase, size_t vstride, int kcount, int lane) {
#pragma unroll
    for (int h = 0; h < 4; ++h) {
        const float sv = valid ? s[h] : -__builtin_inff();
        const float tm = wmax(sv); const float mn = fmaxf(m[h], tm);
        float alpha = 1.f, p = 0.f;
        if (mn > -__builtin_inff()) { alpha = __expf(m[h] - mn); p = valid ? __expf(sv - mn) : 0.f; }
        l[h] = l[h] * alpha + wsum(p); acc[h] *= alpha; m[h] = mn;
        pl[h * 64 + lane] = p;
    }
    lds_fence();
    for (int k = 0; k < kcount; ++k) {
        const unsigned w = *(const unsigned*)(vbase + (size_t)k * vstride + 2 * lane);
        const f32x2 v = {__uint_as_float(w << 16), __uint_as_float(w & 0xffff0000u)};
#pragma unroll
        for (int h = 0; h < 4; ++h) acc[h] += pl[h * 64 + k] * v;
    }
    lds_fence();
}
__device__ __forceinline__ void nsa_attn_ref_phase(const Ctx& c) {
    LDSP float* wl = (LDSP float*)(c.lds + c.wave * 8192);
    LDSP float* qs = wl;
    LDSP float* pl = wl + 512;
    LDSP float* ps = wl + 1024;
    const bf16_t* proj = (const bf16_t*)(c.ws + WS_PROJ);
    const float* CMP = (const float*)(c.ws + WS_CMP);
    bf16_t* O = (bf16_t*)(c.ws + WS_O);
    const int lane = c.lane, nw = c.G * NWAVE;
    const float scale = 0.08838834764831845f;
    for (int u = c.bid * NWAVE + c.wave; u < B_ * S_ * 4; u += nw) {
        const int g = u & 3, t = (u >> 2) & 2047, b = u >> 13;
        const bf16_t* prow = proj + (size_t)(b * S_ + t) * PW0;
        { const u32x4 w = *(const u32x4*)(prow + g * 512 + lane * 8); LDSP float* qd = qs + lane * 8;
          qd[0] = __uint_as_float(w.x << 16) * scale; qd[1] = __uint_as_float(w.x & 0xffff0000u) * scale; qd[2] = __uint_as_float(w.y << 16) * scale; qd[3] = __uint_as_float(w.y & 0xffff0000u) * scale;
          qd[4] = __uint_as_float(w.z << 16) * scale; qd[5] = __uint_as_float(w.z & 0xffff0000u) * scale; qd[6] = __uint_as_float(w.w << 16) * scale; qd[7] = __uint_as_float(w.w & 0xffff0000u) * scale; }
        lds_fence();
        float slope[4], gate[4][3];
#pragma unroll
        for (int h = 0; h < 4; ++h) { slope[h] = exp2f(-0.5f * (float)(4 * g + h + 1));
#pragma unroll
            for (int j = 0; j < 3; ++j) { const float x = bf2f(prow[5120 + (4 * g + h) * 3 + j]); gate[h][j] = 1.f / (1.f + __expf(-x)); } }
        f32x2 ofin[4];
        {
            float s0[4], s1[4]; bool v0, v1;
            { const int n = lane; v0 = (16 * n + 31 <= t); const float* kp = CMP + (((size_t)b * 128 + n) * 4 + g) * 128;
              s0[0] = s0[1] = s0[2] = s0[3] = 0.f;
              if (v0) for (int d = 0; d < 128; d += 4) { const f32x4 k = *(const f32x4*)(kp + d);
#pragma unroll
                  for (int h = 0; h < 4; ++h) { const f32x4 q = *(LDSP const f32x4*)(qs + h * 128 + d); s0[h] += k[0] * q[0] + k[1] * q[1] + k[2] * q[2] + k[3] * q[3]; } } }
            { const int n = lane + 64; v1 = (n < 127) && (16 * n + 31 <= t); const float* kp = CMP + (((size_t)b * 128 + n) * 4 + g) * 128;
              s1[0] = s1[1] = s1[2] = s1[3] = 0.f;
              if (v1) for (int d = 0; d < 128; d += 4) { const f32x4 k = *(const f32x4*)(kp + d);
#pragma unroll
                  for (int h = 0; h < 4; ++h) { const f32x4 q = *(LDSP const f32x4*)(qs + h * 128 + d); s1[h] += k[0] * q[0] + k[1] * q[1] + k[2] * q[2] + k[3] * q[3]; } } }
            float psum0 = 0.f, psum1 = 0.f;
#pragma unroll
            for (int h = 0; h < 4; ++h) {
                const float a0 = v0 ? s0[h] - slope[h] * ((float)t - (16.f * lane + 15.5f)) : -__builtin_inff();
                const float a1 = v1 ? s1[h] - slope[h] * ((float)t - (16.f * (lane + 64) + 15.5f)) : -__builtin_inff();
                const float mx = wmax(fmaxf(a0, a1));
                const float e0 = v0 ? __expf(a0 - mx) : 0.f, e1 = v1 ? __expf(a1 - mx) : 0.f;
                const float sum = wsum(e0 + e1), inv = 1.f / fmaxf(sum, 1e-30f);
                const float p0 = e0 * inv, p1 = e1 * inv;
                pl[h * 128 + lane] = p0; pl[h * 128 + 64 + lane] = p1; psum0 += p0; psum1 += p1;
            }
            ps[1 + lane] = psum0; ps[65 + lane] = psum1; if (lane == 0) { ps[0] = 0.f; ps[129] = 0.f; }
            lds_fence();
            f32x2 acc[4];
#pragma unroll
            for (int h = 0; h < 4; ++h) acc[h] = (f32x2){0.f, 0.f};
            const int nvis = t >= 31 ? ((t - 31) >> 4) + 1 : 0;
            const float* vp = CMP + ((((size_t)8 + b) * 128) * 4 + g) * 128 + 2 * lane;
            for (int n = 0; n < nvis; ++n) { const f32x2 v = *(const f32x2*)(vp + (size_t)n * 512);
#pragma unroll
                for (int h = 0; h < 4; ++h) acc[h] += pl[h * 128 + n] * v; }
#pragma unroll
            for (int h = 0; h < 4; ++h) ofin[h] = gate[h][0] * acc[h];
        }
        unsigned selmask;
        {
            const int j = lane & 31, cur = t >> 6;
            const float imp = ps[4 * j] + 2.f * (ps[1 + 4 * j] + ps[2 + 4 * j] + ps[3 + 4 * j]) + ps[4 + 4 * j];
            const bool forced = (j == 0) || (j == cur) || (j == cur - 1), causal = (64 * j <= t);
            const float score = forced ? 1.0e6f : (causal ? imp : -1.0f);
            int rank = 0;
            for (int i = 0; i < 32; ++i) { const float si = __shfl(score, i); rank += ((si > score) || (si == score && i < j)) ? 1 : 0; }
            selmask = (unsigned)__ballot(rank < 16 && lane < 32);
            if (lane == 0) ((unsigned*)(c.ws + WS_SEL))[((size_t)b * 4 + g) * 2048 + t] = selmask;
        }
        lds_fence();
        {
            float m[4], l[4]; f32x2 acc[4];
#pragma unroll
            for (int h = 0; h < 4; ++h) { m[h] = -__builtin_inff(); l[h] = 0.f; acc[h] = (f32x2){0.f, 0.f}; }
            for (int j = 0; j < 32; ++j) {
                if (!((selmask >> j) & 1u)) continue;
                if (64 * j > t) continue;
                const int kpos = 64 * j + lane, dist = t - kpos; const bool valid = dist >= 0;
                const bf16_t* kb = proj + (size_t)(b * S_ + kpos) * PW0 + 2048 + 1024 + g * 128;
                float s[4]; dots_bf16(kb, valid, qs, s);
#pragma unroll
                for (int h = 0; h < 4; ++h) s[h] -= slope[h] * (float)dist;
                online_tile(s, valid, m, l, acc, pl, proj + (size_t)(b * S_ + 64 * j) * PW0 + 2048 + 1536 + g * 128, PW0, min(64, t - 64 * j + 1), lane);
            }
#pragma unroll
            for (int h = 0; h < 4; ++h) ofin[h] += (gate[h][1] / l[h]) * acc[h];
        }
        {
            float m[4], l[4]; f32x2 acc[4];
#pragma unroll
            for (int h = 0; h < 4; ++h) { m[h] = -__builtin_inff(); l[h] = 0.f; acc[h] = (f32x2){0.f, 0.f}; }
            for (int i = 0; i < 8; ++i) {
                const int k0 = t - 511 + 64 * i; if (k0 + 63 < 0) continue;
                const int kpos = k0 + lane, dist = t - kpos; const bool valid = kpos >= 0;
                const bf16_t* kb = proj + (size_t)(b * S_ + (valid ? kpos : 0)) * PW0 + 2048 + 2048 + g * 128;
                float s[4]; dots_bf16(kb, valid, qs, s);
#pragma unroll
                for (int h = 0; h < 4; ++h) s[h] -= slope[h] * (float)dist;
                const int kfirst = k0 < 0 ? -k0 : 0;
#pragma unroll
                for (int h = 0; h < 4; ++h) {
                    const float sv = valid ? s[h] : -__builtin_inff();
                    const float tm = wmax(sv); const float mn = fmaxf(m[h], tm);
                    float alpha = 1.f, p = 0.f;
                    if (mn > -__builtin_inff()) { alpha = __expf(m[h] - mn); p = valid ? __expf(sv - mn) : 0.f; }
                    l[h] = l[h] * alpha + wsum(p); acc[h] *= alpha; m[h] = mn; pl[h * 64 + lane] = p;
                }
                lds_fence();
                const bf16_t* vb = proj + 2048 + 2560 + g * 128 + 2 * lane;
                for (int k = kfirst; k < 64; ++k) {
                    const unsigned w = *(const unsigned*)(vb + (size_t)(b * S_ + k0 + k) * PW0);
                    const f32x2 v = {__uint_as_float(w << 16), __uint_as_float(w & 0xffff0000u)};
#pragma unroll
                    for (int h = 0; h < 4; ++h) acc[h] += pl[h * 64 + k] * v;
                }
                lds_fence();
            }
#pragma unroll
            for (int h = 0; h < 4; ++h) ofin[h] += (gate[h][2] / l[h]) * acc[h];
        }
#pragma unroll
        for (int h = 0; h < 4; ++h) *(unsigned*)(O + (size_t)(b * S_ + t) * D_ + (4 * g + h) * 128 + 2 * lane) = pk2(ofin[h][0], ofin[h][1]);
        lds_fence();
    }
}

__device__ __forceinline__ void dil_attn_ref_phase(const Ctx& c) {
    LDSP float* wl = (LDSP float*)(c.lds + c.wave * 8192);
    LDSP float* qs = wl;
    LDSP float* pl = wl + 128;
    const bf16_t* proj = (const bf16_t*)(c.ws + WS_PROJ);
    bf16_t* O = (bf16_t*)(c.ws + WS_O);
    const int lane = c.lane, nw = c.G * NWAVE;
    const float scale = 0.08838834764831845f;
    for (int u = c.bid * NWAVE + c.wave; u < B_ * S_ * 16; u += nw) {
        const int h = u & 15, t = (u >> 4) & 2047, b = u >> 15;
        const bf16_t* prow = proj + (size_t)(b * S_ + t) * PW1;
        { const unsigned w = *(const unsigned*)(prow + h * 128 + 2 * lane); qs[2 * lane] = __uint_as_float(w << 16) * scale; qs[2 * lane + 1] = __uint_as_float(w & 0xffff0000u) * scale; }
        lds_fence();
        const float slope = exp2f(-0.5f * (float)(h + 1));
        float lse[3]; f32x2 og[3];
#pragma unroll
        for (int gi = 0; gi < 3; ++gi) {
            const int r = gi == 0 ? 1 : gi == 1 ? 4 : 16;
            const int uq = t / r; const int imax = uq < 128 ? uq : 128;
            const size_t koff = 2048 + (size_t)gi * 4096 + h * 128, voff = koff + 2048;
            float m = -__builtin_inff(), l = 0.f; f32x2 acc = {0.f, 0.f};
            for (int tile = 0; tile * 64 <= imax; ++tile) {
                const int i = tile * 64 + lane; const bool valid = i <= imax;
                float s = 0.f;
                if (valid) { const bf16_t* kr = proj + (size_t)(b * S_ + t - r * i) * PW1 + koff;
                    for (int d8 = 0; d8 < 16; ++d8) { const u32x4 w = *(const u32x4*)(kr + d8 * 8);
                        const f32x4 qa = *(LDSP const f32x4*)(qs + d8 * 8), qb = *(LDSP const f32x4*)(qs + d8 * 8 + 4);
                        s += __uint_as_float(w.x << 16) * qa[0] + __uint_as_float(w.x & 0xffff0000u) * qa[1] + __uint_as_float(w.y << 16) * qa[2] + __uint_as_float(w.y & 0xffff0000u) * qa[3]
                           + __uint_as_float(w.z << 16) * qb[0] + __uint_as_float(w.z & 0xffff0000u) * qb[1] + __uint_as_float(w.w << 16) * qb[2] + __uint_as_float(w.w & 0xffff0000u) * qb[3]; }
                    s -= slope * (float)(r * i); }
                const float sv = valid ? s : -__builtin_inff();
                const float mn = fmaxf(m, wmax(sv));
                const float alpha = __expf(m - mn), p = valid ? __expf(sv - mn) : 0.f;
                l = l * alpha + wsum(p); acc *= alpha; m = mn; pl[lane] = p;
                lds_fence();
                const int kc = min(64, imax - tile * 64 + 1);
                for (int k = 0; k < kc; ++k) { const unsigned w = *(const unsigned*)(proj + (size_t)(b * S_ + t - r * (tile * 64 + k)) * PW1 + voff + 2 * lane);
                    acc += pl[k] * (f32x2){__uint_as_float(w << 16), __uint_as_float(w & 0xffff0000u)}; }
                lds_fence();
            }
            lse[gi] = m + __logf(l); og[gi] = acc * (1.f / l);
        }
        const float mx = fmaxf(lse[0], fmaxf(lse[1], lse[2]));
        const float w0 = __expf(lse[0] - mx), w1 = __expf(lse[1] - mx), w2 = __expf(lse[2] - mx), inv = 1.f / (w0 + w1 + w2);
        const f32x2 o = (w0 * inv) * og[0] + (w1 * inv) * og[1] + (w2 * inv) * og[2];
        *(unsigned*)(O + (size_t)(b * S_ + t) * D_ + h * 128 + 2 * lane) = pk2(o[0], o[1]);
        lds_fence();
    }
}


namespace att {
typedef __attribute__((address_space(1))) char gchar;
typedef __attribute__((address_space(1))) float gfloat;
typedef __attribute__((address_space(1))) unsigned gunsigned;
typedef short bf16x8 __attribute__((ext_vector_type(8)));
typedef short s16x4 __attribute__((ext_vector_type(4)));
typedef float f32x16 __attribute__((ext_vector_type(16)));
constexpr int SHM = 16384;
constexpr int OFF_V = 0, OFF_K = 3 * SHM, OFF_WS = 6 * SHM, OFF_MISC = 6 * SHM + 8 * 256;
constexpr int OFF_PS = OFF_MISC + 256, OFF_SC = OFF_PS + 8 * (8 * 129 * 4), OFF_GT = OFF_SC + 8 * 1024;
constexpr int OFF_AT = OFF_GT + 8 * 512;
constexpr int OFF_PS_ = 0;
constexpr float C2 = 0.08838834764831845f * 1.4426950408889634f;
constexpr float LOG2E = 1.4426950408889634f;
constexpr float THR = 6.0f;

#define ATT_KSWZ(row, colB) ((row) * 256 + ((colB) ^ (((row) & 15) << 4)))
#define ATT_SBAR() __builtin_amdgcn_sched_barrier(0)
__device__ __forceinline__ int v_st(int k, int c) { const int kk = (k & ~0xC) | ((k & 4) << 1) | ((k & 8) >> 1); return ((kk >> 3) * 4 + (c >> 5)) * 512 + ((kk & 7) * 32 + (c & 31)) * 2; }
__device__ __forceinline__ int v_rd_base(int lane) { return ((lane & 3) << 3) | (((lane >> 2) & 3) << 6) | (((lane >> 4) & 1) << 5) | (((lane >> 5) & 1) << 8); }
__device__ __forceinline__ int crow(int r, int hi) { return (r & 3) + 8 * (r >> 2) + 4 * hi; }
extern "C" __device__ float fmul_legacy_(float, float) __asm("llvm.amdgcn.fmul.legacy");
__device__ __forceinline__ unsigned cvtpk(float lo, float hi) { unsigned r; asm volatile("v_cvt_pk_bf16_f32 %0, %1, %2" : "=v"(r) : "v"(lo), "v"(hi)); return r; }

struct Lane { int lane, r32, hi, wid, tid; LDSP const char* at; int atmul; };

template <bool INIT = false>
__device__ __forceinline__ void qkt(f32x16& p0, f32x16& p1, LDSP const char* Kt, int r32, int hi, const bf16x8* qr, LDSP const char* at = nullptr) {
    if (INIT) {
        bf16x8 t_[8];
#pragma unroll
        for (int i = 0; i < 8; ++i) t_[i] = *reinterpret_cast<LDSP const bf16x8*>(at + 16 * i);
#pragma unroll
        for (int i = 0; i < 4; ++i) { const f32x4 a_ = *reinterpret_cast<const f32x4*>(&t_[i]), b_ = *reinterpret_cast<const f32x4*>(&t_[4 + i]);
            p0[4 * i] = a_[0]; p0[4 * i + 1] = a_[1]; p0[4 * i + 2] = a_[2]; p0[4 * i + 3] = a_[3]; p1[4 * i] = b_[0]; p1[4 * i + 1] = b_[1]; p1[4 * i + 2] = b_[2]; p1[4 * i + 3] = b_[3]; } }
    else { p0 = f32x16{}; p1 = f32x16{}; }
    int kb[4];
    int k0_ = ATT_KSWZ(r32, hi * 16); asm volatile("" : "+v"(k0_));
#pragma unroll
    for (int dd = 0; dd < 4; ++dd) kb[dd] = k0_ ^ (dd << 5);
    bf16x8 f[8][2];
#define ATT_KRD(d0) do { LDSP const char* a_ = Kt + (kb[(d0) & 3] ^ (((d0) >> 2) << 7)); f[d0][0] = *reinterpret_cast<LDSP const bf16x8*>(a_); f[d0][1] = *reinterpret_cast<LDSP const bf16x8*>(a_ + 32 * 256); } while (0)
    ATT_KRD(0); ATT_KRD(1); ATT_KRD(2);
#pragma unroll
    for (int d0 = 0; d0 < 8; ++d0) {
        ATT_SBAR();
        if (d0 + 3 < 8) { if (d0 == 0) ATT_KRD(3); else if (d0 == 1) ATT_KRD(4); else if (d0 == 2) ATT_KRD(5); else if (d0 == 3) ATT_KRD(6); else ATT_KRD(7); }
        p0 = __builtin_amdgcn_mfma_f32_32x32x16_bf16(f[d0][0], qr[d0], p0, 0, 0, 0);
        p1 = __builtin_amdgcn_mfma_f32_32x32x16_bf16(f[d0][1], qr[d0], p1, 0, 0, 0);
    }
#undef ATT_KRD
}
__device__ __forceinline__ void pv_tile(f32x16* o, int vb, bf16x8 pa0, bf16x8 pa1, bf16x8 pa2, bf16x8 pa3) {
#define ATT_TRRD(dst, off) asm volatile("ds_read_b64_tr_b16 %0, %1 offset:%2" : "=&v"(dst) : "v"(vb), "i"(off) : "memory")
#define ATT_RD8(S, d0) do { constexpr int b_ = (d0) * 512; ATT_TRRD(S##l0, b_); ATT_TRRD(S##h0, b_ + 2048); ATT_TRRD(S##l1, b_ + 4096); ATT_TRRD(S##h1, b_ + 6144); \
        ATT_TRRD(S##l2, b_ + 8192); ATT_TRRD(S##h2, b_ + 10240); ATT_TRRD(S##l3, b_ + 12288); ATT_TRRD(S##h3, b_ + 14336); } while (0)
#define ATT_MM4(S, d0) do { \
        o[d0] = __builtin_amdgcn_mfma_f32_32x32x16_bf16(pa0, (bf16x8){S##l0[0], S##l0[1], S##l0[2], S##l0[3], S##h0[0], S##h0[1], S##h0[2], S##h0[3]}, o[d0], 0, 0, 0); \
        o[d0] = __builtin_amdgcn_mfma_f32_32x32x16_bf16(pa1, (bf16x8){S##l1[0], S##l1[1], S##l1[2], S##l1[3], S##h1[0], S##h1[1], S##h1[2], S##h1[3]}, o[d0], 0, 0, 0); \
        o[d0] = __builtin_amdgcn_mfma_f32_32x32x16_bf16(pa2, (bf16x8){S##l2[0], S##l2[1], S##l2[2], S##l2[3], S##h2[0], S##h2[1], S##h2[2], S##h2[3]}, o[d0], 0, 0, 0); \
        o[d0] = __builtin_amdgcn_mfma_f32_32x32x16_bf16(pa3, (bf16x8){S##l3[0], S##l3[1], S##l3[2], S##l3[3], S##h3[0], S##h3[1], S##h3[2], S##h3[3]}, o[d0], 0, 0, 0); } while (0)
    s16x4 Al0, Al1, Al2, Al3, Ah0, Ah1, Ah2, Ah3, Bl0, Bl1, Bl2, Bl3, Bh0, Bh1, Bh2, Bh3;
    asm volatile("s_waitcnt lgkmcnt(0)" ::: "memory"); ATT_SBAR();
    ATT_RD8(A, 0); ATT_RD8(B, 1);
    asm volatile("s_waitcnt lgkmcnt(8)" ::: "memory"); ATT_SBAR(); ATT_MM4(A, 0); ATT_SBAR();
    ATT_RD8(A, 2);
    asm volatile("s_waitcnt lgkmcnt(8)" ::: "memory"); ATT_SBAR(); ATT_MM4(B, 1); ATT_SBAR();
    ATT_RD8(B, 3);
    asm volatile("s_waitcnt lgkmcnt(8)" ::: "memory"); ATT_SBAR(); ATT_MM4(A, 2); ATT_SBAR();
    asm volatile("s_waitcnt lgkmcnt(0)" ::: "memory"); ATT_SBAR(); ATT_MM4(B, 3);
#undef ATT_MM4
#undef ATT_RD8
#undef ATT_TRRD
}
__device__ __forceinline__ void mask_tile(f32x16& p0, f32x16& p1, int dq, unsigned W) {
    const float NEG = -__builtin_inff();
#pragma unroll
    for (int r = 0; r < 16; ++r) { const int cc = (r & 3) + 8 * (r >> 2);
        if ((unsigned)(dq - cc) >= W) p0[r] = NEG;
        if ((unsigned)(dq - cc - 32) >= W) p1[r] = NEG; }
}
__device__ __forceinline__ void alibi_tile(f32x16& p0, f32x16& p1, float sl2) {
#pragma unroll
    for (int r = 0; r < 16; ++r) { const float cc = (float)((r & 3) + 8 * (r >> 2)); p0[r] = fmaf(sl2, cc, p0[r]); p1[r] = fmaf(sl2, cc + 32.f, p1[r]); }
}
__device__ __forceinline__ void alibi_table_write(LDSP char* lds, int slot, int i, float sl2) {
    const int r = i & 15; ((LDSP float*)(lds + OFF_AT))[slot * 32 + i] = sl2 * (float)((r & 3) + 8 * (r >> 2) + (i & 16) * 2);
}
__device__ __forceinline__ void softmax_a(f32x16& p0, f32x16& p1, float base, float& m_reg, float& alpha) {
    float pmax = p0[0];
#pragma unroll
    for (int r = 1; r < 16; ++r) pmax = fmaxf(pmax, p0[r]);
#pragma unroll
    for (int r = 0; r < 16; ++r) pmax = fmaxf(pmax, p1[r]);
    pmax += base;
    { auto rr = __builtin_amdgcn_permlane32_swap(__float_as_uint(pmax), __float_as_uint(pmax), false, false); pmax = fmaxf(__uint_as_float(rr[0]), __uint_as_float(rr[1])); }
    float mn;
    if (__all(pmax - m_reg <= THR)) { mn = m_reg; alpha = 1.f; }
    else { mn = fmaxf(m_reg, pmax); alpha = __builtin_amdgcn_exp2f(m_reg - mn); m_reg = mn; }
    const float sub = mn - base;
#pragma unroll
    for (int r = 0; r < 16; ++r) p0[r] = __builtin_amdgcn_exp2f(p0[r] - sub);
#pragma unroll
    for (int r = 0; r < 16; ++r) p1[r] = __builtin_amdgcn_exp2f(p1[r] - sub);
}
__device__ __forceinline__ float rowsum2(const f32x16& p0, const f32x16& p1) {
    float ps = 0;
#pragma unroll
    for (int r = 0; r < 16; ++r) ps += p0[r];
#pragma unroll
    for (int r = 0; r < 16; ++r) ps += p1[r];
    auto rr = __builtin_amdgcn_permlane32_swap(__float_as_uint(ps), __float_as_uint(ps), false, false);
    return __uint_as_float(rr[0]) + __uint_as_float(rr[1]);
}
__device__ __forceinline__ void pack_p(const f32x16& p0, const f32x16& p1, bf16x8& pa0, bf16x8& pa1, bf16x8& pa2, bf16x8& pa3) {
#define ATT_PK4(P, B_, OUT) do { unsigned a0 = cvtpk(P[B_ + 0], P[B_ + 1]), a1 = cvtpk(P[B_ + 2], P[B_ + 3]); \
        unsigned b0 = cvtpk(P[B_ + 4], P[B_ + 5]), b1 = cvtpk(P[B_ + 6], P[B_ + 7]); \
        auto r0 = __builtin_amdgcn_permlane32_swap(a0, b0, false, false); auto r1 = __builtin_amdgcn_permlane32_swap(a1, b1, false, false); \
        u32x4 w = {r0[0], r1[0], r0[1], r1[1]}; OUT = *reinterpret_cast<bf16x8*>(&w); } while (0)
    ATT_PK4(p0, 0, pa0); ATT_PK4(p0, 8, pa1); ATT_PK4(p1, 0, pa2); ATT_PK4(p1, 8, pa3);
#undef ATT_PK4
}
__device__ __forceinline__ void scale_rows(f32x16* o, float f, LDSP float* xl, int r32, int hi) {
    if (hi == 0) xl[r32] = f;
    asm volatile("s_waitcnt lgkmcnt(0)" ::: "memory");
    float fr[16];
#pragma unroll
    for (int r = 0; r < 16; ++r) fr[r] = xl[crow(r, hi)];
#pragma unroll
    for (int d = 0; d < 4; ++d)
#pragma unroll
        for (int r = 0; r < 16; ++r) o[d][r] = fmul_legacy_(o[d][r], fr[r]);
    asm volatile("s_waitcnt lgkmcnt(0)" ::: "memory");
}
__device__ __forceinline__ bf16x8 scale8(u32x4 w, float s) {
    u32x4 o;
    o.x = cvtpk(__uint_as_float(w.x << 16) * s, __uint_as_float(w.x & 0xffff0000u) * s); o.y = cvtpk(__uint_as_float(w.y << 16) * s, __uint_as_float(w.y & 0xffff0000u) * s);
    o.z = cvtpk(__uint_as_float(w.z << 16) * s, __uint_as_float(w.z & 0xffff0000u) * s); o.w = cvtpk(__uint_as_float(w.w << 16) * s, __uint_as_float(w.w & 0xffff0000u) * s);
    return *reinterpret_cast<bf16x8*>(&o);
}
__device__ __forceinline__ bf16x8 aug_frag(unsigned dword0, int hi) { u32x4 w = {hi ? 0u : dword0, 0u, 0u, 0u}; return *reinterpret_cast<bf16x8*>(&w); }
__device__ __forceinline__ unsigned split_bf16(float x) {
    const unsigned hb = (unsigned)f2bf(x); const float rem = x - __uint_as_float(hb << 16); return hb | ((unsigned)f2bf(rem) << 16);
}

struct DmaMap { int m0, m1; };
__device__ __forceinline__ int dma_map1(int q) {
    const int krow = q >> 4, kcol = ((q & 15) ^ (krow & 15)) * 8;
    const int sub = q >> 5, kk = (sub >> 2) * 8 + ((q & 31) >> 2), vrow = (kk & ~0xC) | ((kk & 4) << 1) | ((kk & 8) >> 1), vcol = (sub & 3) * 32 + (q & 3) * 8;
    return krow | (kcol << 6) | (vrow << 13) | (vcol << 19);
}
__device__ __forceinline__ DmaMap dma_map(int wid, int lane) { DmaMap d; d.m0 = dma_map1(wid * 64 + lane); d.m1 = dma_map1(512 + wid * 64 + lane); return d; }
__device__ __forceinline__ void stage_dma(const DmaMap& dm, const bf16_t* Kb, const bf16_t* Vb, size_t stride, int row0, int rmax, LDSP char* lds, int buf, int wid, int which = 3) {
#pragma unroll
    for (int i = 0; i < 2; ++i) {
        const int m = i ? dm.m1 : dm.m0;
        if (which & 1) { int kr = row0 + (m & 63); kr = kr < 0 ? 0 : (kr > rmax ? rmax : kr);
            const bf16_t* ks = Kb + (size_t)kr * stride + ((m >> 6) & 127);
            __builtin_amdgcn_global_load_lds((const unsigned*)ks, (LDSP unsigned*)(lds + OFF_K + buf * SHM + i * 8192 + wid * 1024), 16, 0, 0); }
        if (which & 2) { int vr = row0 + ((m >> 13) & 63); vr = vr < 0 ? 0 : (vr > rmax ? rmax : vr);
            const bf16_t* vs = Vb + (size_t)vr * stride + ((m >> 19) & 127);
            __builtin_amdgcn_global_load_lds((const unsigned*)vs, (LDSP unsigned*)(lds + OFF_V + buf * SHM + i * 8192 + wid * 1024), 16, 0, 0); }
    }
}
struct DmaOff { unsigned k, v; };
__device__ __forceinline__ DmaOff dma_off(const DmaMap& dm, unsigned strideB) {
    const int m = dm.m0; DmaOff o; o.k = (unsigned)(m & 63) * strideB + (unsigned)((m >> 6) & 127) * 2u; o.v = (unsigned)((m >> 13) & 63) * strideB + (unsigned)((m >> 19) & 127) * 2u; return o;
}
__device__ __forceinline__ void stage_dma_fast(const DmaOff& o, const bf16_t* Kb, const bf16_t* Vb, unsigned strideB, int row0, LDSP char* lds, int buf, int wid, int which) {
    const size_t tb = (size_t)(unsigned)row0 * strideB;
#pragma unroll
    for (int i = 0; i < 2; ++i) {
        if (which & 1) __builtin_amdgcn_global_load_lds((const unsigned*)((const char*)Kb + tb + (size_t)i * 32 * strideB + o.k), (LDSP unsigned*)(lds + OFF_K + buf * SHM + i * 8192 + wid * 1024), 16, 0, 0);
        if (which & 2) __builtin_amdgcn_global_load_lds((const unsigned*)((const char*)Vb + tb + (size_t)i * 32 * strideB + o.v), (LDSP unsigned*)(lds + OFF_V + buf * SHM + i * 8192 + wid * 1024), 16, 0, 0);
    }
}
struct Stage { u32x4 k0, k1, v0, v1; };
__device__ __forceinline__ void stage_load(Stage& s, const bf16_t* Kb, const bf16_t* Vb, size_t stride, int row0, int rmax, int tid) {
    const int sr = tid >> 4, sc = (tid & 15) * 8;
    int ra = row0 + sr, rb = row0 + 32 + sr; ra = ra < 0 ? 0 : (ra > rmax ? rmax : ra); rb = rb < 0 ? 0 : (rb > rmax ? rmax : rb);
    s.v0 = *(const u32x4*)(Vb + (size_t)ra * stride + sc); s.v1 = *(const u32x4*)(Vb + (size_t)rb * stride + sc);
    s.k0 = *(const u32x4*)(Kb + (size_t)ra * stride + sc); s.k1 = *(const u32x4*)(Kb + (size_t)rb * stride + sc);
}
__device__ __forceinline__ void stage_write(const Stage& s, LDSP char* lds, int buf, int tid) {
    const int sr = tid >> 4, sc = (tid & 15) * 8;
    *(LDSP u32x4*)(lds + OFF_K + buf * SHM + ATT_KSWZ(sr, sc * 2)) = s.k0; *(LDSP u32x4*)(lds + OFF_K + buf * SHM + ATT_KSWZ(sr, sc * 2) + 32 * 256) = s.k1;
    *(LDSP u32x4*)(lds + OFF_V + buf * SHM + v_st(sr, sc)) = s.v0; *(LDSP u32x4*)(lds + OFF_V + buf * SHM + v_st(32 + sr, sc)) = s.v1;
}
__device__ __forceinline__ void stage_dma_at(const DmaMap& dm, const bf16_t* Kb, const bf16_t* Vb, size_t stride, int row0, int rmax, LDSP char* kdst, LDSP char* vdst, int wid) {
#pragma unroll
    for (int i = 0; i < 2; ++i) {
        const int m = i ? dm.m1 : dm.m0;
        int kr = row0 + (m & 63), vr = row0 + ((m >> 13) & 63); kr = kr < 0 ? 0 : (kr > rmax ? rmax : kr); vr = vr < 0 ? 0 : (vr > rmax ? rmax : vr);
        const bf16_t* ks = Kb + (size_t)kr * stride + ((m >> 6) & 127); const bf16_t* vs = Vb + (size_t)vr * stride + ((m >> 19) & 127);
        __builtin_amdgcn_global_load_lds((const unsigned*)ks, (LDSP unsigned*)(kdst + i * 8192 + wid * 1024), 16, 0, 0);
        __builtin_amdgcn_global_load_lds((const unsigned*)vs, (LDSP unsigned*)(vdst + i * 8192 + wid * 1024), 16, 0, 0);
    }
}
#define ATT_DMA_SYNC() do { asm volatile("s_waitcnt vmcnt(0)" ::: "memory"); __syncthreads(); } while (0)
#define ATT_RING_SYNC(more) do { if (more) asm volatile("s_waitcnt vmcnt(4)" ::: "memory"); else asm volatile("s_waitcnt vmcnt(0)" ::: "memory"); \
        asm volatile("s_waitcnt lgkmcnt(0)" ::: "memory"); __builtin_amdgcn_s_barrier(); asm volatile("" ::: "memory"); } while (0)

struct Pass { float m, l; f32x16 o[4]; };
__device__ __forceinline__ void pass_init(Pass& P) { P.m = -1e30f; P.l = 0.f;
#pragma unroll
    for (int d = 0; d < 4; ++d) P.o[d] = f32x16{}; }

struct PFrag { bf16x8 a0, a1, a2, a3; };
__device__ __forceinline__ void tile_sm(Pass& P, PFrag& F, f32x16& p0, f32x16& p1, LDSP float* xl, const Lane& L, float sl2, bool need_mask, int dq0, unsigned W, float base);
__device__ __forceinline__ void tile_qk_at(Pass& P, PFrag& F, LDSP const char* Kt, LDSP float* xl, const Lane& L, const bf16x8* qr, float sl2, bool need_mask, int dq0, unsigned W, float base) {
    f32x16 p0, p1;
    qkt<true>(p0, p1, Kt, L.r32, L.hi, qr, L.at + (L.r32 >> 3) * L.atmul);
    tile_sm(P, F, p0, p1, xl, L, sl2, need_mask, dq0, W, base);
}
__device__ __forceinline__ void tile_sm(Pass& P, PFrag& F, f32x16& p0, f32x16& p1, LDSP float* xl, const Lane& L, float sl2, bool need_mask, int dq0, unsigned W, float base) {
    if (need_mask) mask_tile(p0, p1, dq0 - 4 * L.hi, W);
    float alpha;
    const float m_prev = P.m;
    softmax_a(p0, p1, base + sl2 * (float)(4 * L.hi), P.m, alpha);
    if (__any(alpha < 1.f && m_prev > -1e29f)) scale_rows(P.o, alpha, xl, L.r32, L.hi);
    P.l = P.l * alpha + rowsum2(p0, p1);
    pack_p(p0, p1, F.a0, F.a1, F.a2, F.a3);
}
__device__ __forceinline__ void tile_qk(Pass& P, PFrag& F, LDSP char* lds, int buf, const Lane& L, const bf16x8* qr, float sl2, bool need_mask, int dq0, unsigned W, float base) {
    tile_qk_at(P, F, lds + OFF_K + buf * SHM, (LDSP float*)(lds + OFF_WS + L.wid * 256), L, qr, sl2, need_mask, dq0, W, base);
}
__device__ __forceinline__ void tile_pv_at(Pass& P, const PFrag& F, LDSP char* Vt, const Lane& L) {
    ATT_SBAR();
    const int vb = (int)(unsigned)(uintptr_t)Vt + v_rd_base(L.lane);
    pv_tile(P.o, vb, F.a0, F.a1, F.a2, F.a3);
}
__device__ __forceinline__ void tile_pv(Pass& P, const PFrag& F, LDSP char* lds, int buf, const Lane& L) {
    ATT_SBAR();
    const int vb = (int)(unsigned)(uintptr_t)(lds + OFF_V + buf * SHM) + v_rd_base(L.lane);
    pv_tile(P.o, vb, F.a0, F.a1, F.a2, F.a3);
}
#define ATT_EV_EVEN(k_) do { if ((k_) == 0 || (k_) >= n) asm volatile("s_waitcnt vmcnt(0)" ::: "memory"); else if ((k_) + 1 < n) asm volatile("s_waitcnt vmcnt(4)" ::: "memory"); else asm volatile("s_waitcnt vmcnt(2)" ::: "memory"); \
        asm volatile("s_waitcnt lgkmcnt(0)" ::: "memory"); __builtin_amdgcn_s_barrier(); asm volatile("" ::: "memory"); } while (0)
#define ATT_ISSUE(k_) do { if ((k_) + 2 < n) pol.dma(pol.tile((k_) + 2), ((k_) + 2) % 3, 1); if ((k_) + 1 < n) pol.dma(pol.tile((k_) + 1), ((k_) + 1) % 3, 2); } while (0)
#define ATT_EV_ODD() do { asm volatile("s_waitcnt lgkmcnt(0)" ::: "memory"); __builtin_amdgcn_s_barrier(); asm volatile("" ::: "memory"); } while (0)
template <class Pol, bool STAGGER = true>
__device__ __forceinline__ void ring_pass(Pass& P, const Pol& pol, LDSP char* lds, const Lane& L, const bf16x8* qr, float sl2, bool pre = false) {
    const int n = pol.n;
    const bool lag = STAGGER && L.wid >= 4;
    LDSP float* xl = (LDSP float*)(lds + OFF_WS + L.wid * 256);
    if (!pre) { pol.dma(pol.tile(0), 0, 3); if (n > 1) pol.dma(pol.tile(1), 1, 1); }
    ATT_EV_EVEN(0); ATT_ISSUE(0);
    if (lag) ATT_EV_ODD();
    PFrag F;
    bool actp = false; int buf = 0, bufp = 0;
    for (int i = 0; i < n; ++i) {
        if (actp) tile_pv(P, F, lds, bufp, L);
        ATT_SBAR();
        const int j = pol.tile(i);
        bool act; f32x16 p0, p1;
        { bool nm_; int dq_; unsigned W_; float base_; pol.prep(j, act, nm_, dq_, W_, base_); }
        if (act) { int rr_ = L.r32; if (L.atmul) asm volatile("" : "+v"(rr_)); qkt<true>(p0, p1, lds + OFF_K + buf * SHM, L.r32, L.hi, qr, L.at + (rr_ >> 3) * L.atmul); }
        if (!lag) { if (STAGGER) ATT_EV_ODD(); } else ATT_EV_EVEN(i + 1);
        if (act) { int j2 = j; asm volatile("" : "+s"(j2));
            bool a2_, need_mask; int dq0; unsigned W; float base; pol.prep(j2, a2_, need_mask, dq0, W, base);
            tile_sm(P, F, p0, p1, xl, L, sl2, need_mask, dq0, W, base); }
        else { const bf16x8 z_ = {}; F.a0 = z_; F.a1 = z_; F.a2 = z_; F.a3 = z_; }
        if (!lag) ATT_EV_EVEN(i + 1); else ATT_EV_ODD();
        ATT_ISSUE(i + 1);
        actp = act; bufp = buf; buf = buf == 2 ? 0 : buf + 1;
    }
    if (actp) tile_pv(P, F, lds, bufp, L);
    if (STAGGER && !lag) ATT_EV_ODD();
}
}

__device__ __forceinline__ void nsa_attn_mfma_phase(const Ctx& c) {
    using namespace att;
    LDSP char* lds = (LDSP char*)c.lds;
    const bf16_t* proj = (const bf16_t*)(c.ws + WS_PROJ);
    const bf16_t* CMPB = (const bf16_t*)(c.ws + WS_CMPB);
    float* ACC = (float*)(c.ws + WS_ACC);
    bf16_t* O = (bf16_t*)(c.ws + WS_O);
    Lane L; L.tid = c.tid; L.lane = c.lane; L.r32 = c.lane & 31; L.hi = c.lane >> 5; L.wid = c.wave; L.at = lds + OFF_AT; L.atmul = 128;
    const DmaMap dm = dma_map(L.wid, L.lane);
    LDSP float* xl = (LDSP float*)(lds + OFF_WS + L.wid * 256);
    LDSP unsigned* misc = (LDSP unsigned*)(lds + OFF_MISC);
    { LDSP float* psw0 = (LDSP float*)(lds + OFF_PS + L.wid * (8 * 129 * 4));
#pragma unroll
      for (int i = 0; i < 17; ++i) { const int w = L.lane + 64 * i; if (w < 8 * 129) psw0[w] = 0.f; } }
    for (int uu = c.bid; uu < (DUP_PH == 104 ? 2048 : 1024); uu += c.G) {
        const int u = uu & 1023, cc_ = u & 255, ri_ = u >> 8, bg = 4 * (cc_ & 7) + ri_, p_ = (ri_ >> 1) ? (((cc_ >> 3) + 16) & 31) : (cc_ >> 3), qb = (ri_ & 1) ? 31 - p_ : p_, b = bg >> 2, g = bg & 3;
        const int qi = L.r32 & 7, hl = L.r32 >> 3, t = 64 * qb + 8 * L.wid + qi, h = 4 * g + hl;
        const bf16_t* prow = proj + (size_t)(b * S_ + t) * PW0;
        __syncthreads();
        { int tw = c.tid; asm volatile("" : "+v"(tw));
          if (tw < 128) alibi_table_write(lds, tw >> 5, tw & 31, exp2f(-0.5f * (float)(4 * g + (tw >> 5) + 1)) * LOG2E); }
        { const bf16_t* Kc0 = CMPB + ((size_t)(0 * 8 + b) * 128 * 4 + g) * 128; const bf16_t* Vc0 = CMPB + ((size_t)(1 * 8 + b) * 128 * 4 + g) * 128;
          stage_dma(dm, Kc0, Vc0, 512, 0, 127, lds, 0, L.wid); stage_dma(dm, Kc0, Vc0, 512, 64, 127, lds, 1, L.wid); }
        bf16x8 qr[8];
        { u32x4 qraw_[8];
#pragma unroll
          for (int d0 = 0; d0 < 8; ++d0) qraw_[d0] = *(const u32x4*)(prow + h * 128 + d0 * 16 + L.hi * 8);
#pragma unroll
          for (int d0 = 0; d0 < 8; ++d0) qr[d0] = scale8(qraw_[d0], C2); }
        const float slope = exp2f(-0.5f * (float)(h + 1));
        LDSP float* gtw = (LDSP float*)(lds + OFF_GT + L.wid * 512);
        if (L.hi == 0) {
#pragma unroll
            for (int j = 0; j < 3; ++j) gtw[L.r32 * 3 + j] = 1.f / (1.f + __expf(-bf2f(prow[5120 + h * 3 + j])));
        }
#define NSA_GATE(j) (gtw[L.r32 * 3 + (j)])
        char* accb = (char*)ACC + ((size_t)c.bid * NWAVE + L.wid) * 16384;
        const unsigned avo = (unsigned)(L.lane * 4);
        unsigned selmask;
#if !defined(NSA_NO_CMP)
        for (int repc_ = 0; repc_ < (DUP_PH == 301 ? 2 : 1); ++repc_) { if (repc_) __syncthreads();
            const bf16_t* Kc = CMPB + ((size_t)(0 * 8 + b) * 128 * 4 + g) * 128; const bf16_t* Vc = CMPB + ((size_t)(1 * 8 + b) * 128 * 4 + g) * 128;
            ATT_DMA_SYNC();
            const float sl2 = slope * 16.f * LOG2E, qf = ((float)t - 15.5f) * 0.0625f;
            const int nq = (t - 31) >> 4;
            f32x16 pA0, pA1, pB0, pB1;
            qkt(pA0, pA1, lds + OFF_K, L.r32, L.hi, qr); alibi_tile(pA0, pA1, sl2);
            qkt(pB0, pB1, lds + OFF_K + SHM, L.r32, L.hi, qr); alibi_tile(pB0, pB1, sl2);
            mask_tile(pA0, pA1, nq - 4 * L.hi, 0x40000000u); mask_tile(pB0, pB1, nq - 64 - 4 * L.hi, 0x40000000u);
            const float baseA = -sl2 * (qf - (float)(4 * L.hi)), baseB = -sl2 * (qf - 64.f - (float)(4 * L.hi));
            float mA = pA0[0], mB = pB0[0];
#pragma unroll
            for (int r = 1; r < 16; ++r) { mA = fmaxf(mA, pA0[r]); mB = fmaxf(mB, pB0[r]); }
#pragma unroll
            for (int r = 0; r < 16; ++r) { mA = fmaxf(mA, pA1[r]); mB = fmaxf(mB, pB1[r]); }
            float mx = fmaxf(mA + baseA, mB + baseB);
            { auto rr = __builtin_amdgcn_permlane32_swap(__float_as_uint(mx), __float_as_uint(mx), false, false); mx = fmaxf(__uint_as_float(rr[0]), __uint_as_float(rr[1])); }
            if (mx == -__builtin_inff()) mx = 0.f;
            const float subA = mx - baseA, subB = mx - baseB;
#pragma unroll
            for (int r = 0; r < 16; ++r) { pA0[r] = __builtin_amdgcn_exp2f(pA0[r] - subA); pA1[r] = __builtin_amdgcn_exp2f(pA1[r] - subA); pB0[r] = __builtin_amdgcn_exp2f(pB0[r] - subB); pB1[r] = __builtin_amdgcn_exp2f(pB1[r] - subB); }
            const float lsum = rowsum2(pA0, pA1) + rowsum2(pB0, pB1);
            const float inv = 1.f / fmaxf(lsum, 1e-30f);
#pragma unroll
            for (int r = 0; r < 16; ++r) { pA0[r] *= inv; pA1[r] *= inv; pB0[r] *= inv; pB1[r] *= inv; }
            bf16x8 paA0, paA1, paA2, paA3, paB0, paB1, paB2, paB3;
            pack_p(pA0, pA1, paA0, paA1, paA2, paA3); pack_p(pB0, pB1, paB0, paB1, paB2, paB3);
            LDSP float* psw = (LDSP float*)(lds + OFF_PS + L.wid * (8 * 129 * 4));
#pragma unroll
            for (int r = 0; r < 16; ++r) {
                float a = pA0[r], b2 = pA1[r], c2 = pB0[r], d2 = pB1[r];
                a += __shfl_xor(a, 8); b2 += __shfl_xor(b2, 8); c2 += __shfl_xor(c2, 8); d2 += __shfl_xor(d2, 8);
                a += __shfl_xor(a, 16); b2 += __shfl_xor(b2, 16); c2 += __shfl_xor(c2, 16); d2 += __shfl_xor(d2, 16);
                if (hl == 0) { const int n0 = crow(r, L.hi); LDSP float* pp = psw + qi * 129 + n0; pp[0] = a; pp[32] = b2; pp[64] = c2; pp[96] = d2; }
                if ((r & 3) == 3) asm volatile("" ::: "memory");
            }
            asm volatile("s_waitcnt lgkmcnt(0)" ::: "memory");
            {
                LDSP float* scw = (LDSP float*)(lds + OFF_SC + L.wid * 1024);
                int sq = L.lane & 7, jb = L.lane >> 3; asm volatile("" : "+v"(sq), "+v"(jb));
                const int tq = 64 * qb + 8 * L.wid + sq;
                const LDSP float* pq = psw + sq * 129;
                float sj[4];
#pragma unroll
                for (int i = 0; i < 4; ++i) { const int j = jb + 8 * i;
                    const float imp = (j ? pq[4 * j - 1] : 0.f) + 2.f * (pq[4 * j] + pq[4 * j + 1] + pq[4 * j + 2]) + pq[4 * j + 3];
                    const bool forced = (j == 0) || (j == qb) || (j == qb - 1), causal = (64 * j <= tq);
                    sj[i] = forced ? 1.0e6f : (causal ? imp : -1.0f); scw[sq * 32 + j] = sj[i]; }
                asm volatile("s_waitcnt lgkmcnt(0)" ::: "memory");
                int rk[4] = {0, 0, 0, 0};
                for (int i2 = 0; i2 < 32; ++i2) { const float si = scw[sq * 32 + i2];
#pragma unroll
                    for (int i = 0; i < 4; ++i) rk[i] += ((si > sj[i]) || (si == sj[i] && i2 < jb + 8 * i)) ? 1 : 0; }
                unsigned bits = 0u;
#pragma unroll
                for (int i = 0; i < 4; ++i) if (rk[i] < 16) bits |= 1u << (jb + 8 * i);
                bits |= (unsigned)__shfl_xor((int)bits, 8); bits |= (unsigned)__shfl_xor((int)bits, 16); bits |= (unsigned)__shfl_xor((int)bits, 32);
                selmask = bits;
                if (L.lane < 8) ((unsigned*)(c.ws + WS_SEL))[((size_t)b * 4 + g) * 2048 + tq] = selmask;
            }
            f32x16 o[4];
#pragma unroll
            for (int d = 0; d < 4; ++d) o[d] = f32x16{};
            ATT_SBAR();
            pv_tile(o, (int)(unsigned)(uintptr_t)(lds + OFF_V) + v_rd_base(L.lane), paA0, paA1, paA2, paA3);
            pv_tile(o, (int)(unsigned)(uintptr_t)(lds + OFF_V + SHM) + v_rd_base(L.lane), paB0, paB1, paB2, paB3);
            scale_rows(o, NSA_GATE(0), xl, L.r32, L.hi);
#pragma unroll
            for (int h2 = 0; h2 < 2; ++h2) { gchar* pq = (gchar*)(accb + avo + h2 * 4096); asm volatile("" : "+v"(pq));
#pragma unroll
                for (int k = 0; k < 16; ++k) { const int q = 2 * h2 + (k >> 3), rl = (k & 7) >> 1, dh = k & 1;
                    *(gunsigned*)(pq + k * 256) = cvtpk(o[2 * dh][q * 4 + rl], o[2 * dh + 1][q * 4 + rl]); } }
        }
#else
        selmask = 0xffffffffu;
#endif
#if !defined(NSA_NO_SEL)
        {
            const unsigned causal_bits = (qb == 31) ? 0xffffffffu : ((1u << (qb + 1)) - 1u);
            unsigned wmask = selmask & causal_bits;
#pragma unroll
            for (int o_ = 1; o_ < 64; o_ <<= 1) wmask |= (unsigned)__shfl_xor((int)wmask, o_);
            if (c.tid == 0) misc[0] = 0u;
            __syncthreads();
            if (L.lane == 0) atomicOr((unsigned*)(misc + 0), wmask);
            __syncthreads();
            unsigned rem = (unsigned)__builtin_amdgcn_readfirstlane((int)misc[0]);
            wmask = (unsigned)__builtin_amdgcn_readfirstlane((int)wmask);
            const float sl2 = slope * LOG2E;
            const bf16_t* Kb = proj + (size_t)b * S_ * PW0 + 2048 + 1024 + g * 128; const bf16_t* Vb = Kb + 512;
            Pass P; pass_init(P);
            const int ntl = __builtin_popcount(rem);
            if (c.tid == 0) { unsigned rr_ = rem; int k_ = 0; while (rr_) { const int jj_ = 31 - __builtin_clz(rr_); rr_ &= ~(1u << jj_); misc[8 + k_] = (unsigned)jj_; ++k_; } }
            __syncthreads();
            const int lv_ = (int)((LDSP const unsigned*)(misc + 8))[L.lane & 31];
            struct SelPol { int n; int lv; DmaOff off; const bf16_t* Kb; const bf16_t* Vb; LDSP char* lds; int wid; unsigned wmask, selmask; int t; float sl2;
                __device__ __forceinline__ int tile(int i) const { return __builtin_amdgcn_readlane(lv, (DUP_PH == 311) ? (i >= (n >> 1) ? i - (n >> 1) : i) : i); }
                __device__ __forceinline__ void dma(int j, int buf, int which) const { stage_dma_fast(off, Kb, Vb, PW0 * 2, 64 * j, lds, buf, wid, which); }
                __device__ __forceinline__ void prep(int j, bool& act, bool& need_mask, int& dq0, unsigned& W, float& base) const {
                    act = (wmask >> j) & 1u; const bool mine = (selmask >> j) & 1u;
                    dq0 = mine ? t - 64 * j : -1; need_mask = !__all(mine && (t - 64 * j >= 63)); W = 0x40000000u; base = -sl2 * (float)(t - 64 * j); }
            } pol{(DUP_PH == 311) ? 2 * ntl : ntl, lv_, dma_off(dm, PW0 * 2), Kb, Vb, lds, L.wid, wmask, selmask, t, sl2};
            ring_pass(P, pol, lds, L, qr, sl2);
            scale_rows(P.o, NSA_GATE(1) / P.l, xl, L.r32, L.hi);
            {
                gchar* pa_ = (gchar*)(accb + avo); asm volatile("" : "+v"(pa_)); gchar* pb_ = (gchar*)(accb + avo + 4096); asm volatile("" : "+v"(pb_));
                unsigned wa[16], wb[16];
#pragma unroll
                for (int k = 0; k < 16; ++k) { wa[k] = *(const gunsigned*)(pa_ + k * 256); wb[k] = *(const gunsigned*)(pb_ + k * 256); }
#pragma unroll
                for (int k = 0; k < 16; ++k) { const int qq = k >> 3, rl = (k & 7) >> 1, dh = k & 1;
                    *(gunsigned*)(pa_ + k * 256) = cvtpk(__uint_as_float(wa[k] << 16) + P.o[2 * dh][qq * 4 + rl], __uint_as_float(wa[k] & 0xffff0000u) + P.o[2 * dh + 1][qq * 4 + rl]);
                    *(gunsigned*)(pb_ + k * 256) = cvtpk(__uint_as_float(wb[k] << 16) + P.o[2 * dh][(2 + qq) * 4 + rl], __uint_as_float(wb[k] & 0xffff0000u) + P.o[2 * dh + 1][(2 + qq) * 4 + rl]); }
                asm volatile("" ::: "memory"); }
        }
#endif
#if !defined(NSA_NO_WIN)
        for (int repw_ = 0; repw_ < (DUP_PH == 302 ? 2 : 1); ++repw_) {
            __syncthreads();
            const float sl2 = slope * LOG2E;
            const bf16_t* Kb = proj + (size_t)b * S_ * PW0 + 2048 + 2048 + g * 128; const bf16_t* Vb = Kb + 512;
            Pass P; pass_init(P);
            const int jlo = qb - 8 > 0 ? qb - 8 : 0;
            struct WinPol { int n, jhi; DmaOff off; const bf16_t* Kb; const bf16_t* Vb; LDSP char* lds; int wid, t; float sl2;
                __device__ __forceinline__ int tile(int i) const { return (DUP_PH == 312) ? jhi - (i >= (n >> 1) ? i - (n >> 1) : i) : jhi - i; }
                __device__ __forceinline__ void dma(int j, int buf, int which) const { stage_dma_fast(off, Kb, Vb, PW0 * 2, 64 * j, lds, buf, wid, which); }
                __device__ __forceinline__ void prep(int j, bool& act, bool& need_mask, int& dq0, unsigned& W, float& base) const {
                    dq0 = t - 64 * j; act = __any((dq0 >= 0) && (dq0 - 63 < 512)); need_mask = !__all(dq0 - 63 >= 0 && dq0 < 512); W = 512u; base = -sl2 * (float)dq0; }
            } pol{(DUP_PH == 312) ? 2 * (qb - jlo + 1) : (qb - jlo + 1), qb, dma_off(dm, PW0 * 2), Kb, Vb, lds, L.wid, t, sl2};
            ring_pass(P, pol, lds, L, qr, sl2);
            scale_rows(P.o, NSA_GATE(2) / P.l, xl, L.r32, L.hi);
            char* ob = (char*)O + ((size_t)(b * S_ + 64 * qb + 8 * L.wid) * D_ + (size_t)(4 * g) * 128) * 2;
            const unsigned ovo = (unsigned)(L.hi * 4 * D_ * 2 + L.r32 * 2);
            {
                gchar* pa_ = (gchar*)(accb + avo); asm volatile("" : "+v"(pa_)); gchar* pb_ = (gchar*)(accb + avo + 4096); asm volatile("" : "+v"(pb_));
                unsigned wa[16], wb[16];
#pragma unroll
                for (int k = 0; k < 16; ++k) { wa[k] = *(const gunsigned*)(pa_ + k * 256); wb[k] = *(const gunsigned*)(pb_ + k * 256); }
#pragma unroll
                for (int q = 0; q < 4; ++q) {
#pragma unroll
                    for (int rl = 0; rl < 4; ++rl) { gchar* po = (gchar*)(ob + ovo + (rl * D_ + q * 128) * 2); asm volatile("" : "+v"(po));
#pragma unroll
                        for (int d = 0; d < 4; ++d) { const unsigned w_ = (q >> 1) ? wb[(q & 1) * 8 + rl * 2 + (d >> 1)] : wa[(q & 1) * 8 + rl * 2 + (d >> 1)];
                            const float v = ((d & 1) ? __uint_as_float(w_ & 0xffff0000u) : __uint_as_float(w_ << 16)) + P.o[d][q * 4 + rl];
                            const float vn = __int_as_float(__builtin_amdgcn_update_dpp(0, __float_as_int(v), 0xB1, 0xF, 0xF, false));
                            if ((L.r32 & 1) == 0) *(gunsigned*)(po + d * 64) = cvtpk(v, vn); } } }
                asm volatile("" ::: "memory"); }
        }
#endif
    }
}

struct DilUnit { int gi, r, b, rho, h, blk, rows, jhi, jlo, Lst; };
__device__ __forceinline__ DilUnit dil_decode(int u) {
    DilUnit d;
    if (u < 2048) { d.gi = u >> 10; const int v = u & 1023; d.h = v & 15; d.r = d.gi ? 4 : 1;
        if (d.gi == 0) { d.rho = 0; d.b = v >> 7; d.blk = ((v >> 4) + (d.b >> 1)) & 7; } else { d.rho = (v >> 5) & 3; d.b = v >> 7; d.blk = ((v >> 4) + (d.b >> 1)) & 1; } d.rows = 256; }
    else { d.gi = 2; const int v = u - 2048; d.h = v & 15; d.rho = (v >> 4) & 15; d.b = v >> 8; d.blk = 0; d.r = 16; d.rows = 128; }
    d.Lst = S_ / d.r; d.jhi = (d.blk * 256 + d.rows - 1) >> 6; d.jlo = (d.blk * 256 - 128) > 0 ? (d.blk * 256 - 128) >> 6 : 0;
    return d;
}
__device__ __forceinline__ void dil_attn_mfma_phase(const Ctx& c) {
    using namespace att;
    LDSP char* lds = (LDSP char*)c.lds;
    const bf16_t* proj = (const bf16_t*)(c.ws + WS_PROJ);
    bf16_t* OG = (bf16_t*)(c.ws + WS_OG); float* LSE = (float*)(c.ws + WS_LSE);
    Lane L; L.tid = c.tid; L.lane = c.lane; L.r32 = c.lane & 31; L.hi = c.lane >> 5; L.wid = c.wave; L.at = lds + OFF_AT; L.atmul = 0;
    const DmaMap dm = dma_map(L.wid, L.lane);
    LDSP float* xl = (LDSP float*)(lds + OFF_WS + L.wid * 256);
    const int NU = 2048;
    int uu = c.bid;
    if (uu >= NU) return;
    DilUnit U = dil_decode(uu);
    u32x4 qraw[8];
#define DIL_ADDR(sec_, b_, h_, pos_) ((((size_t)(sec_) * 8 + (b_)) * 16 + (h_)) * 2048 + (pos_)) * 128
#define DIL_KB(U_) (proj + DIL_ADDR(1 + 2 * (U_).gi, (U_).b, (U_).h, (U_).rho * (U_).Lst))
#define DIL_SEC ((size_t)8 * 16 * 2048 * 128)
#define DIL_ISSUE(U_) do { const bf16_t* kb_ = DIL_KB(U_); \
        stage_dma(dm, kb_, kb_ + DIL_SEC, 128, 64 * (U_).jhi, (U_).Lst - 1, lds, 0, L.wid); \
        if ((U_).jhi > (U_).jlo) stage_dma(dm, kb_, kb_ + DIL_SEC, 128, 64 * ((U_).jhi - 1), (U_).Lst - 1, lds, 1, L.wid, 1); \
        const int uq_ = (U_).blk * 256 + L.wid * 32 + L.r32; const int tq_ = ((L.wid * 32 < (U_).rows) ? uq_ : 0) * (U_).r + (U_).rho; \
        const bf16_t* prow_ = proj + DIL_ADDR(0, (U_).b, (U_).h, tq_); int hiq_ = L.hi; asm volatile("" : "+v"(hiq_));   \
        _Pragma("unroll") for (int d0 = 0; d0 < 8; ++d0) qraw[d0] = *(const u32x4*)(prow_ + d0 * 16 + hiq_ * 8); } while (0)
    __syncthreads();
    DIL_ISSUE(U);
    while (true) {
        const int gi = U.gi, r = U.r, b = U.b, rho = U.rho, h = U.h, blk = U.blk, rows = U.rows;
        const int uq = blk * 256 + L.wid * 32 + L.r32;
        const bool wave_on = L.wid * 32 < rows;
        const int tq = (wave_on ? uq : 0) * r + rho;
        const float slope = exp2f(-0.5f * (float)(h + 1));
        const float sl2 = slope * (float)r * LOG2E;
        { int tw = c.tid; asm volatile("" : "+v"(tw)); if (tw < 32) alibi_table_write(lds, 0, tw, sl2); }
        const bf16_t* Kb = DIL_KB(U); const bf16_t* Vb = Kb + DIL_SEC;
        const size_t kstride = 128;
        bf16x8 qr[8];
#pragma unroll
        for (int d0 = 0; d0 < 8; ++d0) qr[d0] = scale8(qraw[d0], C2);
        Pass P; pass_init(P);
        const int jhi = U.jhi, jlo = U.jlo;
        struct DilPol { int n, jhi; DmaOff off; const bf16_t* Kb; const bf16_t* Vb; size_t kstride; int rmax; LDSP char* lds; int wid, uq; bool wave_on; float sl2;
            __device__ __forceinline__ int tile(int i) const { return jhi - i; }
            __device__ __forceinline__ void dma(int j, int buf, int which) const { stage_dma_fast(off, Kb, Vb, 256u, 64 * j, lds, buf, wid, which); }
            __device__ __forceinline__ void prep(int j, bool& act, bool& need_mask, int& dq0, unsigned& W, float& base) const {
                dq0 = uq - 64 * j; act = wave_on && __any((dq0 >= 0) && (dq0 - 63 < 129)); need_mask = !__all(dq0 - 63 >= 0 && dq0 < 129); W = 129u; base = -sl2 * (float)dq0; }
        } pol{jhi - jlo + 1, jhi, dma_off(dm, 256u), Kb, Vb, kstride, U.Lst - 1, lds, L.wid, uq, wave_on, sl2};
        ring_pass<DilPol, (DIL_STAGGER != 0)>(P, pol, lds, L, qr, sl2, true);
        const int un = uu + c.G; const bool more = un < NU;
        __syncthreads();
        if (more) { U = dil_decode(un); DIL_ISSUE(U); }
        if (wave_on) {
            scale_rows(P.o, 1.f / P.l, xl, L.r32, L.hi);
            if (L.hi == 0) LSE[((size_t)gi * T_ + (size_t)b * S_ + tq) * 16 + h] = P.m + __log2f(P.l);
            int r32e = L.r32; asm volatile("" : "+v"(r32e));
#pragma unroll
            for (int rr = 0; rr < 16; ++rr) { const int rw = crow(rr, L.hi); const int tt = (blk * 256 + L.wid * 32 + rw) * r + rho;
                bf16_t* op = OG + ((size_t)gi * T_ + (size_t)b * S_ + tt) * D_ + h * 128 + r32e;
#pragma unroll
                for (int d = 0; d < 4; ++d) { const float v = P.o[d][rr]; const float vn = __int_as_float(__builtin_amdgcn_update_dpp(0, __float_as_int(v), 0xB1, 0xF, 0xF, false));
                    if ((L.r32 & 1) == 0) *(unsigned*)(op + d * 32) = cvtpk(v, vn); } }
        }
        if (!more) break;
        uu = un;
    }
    {
        int widp = L.wid; asm volatile("" : "+v"(widp));
        asm volatile("" : "+v"(L.r32), "+v"(L.hi), "+v"(L.lane));
        LDSP float* xl2 = (LDSP float*)(lds + 8 * SHM + widp * 256);
        const int half = L.wid >> 2, wl = L.wid & 3;
        L.at = lds + OFF_AT + half * 128;
        for (int v = c.bid; v < 1024; v += c.G) {
            const int hp = v & 7, rho = (v >> 3) & 15, b = v >> 7, h = hp + 8 * half;
            __syncthreads();
            { int tw = c.tid; asm volatile("" : "+v"(tw)); if (tw < 64) alibi_table_write(lds, tw >> 5, tw & 31, exp2f(-0.5f * (float)(hp + 8 * (tw >> 5) + 1)) * 16.f * LOG2E); }
#pragma unroll
            for (int hh = 0; hh < 2; ++hh) {
                const bf16_t* kb_ = proj + DIL_ADDR(5, b, hp + 8 * hh, rho * 128);
                stage_dma_at(dm, kb_, kb_ + DIL_SEC, 128, 64, 127, lds + 4 * SHM + (2 * hh + 1) * SHM, lds + (2 * hh + 1) * SHM, L.wid);
                stage_dma_at(dm, kb_, kb_ + DIL_SEC, 128, 0, 127, lds + 4 * SHM + (2 * hh) * SHM, lds + (2 * hh) * SHM, L.wid);
            }
            const int uq = wl * 32 + L.r32, tq = uq * 16 + rho;
            bf16x8 qr[8];
            { u32x4 qraw_[8]; const bf16_t* prow_ = proj + DIL_ADDR(0, b, h, tq);
#pragma unroll
              for (int d0 = 0; d0 < 8; ++d0) qraw_[d0] = *(const u32x4*)(prow_ + d0 * 16 + L.hi * 8);
#pragma unroll
              for (int d0 = 0; d0 < 8; ++d0) qr[d0] = scale8(qraw_[d0], C2); }
            const float sl2 = exp2f(-0.5f * (float)(h + 1)) * 16.f * LOG2E;
            Pass P; pass_init(P);
            ATT_DMA_SYNC();
#pragma unroll
            for (int jj = 1; jj >= 0; --jj) {
                const int dq0 = uq - 64 * jj;
                if (__any(dq0 >= 0)) {
                    PFrag F;
                    tile_qk_at(P, F, lds + 4 * SHM + (2 * half + jj) * SHM, xl2, L, qr, sl2, !__all(dq0 - 63 >= 0), dq0, 129u, -sl2 * (float)dq0);
                    tile_pv_at(P, F, lds + (2 * half + jj) * SHM, L);
                }
            }
            scale_rows(P.o, 1.f / P.l, xl2, L.r32, L.hi);
            if (L.hi == 0) LSE[((size_t)2 * T_ + (size_t)b * S_ + tq) * 16 + h] = P.m + __log2f(P.l);
#pragma unroll
            for (int rr = 0; rr < 16; ++rr) { const int rw = crow(rr, L.hi); const int tt = (wl * 32 + rw) * 16 + rho;
                bf16_t* op = OG + ((size_t)2 * T_ + (size_t)b * S_ + tt) * D_ + h * 128 + L.r32;
#pragma unroll
                for (int d = 0; d < 4; ++d) { const float v_ = P.o[d][rr]; const float vn = __int_as_float(__builtin_amdgcn_update_dpp(0, __float_as_int(v_), 0xB1, 0xF, 0xF, false));
                    if ((L.r32 & 1) == 0) *(unsigned*)(op + d * 32) = cvtpk(v_, vn); } }
        }
    }
#undef DIL_ISSUE
#undef DIL_KB
#undef DIL_ADDR
#undef DIL_SEC
}
__device__ __forceinline__ void dil_merge_phase(const Ctx& c) {
    const bf16_t* OG = (const bf16_t*)(c.ws + WS_OG); const float* LSE = (const float*)(c.ws + WS_LSE); bf16_t* O = (bf16_t*)(c.ws + WS_O);
    const int nw = c.G * NWAVE, lane = c.lane, h = lane >> 2;
    for (int row0 = c.bid * NWAVE + c.wave; row0 < T_; row0 += 2 * nw) {
        const int row1 = row0 + nw < T_ ? row0 + nw : row0;
        u32x4 a[2][4], bq[2][4], cq[2][4]; float l0[2], l1[2], l2[2];
#pragma unroll
        for (int rr = 0; rr < 2; ++rr) { const int row = rr ? row1 : row0;
            l0[rr] = LSE[((size_t)0 * T_ + row) * 16 + h]; l1[rr] = LSE[((size_t)1 * T_ + row) * 16 + h]; l2[rr] = LSE[((size_t)2 * T_ + row) * 16 + h];
#pragma unroll
            for (int q = 0; q < 4; ++q) { const size_t off = (size_t)row * D_ + lane * 32 + q * 8;
                a[rr][q] = *(const u32x4*)(OG + off); bq[rr][q] = *(const u32x4*)(OG + (size_t)T_ * D_ + off); cq[rr][q] = *(const u32x4*)(OG + (size_t)2 * T_ * D_ + off); } }
#pragma unroll
        for (int rr = 0; rr < 2; ++rr) { const int row = rr ? row1 : row0;
            const float mx = fmaxf(l0[rr], fmaxf(l1[rr], l2[rr]));
            float w0 = exp2f(l0[rr] - mx), w1 = exp2f(l1[rr] - mx), w2 = exp2f(l2[rr] - mx); const float inv = 1.f / (w0 + w1 + w2); w0 *= inv; w1 *= inv; w2 *= inv;
#pragma unroll
            for (int q = 0; q < 4; ++q) { const size_t off = (size_t)row * D_ + lane * 32 + q * 8;
                u32x4 o;
#define MRG(f) o.f = att::cvtpk(w0 * __uint_as_float(a[rr][q].f << 16) + w1 * __uint_as_float(bq[rr][q].f << 16) + w2 * __uint_as_float(cq[rr][q].f << 16), \
                                w0 * __uint_as_float(a[rr][q].f & 0xffff0000u) + w1 * __uint_as_float(bq[rr][q].f & 0xffff0000u) + w2 * __uint_as_float(cq[rr][q].f & 0xffff0000u))
                MRG(x); MRG(y); MRG(z); MRG(w);
#undef MRG
                *(u32x4*)(O + off) = o; } }
    }
}

constexpr int N_PHASES = 20;

__global__ void __launch_bounds__(NTHR, 2) fwd(Args args) {
    extern __shared__ __attribute__((aligned(16))) unsigned char lds_raw[];
    const Ctx c0{args, args.ws, (LDSP unsigned char*)lds_raw, 0, 0, __builtin_amdgcn_readfirstlane((int)threadIdx.x >> 6), (int)gridDim.x, (int)blockIdx.x};
    const int tid0 = (int)threadIdx.x;
    const int lo = args.ph_lo, hi = args.ph_hi;
    LDSP unsigned* xbw = (LDSP unsigned*)(c0.lds + LDS_BYTES - 16);
    XcdBarrier bar; bar.bar = (unsigned*)(c0.ws + WS_BAR); bar.x = 0; bar.st = nullptr;
    if (hi - lo > 1) {
        if (tid0 == 0) { xbw[0] = 0u; xbw[1] = 0u; xbw[2] = 0u; xbw[3] = 0u; }
        __syncthreads();
        bar = xcd_barrier_post((unsigned*)(c0.ws + WS_BAR), (volatile LAS unsigned*)xbw);
    }
#define IN(k) (lo <= (k) && (k) < hi)
#define SEAM(k) do { if (IN(k) && IN((k) + 1)) xcd_barrier(bar); else __syncthreads(); } while (0)
    const int vcu = (c0.G % 8 == 0) ? (c0.bid % 8) * (c0.G / 8) + c0.bid / 8 : c0.bid;
    float* MOD = (float*)(c0.ws + WS_MOD);
    bf16_t* X = (bf16_t*)(c0.ws + WS_X); bf16_t* Hb = (bf16_t*)(c0.ws + WS_H); bf16_t* Ob = (bf16_t*)(c0.ws + WS_O); bf16_t* PROJ = (bf16_t*)(c0.ws + WS_PROJ);
    bf16_t* HID = (bf16_t*)(c0.ws + WS_HID); bf16_t* YO = (bf16_t*)(c0.ws + WS_YO);
    bf16_t* WE1 = (bf16_t*)(c0.ws + WS_WE1); bf16_t* WE2 = (bf16_t*)(c0.ws + WS_WE2);

    enum { PH_PRO = 0, PH_NORM0, PH_PROJ0, PH_CMP, PH_ATT0, PH_OUT0, PH_RT0, PH_DSP0, PH_E1_0, PH_E2_0, PH_CN1, PH_PROJ1, PH_ATT1, PH_MRG1, PH_OUT1, PH_RT1, PH_DSP1, PH_E1_1, PH_E2_1, PH_FIN, PH_COUNT };
    static_assert(PH_COUNT == N_PHASES, "phase count");
    if (IN(PH_PRO)) for (int rep_ = 0; rep_ < ((DUP_PH == 200 + PH_PRO) ? 2 : 1); ++rep_) { const Ctx c = fresh(c0); if (rep_) __syncthreads();
#if DUP_PH == 100
        for (int rep_ = 0; rep_ < 2; ++rep_) {
#endif
        mod_units(c); __syncthreads();
        tr_matrix(c, c.A.in[7], D_, 5168, PW0, (bf16_t*)(c.ws + WS_WNSAIN));
        tr_matrix(c, c.A.in[11], D_, D_, D_, (bf16_t*)(c.ws + WS_WNSAOUT));
        tr_matrix(c, c.A.in[12], D_, PW1, PW1, (bf16_t*)(c.ws + WS_WDILIN));
        tr_matrix(c, c.A.in[13], D_, D_, D_, (bf16_t*)(c.ws + WS_WDILOUT));
        tr_matrix(c, c.A.in[8], 4096, 128, 128, (bf16_t*)(c.ws + WS_W1T));
        tr_matrix(c, c.A.in[8] + (size_t)4096 * 128, 4096, 128, 128, (bf16_t*)(c.ws + WS_W1T) + (size_t)128 * 4096);
        tr_experts(c, 0, TRX_T0, TRX_ALL, c.bid * NWAVE + c.wave, c.G * NWAVE);
#if DUP_PH == 100
        __syncthreads(); }
#endif
        SEAM(PH_PRO);
    }
    if (IN(PH_NORM0)) for (int rep_ = 0; rep_ < ((DUP_PH == 200 + PH_NORM0) ? 2 : 1); ++rep_) { const Ctx c = fresh(c0); if (rep_) __syncthreads(); norm_phase<0>(c, c.A.in[0], nullptr, c.A.in[4], MOD + 0 * 2048, MOD + 1 * 2048, nullptr, Hb); SEAM(PH_NORM0); }
    if (IN(PH_PROJ0)) for (int rep_ = 0; rep_ < ((DUP_PH == 200 + PH_PROJ0) ? 2 : 1); ++rep_) { const Ctx c = fresh(c0); if (rep_) __syncthreads();
        pg8::Gemm g{Hb, (const bf16_t*)(c.ws + WS_WNSAIN), T_, PW0, D_}; pg8::StaticOrder S; S.init(T_, PW0, c.G, c.bid);
        pg8::EpiBf16<0> E{PROJ, PW0, nullptr, 0, 0};
        pg8::gemm_phase<pg8::EpiBf16<0>, pg8::StaticOrder, false>((PG8_LAS unsigned char*)c.lds, g, S, E, nullptr);
        { const int nwg = (T_ / 256) * (PW0 / 256), rounds = (nwg + c.G - 1) / c.G; int first_idle = nwg - (rounds - 1) * c.G; if (first_idle >= c.G) first_idle = 0;
          if (c.bid >= first_idle) tr_experts(c, 0, 0, TRX_T0, (c.bid - first_idle) * NWAVE + c.wave, (c.G - first_idle) * NWAVE); }
        SEAM(PH_PROJ0);
    }
    if (IN(PH_CMP)) for (int rep_ = 0; rep_ < ((DUP_PH == 200 + PH_CMP) ? 2 : 1); ++rep_) { const Ctx c = fresh(c0); if (rep_) __syncthreads();
#if CMP_REF
        compress_phase(c);
#else
        compress_mfma_phase(c);
#endif
        SEAM(PH_CMP); }
    if (IN(PH_ATT0)) for (int rep_ = 0; rep_ < ((DUP_PH == 200 + PH_ATT0) ? 2 : 1); ++rep_) { const Ctx c = fresh(c0); if (rep_) __syncthreads();
#if NSA_REF
        nsa_attn_ref_phase(c);
#else
        nsa_attn_mfma_phase(c);
#endif
        SEAM(PH_ATT0);
    }
    if (IN(PH_OUT0)) for (int rep_ = 0; rep_ < ((DUP_PH == 200 + PH_OUT0) ? 2 : 1); ++rep_) { const Ctx c = fresh(c0); if (rep_) __syncthreads();
        pg8::Gemm g{Ob, (const bf16_t*)(c.ws + WS_WNSAOUT), T_, D_, D_}; pg8::StaticOrder S; S.init(T_, D_, c.G, c.bid);
        EpiResid<true> E{c.A.in[0], X, MOD + 2 * 2048};
        pg8::gemm_phase<EpiResid<true>, pg8::StaticOrder, false>((PG8_LAS unsigned char*)c.lds, g, S, E, nullptr);
        SEAM(PH_OUT0);
    }
    if (IN(PH_RT0)) for (int rep_ = 0; rep_ < ((DUP_PH == 200 + PH_RT0) ? 2 : 1); ++rep_) { const Ctx c = fresh(c0); if (rep_) __syncthreads(); norm_phase<1>(c, X, nullptr, c.A.in[5], MOD + 3 * 2048, MOD + 4 * 2048, nullptr, Hb); SEAM(PH_RT0); }
    if (IN(PH_DSP0)) for (int rep_ = 0; rep_ < ((DUP_PH == 200 + PH_DSP0) ? 2 : 1); ++rep_) { const Ctx c = fresh(c0); if (rep_) __syncthreads(); dispatch_phase(c); SEAM(PH_DSP0); }
    if (IN(PH_E1_0)) for (int rep_ = 0; rep_ < ((DUP_PH == 200 + PH_E1_0) ? 2 : 1); ++rep_) { const Ctx c = fresh(c0); if (rep_) __syncthreads();
        moe_tab_to_lds(c);
        pg8::Gemm g{Hb, WE1, CAP, 16 * 2816, D_}; MoeOrder S{(LDSP const int*)(c.lds + LDS_MISC), c.G, vcu, 11};
        EpiSwiglu E{HID};
        pg8::gemm_phase_g<EpiSwiglu, MoeOrder, false>((const int*)(c.ws + WS_SLOTTOK), (PG8_LAS unsigned char*)c.lds, g, S, E, nullptr);
        SEAM(PH_E1_0);
    }
    if (IN(PH_E2_0)) for (int rep_ = 0; rep_ < ((DUP_PH == 200 + PH_E2_0) ? 2 : 1); ++rep_) { const Ctx c = fresh(c0); if (rep_) __syncthreads();
        moe_tab_to_lds(c);
        pg8::Gemm g{HID, WE2, CAP, 16 * 2048, DE}; MoeOrder S{(LDSP const int*)(c.lds + LDS_MISC), c.G, vcu, 8};
        EpiDown E{YO, (const float*)(c.ws + WS_SLOTW)};
        pg8::gemm_phase<EpiDown, MoeOrder, false>((PG8_LAS unsigned char*)c.lds, g, S, E, nullptr);
        { const int total = ld_i((const int*)(c.ws + WS_TAB) + 16) * 8, rounds = (total + c.G - 1) / c.G; int first_idle = total - (rounds - 1) * c.G; if (first_idle >= c.G || first_idle < 0) first_idle = 0;
          if (vcu >= first_idle) tr_experts(c, 1, 0, TRX_T1, (vcu - first_idle) * NWAVE + c.wave, (c.G - first_idle) * NWAVE); }
        SEAM(PH_E2_0);
    }
    if (IN(PH_CN1)) for (int rep_ = 0; rep_ < ((DUP_PH == 200 + PH_CN1) ? 2 : 1); ++rep_) { const Ctx c = fresh(c0); if (rep_) __syncthreads();
        norm_phase<2>(c, X, X, c.A.in[4] + 2048, MOD + (size_t)8 * MODW + 0 * 2048, MOD + (size_t)8 * MODW + 1 * 2048, MOD + 5 * 2048, Hb);
        __syncthreads();
        tr_experts(c, 1, TRX_T1, TRX_ALL, c.bid * NWAVE + c.wave, c.G * NWAVE);
        SEAM(PH_CN1);
    }
    if (IN(PH_PROJ1)) for (int rep_ = 0; rep_ < ((DUP_PH == 200 + PH_PROJ1) ? 2 : 1); ++rep_) { const Ctx c = fresh(c0); if (rep_) __syncthreads();
        pg8::Gemm g{Hb, (const bf16_t*)(c.ws + WS_WDILIN), T_, PW1, D_}; pg8::StaticOrder S; S.init(T_, PW1, c.G, c.bid);
        EpiDilProj E{PROJ};
        pg8::gemm_phase<EpiDilProj, pg8::StaticOrder, false>((PG8_LAS unsigned char*)c.lds, g, S, E, nullptr);
        SEAM(PH_PROJ1);
    }
    if (IN(PH_ATT1)) for (int rep_ = 0; rep_ < ((DUP_PH == 200 + PH_ATT1) ? 2 : 1); ++rep_) { const Ctx c = fresh(c0); if (rep_) __syncthreads();
#if DIL_REF
        dil_attn_ref_phase(c);
#else
        dil_attn_mfma_phase(c);
#endif
        SEAM(PH_ATT1);
    }
    if (IN(PH_MRG1)) for (int rep_ = 0; rep_ < ((DUP_PH == 200 + PH_MRG1) ? 2 : 1); ++rep_) { const Ctx c = fresh(c0); if (rep_) __syncthreads();
#if !DIL_REF
        dil_merge_phase(c);
#endif
        SEAM(PH_MRG1);
    }
    if (IN(PH_OUT1)) for (int rep_ = 0; rep_ < ((DUP_PH == 200 + PH_OUT1) ? 2 : 1); ++rep_) { const Ctx c = fresh(c0); if (rep_) __syncthreads();
        pg8::Gemm g{Ob, (const bf16_t*)(c.ws + WS_WDILOUT), T_, D_, D_}; pg8::StaticOrder S; S.init(T_, D_, c.G, c.bid);
        EpiResid<false> E{X, X, MOD + (size_t)8 * MODW + 2 * 2048};
        pg8::gemm_phase<EpiResid<false>, pg8::StaticOrder, false>((PG8_LAS unsigned char*)c.lds, g, S, E, nullptr);
        SEAM(PH_OUT1);
    }
    if (IN(PH_RT1)) for (int rep_ = 0; rep_ < ((DUP_PH == 200 + PH_RT1) ? 2 : 1); ++rep_) { const Ctx c = fresh(c0); if (rep_) __syncthreads(); norm_phase<1>(c, X, nullptr, c.A.in[5] + 2048, MOD + (size_t)8 * MODW + 3 * 2048, MOD + (size_t)8 * MODW + 4 * 2048, nullptr, Hb); SEAM(PH_RT1); }
    if (IN(PH_DSP1)) for (int rep_ = 0; rep_ < ((DUP_PH == 200 + PH_DSP1) ? 2 : 1); ++rep_) { const Ctx c = fresh(c0); if (rep_) __syncthreads(); dispatch_phase(c); SEAM(PH_DSP1); }
    if (IN(PH_E1_1)) for (int rep_ = 0; rep_ < ((DUP_PH == 200 + PH_E1_1) ? 2 : 1); ++rep_) { const Ctx c = fresh(c0); if (rep_) __syncthreads();
        moe_tab_to_lds(c);
        pg8::Gemm g{Hb, WE1, CAP, 16 * 2816, D_}; MoeOrder S{(LDSP const int*)(c.lds + LDS_MISC), c.G, vcu, 11};
        EpiSwiglu E{HID};
        pg8::gemm_phase_g<EpiSwiglu, MoeOrder, false>((const int*)(c.ws + WS_SLOTTOK), (PG8_LAS unsigned char*)c.lds, g, S, E, nullptr);
        SEAM(PH_E1_1);
    }
    if (IN(PH_E2_1)) for (int rep_ = 0; rep_ < ((DUP_PH == 200 + PH_E2_1) ? 2 : 1); ++rep_) { const Ctx c = fresh(c0); if (rep_) __syncthreads();
        moe_tab_to_lds(c);
        pg8::Gemm g{HID, WE2, CAP, 16 * 2048, DE}; MoeOrder S{(LDSP const int*)(c.lds + LDS_MISC), c.G, vcu, 8};
        EpiDown E{YO, (const float*)(c.ws + WS_SLOTW)};
        pg8::gemm_phase<EpiDown, MoeOrder, false>((PG8_LAS unsigned char*)c.lds, g, S, E, nullptr);
        SEAM(PH_E2_1);
    }
#if DUP_PH == 250
    if (hi - lo > 1) { for (int k_ = 0; k_ < 10; ++k_) xcd_barrier(bar); }
#endif
    if (IN(PH_FIN)) for (int rep_ = 0; rep_ < ((DUP_PH == 200 + PH_FIN) ? 2 : 1); ++rep_) { const Ctx c = fresh(c0); if (rep_) __syncthreads(); norm_phase<3>(c, X, nullptr, c.A.in[6], nullptr, nullptr, MOD + (size_t)8 * MODW + 5 * 2048, nullptr); }
#undef IN
#undef SEAM
}

extern "C" void kernel_launch(void* const* d_in, const int* in_sizes, int n_in, void* d_out, int out_size, void* d_ws, size_t ws_size, hipStream_t stream) {
    static int grid = 0;
    if (grid == 0) {
        if (n_in != 19 || out_size != T_ * D_ || ws_size < WS_END) { fprintf(stderr, "kernel_launch: unexpected shapes (n_in %d out %d ws %zu need %zu)\n", n_in, out_size, ws_size, (size_t)WS_END); grid = -1; return; }
        int dev = 0, cus = 0;
        if (hipGetDevice(&dev) != hipSuccess || hipDeviceGetAttribute(&cus, hipDeviceAttributeMultiprocessorCount, dev) != hipSuccess) { grid = -1; return; }
        if (hipFuncSetAttribute((const void*)fwd, hipFuncAttributeMaxDynamicSharedMemorySize, LDS_BYTES) != hipSuccess) { fprintf(stderr, "kernel_launch: hipFuncSetAttribute failed\n"); grid = -1; return; }
        int per_cu = 0;
        if (hipOccupancyMaxActiveBlocksPerMultiprocessor(&per_cu, (const void*)fwd, NTHR, LDS_BYTES) != hipSuccess || per_cu < 1) fprintf(stderr, "kernel_launch: occupancy query says %d\n", per_cu);
        (void)hipGetLastError();
        grid = cus > 256 ? 256 : cus;
    }
    if (grid < 0) return;
    (void)hipMemsetAsync((char*)d_ws + WS_BAR, 0, WS_CTL_END, stream);
    Args a{};
    for (int i = 0; i < 19; ++i) a.in[i] = (const float*)d_in[i];
    a.out = (float*)d_out; a.ws = (unsigned char*)d_ws;
#if MK_ONE_LAUNCH
    a.ph_lo = 0; a.ph_hi = N_PHASES;
    hipLaunchKernelGGL(fwd, dim3(grid), dim3(NTHR), LDS_BYTES, stream, a);
#else
    for (int p = 0; p < N_PHASES; ++p) { a.ph_lo = p; a.ph_hi = p + 1; hipLaunchKernelGGL(fwd, dim3(grid), dim3(NTHR), LDS_BYTES, stream, a); }
#endif
}
```
